# Optimizing an MI355X kernel written in HIP

```python
import math
import jax, jax.numpy as jnp
from jax import lax
import numpy as np


D_MODEL = 2048
BATCH = 4
SEQ = 2048
DEPTH = 2
DEC_BATCH = 32
DEC_SEQ = 8
PAST_LEN = 16384
PAGE_SIZE = 128

N_A_LAYERS = DEPTH // 2
N_B_LAYERS = DEPTH - N_A_LAYERS
GLA_HEADS = 4
GLA_KEY_DIM = D_MODEL // 2
GLA_VALUE_DIM = D_MODEL
GLA_DK = GLA_KEY_DIM // GLA_HEADS
GLA_DV = GLA_VALUE_DIM // GLA_HEADS
GLA_GATE_RANK = 16
GLA_GATE_TEMP = 16.0
GLA_CHUNK = 64
SWA_HEAD_DIM = 64
SWA_HEADS = D_MODEL // SWA_HEAD_DIM
SWA_KV_HEADS = 4
SWA_WIDTH = SWA_HEADS * SWA_HEAD_DIM
WINDOW = 128
ATTN_BLOCK = WINDOW
RMS_EPS = 1e-6

kernel_name = 'gla_swa_sink_yoco_hybrid_step'


def rmsnorm(x, g):
    x32 = x.astype(jnp.float32)
    y = x32 * lax.rsqrt(jnp.mean(x32 * x32, axis=-1, keepdims=True) + RMS_EPS)
    return (y * g.astype(jnp.float32)).astype(x.dtype)


def alibi_slopes(n_heads):
    return jnp.exp2(-8.0 * jnp.arange(1, n_heads + 1, dtype=jnp.float32) / n_heads)


def gla_chunked(q, k, v, logg, s0):
    B, L, H, DK = q.shape
    DV = v.shape[-1]
    C = math.gcd(L, GLA_CHUNK)
    n = L // C

    def blocks(t):
        return t.astype(jnp.float32).reshape(B, n, C, H, t.shape[-1]).transpose(1, 0, 3, 2, 4)

    causal = jnp.tril(jnp.ones((C, C), dtype=bool))[:, :, None]

    def step(S, inp):
        qc, kc, vc, gc = inp
        b = jnp.cumsum(gc, axis=2)
        o_inter = jnp.einsum('bhtd,bhde->bhte', qc * jnp.exp(b), S)
        diff = b[:, :, :, None, :] - b[:, :, None, :, :]
        decay = jnp.exp(jnp.where(causal, diff, -jnp.inf))
        scores = jnp.einsum('bhtd,bhsd,bhtsd->bhts', qc, kc, decay)
        o_intra = jnp.einsum('bhts,bhse->bhte', scores, vc)
        b_last = b[:, :, -1:, :]
        S_new = (jnp.exp(b_last[:, :, 0, :])[..., None] * S
                 + jnp.einsum('bhsd,bhse->bhde', kc * jnp.exp(b_last - b), vc))
        return S_new, o_inter + o_intra

    S_fin, o = lax.scan(step, s0.astype(jnp.float32),
                        (blocks(q), blocks(k), blocks(v), blocks(logg)))
    o = o.transpose(1, 0, 3, 2, 4).reshape(B, L, H, DV)
    return o, S_fin


def gla_layer(h, s0, g_norm, w_in, w_gate_up, b_gate, g_onorm, w_out):
    B, L, _ = h.shape
    xn = rmsnorm(h, g_norm)
    proj = xn @ w_in
    q, k, v, r, glow = jnp.split(
        proj, [GLA_KEY_DIM, 2 * GLA_KEY_DIM, 2 * GLA_KEY_DIM + GLA_VALUE_DIM,
               2 * GLA_KEY_DIM + 2 * GLA_VALUE_DIM], axis=-1)
    logg = jax.nn.log_sigmoid((glow @ w_gate_up + b_gate).astype(jnp.float32)) / GLA_GATE_TEMP
    q = q.reshape(B, L, GLA_HEADS, GLA_DK).astype(jnp.float32) * (GLA_DK ** -0.5)
    k = k.reshape(B, L, GLA_HEADS, GLA_DK)
    v = v.reshape(B, L, GLA_HEADS, GLA_DV)
    logg = logg.reshape(B, L, GLA_HEADS, GLA_DK)
    o, S = gla_chunked(q, k, v, logg, s0)
    o = rmsnorm(o, g_onorm.reshape(GLA_HEADS, GLA_DV))
    o = o.reshape(B, L, GLA_VALUE_DIM).astype(h.dtype) * jax.nn.silu(r)
    return h + o @ w_out, S.astype(s0.dtype)


def sink_attention(q, k, v, qpos, kpos, sinks):
    B, N, Tq, H, HD = q.shape
    KVH = k.shape[3]
    G = H // KVH
    qg = q.reshape(B, N, Tq, KVH, G, HD).astype(jnp.float32)
    s = jnp.einsum('bnqkgd,bnskd->bkgnqs', qg, k.astype(jnp.float32)) * (HD ** -0.5)
    dist = qpos[:, :, None] - kpos[:, None, :]
    allowed = (dist >= 0) & (dist <= WINDOW) & (kpos >= 0)[:, None, :]
    slopes = alibi_slopes(H).reshape(KVH, G)[:, :, None, None, None]
    s = s - slopes * dist.astype(jnp.float32)
    s = jnp.where(allowed, s, -jnp.inf)
    sink = sinks.astype(jnp.float32).reshape(KVH, G)[:, :, None, None, None]
    m = jnp.maximum(jnp.max(s, axis=-1, keepdims=True), sink)
    p = jnp.exp(s - m)
    denom = jnp.sum(p, axis=-1, keepdims=True) + jnp.exp(sink - m)
    o = jnp.einsum('bkgnqs,bnskd->bnqkgd', p / denom, v.astype(jnp.float32))
    return o.reshape(B, N * Tq, H * HD)


def swa_layer(h, k, v, k_buf, v_buf, g_norm, w_in, sinks, w_out):
    B, L, _ = h.shape
    xn = rmsnorm(h, g_norm)
    q, z = jnp.split(xn @ w_in, 2, axis=-1)
    q = q.reshape(B, L, SWA_HEADS, SWA_HEAD_DIM)
    if k_buf is None:
        nb = L // ATTN_BLOCK
        qb = q.reshape(B, nb, ATTN_BLOCK, SWA_HEADS, SWA_HEAD_DIM)

        def band(t):
            prev = jnp.pad(t, ((0, 0), (ATTN_BLOCK, 0), (0, 0), (0, 0)))[:, :L]
            shp = (B, nb, ATTN_BLOCK, SWA_KV_HEADS, SWA_HEAD_DIM)
            return jnp.concatenate([prev.reshape(shp), t.reshape(shp)], axis=2)

        kb, vb = band(k), band(v)
        qpos = jnp.arange(L).reshape(nb, ATTN_BLOCK)
        kpos = (jnp.arange(nb)[:, None] - 1) * ATTN_BLOCK + jnp.arange(2 * ATTN_BLOCK)[None, :]
    else:
        Wb = k_buf.shape[1]
        qb = q[:, None]
        kb = jnp.concatenate([k_buf.astype(k.dtype), k], axis=1)[:, None]
        vb = jnp.concatenate([v_buf.astype(v.dtype), v], axis=1)[:, None]
        qpos = (Wb + jnp.arange(L))[None]
        kpos = jnp.arange(Wb + L)[None]
    o = sink_attention(qb, kb, vb, qpos, kpos, sinks)
    o = o.astype(h.dtype) * jax.nn.silu(z)
    return h + o @ w_out


def trunk(x, gla_init, k_buf, v_buf, g_norm_a, w_in_a, w_gate_up, b_gate, g_onorm_a, w_out_a,
          g_norm_kv, w_kv, g_norm_b, w_in_b, sinks, w_out_b, g_final):
    B, L, _ = x.shape
    h = x
    new_states = []
    k = v = None
    for layer in range(DEPTH):
        if layer < N_A_LAYERS:
            h, S = gla_layer(h, gla_init[layer], g_norm_a[layer], w_in_a[layer], w_gate_up[layer],
                             b_gate[layer], g_onorm_a[layer], w_out_a[layer])
            new_states.append(S)
        else:
            if layer == N_A_LAYERS:
                kv = rmsnorm(h, g_norm_kv) @ w_kv
                k, v = jnp.split(kv, 2, axis=-1)
                k = k.reshape(B, L, SWA_KV_HEADS, SWA_HEAD_DIM)
                v = v.reshape(B, L, SWA_KV_HEADS, SWA_HEAD_DIM)
            j = layer - N_A_LAYERS
            h = swa_layer(h, k, v, k_buf, v_buf, g_norm_b[j], w_in_b[j], sinks[j], w_out_b[j])
    y = rmsnorm(h, g_final)
    return y, jnp.stack(new_states, axis=0), k, v


def setup_inputs(seed: int = 0) -> dict:
    key = jax.random.key(seed)
    ks = jax.random.split(key, 20)
    f32 = jnp.float32
    D = D_MODEL
    n_in_a = 2 * GLA_KEY_DIM + 2 * GLA_VALUE_DIM + GLA_GATE_RANK
    win_rows = min(WINDOW, PAST_LEN)
    nrm = lambda k_, shp, sc: jax.random.normal(k_, shp, f32) * sc
    return {
        'x_prompt': nrm(ks[0], (BATCH, SEQ, D), 1.0),
        'x_sample': nrm(ks[1], (DEC_BATCH, DEC_SEQ, D), 1.0),
        'state_gla': nrm(ks[2], (N_A_LAYERS, DEC_BATCH, GLA_HEADS, GLA_DK, GLA_DV), 0.3),
        'cache_k_win': nrm(ks[3], (DEC_BATCH, win_rows, SWA_KV_HEADS, SWA_HEAD_DIM), 1.0),
        'cache_v_win': nrm(ks[4], (DEC_BATCH, win_rows, SWA_KV_HEADS, SWA_HEAD_DIM), 1.0),
        'g_norm_a': 1.0 + nrm(ks[5], (N_A_LAYERS, D), 0.02),
        'w_in_a': nrm(ks[6], (N_A_LAYERS, D, n_in_a), D ** -0.5),
        'w_gate_up': nrm(ks[7], (N_A_LAYERS, GLA_GATE_RANK, GLA_KEY_DIM), GLA_GATE_RANK ** -0.5),
        'b_gate': nrm(ks[8], (N_A_LAYERS, GLA_KEY_DIM), 0.1),
        'g_onorm_a': 1.0 + nrm(ks[9], (N_A_LAYERS, GLA_VALUE_DIM), 0.02),
        'w_out_a': nrm(ks[10], (N_A_LAYERS, GLA_VALUE_DIM, D), GLA_VALUE_DIM ** -0.5),
        'g_norm_kv': 1.0 + nrm(ks[11], (D,), 0.02),
        'w_kv': nrm(ks[12], (D, 2 * SWA_KV_HEADS * SWA_HEAD_DIM), D ** -0.5),
        'g_norm_b': 1.0 + nrm(ks[13], (N_B_LAYERS, D), 0.02),
        'w_in_b': nrm(ks[14], (N_B_LAYERS, D, 2 * SWA_WIDTH), D ** -0.5),
        'sinks': nrm(ks[15], (N_B_LAYERS, SWA_HEADS), 1.0),
        'w_out_b': nrm(ks[16], (N_B_LAYERS, SWA_WIDTH, D), SWA_WIDTH ** -0.5),
        'g_final': 1.0 + nrm(ks[17], (D,), 0.02),
    }


def reference(x_prompt, x_sample, state_gla, cache_k_win, cache_v_win, g_norm_a, w_in_a,
              w_gate_up, b_gate, g_onorm_a, w_out_a, g_norm_kv, w_kv, g_norm_b, w_in_b, sinks,
              w_out_b, g_final):
    gla0 = jnp.zeros((N_A_LAYERS, x_prompt.shape[0], GLA_HEADS, GLA_DK, GLA_DV), x_prompt.dtype)
    y_prompt, gla_prompt, k_p, v_p = trunk(
        x_prompt, gla0, None, None, g_norm_a, w_in_a, w_gate_up, b_gate, g_onorm_a, w_out_a,
        g_norm_kv, w_kv, g_norm_b, w_in_b, sinks, w_out_b, g_final)
    y_sample, gla_sample, k_s, v_s = trunk(
        x_sample, state_gla, cache_k_win, cache_v_win, g_norm_a, w_in_a, w_gate_up, b_gate,
        g_onorm_a, w_out_a, g_norm_kv, w_kv, g_norm_b, w_in_b, sinks, w_out_b, g_final)
    win_p = min(WINDOW, k_p.shape[1])
    k_win_prompt = k_p[:, -win_p:]
    v_win_prompt = v_p[:, -win_p:]
    wb = cache_k_win.shape[1]
    k_win_sample = jnp.concatenate([cache_k_win, k_s.astype(cache_k_win.dtype)], axis=1)[:, -wb:]
    v_win_sample = jnp.concatenate([cache_v_win, v_s.astype(cache_v_win.dtype)], axis=1)[:, -wb:]
    return (y_prompt, y_sample, gla_prompt, gla_sample, k_win_prompt, v_win_prompt,
            k_win_sample, v_win_sample)
```

```cpp
#include <hip/hip_runtime.h>
#include <cstdio>
#include <cstdint>
#include <cmath>
namespace pg8 {
#define PG8_LAS __attribute__((address_space(3)))
typedef unsigned short bf16_t;
typedef short bf16x8 __attribute__((ext_vector_type(8)));
typedef float f32x4 __attribute__((ext_vector_type(4)));
typedef unsigned u32x4 __attribute__((ext_vector_type(4)));
constexpr int BM = 256, BK = 64, HALF = 128, HTB = HALF * BK * 2  , STAGE_BYTES = 8 * HTB, NXCD = 8, WGM = 8;

__host__ __device__ __forceinline__ int lds_byte(int r, int c) { const int st = (r >> 4) * 2 + (c >> 5), rr = r & 15, cc = c & 31, ob = rr * 64 + cc * 2; return st * 1024 + (ob ^ (((ob >> 9) & 1) << 5)); }
__host__ __device__ __forceinline__ void stage_rc(int b, int& R, int& C) { const int st = b / 1024, sb = b % 1024, swz = sb ^ (((sb >> 9) & 1) << 5); R = (st >> 1) * 16 + swz / 64; C = (st & 1) * 32 + (swz % 64) / 2; }
__host__ __device__ __forceinline__ int perm32(int rho) { const int n = rho >> 4, i = rho & 15; return 8 * (i >> 2) + 4 * n + (i & 3); }

struct Unit { const char* a; const char* b; int pm, pn, kind; };
__device__ __forceinline__ void tile_map(int L, int nM, int nN, int& pm, int& pn) {
    const int nwg = nM * nN; int wgid = L; { const int q = nwg / NXCD, r = nwg % NXCD, xcd = wgid % NXCD, off = wgid / NXCD; wgid = (xcd < r ? xcd * (q + 1) : r * (q + 1) + (xcd - r) * q) + off; }
    const int nig = WGM * nN, gid = wgid / nig, fm = gid * WGM, gsz = (nM - fm) < WGM ? (nM - fm) : WGM;
    pm = fm + ((wgid % nig) % gsz); pn = (wgid % nig) / gsz;
}
typedef float f32x2_t __attribute__((ext_vector_type(2))); typedef __bf16 bf16x2_t __attribute__((ext_vector_type(2)));
__device__ __forceinline__ unsigned cvtpk(float lo, float hi) { f32x2_t v = {lo, hi}; bf16x2_t b = __builtin_convertvector(v, bf16x2_t); return __builtin_bit_cast(unsigned, b); }
__device__ __forceinline__ float silu_f(float v) { return v / (1.0f + __expf(-v)); }

template <bool SILU>
__device__ __forceinline__ void store_tile_bf16(const f32x4 (&acc)[2][2][4][2], bf16_t* base, int ldc, int row_t, int col_t, int wr, int wc, int fr, int fq) {
    const int row0 = row_t + wr * 64 + fr, col0 = col_t + wc * 32 + 8 * fq;
#pragma unroll
    for (int ai = 0; ai < 2; ++ai)
#pragma unroll
        for (int m = 0; m < 4; ++m) { bf16_t* rowp = base + (size_t)(row0 + ai * HALF + m * 16) * ldc + col0;
#pragma unroll
            for (int bj = 0; bj < 2; ++bj) { f32x4 v0 = acc[ai][bj][m][0], v1 = acc[ai][bj][m][1];
                if (SILU) { v0[0] = silu_f(v0[0]); v0[1] = silu_f(v0[1]); v0[2] = silu_f(v0[2]); v0[3] = silu_f(v0[3]); v1[0] = silu_f(v1[0]); v1[1] = silu_f(v1[1]); v1[2] = silu_f(v1[2]); v1[3] = silu_f(v1[3]); }
                u32x4 w; w.x = cvtpk(v0[0], v0[1]); w.y = cvtpk(v0[2], v0[3]); w.z = cvtpk(v1[0], v1[1]); w.w = cvtpk(v1[2], v1[3]);
                *(u32x4*)(rowp + bj * HALF) = w; } }
}

struct EpiInA {
    static constexpr bool PERM = true, AFTER_DRAIN = false;
    bf16_t* QK; bf16_t* SR; bf16_t* VT; int MT;
    __device__ __forceinline__ void operator()(const f32x4 (&acc)[2][2][4][2], const Unit& u, int wr, int wc, int fr, int fq) const {
        if (u.kind == 0) store_tile_bf16<false>(acc, QK, 2048, u.pm * BM, u.pn * BM, wr, wc, fr, fq);
        else if (u.kind == 1) store_tile_bf16<true>(acc, SR, 2048, u.pm * BM, (u.pn - 8) * BM, wr, wc, fr, fq);
        else store_tile_bf16<false>(acc, VT, MT, u.pm * BM, u.pn * BM, wr, wc, fr, fq);
    }
};

struct EpiInB {
    static constexpr bool PERM = true, AFTER_DRAIN = false;
    bf16_t* QZ; bf16_t* KB; bf16_t* VT2; int MT; float* kwp; float* vwp; float* kws; float* vws;
    __device__ __forceinline__ static float* win_row(int t, float* wp, float* wsmp) {
        if (t < 8192) { const int pos = t & 2047; if (pos < 1920) return nullptr; return wp + ((size_t)(t >> 11) * 128 + (pos - 1920)) * 256; }
        const int s = t - 8192; return wsmp + ((size_t)(s >> 3) * 128 + 120 + (s & 7)) * 256;
    }
    __device__ __forceinline__ void operator()(const f32x4 (&acc)[2][2][4][2], const Unit& u, int wr, int wc, int fr, int fq) const {
        if (u.kind == 0) { store_tile_bf16<false>(acc, QZ, 4096, u.pm * BM, u.pn * BM, wr, wc, fr, fq); return; }
        if (u.kind == 1) { store_tile_bf16<true>(acc, QZ, 4096, u.pm * BM, u.pn * BM, wr, wc, fr, fq); return; }
        if (u.kind == 2) {
            store_tile_bf16<false>(acc, KB, 256, u.pm * BM, 0, wr, wc, fr, fq);
            if ((u.pm & 7) == 7 || u.pm == 32) {
                const int row0 = u.pm * BM + wr * 64 + fr, col0 = wc * 32 + 8 * fq;
#pragma unroll
                for (int ai = 0; ai < 2; ++ai)
#pragma unroll
                    for (int m = 0; m < 4; ++m) { float* d = win_row(row0 + ai * HALF + m * 16, kwp, kws);
                        if (d) {
#pragma unroll
                            for (int bj = 0; bj < 2; ++bj) { *(f32x4*)(d + col0 + bj * HALF) = acc[ai][bj][m][0]; *(f32x4*)(d + col0 + bj * HALF + 4) = acc[ai][bj][m][1]; } } }
            }
            return;
        }
        store_tile_bf16<false>(acc, VT2, MT, 0, u.pn * BM, wr, wc, fr, fq);
        if ((u.pn & 7) == 7 || u.pn == 32) {
            const int row0 = wr * 64 + fr, col0 = u.pn * BM + wc * 32 + 8 * fq;
#pragma unroll
            for (int bj = 0; bj < 2; ++bj)
#pragma unroll
                for (int n = 0; n < 2; ++n)
#pragma unroll
                    for (int j = 0; j < 4; ++j) { float* d = win_row(col0 + bj * HALF + 4 * n + j, vwp, vws);
                        if (d) {
#pragma unroll
                            for (int ai = 0; ai < 2; ++ai)
#pragma unroll
                                for (int m = 0; m < 4; ++m) d[row0 + ai * HALF + m * 16] = acc[ai][bj][m][n][j]; } }
        }
    }
};

struct EpiRes {
    static constexpr bool PERM = false, AFTER_DRAIN = false;
    const float* res; const float* res2; float* out;
    __device__ __forceinline__ void operator()(const f32x4 (&acc)[2][2][4][2], const Unit& u, int wr, int wc, int fr, int fq) const {
        const int row0 = u.pm * BM + wr * 64 + fr, col0 = u.pn * BM + wc * 32 + 4 * fq;
        const float* rb = (res2 != nullptr && u.pm == 32) ? res2 - (size_t)8192 * 2048 : res;
#pragma unroll
        for (int ai = 0; ai < 2; ++ai)
#pragma unroll
            for (int m = 0; m < 4; ++m) { const size_t off = (size_t)(row0 + ai * HALF + m * 16) * 2048 + col0;
#pragma unroll
                for (int bj = 0; bj < 2; ++bj)
#pragma unroll
                    for (int n = 0; n < 2; ++n) { const f32x4 r = *(const f32x4*)(rb + off + bj * HALF + n * 16); *(f32x4*)(out + off + bj * HALF + n * 16) = r + acc[ai][bj][m][n]; } }
    }
};

struct SchedInA {
    int G, c; const char* XN; const char* W;
    __device__ __forceinline__ bool next(int i, Unit& u) const {
        const int L = i * G + c; const size_t P = (size_t)BM * 2048 * 2;
        if (L < 528) { tile_map(L, 33, 16, u.pm, u.pn); u.kind = u.pn < 8 ? 0 : 1; u.a = XN + u.pm * P; u.b = W + (u.pn < 8 ? u.pn : u.pn + 8) * P; return true; }
        if (L < 792) { tile_map(L - 528, 8, 33, u.pm, u.pn); u.kind = 2; u.a = W + (8 + u.pm) * P; u.b = XN + u.pn * P; return true; }
        return false;
    }
    __device__ __forceinline__ void a_ready(const Unit&) const {}
    __device__ __forceinline__ void done(const Unit&) const {}
};
struct SchedInB {
    int G, c; const char* XN; const char* W;
    __device__ __forceinline__ bool next(int i, Unit& u) const {
        const int L = i * G + c; const size_t P = (size_t)BM * 2048 * 2;
        if (L < 561) { tile_map(L, 33, 17, u.pm, u.pn); u.kind = u.pn < 8 ? 0 : (u.pn < 16 ? 1 : 2); u.a = XN + u.pm * P; u.b = W + u.pn * P; return true; }
        if (L < 594) { u.pm = 0; u.pn = L - 561; u.kind = 3; u.a = W + 17 * P; u.b = XN + u.pn * P; return true; }
        return false;
    }
    __device__ __forceinline__ void a_ready(const Unit&) const {}
    __device__ __forceinline__ void done(const Unit&) const {}
};
struct SchedOut {
    int G, c; const char* A; const char* W;
    __device__ __forceinline__ bool next(int i, Unit& u) const {
        const int L = i * G + c; const size_t P = (size_t)BM * 2048 * 2;
        if (L >= 264) return false;
        tile_map(L, 33, 8, u.pm, u.pn); u.kind = 0; u.a = A + u.pm * P; u.b = W + u.pn * P; return true;
    }
    __device__ __forceinline__ void a_ready(const Unit&) const {}
    __device__ __forceinline__ void done(const Unit&) const {}
};
template <class Epi, class Sched, bool ALIGN_EPI = false, bool SP2 = false>
__device__ __forceinline__ void gemm_phase(PG8_LAS unsigned char* lds, const int K_, const Sched& S, const Epi& E) {
    const int tid = threadIdx.x, wid = __builtin_amdgcn_readfirstlane(tid >> 6), lane = tid & 63, wr = wid >> 2, wc = wid & 3, fr = lane & 15, fq = lane >> 4;
    const int K = K_, nt = K / BK;
    unsigned voffA[2], voffB[2];
#pragma unroll
    for (int i = 0; i < 2; ++i) { int R, C; stage_rc(tid * 16 + i * 8192, R, C); const int Rb = Epi::PERM ? ((R & ~31) + perm32(R & 31)) : R;
        voffA[i] = (unsigned)(R * K + C) * 2u; voffB[i] = (unsigned)(Rb * K + C) * 2u; }
    const size_t kstep = (size_t)(BK * 2);
    const size_t hstep = (size_t)HALF * K * 2;
    const unsigned ldsw = (unsigned)wid * 1024u;
    const int aoff = lds_byte(wr * 64 + fr, fq * 8), boff = lds_byte(wc * 32 + fr, fq * 8);
#define PG8_SA(b, h) (((b) * 2 + (h)) * HTB)
#define PG8_SB(b, h) ((4 + (b) * 2 + (h)) * HTB)
#define PG8_STAGE(bufoff, gbase, voff) do { _Pragma("unroll") for (int _i = 0; _i < 2; ++_i) \
        __builtin_amdgcn_global_load_lds((const unsigned*)((const char*)(gbase) + (voff)[_i]), (PG8_LAS unsigned*)(lds + (bufoff) + ldsw + _i * 8192), 16, 0, 0); } while (0)
#define PG8_LDA(dst, b, h) do { _Pragma("unroll") for (int m = 0; m < 4; ++m) _Pragma("unroll") for (int k = 0; k < 2; ++k) dst[m][k] = *(const PG8_LAS bf16x8*)(lds + PG8_SA(b, h) + aoff + m * 2048 + k * 1024); } while (0)
#define PG8_LDB(dst, b, h) do { _Pragma("unroll") for (int n = 0; n < 2; ++n) _Pragma("unroll") for (int k = 0; k < 2; ++k) dst[n][k] = *(const PG8_LAS bf16x8*)(lds + PG8_SB(b, h) + boff + n * 2048 + k * 1024); } while (0)
#define PG8_MMA(ai, bj, At, Bt) do { __builtin_amdgcn_s_setprio(1); _Pragma("unroll") for (int m = 0; m < 4; ++m) _Pragma("unroll") for (int n = 0; n < 2; ++n) _Pragma("unroll") for (int k = 0; k < 2; ++k) \
        acc[ai][bj][m][n] = __builtin_amdgcn_mfma_f32_16x16x32_bf16(Bt[n][k], At[m][k], acc[ai][bj][m][n], 0, 0, 0); __builtin_amdgcn_s_setprio(0); } while (0)
#define PG8_WAIT_V(n) asm volatile("s_waitcnt vmcnt(" #n ")" ::: "memory")
#define PG8_WAIT_L(n) asm volatile("s_waitcnt lgkmcnt(" #n ")" ::: "memory")
#define PG8_BAR __builtin_amdgcn_s_barrier()
#define PG8_SCHED __builtin_amdgcn_sched_barrier(0)
    Unit cur, nxt; int ui = 0;
    if (!S.next(0, cur)) return;
    f32x4 acc[2][2][4][2];
#pragma unroll
    for (int a = 0; a < 2; ++a)
#pragma unroll
        for (int b = 0; b < 2; ++b)
#pragma unroll
            for (int m = 0; m < 4; ++m)
#pragma unroll
                for (int n = 0; n < 2; ++n) acc[a][b][m][n] = (f32x4){0.f, 0.f, 0.f, 0.f};
    bf16x8 At[4][2], B0[2][2], B1[2][2];
    const char* cA = cur.a; const char* cB = cur.b;
    S.a_ready(cur);
    if constexpr (SP2) {
        PG8_STAGE(PG8_SB(0, 0), cB, voffB); PG8_STAGE(PG8_SB(0, 1), cB + hstep, voffB); PG8_STAGE(PG8_SA(0, 0), cA, voffA); PG8_STAGE(PG8_SA(0, 1), cA + hstep, voffA);
        if (wr == 1) PG8_BAR;
        PG8_WAIT_V(2); PG8_BAR;
        PG8_STAGE(PG8_SB(1, 0), cB + kstep, voffB); PG8_STAGE(PG8_SA(1, 0), cA + kstep, voffA); PG8_STAGE(PG8_SB(1, 1), cB + hstep + kstep, voffB);
        PG8_WAIT_V(6); PG8_BAR;
    } else {
        PG8_STAGE(PG8_SB(0, 0), cB, voffB); PG8_STAGE(PG8_SA(0, 0), cA, voffA); PG8_STAGE(PG8_SB(0, 1), cB + hstep, voffB); PG8_STAGE(PG8_SA(0, 1), cA + hstep, voffA);
        if (wr == 1) PG8_BAR;
        PG8_WAIT_V(4); PG8_BAR;
        PG8_STAGE(PG8_SB(1, 0), cB + kstep, voffB); PG8_STAGE(PG8_SA(1, 0), cA + kstep, voffA); PG8_STAGE(PG8_SB(1, 1), cB + hstep + kstep, voffB);
        PG8_WAIT_V(6); PG8_BAR;
    }
    for (;;) {
        const bool has_next = S.next(ui + 1, nxt);
        const char* nA = has_next ? nxt.a : cA; const char* nB = has_next ? nxt.b : cB;
        for (int t = 0; t < nt; t += 2) {
            const bool last = (t == nt - 2);
            const char* a1 = cA + (size_t)(t + 1) * kstep;
            const char* a2 = last ? nA : cA + (size_t)(t + 2) * kstep; const char* b2 = last ? nB : cB + (size_t)(t + 2) * kstep;
            const char* a3 = a2 + kstep; const char* b3 = b2 + kstep;
            if (last && has_next) S.a_ready(nxt);
            if constexpr (SP2) {
            PG8_LDB(B0, 0, 0); PG8_LDB(B1, 0, 1); PG8_SCHED; PG8_LDA(At, 0, 0); PG8_STAGE(PG8_SA(1, 1), a1 + hstep, voffA);
            PG8_WAIT_V(8); PG8_WAIT_L(0); PG8_BAR; PG8_MMA(0, 0, At, B0); PG8_MMA(0, 1, At, B1); PG8_BAR; PG8_SCHED;
            PG8_LDA(At, 0, 1); PG8_STAGE(PG8_SB(0, 0), b2, voffB); PG8_STAGE(PG8_SB(0, 1), b2 + hstep, voffB); PG8_STAGE(PG8_SA(0, 0), a2, voffA);
            PG8_WAIT_V(8); PG8_WAIT_L(0); PG8_BAR; PG8_MMA(1, 0, At, B0); PG8_MMA(1, 1, At, B1); PG8_BAR; PG8_SCHED;
            PG8_LDB(B0, 1, 0); PG8_LDB(B1, 1, 1); PG8_SCHED; PG8_LDA(At, 1, 0); PG8_STAGE(PG8_SA(0, 1), a2 + hstep, voffA);
            PG8_WAIT_V(8); PG8_WAIT_L(0); PG8_BAR; PG8_MMA(0, 0, At, B0); PG8_MMA(0, 1, At, B1); PG8_BAR; PG8_SCHED;
            PG8_LDA(At, 1, 1); PG8_STAGE(PG8_SB(1, 0), b3, voffB); PG8_STAGE(PG8_SB(1, 1), b3 + hstep, voffB); PG8_STAGE(PG8_SA(1, 0), a3, voffA);
            PG8_WAIT_V(8); PG8_WAIT_L(0); PG8_BAR; PG8_MMA(1, 0, At, B0); PG8_MMA(1, 1, At, B1); PG8_BAR; PG8_SCHED;
            } else {
            PG8_LDB(B0, 0, 0); PG8_SCHED; PG8_LDA(At, 0, 0); PG8_STAGE(PG8_SA(1, 1), a1 + hstep, voffA);
            PG8_WAIT_L(8); PG8_BAR; PG8_WAIT_L(0); PG8_MMA(0, 0, At, B0); PG8_BAR; PG8_SCHED;
            PG8_LDB(B1, 0, 1); PG8_STAGE(PG8_SB(0, 0), b2, voffB);
            PG8_BAR; PG8_WAIT_L(0); PG8_MMA(0, 1, At, B1); PG8_BAR;
            PG8_LDA(At, 0, 1); PG8_STAGE(PG8_SA(0, 0), a2, voffA);
            PG8_BAR; PG8_WAIT_L(0); PG8_MMA(1, 0, At, B0); PG8_BAR; PG8_SCHED;
            PG8_STAGE(PG8_SB(0, 1), b2 + hstep, voffB);
            PG8_WAIT_V(6); PG8_BAR; PG8_MMA(1, 1, At, B1); PG8_BAR;
            PG8_LDB(B0, 1, 0); PG8_SCHED; PG8_LDA(At, 1, 0); PG8_STAGE(PG8_SA(0, 1), a2 + hstep, voffA);
            PG8_WAIT_L(8); PG8_BAR; PG8_WAIT_L(0); PG8_MMA(0, 0, At, B0); PG8_BAR; PG8_SCHED;
            PG8_LDB(B1, 1, 1); PG8_STAGE(PG8_SB(1, 0), b3, voffB);
            PG8_BAR; PG8_WAIT_L(0); PG8_MMA(0, 1, At, B1); PG8_BAR;
            PG8_LDA(At, 1, 1); PG8_STAGE(PG8_SA(1, 0), a3, voffA);
            PG8_BAR; PG8_WAIT_L(0); PG8_MMA(1, 0, At, B0); PG8_BAR; PG8_SCHED;
            PG8_STAGE(PG8_SB(1, 1), b3 + hstep, voffB);
            PG8_WAIT_V(6); PG8_BAR; PG8_MMA(1, 1, At, B1); PG8_BAR;
            }
        }
        if constexpr (ALIGN_EPI) { if (wr == 0) PG8_BAR; }
        if constexpr (!Epi::AFTER_DRAIN) { E(acc, cur, wr, wc, fr, fq); S.done(cur); }
        if (!has_next) break;
#pragma unroll
        for (int a = 0; a < 2; ++a)
#pragma unroll
            for (int b = 0; b < 2; ++b)
#pragma unroll
                for (int m = 0; m < 4; ++m)
#pragma unroll
                    for (int n = 0; n < 2; ++n) acc[a][b][m][n] = (f32x4){0.f, 0.f, 0.f, 0.f};
        cur = nxt; cA = nA; cB = nB; ++ui;
        if constexpr (ALIGN_EPI) { if (wr == 1) PG8_BAR; }
    }
    PG8_WAIT_V(0);
    if constexpr (!ALIGN_EPI) { if (wr == 0) PG8_BAR; }
    PG8_BAR;
    if constexpr (Epi::AFTER_DRAIN) { E.fused(acc, cur, wr, wc, fr, fq, lds, wid, lane); S.done(cur); }
#undef PG8_SA
#undef PG8_SB
#undef PG8_STAGE
#undef PG8_LDA
#undef PG8_LDB
#undef PG8_MMA
#undef PG8_WAIT_V
#undef PG8_WAIT_L
#undef PG8_BAR
#undef PG8_SCHED
}
}
#define GAS __attribute__((address_space(1)))
#define LAS __attribute__((address_space(3)))
typedef unsigned short bf16;
typedef unsigned v4u __attribute__((ext_vector_type(4)));
typedef float f32x4 __attribute__((ext_vector_type(4)));
typedef short bf16x8 __attribute__((ext_vector_type(8)));
typedef GAS unsigned gu32;
typedef GAS unsigned long long gu64;
#define RLX_AGENT __ATOMIC_RELAXED, __HIP_MEMORY_SCOPE_AGENT
#define LDS_WAIT() asm volatile("s_waitcnt lgkmcnt(0)" ::: "memory")
#define VM_WAIT() asm volatile("s_waitcnt vmcnt(0)" ::: "memory")
__device__ __forceinline__ unsigned long long rt() { return __builtin_amdgcn_s_memrealtime(); }
__device__ __forceinline__ unsigned f2bf(float f) { unsigned u = __builtin_bit_cast(unsigned, f); return (u + 0x7fffu + ((u >> 16) & 1u)) >> 16; }
__device__ __forceinline__ unsigned pk2(float lo, float hi) { return f2bf(lo) | (f2bf(hi) << 16); }

#define XB_TMO      128
#define XB_XCNT(j)  (256  + 64 * (j))
#define XB_XSUB(j)  (1280 + 64 * (j))
#define XB_XGEN(j)  (2304 + 64 * (j))
#define XB_TOP      3328
#define XB_TOPGEN   3392
#define XCD_BAR_WORDS 3456
#define XB_SPIN_CAP (1u << 18)

__device__ __forceinline__ unsigned xb_ld(unsigned* p)              { return __hip_atomic_load(p, __ATOMIC_RELAXED, __HIP_MEMORY_SCOPE_AGENT); }
__device__ __forceinline__ unsigned xb_add(unsigned* p, unsigned v) { return __hip_atomic_fetch_add(p, v, __ATOMIC_RELAXED, __HIP_MEMORY_SCOPE_AGENT); }
__device__ __forceinline__ unsigned xb_xcc_id() { return (unsigned)__builtin_amdgcn_s_getreg((3 << 11) | 20) & 0xFu; }
#define XB_SPIN(cond, bar) do { unsigned _sp = 0; while (cond) { __builtin_amdgcn_s_sleep(1); \
    if ((++_sp & 255u) == 0u) { if (xb_ld(&(bar)[XB_TMO])) break; if (_sp > XB_SPIN_CAP) { atomicAdd(&(bar)[XB_TMO], 1u); break; } } } } while (0)

struct XcdBarrier {
    unsigned* bar; unsigned x;
    volatile LAS unsigned* st;
};

__device__ __forceinline__ XcdBarrier xcd_barrier_post(unsigned* bar, volatile LAS unsigned* st) {
    XcdBarrier b; b.bar = bar; b.x = xb_xcc_id(); b.st = st;
    if (threadIdx.x == 0) (void)xb_add(&bar[XB_XCNT(b.x)], 1u);
    return b;
}
__device__ __forceinline__ void xcd_barrier_complete(unsigned* bar, unsigned x, unsigned& nloc, unsigned& nx) {
    const unsigned G = gridDim.x * gridDim.y * gridDim.z;
    unsigned sum, cnt, mine, sp = 0u;
    for (;;) {
        sum = 0u; cnt = 0u; mine = 0u;
#pragma unroll
        for (unsigned j = 0; j < 16; ++j) { const unsigned c = xb_ld(&bar[XB_XCNT(j)]); sum += c; cnt += (c > 0u) ? 1u : 0u; mine = (j == x) ? c : mine; }
        if (sum == G) break;
        __builtin_amdgcn_s_sleep(1);
        if ((++sp & 255u) == 0u) { if (xb_ld(&bar[XB_TMO])) break; if (sp > XB_SPIN_CAP) { atomicAdd(&bar[XB_TMO], 1u); break; } }
    }
    nloc = mine > 0u ? mine : 1u; nx = cnt > 0u ? cnt : 1u;
}

__device__ __forceinline__ void xcd_barrier(const XcdBarrier& b) {
    asm volatile("s_waitcnt vmcnt(0)" ::: "memory");
    __syncthreads();
    if (threadIdx.x == 0) {
        unsigned* bar = b.bar;
        __builtin_amdgcn_s_waitcnt(0);
        unsigned nloc = b.st[0], nx = b.st[1];
        if (nloc == 0u) { xcd_barrier_complete(bar, b.x, nloc, nx); b.st[0] = nloc; b.st[1] = nx; }
        const unsigned old = xb_add(&bar[XB_XSUB(b.x)], 1u);
        const unsigned gen = old / nloc;
        if (old + 1u == (gen + 1u) * nloc) {
            __builtin_amdgcn_fence(__ATOMIC_RELEASE, "agent");
            asm volatile("s_waitcnt vmcnt(0)" ::: "memory");
            const unsigned og = xb_add(&bar[XB_TOP], 1u);
            const unsigned tg = og / nx;
            if (og + 1u == (tg + 1u) * nx) xb_add(&bar[XB_TOPGEN], 1u);
            else XB_SPIN(xb_ld(&bar[XB_TOPGEN]) == tg, bar);
            __builtin_amdgcn_fence(__ATOMIC_ACQUIRE, "agent");
            xb_add(&bar[XB_XGEN(b.x)], 1u);
            asm volatile("s_waitcnt vmcnt(0)" ::: "memory");
        } else {
            XB_SPIN(xb_ld(&bar[XB_XGEN(b.x)]) == gen, bar);
            __builtin_amdgcn_fence(__ATOMIC_ACQUIRE, "agent");
            asm volatile("s_waitcnt vmcnt(0)" ::: "memory");
        }
    }
    __syncthreads();
}
constexpr int NWAVES = 8;
constexpr int MPR = 8192, MSM = 256, MT = MPR + MSM;
constexpr int DM = 2048;
constexpr float RMS_EPS = 1e-6f;
constexpr float LOG2E = 1.4426950408889634f;
constexpr size_t MiB = 1u << 20;
constexpr size_t WS_CTL = 0, CTL_ZERO_BYTES = 64 * 1024;
constexpr size_t WS_WINA = 1 * MiB;
constexpr size_t WS_WOA = 26 * MiB;
constexpr size_t WS_WINB = 34 * MiB;
constexpr size_t WS_WOB = 52 * MiB;
constexpr size_t WS_BUFA = 60 * MiB;
constexpr size_t WS_QK = 93 * MiB;
constexpr size_t WS_VT = 126 * MiB;
constexpr size_t WS_QZ = 93 * MiB;
constexpr size_t WS_SR = 159 * MiB;
constexpr size_t WS_REC = 192 * MiB;
constexpr size_t WS_KB = 192 * MiB;
constexpr size_t WS_VT2 = 198 * MiB;
constexpr size_t WS_GLOW = 234 * MiB;
constexpr size_t WS_SSQP = 235 * MiB;
constexpr size_t WS_END = 240 * MiB;
constexpr int CW_BAR = 1024;
constexpr int REC_QT = 0, REC_KT = 33792, REC_P = 33792 + 40960, REC_G = REC_P + 10240, REC_BYTES = REC_G + 1024;
static_assert(REC_BYTES == 86016 && 512 * (size_t)REC_BYTES <= 42 * MiB, "record");
constexpr size_t OUT_Y = 0, OUT_GLAP = 17301504, OUT_GLAS = 19398656, OUT_KWP = 36175872, OUT_VWP = 36306944, OUT_KWS = 36438016, OUT_VWS = 37486592, OUT_TOTAL = 38535168;
constexpr int RING_BYTES = 131072, LDSCTL_OFF = RING_BYTES, MISC_OFF = LDSCTL_OFF + 320, LDS_BYTES = 147456;

__device__ __forceinline__ float bf2f(unsigned short u) { return __uint_as_float(((unsigned)u) << 16); }
__device__ __forceinline__ unsigned cvtpk2(float lo, float hi) { return pg8::cvtpk(lo, hi); }
__device__ __forceinline__ float wave_sum(float v) {
#pragma unroll
    for (int o = 1; o < 64; o <<= 1) v += __shfl_xor(v, o);
    return v;
}
#define MFMA16(a, b, c) __builtin_amdgcn_mfma_f32_16x16x32_bf16((a), (b), (c), 0, 0, 0)
typedef unsigned u32x2 __attribute__((ext_vector_type(2)));

struct Ptrs {
    const float *x_prompt, *x_sample, *state, *ck, *cv, *g_norm_a, *w_in_a, *w_gate_up, *b_gate, *g_onorm, *w_out_a, *g_norm_kv, *w_kv, *g_norm_b, *w_in_b, *sinks, *w_out_b, *g_final;
    float* out; unsigned char* ws;
};

__device__ __forceinline__ void p0_transpose_item(const float* W, int ldw, int ncol0, int nvalid, const float* gain, int scale_cols, float scale, bf16* WT, int row_off, LAS float* scr, int kb, int nb, int lane) {
    const int k0 = 64 * kb, n0 = 32 * nb, nl = lane & 31; const bool ok = (n0 + nl) < nvalid; const float cs = (n0 + nl) < scale_cols ? scale : 1.0f;
#pragma unroll 8
    for (int i = 0; i < 32; ++i) { const int kk = 2 * i + (lane >> 5); float v = ok ? W[(size_t)(k0 + kk) * ldw + ncol0 + n0 + nl] : 0.f; if (gain) v *= gain[k0 + kk]; scr[kk * 33 + nl] = v * cs; }
    LDS_WAIT(); asm volatile("" ::: "memory");
    const int c = lane & 7;
#pragma unroll
    for (int j = 0; j < 4; ++j) { const int n = (lane >> 3) + 8 * j; const LAS float* s = scr + (8 * c) * 33 + n;
        v4u o; o.x = cvtpk2(s[0 * 33], s[1 * 33]); o.y = cvtpk2(s[2 * 33], s[3 * 33]); o.z = cvtpk2(s[4 * 33], s[5 * 33]); o.w = cvtpk2(s[6 * 33], s[7 * 33]);
        if (n0 + n < nvalid) *(GAS v4u*)(WT + (size_t)(row_off + n0 + n) * 2048 + k0 + 8 * c) = o; }
    LDS_WAIT(); asm volatile("" ::: "memory");
}
__device__ __forceinline__ void rms_row_to_bf16(const float* xrow, bf16* orow, int lane) {
    const GAS f32x4* xr = (const GAS f32x4*)xrow + lane;
    f32x4 v[8]; float s = 0.f;
#pragma unroll
    for (int j = 0; j < 8; ++j) { v[j] = xr[64 * j]; s += (v[j].x * v[j].x + v[j].y * v[j].y) + (v[j].z * v[j].z + v[j].w * v[j].w); }
    const float rstd = 1.0f / sqrtf(wave_sum(s) * (1.f / DM) + RMS_EPS);
    GAS u32x2* o8 = (GAS u32x2*)orow + lane;
#pragma unroll
    for (int j = 0; j < 8; ++j) { u32x2 w; w.x = cvtpk2(v[j].x * rstd, v[j].y * rstd); w.y = cvtpk2(v[j].z * rstd, v[j].w * rstd); o8[64 * j] = w; }
}
__device__ __forceinline__ void p0_prologue(const Ptrs& P, LAS unsigned char* lds, int vcu, int G, int tid, int wave, int lane) {
    LAS float* scr = (LAS float*)(lds + wave * 16384);
    const int gw = vcu * NWAVES + wave, NGW = G * NWAVES;
    bf16* WinaT = (bf16*)(P.ws + WS_WINA); bf16* WoaT = (bf16*)(P.ws + WS_WOA); bf16* WinbT = (bf16*)(P.ws + WS_WINB); bf16* WobT = (bf16*)(P.ws + WS_WOB);
    constexpr int I0 = 32 * 192, I1 = 32, I2 = 32 * 64, I3 = 32 * 128, I4 = 32 * 16, I5 = 32 * 64, NIT = I0 + I1 + I2 + I3 + I4 + I5;
    for (int it = gw; it < NIT; it += NGW) {
        int r = it;
        if (r < I0) { p0_transpose_item(P.w_in_a, 6160, 0, 6144, P.g_norm_a, 1024, 0.0625f, WinaT, 0, scr, r / 192, r % 192, lane); continue; } r -= I0;
        if (r < I1) { p0_transpose_item(P.w_in_a, 6160, 6144, 16, P.g_norm_a, 0, 1.f, WinaT, 6144, scr, r, 0, lane); continue; } r -= I1;
        if (r < I2) { p0_transpose_item(P.w_out_a, 2048, 0, 2048, P.g_onorm, 0, 1.f, WoaT, 0, scr, r / 64, r % 64, lane); continue; } r -= I2;
        if (r < I3) { p0_transpose_item(P.w_in_b, 4096, 0, 4096, P.g_norm_b, 2048, 0.125f * LOG2E, WinbT, 0, scr, r / 128, r % 128, lane); continue; } r -= I3;
        if (r < I4) { p0_transpose_item(P.w_kv, 512, 0, 512, P.g_norm_kv, 0, 1.f, WinbT, 4096, scr, r / 16, r % 16, lane); continue; } r -= I4;
        p0_transpose_item(P.w_out_b, 2048, 0, 2048, nullptr, 0, 1.f, WobT, 0, scr, r / 64, r % 64, lane);
    }
    bf16* XN = (bf16*)(P.ws + WS_BUFA);
    for (int m = gw; m < MT; m += NGW) rms_row_to_bf16(m < MPR ? P.x_prompt + (size_t)m * DM : P.x_sample + (size_t)(m - MPR) * DM, XN + (size_t)m * DM, lane);
    const int gt = vcu * (NWAVES * 64) + tid, NGT = G * NWAVES * 64;
    for (int i = gt; i < 32 * 120 * 64; i += NGT) { const int b = i / (120 * 64), rem = i % (120 * 64);
        ((f32x4*)(P.out + OUT_KWS))[(size_t)b * 128 * 64 + rem] = ((const f32x4*)P.ck)[(size_t)b * 128 * 64 + 8 * 64 + rem];
        ((f32x4*)(P.out + OUT_VWS))[(size_t)b * 128 * 64 + rem] = ((const f32x4*)P.cv)[(size_t)b * 128 * 64 + 8 * 64 + rem]; }
}

__device__ __forceinline__ void glow_task(const bf16* XN, const bf16* WgT, float* GLOW, int task, int lane) {
    const int r = lane & 15, g = lane >> 4, row0 = task * 16;
    const bf16* ap = XN + (size_t)(row0 + r) * DM + g * 8; const bf16* bp = WgT + (size_t)r * DM + g * 8;
    f32x4 acc = {0.f, 0.f, 0.f, 0.f};
#pragma unroll 8
    for (int kk = 0; kk < 64; ++kk) { const bf16x8 a = *(const bf16x8*)(ap + kk * 32); const bf16x8 b = *(const bf16x8*)(bp + kk * 32); acc = MFMA16(a, b, acc); }
#pragma unroll
    for (int i = 0; i < 4; ++i) GLOW[(size_t)(row0 + 4 * g + i) * 16 + r] = acc[i];
}

__device__ __forceinline__ void gla_prep_unit(const Ptrs& P, LAS unsigned char* lds, int u, int tid, int wave, int lane) {
    const int c = u & 31, h = (u >> 5) & 3, b = u >> 7;
    const int d = tid & 255, th = tid >> 8;
    LAS float* GL = (LAS float*)lds;
    LAS float* TOT = (LAS float*)(lds + 4096);
    LAS bf16* QT = (LAS bf16*)(lds + 8192);
    LAS bf16* KS = (LAS bf16*)(lds + 8192 + 33792);
    const int row0 = b * 2048 + c * 64;
    const float* GLOW = (const float*)(P.ws + WS_GLOW);
    const bf16* QK = (const bf16*)(P.ws + WS_QK);
    unsigned char* rec = P.ws + WS_REC + (size_t)u * REC_BYTES;
    if (tid < 256) ((LAS f32x4*)GL)[tid] = ((const f32x4*)(GLOW + (size_t)row0 * 16))[tid];
    float wg[16];
#pragma unroll
    for (int r = 0; r < 16; ++r) wg[r] = P.w_gate_up[r * 1024 + h * 256 + d];
    const float bias = P.b_gate[h * 256 + d];
    __syncthreads();
    float bl[32]; float run = 0.f;
#pragma unroll
    for (int tt = 0; tt < 32; ++tt) { const int t = th * 32 + tt; const LAS f32x4* gr = (const LAS f32x4*)(GL + t * 16);
        const f32x4 g0 = gr[0], g1 = gr[1], g2 = gr[2], g3 = gr[3];
        float z = bias + g0.x * wg[0] + g0.y * wg[1] + g0.z * wg[2] + g0.w * wg[3] + g1.x * wg[4] + g1.y * wg[5] + g1.z * wg[6] + g1.w * wg[7]
                       + g2.x * wg[8] + g2.y * wg[9] + g2.z * wg[10] + g2.w * wg[11] + g3.x * wg[12] + g3.y * wg[13] + g3.z * wg[14] + g3.w * wg[15];
        const float ls = fminf(z, 0.f) - __logf(1.0f + __expf(-fabsf(z)));
        run += ls * 0.0625f; bl[tt] = run; }
    TOT[th * 256 + d] = run;
    __syncthreads();
    const float tot0 = TOT[d], tot1 = TOT[256 + d], blast = tot0 + tot1, base = th ? tot0 : 0.f;
    unsigned kt[16];
    const bf16* qp = QK + (size_t)(row0 + th * 32) * DM + h * 256 + d;
#pragma unroll
    for (int tt = 0; tt < 32; tt += 2) {
        float kv2[2];
#pragma unroll
        for (int k2 = 0; k2 < 2; ++k2) { const int t = th * 32 + tt + k2; const float bt = base + bl[tt + k2];
            const float e1 = __expf(bt - blast), e2 = __expf(blast - bt);
            const float q = bf2f(qp[(size_t)(tt + k2) * DM]), k = bf2f(qp[(size_t)(tt + k2) * DM + 1024]);
            const float qv = q * e1, kv = k * e2; kv2[k2] = kv;
            QT[t * 264 + d] = (bf16)(cvtpk2(qv, 0.f) & 0xffffu); KS[t * 264 + d] = (bf16)(cvtpk2(kv, 0.f) & 0xffffu); }
        kt[tt >> 1] = cvtpk2(kv2[0], kv2[1]); }
    { GAS v4u* kd = (GAS v4u*)(rec + REC_KT + d * 160 + th * 64);
#pragma unroll
      for (int i = 0; i < 4; ++i) { v4u o; o.x = kt[4 * i]; o.y = kt[4 * i + 1]; o.z = kt[4 * i + 2]; o.w = kt[4 * i + 3]; kd[i] = o; } }
    if (th == 0) ((GAS float*)(rec + REC_G))[d] = __expf(blast);
    __syncthreads();
    { const int r = lane & 15, g = lane >> 4, mt = wave >> 1, st0 = 2 * (wave & 1);
      f32x4 a0 = {0.f, 0.f, 0.f, 0.f}, a1 = {0.f, 0.f, 0.f, 0.f};
#pragma unroll
      for (int kk = 0; kk < 8; ++kk) { const bf16x8 bq = *(const LAS bf16x8*)(QT + (16 * mt + r) * 264 + 32 * kk + 8 * g);
          const bf16x8 k0 = *(const LAS bf16x8*)(KS + (16 * st0 + r) * 264 + 32 * kk + 8 * g); const bf16x8 k1 = *(const LAS bf16x8*)(KS + (16 * st0 + 16 + r) * 264 + 32 * kk + 8 * g);
          a0 = MFMA16(k0, bq, a0); a1 = MFMA16(k1, bq, a1); }
      const int t = 16 * mt + r;
#pragma unroll
      for (int j = 0; j < 2; ++j) { const f32x4 a = j ? a1 : a0; const int s0 = 16 * (st0 + j) + 4 * g;
          u32x2 w; w.x = cvtpk2(s0 + 0 <= t ? a[0] : 0.f, s0 + 1 <= t ? a[1] : 0.f); w.y = cvtpk2(s0 + 2 <= t ? a[2] : 0.f, s0 + 3 <= t ? a[3] : 0.f);
          *(GAS u32x2*)(rec + REC_P + t * 160 + s0 * 2) = w; } }
    for (int i = tid; i < 2112; i += NWAVES * 64) ((GAS v4u*)(rec + REC_QT))[i] = ((const LAS v4u*)QT)[i];
    __syncthreads();
}

__device__ __forceinline__ void gla_scan_unit(const Ptrs& P, LAS unsigned char* lds, int bh, int slice, int tid, int wave, int lane) {
    const int b = bh >> 2, h = bh & 3, r = lane & 15, g = lane >> 4;
    const int ecol = h * 512 + slice * 128 + 16 * wave;
    const bf16* VT = (const bf16*)(P.ws + WS_VT);
    bf16* ORAW = (bf16*)(P.ws + WS_BUFA);
    float* SSQP = (float*)(P.ws + WS_SSQP);
    const unsigned char* rec0 = P.ws + WS_REC + (size_t)(bh * 32) * REC_BYTES;
    const LAS bf16* QT = (const LAS bf16*)(lds + REC_QT); const LAS bf16* KT = (const LAS bf16*)(lds + REC_KT); const LAS bf16* PL = (const LAS bf16*)(lds + REC_P); const LAS float* GL = (const LAS float*)(lds + REC_G);
    f32x4 S[16];
#pragma unroll
    for (int i = 0; i < 16; ++i) S[i] = (f32x4){0.f, 0.f, 0.f, 0.f};
    v4u pf[11];
    constexpr int N16 = REC_BYTES / 16;
#define REC_LOAD(recp) do { _Pragma("unroll") for (int i_ = 0; i_ < 11; ++i_) { const int idx_ = tid + 512 * i_; if (idx_ < N16) pf[i_] = ((const GAS v4u*)(recp))[idx_]; } } while (0)
#define REC_STORE() do { _Pragma("unroll") for (int i_ = 0; i_ < 11; ++i_) { const int idx_ = tid + 512 * i_; if (idx_ < N16) ((LAS v4u*)lds)[idx_] = pf[i_]; } } while (0)
    REC_LOAD(rec0); REC_STORE();
    __syncthreads();
    for (int c = 0; c < 32; ++c) {
        if (c + 1 < 32) REC_LOAD(rec0 + (size_t)(c + 1) * REC_BYTES);
        const int row0 = b * 2048 + c * 64;
        bf16x8 vf[2];
#pragma unroll
        for (int ks = 0; ks < 2; ++ks) vf[ks] = *(const bf16x8*)(VT + (size_t)(ecol + r) * MT + row0 + 32 * ks + 8 * g);
#pragma unroll
        for (int dt = 0; dt < 16; ++dt) { const f32x4 gm = *(const LAS f32x4*)(GL + 16 * dt + 4 * g); S[dt] = S[dt] * gm; }
        f32x4 Z[4];
#pragma unroll
        for (int tt = 0; tt < 4; ++tt) Z[tt] = (f32x4){0.f, 0.f, 0.f, 0.f};
#pragma unroll
        for (int kk = 0; kk < 8; ++kk) {
            v4u af; af.x = cvtpk2(S[2 * kk][0], S[2 * kk][1]); af.y = cvtpk2(S[2 * kk][2], S[2 * kk][3]); af.z = cvtpk2(S[2 * kk + 1][0], S[2 * kk + 1][1]); af.w = cvtpk2(S[2 * kk + 1][2], S[2 * kk + 1][3]);
            const bf16x8 afr = __builtin_bit_cast(bf16x8, af);
#pragma unroll
            for (int tt = 0; tt < 4; ++tt) { const LAS bf16* qrow = QT + (16 * tt + r) * 264 + 32 * kk + 4 * g;
                const u32x2 lo = *(const LAS u32x2*)qrow, hi = *(const LAS u32x2*)(qrow + 16);
                v4u bq; bq.x = lo.x; bq.y = lo.y; bq.z = hi.x; bq.w = hi.y;
                Z[tt] = MFMA16(afr, __builtin_bit_cast(bf16x8, bq), Z[tt]); } }
#pragma unroll
        for (int ks = 0; ks < 2; ++ks)
#pragma unroll
            for (int tt = 0; tt < 4; ++tt) { const bf16x8 pb = *(const LAS bf16x8*)(PL + (16 * tt + r) * 80 + 32 * ks + 8 * g); Z[tt] = MFMA16(vf[ks], pb, Z[tt]); }
#pragma unroll
        for (int dt = 0; dt < 16; ++dt)
#pragma unroll
            for (int ks = 0; ks < 2; ++ks) { const bf16x8 kf = *(const LAS bf16x8*)(KT + (16 * dt + r) * 80 + 32 * ks + 8 * g); S[dt] = MFMA16(kf, vf[ks], S[dt]); }
#pragma unroll
        for (int tt = 0; tt < 4; ++tt) { const int row = row0 + 16 * tt + r; const f32x4 z = Z[tt];
            u32x2 w; w.x = cvtpk2(z[0], z[1]); w.y = cvtpk2(z[2], z[3]);
            *(GAS u32x2*)(ORAW + (size_t)row * DM + ecol + 4 * g) = w;
            float s = (z[0] * z[0] + z[1] * z[1]) + (z[2] * z[2] + z[3] * z[3]); s += __shfl_xor(s, 16); s += __shfl_xor(s, 32);
            if (g == 0) SSQP[((size_t)row * 4 + h) * 32 + slice * 8 + wave] = s; }
        __syncthreads();
        if (c + 1 < 32) REC_STORE();
        __syncthreads();
    }
#undef REC_LOAD
#undef REC_STORE
    float* SO = P.out + OUT_GLAP + (size_t)bh * 256 * 512 + slice * 128 + 16 * wave + r;
#pragma unroll
    for (int dt = 0; dt < 16; ++dt)
#pragma unroll
        for (int i = 0; i < 4; ++i) SO[(size_t)(16 * dt + 4 * g + i) * 512] = S[dt][i];
}

__device__ __forceinline__ void gla_sample_unit(const Ptrs& P, LAS unsigned char* lds, int task, int tid, int wave, int lane) {
    const int es = task & 7, h = (task >> 3) & 3, b = task >> 5;
    LAS float* GL = (LAS float*)lds;
    LAS float* QD = (LAS float*)(lds + 1024);
    LAS float* KD = (LAS float*)(lds + 1024 + 8192);
    LAS float* GD = (LAS float*)(lds + 1024 + 16384);
    LAS float* PR = (LAS float*)(lds + 18432);
    LAS float* VL = (LAS float*)(lds + 18688);
    LAS float* RED = (LAS float*)(lds + 20736);
    LAS float* OP = (LAS float*)(lds + 24576);
    const int row0 = MPR + b * 8;
    const bf16* QK = (const bf16*)(P.ws + WS_QK); const bf16* VT = (const bf16*)(P.ws + WS_VT); const float* GLOW = (const float*)(P.ws + WS_GLOW);
    if (tid < 32) ((LAS f32x4*)GL)[tid] = ((const f32x4*)(GLOW + (size_t)row0 * 16))[tid];
    { const int e = tid & 63, s = tid >> 6; VL[s * 64 + e] = bf2f(VT[(size_t)(h * 512 + es * 64 + e) * MT + row0 + s]); }
    __syncthreads();
    if (tid < 256) {
        const int d = tid;
        float wg[16];
#pragma unroll
        for (int r = 0; r < 16; ++r) wg[r] = P.w_gate_up[r * 1024 + h * 256 + d];
        const float bias = P.b_gate[h * 256 + d];
        float bc[8], q[8], k[8]; float run = 0.f;
#pragma unroll
        for (int t = 0; t < 8; ++t) { const LAS f32x4* gr = (const LAS f32x4*)(GL + t * 16); const f32x4 g0 = gr[0], g1 = gr[1], g2 = gr[2], g3 = gr[3];
            float z = bias + g0.x * wg[0] + g0.y * wg[1] + g0.z * wg[2] + g0.w * wg[3] + g1.x * wg[4] + g1.y * wg[5] + g1.z * wg[6] + g1.w * wg[7]
                           + g2.x * wg[8] + g2.y * wg[9] + g2.z * wg[10] + g2.w * wg[11] + g3.x * wg[12] + g3.y * wg[13] + g3.z * wg[14] + g3.w * wg[15];
            const float ls = fminf(z, 0.f) - __logf(1.0f + __expf(-fabsf(z)));
            run += ls * 0.0625f; bc[t] = run;
            q[t] = bf2f(QK[(size_t)(row0 + t) * DM + h * 256 + d]); k[t] = bf2f(QK[(size_t)(row0 + t) * DM + 1024 + h * 256 + d]); }
        const float blast = bc[7];
#pragma unroll
        for (int t = 0; t < 8; ++t) { QD[d * 8 + t] = q[t] * __expf(bc[t]); KD[d * 8 + t] = k[t] * __expf(blast - bc[t]); }
        GD[d] = __expf(blast);
        int idx = 0;
#pragma unroll
        for (int t = 0; t < 8; ++t)
#pragma unroll
            for (int s = 0; s <= t; ++s) { float v = q[t] * k[s] * __expf(bc[t] - bc[s]); v = wave_sum(v); if (lane == 0) RED[wave * 36 + idx] = v; ++idx; }
    }
    __syncthreads();
    if (tid < 64) { const int t = tid >> 3, s = tid & 7; float v = 0.f; if (s <= t) { const int idx = t * (t + 1) / 2 + s; v = RED[idx] + RED[36 + idx] + RED[72 + idx] + RED[108 + idx]; } PR[t * 8 + s] = v; }
    { const int eq = tid & 15, dg = tid >> 4;
      f32x4 v[8];
#pragma unroll
      for (int s = 0; s < 8; ++s) v[s] = *(const LAS f32x4*)(VL + s * 64 + 4 * eq);
      f32x4 o[8];
#pragma unroll
      for (int t = 0; t < 8; ++t) o[t] = (f32x4){0.f, 0.f, 0.f, 0.f};
      const size_t sbase = ((size_t)(b * 4 + h) * 256) * 512 + es * 64 + 4 * eq;
      const float* S0p = P.state + sbase; float* S1p = P.out + OUT_GLAS + sbase;
      f32x4 s0[8];
#pragma unroll
      for (int dd = 0; dd < 8; ++dd) s0[dd] = *(const f32x4*)(S0p + (size_t)(8 * dg + dd) * 512);
#pragma unroll
      for (int dd = 0; dd < 8; ++dd) { const int d = 8 * dg + dd;
          const f32x4 qa = *(const LAS f32x4*)(QD + d * 8), qb = *(const LAS f32x4*)(QD + d * 8 + 4), ka = *(const LAS f32x4*)(KD + d * 8), kb = *(const LAS f32x4*)(KD + d * 8 + 4);
          const float gm = GD[d]; const f32x4 x = s0[dd];
          o[0] += x * qa.x; o[1] += x * qa.y; o[2] += x * qa.z; o[3] += x * qa.w; o[4] += x * qb.x; o[5] += x * qb.y; o[6] += x * qb.z; o[7] += x * qb.w;
          f32x4 sn = x * gm; sn += v[0] * ka.x; sn += v[1] * ka.y; sn += v[2] * ka.z; sn += v[3] * ka.w; sn += v[4] * kb.x; sn += v[5] * kb.y; sn += v[6] * kb.z; sn += v[7] * kb.w;
          *(f32x4*)(S1p + (size_t)d * 512) = sn; }
#pragma unroll
      for (int t = 0; t < 8; ++t) *(LAS f32x4*)(OP + (dg * 8 + t) * 64 + 4 * eq) = o[t];
    }
    __syncthreads();
    { const int t = tid >> 6, e = tid & 63; float acc = 0.f;
#pragma unroll 8
      for (int dg = 0; dg < 32; ++dg) acc += OP[(dg * 8 + t) * 64 + e];
#pragma unroll
      for (int s = 0; s < 8; ++s) acc += PR[t * 8 + s] * VL[s * 64 + e];
      bf16* ORAW = (bf16*)(P.ws + WS_BUFA); float* SSQP = (float*)(P.ws + WS_SSQP);
      ORAW[(size_t)(row0 + t) * DM + h * 512 + es * 64 + e] = (bf16)(cvtpk2(acc, 0.f) & 0xffffu);
      const float ss = wave_sum(acc * acc);
      if (lane == 0) SSQP[((size_t)(row0 + t) * 4 + h) * 32 + es] = ss; }
    __syncthreads();
}

__device__ __forceinline__ void gate_row(const Ptrs& P, int row, int lane) {
    bf16* ORAW = (bf16*)(P.ws + WS_BUFA); const bf16* SR = (const bf16*)(P.ws + WS_SR); const float* SSQP = (const float*)(P.ws + WS_SSQP);
    const int np = row < MPR ? 32 : 8;
    float rstd[4];
#pragma unroll
    for (int h = 0; h < 4; ++h) { float v = lane < np ? SSQP[((size_t)row * 4 + h) * 32 + lane] : 0.f; v = wave_sum(v); rstd[h] = 1.0f / sqrtf(v * (1.f / 512.f) + RMS_EPS); }
#pragma unroll
    for (int j = 0; j < 4; ++j) { const size_t off = (size_t)row * DM + 512 * j + 8 * lane;
        const v4u o = *(const GAS v4u*)(ORAW + off), s = *(const GAS v4u*)(SR + off); const float rs = rstd[j];
        v4u w;
        w.x = cvtpk2(__uint_as_float(o.x << 16) * rs * __uint_as_float(s.x << 16), __uint_as_float(o.x & 0xffff0000u) * rs * __uint_as_float(s.x & 0xffff0000u));
        w.y = cvtpk2(__uint_as_float(o.y << 16) * rs * __uint_as_float(s.y << 16), __uint_as_float(o.y & 0xffff0000u) * rs * __uint_as_float(s.y & 0xffff0000u));
        w.z = cvtpk2(__uint_as_float(o.z << 16) * rs * __uint_as_float(s.z << 16), __uint_as_float(o.z & 0xffff0000u) * rs * __uint_as_float(s.z & 0xffff0000u));
        w.w = cvtpk2(__uint_as_float(o.w << 16) * rs * __uint_as_float(s.w << 16), __uint_as_float(o.w & 0xffff0000u) * rs * __uint_as_float(s.w & 0xffff0000u));
        *(GAS v4u*)(ORAW + off) = w; }
}
__device__ __forceinline__ void final_row(float* hrow, const float* gfin, int lane) {
    GAS f32x4* xr = (GAS f32x4*)hrow + lane; const GAS f32x4* gr = (const GAS f32x4*)gfin + lane;
    f32x4 v[8]; float s = 0.f;
#pragma unroll
    for (int j = 0; j < 8; ++j) { v[j] = xr[64 * j]; s += (v[j].x * v[j].x + v[j].y * v[j].y) + (v[j].z * v[j].z + v[j].w * v[j].w); }
    const float rstd = 1.0f / sqrtf(wave_sum(s) * (1.f / DM) + RMS_EPS);
#pragma unroll
    for (int j = 0; j < 8; ++j) xr[64 * j] = v[j] * rstd * gr[64 * j];
}

__device__ __forceinline__ void attn_subblock(const LAS bf16* KI, const LAS bf16* VI, int ts, const bf16* qrow, int qpos, int kpos0, float slope2, float sink2,
                                              const bf16* zrow, bf16* orow, bool store, int lane) {
    const int r = lane & 15, g = lane >> 4;
    const bf16x8 q0 = *(const bf16x8*)(qrow + 8 * g), q1 = *(const bf16x8*)(qrow + 32 + 8 * g);
    f32x4 sc[10]; float mx = -INFINITY;
#pragma unroll
    for (int i = 0; i < 10; ++i) { const LAS bf16* kr = KI + (16 * (ts + i) + r) * 80 + 8 * g;
        f32x4 a = {0.f, 0.f, 0.f, 0.f};
        a = MFMA16(*(const LAS bf16x8*)kr, q0, a); a = MFMA16(*(const LAS bf16x8*)(kr + 32), q1, a);
#pragma unroll
        for (int e = 0; e < 4; ++e) { const int kpos = kpos0 + 16 * (ts + i) + 4 * g + e; const int dist = qpos - kpos;
            const bool ok = dist >= 0 && dist <= 128 && kpos >= 0;
            const float v = ok ? a[e] - slope2 * (float)dist : -INFINITY; a[e] = v; mx = fmaxf(mx, v); }
        sc[i] = a; }
    mx = fmaxf(mx, __shfl_xor(mx, 16)); mx = fmaxf(mx, __shfl_xor(mx, 32)); mx = fmaxf(mx, sink2);
    float l = 0.f;
#pragma unroll
    for (int i = 0; i < 10; ++i)
#pragma unroll
        for (int e = 0; e < 4; ++e) { const float p = __builtin_amdgcn_exp2f(sc[i][e] - mx); sc[i][e] = p; l += p; }
    l += __shfl_xor(l, 16); l += __shfl_xor(l, 32);
    const float inv = 1.0f / (l + __builtin_amdgcn_exp2f(sink2 - mx));
    f32x4 o[4];
#pragma unroll
    for (int dt = 0; dt < 4; ++dt) o[dt] = (f32x4){0.f, 0.f, 0.f, 0.f};
#pragma unroll
    for (int ks = 0; ks < 5; ++ks) {
        v4u pp; pp.x = cvtpk2(sc[2 * ks][0], sc[2 * ks][1]); pp.y = cvtpk2(sc[2 * ks][2], sc[2 * ks][3]); pp.z = cvtpk2(sc[2 * ks + 1][0], sc[2 * ks + 1][1]); pp.w = cvtpk2(sc[2 * ks + 1][2], sc[2 * ks + 1][3]);
        const bf16x8 pb = __builtin_bit_cast(bf16x8, pp);
#pragma unroll
        for (int dt = 0; dt < 4; ++dt) { const LAS bf16* vr = VI + (16 * dt + r) * 264 + 16 * (ts + 2 * ks) + 4 * g;
            const u32x2 lo = *(const LAS u32x2*)vr, hi = *(const LAS u32x2*)(vr + 16);
            v4u va; va.x = lo.x; va.y = lo.y; va.z = hi.x; va.w = hi.y;
            o[dt] = MFMA16(__builtin_bit_cast(bf16x8, va), pb, o[dt]); } }
    if (store) {
#pragma unroll
        for (int dt = 0; dt < 4; ++dt) { const u32x2 zz = *(const GAS u32x2*)(zrow + 16 * dt + 4 * g);
            u32x2 w; w.x = cvtpk2(o[dt][0] * inv * __uint_as_float(zz.x << 16), o[dt][1] * inv * __uint_as_float(zz.x & 0xffff0000u));
            w.y = cvtpk2(o[dt][2] * inv * __uint_as_float(zz.y << 16), o[dt][3] * inv * __uint_as_float(zz.y & 0xffff0000u));
            *(GAS u32x2*)(orow + 16 * dt + 4 * g) = w; }
    }
}
__device__ __forceinline__ void attn_prompt_unit(const Ptrs& P, LAS unsigned char* lds, int u, int tid, int wave, int lane) {
    const int kvh = u & 3, qb = (u >> 2) & 15, b = u >> 6;
    LAS bf16* KI = (LAS bf16*)lds;
    LAS bf16* VI = (LAS bf16*)(lds + 40960);
    const bf16* KB = (const bf16*)(P.ws + WS_KB); const bf16* VT2 = (const bf16*)(P.ws + WS_VT2); const bf16* QZ = (const bf16*)(P.ws + WS_QZ); bf16* A3 = (bf16*)(P.ws + WS_SR);
    const int kpos0 = (qb - 1) * 128;
    for (int i = tid; i < 2048; i += NWAVES * 64) { const int j = i >> 3, ch = i & 7; const int kpos = kpos0 + j;
        v4u v = {0u, 0u, 0u, 0u}; if (kpos >= 0) v = *(const GAS v4u*)(KB + (size_t)(b * 2048 + kpos) * 256 + kvh * 64 + ch * 8);
        *(LAS v4u*)(KI + j * 80 + ch * 8) = v; }
    for (int i = tid; i < 2048; i += NWAVES * 64) { const int d = i >> 5, ch = i & 31; const int kpos = kpos0 + ch * 8;
        v4u v = {0u, 0u, 0u, 0u}; if (kpos >= 0) v = *(const GAS v4u*)(VT2 + (size_t)(kvh * 64 + d) * MT + b * 2048 + kpos);
        *(LAS v4u*)(VI + d * 264 + ch * 8) = v; }
    __syncthreads();
    const int hh = kvh * 8 + wave;
    const float slope2 = __builtin_amdgcn_exp2f(-0.25f * (float)(hh + 1)) * LOG2E, sink2 = P.sinks[hh] * LOG2E;
#pragma unroll 1
    for (int qs = 0; qs < 8; ++qs) { const int qpos = qb * 128 + 16 * qs + (lane & 15); const size_t row = (size_t)b * 2048 + qpos;
        attn_subblock(KI, VI, qs < 6 ? qs : 6, QZ + row * 4096 + hh * 64, qpos, kpos0, slope2, sink2, QZ + row * 4096 + 2048 + hh * 64, A3 + row * DM + hh * 64, true, lane); }
    __syncthreads();
}
__device__ __forceinline__ void attn_sample_unit(const Ptrs& P, LAS unsigned char* lds, int u, int tid, int wave, int lane) {
    const int kvh = u & 3, b = u >> 2;
    LAS bf16* KI = (LAS bf16*)lds;
    LAS bf16* VI = (LAS bf16*)(lds + 40960);
    const bf16* KB = (const bf16*)(P.ws + WS_KB); const bf16* VT2 = (const bf16*)(P.ws + WS_VT2); const bf16* QZ = (const bf16*)(P.ws + WS_QZ); bf16* A3 = (bf16*)(P.ws + WS_SR);
    for (int i = tid; i < 160 * 64; i += NWAVES * 64) { const int j = i >> 6, d = i & 63; float kv = 0.f, vv = 0.f;
        if (j < 128) { kv = P.ck[((size_t)(b * 128 + j) * 4 + kvh) * 64 + d]; vv = P.cv[((size_t)(b * 128 + j) * 4 + kvh) * 64 + d]; }
        else if (j < 136) { kv = bf2f(KB[(size_t)(MPR + b * 8 + j - 128) * 256 + kvh * 64 + d]); vv = bf2f(VT2[(size_t)(kvh * 64 + d) * MT + MPR + b * 8 + j - 128]); }
        KI[j * 80 + d] = (bf16)(cvtpk2(kv, 0.f) & 0xffffu); VI[d * 264 + j] = (bf16)(cvtpk2(vv, 0.f) & 0xffffu); }
    __syncthreads();
    const int hh = kvh * 8 + wave;
    const float slope2 = __builtin_amdgcn_exp2f(-0.25f * (float)(hh + 1)) * LOG2E, sink2 = P.sinks[hh] * LOG2E;
    const int n = lane & 15, qi = n < 8 ? n : 7; const size_t row = (size_t)MPR + b * 8 + qi;
    attn_subblock(KI, VI, 0, QZ + row * 4096 + hh * 64, 128 + qi, 0, slope2, sink2, QZ + row * 4096 + 2048 + hh * 64, A3 + row * DM + hh * 64, n < 8, lane);
    __syncthreads();
}
#ifndef MK_N_LAUNCHES
#define MK_N_LAUNCHES 1
#endif
constexpr int N_PHASES = 11;
constexpr int N_LAUNCHES = MK_N_LAUNCHES;
struct Args { Ptrs p; int ph_lo, ph_hi; };
static_assert(sizeof(Args) == 20 * 8 + 8, "Args has no padding");

__global__ void __launch_bounds__(NWAVES * 64, 2) yoco_fwd(Args args) {
    extern __shared__ __attribute__((aligned(16))) unsigned char lds_raw[];
    LAS unsigned char* lds = (LAS unsigned char*)lds_raw;
    volatile LAS unsigned* MISC = (volatile LAS unsigned*)(lds + MISC_OFF);
    const int tid = threadIdx.x, lane = tid & 63, wave = __builtin_amdgcn_readfirstlane(tid >> 6);
    const int G = gridDim.x, c = blockIdx.x;
    const int vcu = (G % 8 == 0) ? (c % 8) * (G / 8) + c / 8 : c;
    const Ptrs& P = args.p;
    gu32* ctl = (gu32*)(P.ws + WS_CTL);
    for (int u = tid; u < (LDS_BYTES - LDSCTL_OFF) / 4; u += NWAVES * 64) ((LAS unsigned*)(lds + LDSCTL_OFF))[u] = 0u;
    __syncthreads();
    XcdBarrier bar; bar.bar = (unsigned*)(ctl + CW_BAR); bar.x = 0; bar.st = nullptr;
    if (N_LAUNCHES == 1) bar = xcd_barrier_post((unsigned*)(ctl + CW_BAR), MISC + 8);
    const int lo = args.ph_lo, hi = args.ph_hi;
#define IN(k) (lo <= (k) && (k) < hi)
#define SEAM(k) do { if (IN(k) && IN((k) + 1)) xcd_barrier(bar); } while (0)
    const int gw = vcu * NWAVES + wave, NGW = G * NWAVES;

    if (IN(0)) { p0_prologue(P, lds, vcu, G, tid, wave, lane); SEAM(0); }

    if (IN(1)) {
        pg8::SchedInA S{G, c, (const char*)(P.ws + WS_BUFA), (const char*)(P.ws + WS_WINA)};
        pg8::EpiInA E{(pg8::bf16_t*)(P.ws + WS_QK), (pg8::bf16_t*)(P.ws + WS_SR), (pg8::bf16_t*)(P.ws + WS_VT), MT};
        pg8::gemm_phase<pg8::EpiInA, pg8::SchedInA, true, true>(lds, 2048, S, E);
        const int base = (c + G - (24 % G)) % G;
        for (int task = base * NWAVES + wave; task < MT / 16; task += NGW)
            glow_task((const bf16*)(P.ws + WS_BUFA), (const bf16*)(P.ws + WS_WINA) + (size_t)6144 * DM, (float*)(P.ws + WS_GLOW), task, lane);
        SEAM(1);
    }

    if (IN(2)) { for (int u = c; u < 512; u += G) gla_prep_unit(P, lds, u, tid, wave, lane); SEAM(2); }

    if (IN(3)) {
        if (G >= 128) {
            if (c < 64) { const int xcd = c & 7, idx = c >> 3; gla_scan_unit(P, lds, xcd * 2 + (idx >> 2), idx & 3, tid, wave, lane); }
            else for (int t = c - 64; t < 1024; t += G - 64) gla_sample_unit(P, lds, t, tid, wave, lane);
        } else {
            for (int u = c; u < 64; u += G) gla_scan_unit(P, lds, u >> 2, u & 3, tid, wave, lane);
            for (int t = c; t < 1024; t += G) gla_sample_unit(P, lds, t, tid, wave, lane);
        }
        SEAM(3);
    }

    if (IN(4)) { for (int m = gw; m < MT; m += NGW) gate_row(P, m, lane); SEAM(4); }

    if (IN(5)) {
        pg8::SchedOut S{G, c, (const char*)(P.ws + WS_BUFA), (const char*)(P.ws + WS_WOA)};
        pg8::EpiRes E{P.x_prompt, P.x_sample, P.out + OUT_Y};
        pg8::gemm_phase<pg8::EpiRes, pg8::SchedOut, true, true>(lds, 2048, S, E);
        SEAM(5);
    }

    if (IN(6)) { bf16* H1N = (bf16*)(P.ws + WS_BUFA); for (int m = gw; m < MT; m += NGW) rms_row_to_bf16(P.out + OUT_Y + (size_t)m * DM, H1N + (size_t)m * DM, lane); SEAM(6); }

    if (IN(7)) {
        pg8::SchedInB S{G, c, (const char*)(P.ws + WS_BUFA), (const char*)(P.ws + WS_WINB)};
        pg8::EpiInB E{(pg8::bf16_t*)(P.ws + WS_QZ), (pg8::bf16_t*)(P.ws + WS_KB), (pg8::bf16_t*)(P.ws + WS_VT2), MT, P.out + OUT_KWP, P.out + OUT_VWP, P.out + OUT_KWS, P.out + OUT_VWS};
        pg8::gemm_phase<pg8::EpiInB, pg8::SchedInB, true, true>(lds, 2048, S, E);
        SEAM(7);
    }

    if (IN(8)) {
        for (int u = c; u < 256; u += G) attn_prompt_unit(P, lds, u, tid, wave, lane);
        for (int u = c; u < 128; u += G) attn_sample_unit(P, lds, u, tid, wave, lane);
        SEAM(8);
    }

    if (IN(9)) {
        pg8::SchedOut S{G, c, (const char*)(P.ws + WS_SR), (const char*)(P.ws + WS_WOB)};
        pg8::EpiRes E{P.out + OUT_Y, nullptr, P.out + OUT_Y};
        pg8::gemm_phase<pg8::EpiRes, pg8::SchedOut, true, true>(lds, 2048, S, E);
        SEAM(9);
    }

    if (IN(10)) { for (int m = gw; m < MT; m += NGW) final_row(P.out + OUT_Y + (size_t)m * DM, P.g_final, lane); }
#undef IN
#undef SEAM
}

extern "C" void kernel_launch(void* const* d_in, const int* in_sizes, int n_in, void* d_out, int out_size, void* d_ws, size_t ws_size, hipStream_t stream) {
    static int grid = 0;
    if (grid == 0) {
        if (n_in != 18 || (size_t)out_size != OUT_TOTAL || ws_size < WS_END) { fprintf(stderr, "kernel_launch: unexpected shapes (n_in %d, out %d, ws %zu); nothing launched\n", n_in, out_size, ws_size); grid = -1; return; }
        int dev = 0, cus = 0, per_cu = 0;
        if (hipGetDevice(&dev) != hipSuccess || hipDeviceGetAttribute(&cus, hipDeviceAttributeMultiprocessorCount, dev) != hipSuccess) { grid = -1; return; }
        if (hipFuncSetAttribute((const void*)yoco_fwd, hipFuncAttributeMaxDynamicSharedMemorySize, LDS_BYTES) != hipSuccess) { fprintf(stderr, "kernel_launch: hipFuncSetAttribute failed\n"); grid = -1; return; }
        if (hipOccupancyMaxActiveBlocksPerMultiprocessor(&per_cu, (const void*)yoco_fwd, NWAVES * 64, LDS_BYTES) != hipSuccess || per_cu < 1)
            fprintf(stderr, "kernel_launch: note: occupancy query reports %d workgroups per CU\n", per_cu);
        (void)hipGetLastError();
        grid = cus;
    }
    if (grid < 0) return;
    (void)hipMemsetAsync((char*)d_ws + WS_CTL, 0, CTL_ZERO_BYTES, stream);
    Args a{};
    const float** pp = (const float**)&a.p;
    for (int i = 0; i < 18; ++i) pp[i] = (const float*)d_in[i];
    a.p.out = (float*)d_out; a.p.ws = (unsigned char*)d_ws;
    for (int li = 0; li < N_LAUNCHES; ++li) {
        a.ph_lo = (N_LAUNCHES == 1) ? 0 : li; a.ph_hi = (N_LAUNCHES == 1) ? N_PHASES : li + 1;
        hipLaunchKernelGGL(yoco_fwd, dim3(grid), dim3(NWAVES * 64), LDS_BYTES, stream, a);
    }
}
```

```cpp
#include <hip/hip_runtime.h>
#include <cstdio>
#include <cstdint>
#include <cmath>
namespace pg8 {
#define PG8_LAS __attribute__((address_space(3)))
typedef unsigned short bf16_t;
typedef short bf16x8 __attribute__((ext_vector_type(8)));
typedef float f32x4 __attribute__((ext_vector_type(4)));
typedef unsigned u32x4 __attribute__((ext_vector_type(4)));
constexpr int BM = 256, BK = 64, HALF = 128, HTB = HALF * BK * 2  , STAGE_BYTES = 8 * HTB, NXCD = 8, WGM = 8;

__host__ __device__ __forceinline__ int lds_byte(int r, int c) { const int st = (r >> 4) * 2 + (c >> 5), rr = r & 15, cc = c & 31, ob = rr * 64 + cc * 2; return st * 1024 + (ob ^ (((ob >> 9) & 1) << 5)); }
__host__ __device__ __forceinline__ void stage_rc(int b, int& R, int& C) { const int st = b / 1024, sb = b % 1024, swz = sb ^ (((sb >> 9) & 1) << 5); R = (st >> 1) * 16 + swz / 64; C = (st & 1) * 32 + (swz % 64) / 2; }
__host__ __device__ __forceinline__ int perm32(int rho) { const int n = rho >> 4, i = rho & 15; return 8 * (i >> 2) + 4 * n + (i & 3); }

struct Unit { const char* a; const char* b; int pm, pn, kind; };
__device__ __forceinline__ void tile_map(int L, int nM, int nN, int& pm, int& pn) {
    const int nwg = nM * nN; int wgid = L; { const int q = nwg / NXCD, r = nwg % NXCD, xcd = wgid % NXCD, off = wgid / NXCD; wgid = (xcd < r ? xcd * (q + 1) : r * (q + 1) + (xcd - r) * q) + off; }
    const int nig = WGM * nN, gid = wgid / nig, fm = gid * WGM, gsz = (nM - fm) < WGM ? (nM - fm) : WGM;
    pm = fm + ((wgid % nig) % gsz); pn = (wgid % nig) / gsz;
}
typedef float f32x2_t __attribute__((ext_vector_type(2))); typedef __bf16 bf16x2_t __attribute__((ext_vector_type(2)));
__device__ __forceinline__ unsigned cvtpk(float lo, float hi) { f32x2_t v = {lo, hi}; bf16x2_t b = __builtin_convertvector(v, bf16x2_t); return __builtin_bit_cast(unsigned, b); }
__device__ __forceinline__ float silu_f(float v) { return v / (1.0f + __expf(-v)); }

template <bool SILU>
__device__ __forceinline__ void store_tile_bf16(const f32x4 (&acc)[2][2][4][2], bf16_t* base, int ldc, int row_t, int col_t, int wr, int wc, int fr, int fq) {
    const int row0 = row_t + wr * 64 + fr, col0 = col_t + wc * 32 + 8 * fq;
#pragma unroll
    for (int ai = 0; ai < 2; ++ai)
#pragma unroll
        for (int m = 0; m < 4; ++m) { bf16_t* rowp = base + (size_t)(row0 + ai * HALF + m * 16) * ldc + col0;
#pragma unroll
            for (int bj = 0; bj < 2; ++bj) { f32x4 v0 = acc[ai][bj][m][0], v1 = acc[ai][bj][m][1];
                if (SILU) { v0[0] = silu_f(v0[0]); v0[1] = silu_f(v0[1]); v0[2] = silu_f(v0[2]); v0[3] = silu_f(v0[3]); v1[0] = silu_f(v1[0]); v1[1] = silu_f(v1[1]); v1[2] = silu_f(v1[2]); v1[3] = silu_f(v1[3]); }
                u32x4 w; w.x = cvtpk(v0[0], v0[1]); w.y = cvtpk(v0[2], v0[3]); w.z = cvtpk(v1[0], v1[1]); w.w = cvtpk(v1[2], v1[3]);
                *(u32x4*)(rowp + bj * HALF) = w; } }
}

struct EpiInA {
    static constexpr bool PERM = true, AFTER_DRAIN = false;
    bf16_t* QK; bf16_t* SR; bf16_t* VT; int MT;
    __device__ __forceinline__ void operator()(const f32x4 (&acc)[2][2][4][2], const Unit& u, int wr, int wc, int fr, int fq) const {
        if (u.kind == 0) store_tile_bf16<false>(acc, QK, 2048, u.pm * BM, u.pn * BM, wr, wc, fr, fq);
        else if (u.kind == 1) store_tile_bf16<true>(acc, SR, 2048, u.pm * BM, (u.pn - 8) * BM, wr, wc, fr, fq);
        else store_tile_bf16<false>(acc, VT, MT, u.pm * BM, u.pn * BM, wr, wc, fr, fq);
    }
};

struct EpiInB {
    static constexpr bool PERM = true, AFTER_DRAIN = false;
    bf16_t* QZ; bf16_t* KB; bf16_t* VT2; int MT; float* kwp; float* vwp; float* kws; float* vws;
    __device__ __forceinline__ static float* win_row(int t, float* wp, float* wsmp) {
        if (t < 8192) { const int pos = t & 2047; if (pos < 1920) return nullptr; return wp + ((size_t)(t >> 11) * 128 + (pos - 1920)) * 256; }
        const int s = t - 8192; return wsmp + ((size_t)(s >> 3) * 128 + 120 + (s & 7)) * 256;
    }
    __device__ __forceinline__ void operator()(const f32x4 (&acc)[2][2][4][2], const Unit& u, int wr, int wc, int fr, int fq) const {
        if (u.kind == 0) { store_tile_bf16<false>(acc, QZ, 4096, u.pm * BM, u.pn * BM, wr, wc, fr, fq); return; }
        if (u.kind == 1) { store_tile_bf16<true>(acc, QZ, 4096, u.pm * BM, u.pn * BM, wr, wc, fr, fq); return; }
        if (u.kind == 2) {
            store_tile_bf16<false>(acc, KB, 256, u.pm * BM, 0, wr, wc, fr, fq);
            if ((u.pm & 7) == 7 || u.pm == 32) {
                const int row0 = u.pm * BM + wr * 64 + fr, col0 = wc * 32 + 8 * fq;
#pragma unroll
                for (int ai = 0; ai < 2; ++ai)
#pragma unroll
                    for (int m = 0; m < 4; ++m) { float* d = win_row(row0 + ai * HALF + m * 16, kwp, kws);
                        if (d) {
#pragma unroll
                            for (int bj = 0; bj < 2; ++bj) { *(f32x4*)(d + col0 + bj * HALF) = acc[ai][bj][m][0]; *(f32x4*)(d + col0 + bj * HALF + 4) = acc[ai][bj][m][1]; } } }
            }
            return;
        }
        store_tile_bf16<false>(acc, VT2, MT, 0, u.pn * BM, wr, wc, fr, fq);
        if ((u.pn & 7) == 7 || u.pn == 32) {
            const int row0 = wr * 64 + fr, col0 = u.pn * BM + wc * 32 + 8 * fq;
#pragma unroll
            for (int bj = 0; bj < 2; ++bj)
#pragma unroll
                for (int n = 0; n < 2; ++n)
#pragma unroll
                    for (int j = 0; j < 4; ++j) { float* d = win_row(col0 + bj * HALF + 4 * n + j, vwp, vws);
                        if (d) {
#pragma unroll
                            for (int ai = 0; ai < 2; ++ai)
#pragma unroll
                                for (int m = 0; m < 4; ++m) d[row0 + ai * HALF + m * 16] = acc[ai][bj][m][n][j]; } }
        }
    }
};

struct EpiRes {
    static constexpr bool PERM = false, AFTER_DRAIN = false;
    const float* res; const float* res2; float* out;
    __device__ __forceinline__ void operator()(const f32x4 (&acc)[2][2][4][2], const Unit& u, int wr, int wc, int fr, int fq) const {
        const int row0 = u.pm * BM + wr * 64 + fr, col0 = u.pn * BM + wc * 32 + 4 * fq;
        const float* rb = (res2 != nullptr && u.pm == 32) ? res2 - (size_t)8192 * 2048 : res;
#pragma unroll
        for (int ai = 0; ai < 2; ++ai)
#pragma unroll
            for (int m = 0; m < 4; ++m) { const size_t off = (size_t)(row0 + ai * HALF + m * 16) * 2048 + col0;
#pragma unroll
                for (int bj = 0; bj < 2; ++bj)
#pragma unroll
                    for (int n = 0; n < 2; ++n) { const f32x4 r = *(const f32x4*)(rb + off + bj * HALF + n * 16); *(f32x4*)(out + off + bj * HALF + n * 16) = r + acc[ai][bj][m][n]; } }
    }
};

struct SchedInA {
    int G, c; const char* XN; const char* W;
    __device__ __forceinline__ bool next(int i, Unit& u) const {
        const int L = i * G + c; const size_t P = (size_t)BM * 2048 * 2;
        if (L < 512) { tile_map(L, 32, 16, u.pm, u.pn); u.kind = u.pn < 8 ? 0 : 1; u.a = XN + u.pm * P; u.b = W + (u.pn < 8 ? u.pn : u.pn + 8) * P; return true; }
        if (L < 768) { tile_map(L - 512, 8, 32, u.pm, u.pn); u.kind = 2; u.a = W + (8 + u.pm) * P; u.b = XN + u.pn * P; return true; }
        return false;
    }
    __device__ __forceinline__ void a_ready(const Unit&) const {}
    __device__ __forceinline__ void done(const Unit&) const {}
};
struct SchedInB {
    int G, c; const char* XN; const char* W;
    __device__ __forceinline__ bool next(int i, Unit& u) const {
        const int L = i * G + c; const size_t P = (size_t)BM * 2048 * 2;
        if (L < 544) { tile_map(L, 32, 17, u.pm, u.pn); u.kind = u.pn < 8 ? 0 : (u.pn < 16 ? 1 : 2); u.a = XN + u.pm * P; u.b = W + u.pn * P; return true; }
        if (L < 576) { u.pm = 0; u.pn = L - 544; u.kind = 3; u.a = W + 17 * P; u.b = XN + u.pn * P; return true; }
        return false;
    }
    __device__ __forceinline__ void a_ready(const Unit&) const {}
    __device__ __forceinline__ void done(const Unit&) const {}
};
struct SchedOut {
    int G, c; const char* A; const char* W;
    __device__ __forceinline__ bool next(int i, Unit& u) const {
        const int L = i * G + c; const size_t P = (size_t)BM * 2048 * 2;
        if (L >= 256) return false;
        tile_map(L, 32, 8, u.pm, u.pn); u.kind = 0; u.a = A + u.pm * P; u.b = W + u.pn * P; return true;
    }
    __device__ __forceinline__ void a_ready(const Unit&) const {}
    __device__ __forceinline__ void done(const Unit&) const {}
};
template <class Epi, class Sched, bool ALIGN_EPI = false, bool SP2 = false>
__device__ __forceinline__ void gemm_phase(PG8_LAS unsigned char* lds, const int K_, const Sched& S, const Epi& E) {
    const int tid = threadIdx.x, wid = __builtin_amdgcn_readfirstlane(tid >> 6), lane = tid & 63, wr = wid >> 2, wc = wid & 3, fr = lane & 15, fq = lane >> 4;
    const int K = K_, nt = K / BK;
    unsigned voffA[2], voffB[2];
#pragma unroll
    for (int i = 0; i < 2; ++i) { int R, C; stage_rc(tid * 16 + i * 8192, R, C); const int Rb = Epi::PERM ? ((R & ~31) + perm32(R & 31)) : R;
        voffA[i] = (unsigned)(R * K + C) * 2u; voffB[i] = (unsigned)(Rb * K + C) * 2u; }
    const size_t kstep = (size_t)(BK * 2);
    const size_t hstep = (size_t)HALF * K * 2;
    const unsigned ldsw = (unsigned)wid * 1024u;
    const int aoff = lds_byte(wr * 64 + fr, fq * 8), boff = lds_byte(wc * 32 + fr, fq * 8);
#define PG8_SA(b, h) (((b) * 2 + (h)) * HTB)
#define PG8_SB(b, h) ((4 + (b) * 2 + (h)) * HTB)
#define PG8_STAGE(bufoff, gbase, voff) do { _Pragma("unroll") for (int _i = 0; _i < 2; ++_i) \
        __builtin_amdgcn_global_load_lds((const unsigned*)((const char*)(gbase) + (voff)[_i]), (PG8_LAS unsigned*)(lds + (bufoff) + ldsw + _i * 8192), 16, 0, 0); } while (0)
#define PG8_LDA(dst, b, h) do { _Pragma("unroll") for (int m = 0; m < 4; ++m) _Pragma("unroll") for (int k = 0; k < 2; ++k) dst[m][k] = *(const PG8_LAS bf16x8*)(lds + PG8_SA(b, h) + aoff + m * 2048 + k * 1024); } while (0)
#define PG8_LDB(dst, b, h) do { _Pragma("unroll") for (int n = 0; n < 2; ++n) _Pragma("unroll") for (int k = 0; k < 2; ++k) dst[n][k] = *(const PG8_LAS bf16x8*)(lds + PG8_SB(b, h) + boff + n * 2048 + k * 1024); } while (0)
#define PG8_MMA(ai, bj, At, Bt) do { __builtin_amdgcn_s_setprio(1); _Pragma("unroll") for (int m = 0; m < 4; ++m) _Pragma("unroll") for (int n = 0; n < 2; ++n) _Pragma("unroll") for (int k = 0; k < 2; ++k) \
        acc[ai][bj][m][n] = __builtin_amdgcn_mfma_f32_16x16x32_bf16(Bt[n][k], At[m][k], acc[ai][bj][m][n], 0, 0, 0); __builtin_amdgcn_s_setprio(0); } while (0)
#define PG8_WAIT_V(n) asm volatile("s_waitcnt vmcnt(" #n ")" ::: "memory")
#define PG8_WAIT_L(n) asm volatile("s_waitcnt lgkmcnt(" #n ")" ::: "memory")
#define PG8_BAR __builtin_amdgcn_s_barrier()
#define PG8_SCHED __builtin_amdgcn_sched_barrier(0)
    Unit cur, nxt; int ui = 0;
    if (!S.next(0, cur)) return;
    f32x4 acc[2][2][4][2];
#pragma unroll
    for (int a = 0; a < 2; ++a)
#pragma unroll
        for (int b = 0; b < 2; ++b)
#pragma unroll
            for (int m = 0; m < 4; ++m)
#pragma unroll
                for (int n = 0; n < 2; ++n) acc[a][b][m][n] = (f32x4){0.f, 0.f, 0.f, 0.f};
    bf16x8 At[4][2], B0[2][2], B1[2][2];
    const char* cA = cur.a; const char* cB = cur.b;
    S.a_ready(cur);
    if constexpr (SP2) {
        PG8_STAGE(PG8_SB(0, 0), cB, voffB); PG8_STAGE(PG8_SB(0, 1), cB + hstep, voffB); PG8_STAGE(PG8_SA(0, 0), cA, voffA); PG8_STAGE(PG8_SA(0, 1), cA + hstep, voffA);
        if (wr == 1) PG8_BAR;
        PG8_WAIT_V(2); PG8_BAR;
        PG8_STAGE(PG8_SB(1, 0), cB + kstep, voffB); PG8_STAGE(PG8_SA(1, 0), cA + kstep, voffA); PG8_STAGE(PG8_SB(1, 1), cB + hstep + kstep, voffB);
        PG8_WAIT_V(6); PG8_BAR;
    } else {
        PG8_STAGE(PG8_SB(0, 0), cB, voffB); PG8_STAGE(PG8_SA(0, 0), cA, voffA); PG8_STAGE(PG8_SB(0, 1), cB + hstep, voffB); PG8_STAGE(PG8_SA(0, 1), cA + hstep, voffA);
        if (wr == 1) PG8_BAR;
        PG8_WAIT_V(4); PG8_BAR;
        PG8_STAGE(PG8_SB(1, 0), cB + kstep, voffB); PG8_STAGE(PG8_SA(1, 0), cA + kstep, voffA); PG8_STAGE(PG8_SB(1, 1), cB + hstep + kstep, voffB);
        PG8_WAIT_V(6); PG8_BAR;
    }
    for (;;) {
        const bool has_next = S.next(ui + 1, nxt);
        const char* nA = has_next ? nxt.a : cA; const char* nB = has_next ? nxt.b : cB;
        for (int t = 0; t < nt; t += 2) {
            const bool last = (t == nt - 2);
            const char* a1 = cA + (size_t)(t + 1) * kstep;
            const char* a2 = last ? nA : cA + (size_t)(t + 2) * kstep; const char* b2 = last ? nB : cB + (size_t)(t + 2) * kstep;
            const char* a3 = a2 + kstep; const char* b3 = b2 + kstep;
            if (last && has_next) S.a_ready(nxt);
            if constexpr (SP2) {
            PG8_LDB(B0, 0, 0); PG8_LDB(B1, 0, 1); PG8_SCHED; PG8_LDA(At, 0, 0); PG8_STAGE(PG8_SA(1, 1), a1 + hstep, voffA);
            PG8_WAIT_V(8); PG8_WAIT_L(0); PG8_BAR; PG8_MMA(0, 0, At, B0); PG8_MMA(0, 1, At, B1); PG8_BAR; PG8_SCHED;
            PG8_LDA(At, 0, 1); PG8_STAGE(PG8_SB(0, 0), b2, voffB); PG8_STAGE(PG8_SB(0, 1), b2 + hstep, voffB); PG8_STAGE(PG8_SA(0, 0), a2, voffA);
            PG8_WAIT_V(8); PG8_WAIT_L(0); PG8_BAR; PG8_MMA(1, 0, At, B0); PG8_MMA(1, 1, At, B1); PG8_BAR; PG8_SCHED;
            PG8_LDB(B0, 1, 0); PG8_LDB(B1, 1, 1); PG8_SCHED; PG8_LDA(At, 1, 0); PG8_STAGE(PG8_SA(0, 1), a2 + hstep, voffA);
            PG8_WAIT_V(8); PG8_WAIT_L(0); PG8_BAR; PG8_MMA(0, 0, At, B0); PG8_MMA(0, 1, At, B1); PG8_BAR; PG8_SCHED;
            PG8_LDA(At, 1, 1); PG8_STAGE(PG8_SB(1, 0), b3, voffB); PG8_STAGE(PG8_SB(1, 1), b3 + hstep, voffB); PG8_STAGE(PG8_SA(1, 0), a3, voffA);
            PG8_WAIT_V(8); PG8_WAIT_L(0); PG8_BAR; PG8_MMA(1, 0, At, B0); PG8_MMA(1, 1, At, B1); PG8_BAR; PG8_SCHED;
            } else {
            PG8_LDB(B0, 0, 0); PG8_SCHED; PG8_LDA(At, 0, 0); PG8_STAGE(PG8_SA(1, 1), a1 + hstep, voffA);
            PG8_WAIT_L(8); PG8_BAR; PG8_WAIT_L(0); PG8_MMA(0, 0, At, B0); PG8_BAR; PG8_SCHED;
            PG8_LDB(B1, 0, 1); PG8_STAGE(PG8_SB(0, 0), b2, voffB);
            PG8_BAR; PG8_WAIT_L(0); PG8_MMA(0, 1, At, B1); PG8_BAR;
            PG8_LDA(At, 0, 1); PG8_STAGE(PG8_SA(0, 0), a2, voffA);
            PG8_BAR; PG8_WAIT_L(0); PG8_MMA(1, 0, At, B0); PG8_BAR; PG8_SCHED;
            PG8_STAGE(PG8_SB(0, 1), b2 + hstep, voffB);
            PG8_WAIT_V(6); PG8_BAR; PG8_MMA(1, 1, At, B1); PG8_BAR;
            PG8_LDB(B0, 1, 0); PG8_SCHED; PG8_LDA(At, 1, 0); PG8_STAGE(PG8_SA(0, 1), a2 + hstep, voffA);
            PG8_WAIT_L(8); PG8_BAR; PG8_WAIT_L(0); PG8_MMA(0, 0, At, B0); PG8_BAR; PG8_SCHED;
            PG8_LDB(B1, 1, 1); PG8_STAGE(PG8_SB(1, 0), b3, voffB);
            PG8_BAR; PG8_WAIT_L(0); PG8_MMA(0, 1, At, B1); PG8_BAR;
            PG8_LDA(At, 1, 1); PG8_STAGE(PG8_SA(1, 0), a3, voffA);
            PG8_BAR; PG8_WAIT_L(0); PG8_MMA(1, 0, At, B0); PG8_BAR; PG8_SCHED;
            PG8_STAGE(PG8_SB(1, 1), b3 + hstep, voffB);
            PG8_WAIT_V(6); PG8_BAR; PG8_MMA(1, 1, At, B1); PG8_BAR;
            }
        }
        if constexpr (ALIGN_EPI) { if (wr == 0) PG8_BAR; }
        if constexpr (!Epi::AFTER_DRAIN) { E(acc, cur, wr, wc, fr, fq); S.done(cur); }
        if (!has_next) break;
#pragma unroll
        for (int a = 0; a < 2; ++a)
#pragma unroll
            for (int b = 0; b < 2; ++b)
#pragma unroll
                for (int m = 0; m < 4; ++m)
#pragma unroll
                    for (int n = 0; n < 2; ++n) acc[a][b][m][n] = (f32x4){0.f, 0.f, 0.f, 0.f};
        cur = nxt; cA = nA; cB = nB; ++ui;
        if constexpr (ALIGN_EPI) { if (wr == 1) PG8_BAR; }
    }
    PG8_WAIT_V(0);
    if constexpr (!ALIGN_EPI) { if (wr == 0) PG8_BAR; }
    PG8_BAR;
    if constexpr (Epi::AFTER_DRAIN) { E.fused(acc, cur, wr, wc, fr, fq, lds, wid, lane); S.done(cur); }
#undef PG8_SA
#undef PG8_SB
#undef PG8_STAGE
#undef PG8_LDA
#undef PG8_LDB
#undef PG8_MMA
#undef PG8_WAIT_V
#undef PG8_WAIT_L
#undef PG8_BAR
#undef PG8_SCHED
}
}
#define GAS __attribute__((address_space(1)))
#define LAS __attribute__((address_space(3)))
typedef unsigned short bf16;
typedef unsigned v4u __attribute__((ext_vector_type(4)));
typedef float f32x4 __attribute__((ext_vector_type(4)));
typedef short bf16x8 __attribute__((ext_vector_type(8)));
typedef GAS unsigned gu32;
typedef GAS unsigned long long gu64;
#define RLX_AGENT __ATOMIC_RELAXED, __HIP_MEMORY_SCOPE_AGENT
#define LDS_WAIT() asm volatile("s_waitcnt lgkmcnt(0)" ::: "memory")
#define VM_WAIT() asm volatile("s_waitcnt vmcnt(0)" ::: "memory")
__device__ __forceinline__ unsigned long long rt() { return __builtin_amdgcn_s_memrealtime(); }
__device__ __forceinline__ unsigned f2bf(float f) { unsigned u = __builtin_bit_cast(unsigned, f); return (u + 0x7fffu + ((u >> 16) & 1u)) >> 16; }
__device__ __forceinline__ unsigned pk2(float lo, float hi) { return f2bf(lo) | (f2bf(hi) << 16); }

#define XB_TMO      128
#define XB_XCNT(j)  (256  + 64 * (j))
#define XB_XSUB(j)  (1280 + 64 * (j))
#define XB_XGEN(j)  (2304 + 64 * (j))
#define XB_TOP      3328
#define XB_TOPGEN   3392
#define XCD_BAR_WORDS 3456
#define XB_SPIN_CAP (1u << 18)

__device__ __forceinline__ unsigned xb_ld(unsigned* p)              { return __hip_atomic_load(p, __ATOMIC_RELAXED, __HIP_MEMORY_SCOPE_AGENT); }
__device__ __forceinline__ unsigned xb_add(unsigned* p, unsigned v) { return __hip_atomic_fetch_add(p, v, __ATOMIC_RELAXED, __HIP_MEMORY_SCOPE_AGENT); }
__device__ __forceinline__ unsigned xb_xcc_id() { return (unsigned)__builtin_amdgcn_s_getreg((3 << 11) | 20) & 0xFu; }
#define XB_SPIN(cond, bar) do { unsigned _sp = 0; while (cond) { __builtin_amdgcn_s_sleep(1); \
    if ((++_sp & 255u) == 0u) { if (xb_ld(&(bar)[XB_TMO])) break; if (_sp > XB_SPIN_CAP) { atomicAdd(&(bar)[XB_TMO], 1u); break; } } } } while (0)

struct XcdBarrier {
    unsigned* bar; unsigned x;
    volatile LAS unsigned* st;
};

__device__ __forceinline__ XcdBarrier xcd_barrier_post(unsigned* bar, volatile LAS unsigned* st) {
    XcdBarrier b; b.bar = bar; b.x = xb_xcc_id(); b.st = st;
    if (threadIdx.x == 0) (void)xb_add(&bar[XB_XCNT(b.x)], 1u);
    return b;
}
__device__ __forceinline__ void xcd_barrier_complete(unsigned* bar, unsigned x, unsigned& nloc, unsigned& nx) {
    const unsigned G = gridDim.x * gridDim.y * gridDim.z;
    unsigned sum, cnt, mine, sp = 0u;
    for (;;) {
        sum = 0u; cnt = 0u; mine = 0u;
#pragma unroll
        for (unsigned j = 0; j < 16; ++j) { const unsigned c = xb_ld(&bar[XB_XCNT(j)]); sum += c; cnt += (c > 0u) ? 1u : 0u; mine = (j == x) ? c : mine; }
        if (sum == G) break;
        __builtin_amdgcn_s_sleep(1);
        if ((++sp & 255u) == 0u) { if (xb_ld(&bar[XB_TMO])) break; if (sp > XB_SPIN_CAP) { atomicAdd(&bar[XB_TMO], 1u); break; } }
    }
    nloc = mine > 0u ? mine : 1u; nx = cnt > 0u ? cnt : 1u;
}

__device__ __forceinline__ void xcd_barrier(const XcdBarrier& b) {
    asm volatile("s_waitcnt vmcnt(0)" ::: "memory");
    __syncthreads();
    if (threadIdx.x == 0) {
        unsigned* bar = b.bar;
        __builtin_amdgcn_s_waitcnt(0);
        unsigned nloc = b.st[0], nx = b.st[1];
        if (nloc == 0u) { xcd_barrier_complete(bar, b.x, nloc, nx); b.st[0] = nloc; b.st[1] = nx; }
        const unsigned old = xb_add(&bar[XB_XSUB(b.x)], 1u);
        const unsigned gen = old / nloc;
        if (old + 1u == (gen + 1u) * nloc) {
            __builtin_amdgcn_fence(__ATOMIC_RELEASE, "agent");
            asm volatile("s_waitcnt vmcnt(0)" ::: "memory");
            const unsigned og = xb_add(&bar[XB_TOP], 1u);
            const unsigned tg = og / nx;
            if (og + 1u == (tg + 1u) * nx) xb_add(&bar[XB_TOPGEN], 1u);
            else XB_SPIN(xb_ld(&bar[XB_TOPGEN]) == tg, bar);
            __builtin_amdgcn_fence(__ATOMIC_ACQUIRE, "agent");
            xb_add(&bar[XB_XGEN(b.x)], 1u);
            asm volatile("s_waitcnt vmcnt(0)" ::: "memory");
        } else {
            XB_SPIN(xb_ld(&bar[XB_XGEN(b.x)]) == gen, bar);
            __builtin_amdgcn_fence(__ATOMIC_ACQUIRE, "agent");
            asm volatile("s_waitcnt vmcnt(0)" ::: "memory");
        }
    }
    __syncthreads();
}
constexpr int NWAVES = 8;
constexpr int MPR = 8192, MSM = 256, MT = MPR + MSM;
constexpr int DM = 2048;
constexpr float RMS_EPS = 1e-6f;
constexpr float LOG2E = 1.4426950408889634f;
constexpr size_t MiB = 1u << 20;
constexpr size_t WS_CTL = 0, CTL_ZERO_BYTES = 64 * 1024;
constexpr size_t WS_WINA = 1 * MiB;
constexpr size_t WS_WOA = 26 * MiB;
constexpr size_t WS_WINB = 34 * MiB;
constexpr size_t WS_WOB = 52 * MiB;
constexpr size_t WS_BUFA = 60 * MiB;
constexpr size_t WS_QK = 93 * MiB;
constexpr size_t WS_VT = 126 * MiB;
constexpr size_t WS_QZ = 93 * MiB;
constexpr size_t WS_SR = 159 * MiB;
constexpr size_t WS_REC = 192 * MiB;
constexpr size_t WS_KB = 192 * MiB;
constexpr size_t WS_VT2 = 198 * MiB;
constexpr size_t WS_GLOW = 234 * MiB;
constexpr size_t WS_SSQP = 235 * MiB;
constexpr size_t WS_END = 240 * MiB;
constexpr int CW_BAR = 1024;
constexpr int REC_QT = 0, REC_KT = 33792, REC_P = 33792 + 40960, REC_G = REC_P + 10240, REC_BYTES = REC_G + 1024;
static_assert(REC_BYTES == 86016 && 512 * (size_t)REC_BYTES <= 42 * MiB, "record");
constexpr size_t OUT_Y = 0, OUT_GLAP = 17301504, OUT_GLAS = 19398656, OUT_KWP = 36175872, OUT_VWP = 36306944, OUT_KWS = 36438016, OUT_VWS = 37486592, OUT_TOTAL = 38535168;
constexpr int RING_BYTES = 131072, LDSCTL_OFF = RING_BYTES, MISC_OFF = LDSCTL_OFF + 320, LDS_BYTES = 147456;

__device__ __forceinline__ float bf2f(unsigned short u) { return __uint_as_float(((unsigned)u) << 16); }
__device__ __forceinline__ unsigned cvtpk2(float lo, float hi) { return pg8::cvtpk(lo, hi); }
__device__ __forceinline__ float wave_sum(float v) {
#pragma unroll
    for (int o = 1; o < 64; o <<= 1) v += __shfl_xor(v, o);
    return v;
}
#define MFMA16(a, b, c) __builtin_amdgcn_mfma_f32_16x16x32_bf16((a), (b), (c), 0, 0, 0)
typedef unsigned u32x2 __attribute__((ext_vector_type(2)));

struct Ptrs {
    const float *x_prompt, *x_sample, *state, *ck, *cv, *g_norm_a, *w_in_a, *w_gate_up, *b_gate, *g_onorm, *w_out_a, *g_norm_kv, *w_kv, *g_norm_b, *w_in_b, *sinks, *w_out_b, *g_final;
    float* out; unsigned char* ws;
};

__device__ __forceinline__ void p0_transpose_item(const float* W, int ldw, int ncol0, int nvalid, const float* gain, int scale_cols, float scale, bf16* WT, int row_off, LAS float* scr, int kb, int nb, int lane) {
    const int k0 = 64 * kb, n0 = 32 * nb, nl = lane & 31; const bool ok = (n0 + nl) < nvalid; const float cs = (n0 + nl) < scale_cols ? scale : 1.0f;
#pragma unroll 8
    for (int i = 0; i < 32; ++i) { const int kk = 2 * i + (lane >> 5); float v = ok ? W[(size_t)(k0 + kk) * ldw + ncol0 + n0 + nl] : 0.f; if (gain) v *= gain[k0 + kk]; scr[kk * 33 + nl] = v * cs; }
    LDS_WAIT(); asm volatile("" ::: "memory");
    const int c = lane & 7;
#pragma unroll
    for (int j = 0; j < 4; ++j) { const int n = (lane >> 3) + 8 * j; const LAS float* s = scr + (8 * c) * 33 + n;
        v4u o; o.x = cvtpk2(s[0 * 33], s[1 * 33]); o.y = cvtpk2(s[2 * 33], s[3 * 33]); o.z = cvtpk2(s[4 * 33], s[5 * 33]); o.w = cvtpk2(s[6 * 33], s[7 * 33]);
        if (n0 + n < nvalid) *(GAS v4u*)(WT + (size_t)(row_off + n0 + n) * 2048 + k0 + 8 * c) = o; }
    LDS_WAIT(); asm volatile("" ::: "memory");
}
__device__ __forceinline__ void rms_row_to_bf16(const float* xrow, bf16* orow, int lane) {
    const GAS f32x4* xr = (const GAS f32x4*)xrow + lane;
    f32x4 v[8]; float s = 0.f;
#pragma unroll
    for (int j = 0; j < 8; ++j) { v[j] = xr[64 * j]; s += (v[j].x * v[j].x + v[j].y * v[j].y) + (v[j].z * v[j].z + v[j].w * v[j].w); }
    const float rstd = 1.0f / sqrtf(wave_sum(s) * (1.f / DM) + RMS_EPS);
    GAS u32x2* o8 = (GAS u32x2*)orow + lane;
#pragma unroll
    for (int j = 0; j < 8; ++j) { u32x2 w; w.x = cvtpk2(v[j].x * rstd, v[j].y * rstd); w.y = cvtpk2(v[j].z * rstd, v[j].w * rstd); o8[64 * j] = w; }
}
__device__ __forceinline__ void p0_transpose_big(const float* W, int ldw, const float* gain, float cs, bf16* WT, int row_off, LAS unsigned char* scr, int kb, int nb, int lane) {
    const int k0 = 64 * kb, n0 = 128 * nb, hl = lane >> 5, nl = lane & 31;
    const GAS f32x4* src = (const GAS f32x4*)(W + (size_t)(k0 + 32 * hl) * ldw + n0 + 4 * nl);
    f32x4 v[32];
#pragma unroll
    for (int i = 0; i < 32; ++i) v[i] = src[(size_t)i * (ldw / 4)];
    f32x4 gk[8];
#pragma unroll
    for (int i = 0; i < 8; ++i) gk[i] = gain ? *(const GAS f32x4*)(gain + k0 + 32 * hl + 4 * i) * cs : (f32x4){cs, cs, cs, cs};
#pragma unroll
    for (int j = 0; j < 4; ++j) { const int n = 4 * nl + j;
#pragma unroll
        for (int q = 0; q < 4; ++q) { v4u o;
            o.x = cvtpk2(v[8 * q + 0][j] * gk[2 * q][0], v[8 * q + 1][j] * gk[2 * q][1]); o.y = cvtpk2(v[8 * q + 2][j] * gk[2 * q][2], v[8 * q + 3][j] * gk[2 * q][3]);
            o.z = cvtpk2(v[8 * q + 4][j] * gk[2 * q + 1][0], v[8 * q + 5][j] * gk[2 * q + 1][1]); o.w = cvtpk2(v[8 * q + 6][j] * gk[2 * q + 1][2], v[8 * q + 7][j] * gk[2 * q + 1][3]);
            *(LAS v4u*)(scr + n * 128 + (((4 * hl + q) ^ (n & 7)) << 4)) = o; } }
    LDS_WAIT(); asm volatile("" ::: "memory");
#pragma unroll
    for (int it = 0; it < 16; ++it) { const int idx = it * 64 + lane, n = idx >> 3, ch = idx & 7;
        const v4u o = *(const LAS v4u*)(scr + n * 128 + ((ch ^ (n & 7)) << 4));
        *(GAS v4u*)(WT + (size_t)(row_off + n0 + n) * 2048 + k0 + 8 * ch) = o; }
    LDS_WAIT(); asm volatile("" ::: "memory");
}
__device__ __forceinline__ void p0_prologue(const Ptrs& P, LAS unsigned char* lds, int vcu, int G, int tid, int wave, int lane) {
    LAS unsigned char* scr = lds + wave * 16384;
    const int gw = vcu * NWAVES + wave, NGW = G * NWAVES;
    bf16* WinaT = (bf16*)(P.ws + WS_WINA); bf16* WoaT = (bf16*)(P.ws + WS_WOA); bf16* WinbT = (bf16*)(P.ws + WS_WINB); bf16* WobT = (bf16*)(P.ws + WS_WOB);
    constexpr int I0 = 32 * 48, I2 = 32 * 16, I3 = 32 * 32, I4 = 32 * 4, I5 = 32 * 16, I1 = 32, NIT = I0 + I2 + I3 + I4 + I5;
    for (int it = gw; it < NIT; it += NGW) {
        int r = it;
        if (r < I0) { const int nb = r % 48; p0_transpose_big(P.w_in_a, 6160, P.g_norm_a, nb < 8 ? 0.0625f : 1.f, WinaT, 0, scr, r / 48, nb, lane); continue; } r -= I0;
        if (r < I2) { p0_transpose_big(P.w_out_a, 2048, P.g_onorm, 1.f, WoaT, 0, scr, r / 16, r % 16, lane); continue; } r -= I2;
        if (r < I3) { const int nb = r % 32; p0_transpose_big(P.w_in_b, 4096, P.g_norm_b, nb < 16 ? 0.125f * LOG2E : 1.f, WinbT, 0, scr, r / 32, nb, lane); continue; } r -= I3;
        if (r < I4) { p0_transpose_big(P.w_kv, 512, P.g_norm_kv, 1.f, WinbT, 4096, scr, r / 4, r % 4, lane); continue; } r -= I4;
        p0_transpose_big(P.w_out_b, 2048, nullptr, 1.f, WobT, 0, scr, r / 16, r % 16, lane);
    }
    for (int it = NGW - 1 - gw; it < I1; it += NGW) p0_transpose_item(P.w_in_a, 6160, 6144, 16, P.g_norm_a, 0, 1.f, WinaT, 6144, (LAS float*)scr, it, 0, lane);
    bf16* XN = (bf16*)(P.ws + WS_BUFA);
    for (int m = gw; m < MT; m += NGW) rms_row_to_bf16(m < MPR ? P.x_prompt + (size_t)m * DM : P.x_sample + (size_t)(m - MPR) * DM, XN + (size_t)m * DM, lane);
    const int gt = vcu * (NWAVES * 64) + tid, NGT = G * NWAVES * 64;
    for (int i = gt; i < 32 * 120 * 64; i += NGT) { const int b = i / (120 * 64), rem = i % (120 * 64);
        ((f32x4*)(P.out + OUT_KWS))[(size_t)b * 128 * 64 + rem] = ((const f32x4*)P.ck)[(size_t)b * 128 * 64 + 8 * 64 + rem];
        ((f32x4*)(P.out + OUT_VWS))[(size_t)b * 128 * 64 + rem] = ((const f32x4*)P.cv)[(size_t)b * 128 * 64 + 8 * 64 + rem]; }
}

__device__ __forceinline__ void glow_task(const bf16* XN, const bf16* WgT, float* GLOW, int task, int lane) {
    const int r = lane & 15, g = lane >> 4, row0 = task * 16;
    const bf16* ap = XN + (size_t)(row0 + r) * DM + g * 8; const bf16* bp = WgT + (size_t)r * DM + g * 8;
    f32x4 acc = {0.f, 0.f, 0.f, 0.f};
#pragma unroll 8
    for (int kk = 0; kk < 64; ++kk) { const bf16x8 a = *(const bf16x8*)(ap + kk * 32); const bf16x8 b = *(const bf16x8*)(bp + kk * 32); acc = MFMA16(a, b, acc); }
#pragma unroll
    for (int i = 0; i < 4; ++i) GLOW[(size_t)(row0 + 4 * g + i) * 16 + r] = acc[i];
}

__device__ __forceinline__ void gla_prep_unit(const Ptrs& P, LAS unsigned char* lds, int u, int tid, int wave, int lane) {
    const int c = u & 31, h = (u >> 5) & 3, b = u >> 7;
    const int d = tid & 255, th = tid >> 8;
    LAS float* GL = (LAS float*)lds;
    LAS float* TOT = (LAS float*)(lds + 4096);
    LAS bf16* QT = (LAS bf16*)(lds + 8192);
    LAS bf16* KS = (LAS bf16*)(lds + 8192 + 33792);
    const int row0 = b * 2048 + c * 64;
    const float* GLOW = (const float*)(P.ws + WS_GLOW);
    const bf16* QK = (const bf16*)(P.ws + WS_QK);
    unsigned char* rec = P.ws + WS_REC + (size_t)u * REC_BYTES;
    if (tid < 256) ((LAS f32x4*)GL)[tid] = ((const f32x4*)(GLOW + (size_t)row0 * 16))[tid];
    float wg[16];
#pragma unroll
    for (int r = 0; r < 16; ++r) wg[r] = P.w_gate_up[r * 1024 + h * 256 + d];
    const float bias = P.b_gate[h * 256 + d];
    __syncthreads();
    float bl[32]; float run = 0.f;
#pragma unroll
    for (int tt = 0; tt < 32; ++tt) { const int t = th * 32 + tt; const LAS f32x4* gr = (const LAS f32x4*)(GL + t * 16);
        const f32x4 g0 = gr[0], g1 = gr[1], g2 = gr[2], g3 = gr[3];
        float z = bias + g0.x * wg[0] + g0.y * wg[1] + g0.z * wg[2] + g0.w * wg[3] + g1.x * wg[4] + g1.y * wg[5] + g1.z * wg[6] + g1.w * wg[7]
                       + g2.x * wg[8] + g2.y * wg[9] + g2.z * wg[10] + g2.w * wg[11] + g3.x * wg[12] + g3.y * wg[13] + g3.z * wg[14] + g3.w * wg[15];
        const float ls = fminf(z, 0.f) - __logf(1.0f + __expf(-fabsf(z)));
        run += ls * 0.0625f; bl[tt] = run; }
    TOT[th * 256 + d] = run;
    __syncthreads();
    const float tot0 = TOT[d], tot1 = TOT[256 + d], blast = tot0 + tot1, base = th ? tot0 : 0.f;
    unsigned kt[16];
    const bf16* qp = QK + (size_t)(row0 + th * 32) * DM + h * 256 + d;
#pragma unroll
    for (int tt = 0; tt < 32; tt += 2) {
        float kv2[2];
#pragma unroll
        for (int k2 = 0; k2 < 2; ++k2) { const int t = th * 32 + tt + k2; const float bt = base + bl[tt + k2];
            const float e1 = __expf(bt - blast), e2 = __expf(blast - bt);
            const float q = bf2f(qp[(size_t)(tt + k2) * DM]), k = bf2f(qp[(size_t)(tt + k2) * DM + 1024]);
            const float qv = q * e1, kv = k * e2; kv2[k2] = kv;
            QT[t * 264 + d] = (bf16)(cvtpk2(qv, 0.f) & 0xffffu); KS[t * 264 + d] = (bf16)(cvtpk2(kv, 0.f) & 0xffffu); }
        kt[tt >> 1] = cvtpk2(kv2[0], kv2[1]); }
    { GAS v4u* kd = (GAS v4u*)(rec + REC_KT + d * 160 + th * 64);
#pragma unroll
      for (int i = 0; i < 4; ++i) { v4u o; o.x = kt[4 * i]; o.y = kt[4 * i + 1]; o.z = kt[4 * i + 2]; o.w = kt[4 * i + 3]; kd[i] = o; } }
    if (th == 0) ((GAS float*)(rec + REC_G))[d] = __expf(blast);
    __syncthreads();
    { const int r = lane & 15, g = lane >> 4, mt = wave >> 1, st0 = 2 * (wave & 1);
      f32x4 a0 = {0.f, 0.f, 0.f, 0.f}, a1 = {0.f, 0.f, 0.f, 0.f};
#pragma unroll
      for (int kk = 0; kk < 8; ++kk) { const bf16x8 bq = *(const LAS bf16x8*)(QT + (16 * mt + r) * 264 + 32 * kk + 8 * g);
          const bf16x8 k0 = *(const LAS bf16x8*)(KS + (16 * st0 + r) * 264 + 32 * kk + 8 * g); const bf16x8 k1 = *(const LAS bf16x8*)(KS + (16 * st0 + 16 + r) * 264 + 32 * kk + 8 * g);
          a0 = MFMA16(k0, bq, a0); a1 = MFMA16(k1, bq, a1); }
      const int t = 16 * mt + r;
#pragma unroll
      for (int j = 0; j < 2; ++j) { const f32x4 a = j ? a1 : a0; const int s0 = 16 * (st0 + j) + 4 * g;
          u32x2 w; w.x = cvtpk2(s0 + 0 <= t ? a[0] : 0.f, s0 + 1 <= t ? a[1] : 0.f); w.y = cvtpk2(s0 + 2 <= t ? a[2] : 0.f, s0 + 3 <= t ? a[3] : 0.f);
          *(GAS u32x2*)(rec + REC_P + t * 160 + s0 * 2) = w; } }
    for (int i = tid; i < 2112; i += NWAVES * 64) ((GAS v4u*)(rec + REC_QT))[i] = ((const LAS v4u*)QT)[i];
    __syncthreads();
}

__device__ __forceinline__ void gla_scan_unit(const Ptrs& P, LAS unsigned char* lds, int bh, int slice, int tid, int wave, int lane) {
    const int b = bh >> 2, h = bh & 3, r = lane & 15, g = lane >> 4;
    const int ecol = h * 512 + slice * 128 + 16 * wave;
    const bf16* VT = (const bf16*)(P.ws + WS_VT);
    bf16* ORAW = (bf16*)(P.ws + WS_BUFA);
    float* SSQP = (float*)(P.ws + WS_SSQP);
    const unsigned char* rec0 = P.ws + WS_REC + (size_t)(bh * 32) * REC_BYTES;
    const LAS bf16* QT = (const LAS bf16*)(lds + REC_QT); const LAS bf16* KT = (const LAS bf16*)(lds + REC_KT); const LAS bf16* PL = (const LAS bf16*)(lds + REC_P); const LAS float* GL = (const LAS float*)(lds + REC_G);
    f32x4 S[16];
#pragma unroll
    for (int i = 0; i < 16; ++i) S[i] = (f32x4){0.f, 0.f, 0.f, 0.f};
    v4u pf[11];
    constexpr int N16 = REC_BYTES / 16;
#define REC_LOAD(recp) do { _Pragma("unroll") for (int i_ = 0; i_ < 11; ++i_) { const int idx_ = tid + 512 * i_; if (idx_ < N16) pf[i_] = ((const GAS v4u*)(recp))[idx_]; } } while (0)
#define REC_STORE() do { _Pragma("unroll") for (int i_ = 0; i_ < 11; ++i_) { const int idx_ = tid + 512 * i_; if (idx_ < N16) ((LAS v4u*)lds)[idx_] = pf[i_]; } } while (0)
    REC_LOAD(rec0); REC_STORE();
    __syncthreads();
    for (int c = 0; c < 32; ++c) {
        if (c + 1 < 32) REC_LOAD(rec0 + (size_t)(c + 1) * REC_BYTES);
        const int row0 = b * 2048 + c * 64;
        bf16x8 vf[2];
#pragma unroll
        for (int ks = 0; ks < 2; ++ks) vf[ks] = *(const bf16x8*)(VT + (size_t)(ecol + r) * MT + row0 + 32 * ks + 8 * g);
#pragma unroll
        for (int dt = 0; dt < 16; ++dt) { const f32x4 gm = *(const LAS f32x4*)(GL + 16 * dt + 4 * g); S[dt] = S[dt] * gm; }
        f32x4 Z[4];
#pragma unroll
        for (int tt = 0; tt < 4; ++tt) Z[tt] = (f32x4){0.f, 0.f, 0.f, 0.f};
#pragma unroll
        for (int kk = 0; kk < 8; ++kk) {
            v4u af; af.x = cvtpk2(S[2 * kk][0], S[2 * kk][1]); af.y = cvtpk2(S[2 * kk][2], S[2 * kk][3]); af.z = cvtpk2(S[2 * kk + 1][0], S[2 * kk + 1][1]); af.w = cvtpk2(S[2 * kk + 1][2], S[2 * kk + 1][3]);
            const bf16x8 afr = __builtin_bit_cast(bf16x8, af);
#pragma unroll
            for (int tt = 0; tt < 4; ++tt) { const LAS bf16* qrow = QT + (16 * tt + r) * 264 + 32 * kk + 4 * g;
                const u32x2 lo = *(const LAS u32x2*)qrow, hi = *(const LAS u32x2*)(qrow + 16);
                v4u bq; bq.x = lo.x; bq.y = lo.y; bq.z = hi.x; bq.w = hi.y;
                Z[tt] = MFMA16(afr, __builtin_bit_cast(bf16x8, bq), Z[tt]); } }
#pragma unroll
        for (int ks = 0; ks < 2; ++ks)
#pragma unroll
            for (int tt = 0; tt < 4; ++tt) { const bf16x8 pb = *(const LAS bf16x8*)(PL + (16 * tt + r) * 80 + 32 * ks + 8 * g); Z[tt] = MFMA16(vf[ks], pb, Z[tt]); }
#pragma unroll
        for (int dt = 0; dt < 16; ++dt)
#pragma unroll
            for (int ks = 0; ks < 2; ++ks) { const bf16x8 kf = *(const LAS bf16x8*)(KT + (16 * dt + r) * 80 + 32 * ks + 8 * g); S[dt] = MFMA16(kf, vf[ks], S[dt]); }
#pragma unroll
        for (int tt = 0; tt < 4; ++tt) { const int row = row0 + 16 * tt + r; const f32x4 z = Z[tt];
            u32x2 w; w.x = cvtpk2(z[0], z[1]); w.y = cvtpk2(z[2], z[3]);
            *(GAS u32x2*)(ORAW + (size_t)row * DM + ecol + 4 * g) = w;
            float s = (z[0] * z[0] + z[1] * z[1]) + (z[2] * z[2] + z[3] * z[3]); s += __shfl_xor(s, 16); s += __shfl_xor(s, 32);
            if (g == 0) SSQP[((size_t)row * 4 + h) * 32 + slice * 8 + wave] = s; }
        __syncthreads();
        if (c + 1 < 32) REC_STORE();
        __syncthreads();
    }
#undef REC_LOAD
#undef REC_STORE
    float* SO = P.out + OUT_GLAP + (size_t)bh * 256 * 512 + slice * 128 + 16 * wave + r;
#pragma unroll
    for (int dt = 0; dt < 16; ++dt)
#pragma unroll
        for (int i = 0; i < 4; ++i) SO[(size_t)(16 * dt + 4 * g + i) * 512] = S[dt][i];
}

__device__ __forceinline__ void gla_sample_unit(const Ptrs& P, LAS unsigned char* lds, int task, int tid, int wave, int lane) {
    const int es = task & 7, h = (task >> 3) & 3, b = task >> 5;
    LAS float* GL = (LAS float*)lds;
    LAS float* QD = (LAS float*)(lds + 1024);
    LAS float* KD = (LAS float*)(lds + 1024 + 8192);
    LAS float* GD = (LAS float*)(lds + 1024 + 16384);
    LAS float* PR = (LAS float*)(lds + 18432);
    LAS float* VL = (LAS float*)(lds + 18688);
    LAS float* RED = (LAS float*)(lds + 20736);
    LAS float* OP = (LAS float*)(lds + 24576);
    const int row0 = MPR + b * 8;
    const bf16* QK = (const bf16*)(P.ws + WS_QK); const bf16* VT = (const bf16*)(P.ws + WS_VT); const float* GLOW = (const float*)(P.ws + WS_GLOW);
    if (tid < 32) ((LAS f32x4*)GL)[tid] = ((const f32x4*)(GLOW + (size_t)row0 * 16))[tid];
    { const int e = tid & 63, s = tid >> 6; VL[s * 64 + e] = bf2f(VT[(size_t)(h * 512 + es * 64 + e) * MT + row0 + s]); }
    __syncthreads();
    if (tid < 256) {
        const int d = tid;
        float wg[16];
#pragma unroll
        for (int r = 0; r < 16; ++r) wg[r] = P.w_gate_up[r * 1024 + h * 256 + d];
        const float bias = P.b_gate[h * 256 + d];
        float bc[8], q[8], k[8]; float run = 0.f;
#pragma unroll
        for (int t = 0; t < 8; ++t) { const LAS f32x4* gr = (const LAS f32x4*)(GL + t * 16); const f32x4 g0 = gr[0], g1 = gr[1], g2 = gr[2], g3 = gr[3];
            float z = bias + g0.x * wg[0] + g0.y * wg[1] + g0.z * wg[2] + g0.w * wg[3] + g1.x * wg[4] + g1.y * wg[5] + g1.z * wg[6] + g1.w * wg[7]
                           + g2.x * wg[8] + g2.y * wg[9] + g2.z * wg[10] + g2.w * wg[11] + g3.x * wg[12] + g3.y * wg[13] + g3.z * wg[14] + g3.w * wg[15];
            const float ls = fminf(z, 0.f) - __logf(1.0f + __expf(-fabsf(z)));
            run += ls * 0.0625f; bc[t] = run;
            q[t] = bf2f(QK[(size_t)(row0 + t) * DM + h * 256 + d]); k[t] = bf2f(QK[(size_t)(row0 + t) * DM + 1024 + h * 256 + d]); }
        const float blast = bc[7];
#pragma unroll
        for (int t = 0; t < 8; ++t) { QD[d * 8 + t] = q[t] * __expf(bc[t]); KD[d * 8 + t] = k[t] * __expf(blast - bc[t]); }
        GD[d] = __expf(blast);
        int idx = 0;
#pragma unroll
        for (int t = 0; t < 8; ++t)
#pragma unroll
            for (int s = 0; s <= t; ++s) { float v = q[t] * k[s] * __expf(bc[t] - bc[s]); v = wave_sum(v); if (lane == 0) RED[wave * 36 + idx] = v; ++idx; }
    }
    __syncthreads();
    if (tid < 64) { const int t = tid >> 3, s = tid & 7; float v = 0.f; if (s <= t) { const int idx = t * (t + 1) / 2 + s; v = RED[idx] + RED[36 + idx] + RED[72 + idx] + RED[108 + idx]; } PR[t * 8 + s] = v; }
    { const int eq = tid & 15, dg = tid >> 4;
      f32x4 v[8];
#pragma unroll
      for (int s = 0; s < 8; ++s) v[s] = *(const LAS f32x4*)(VL + s * 64 + 4 * eq);
      f32x4 o[8];
#pragma unroll
      for (int t = 0; t < 8; ++t) o[t] = (f32x4){0.f, 0.f, 0.f, 0.f};
      const size_t sbase = ((size_t)(b * 4 + h) * 256) * 512 + es * 64 + 4 * eq;
      const float* S0p = P.state + sbase; float* S1p = P.out + OUT_GLAS + sbase;
      f32x4 s0[8];
#pragma unroll
      for (int dd = 0; dd < 8; ++dd) s0[dd] = *(const f32x4*)(S0p + (size_t)(8 * dg + dd) * 512);
#pragma unroll
      for (int dd = 0; dd < 8; ++dd) { const int d = 8 * dg + dd;
          const f32x4 qa = *(const LAS f32x4*)(QD + d * 8), qb = *(const LAS f32x4*)(QD + d * 8 + 4), ka = *(const LAS f32x4*)(KD + d * 8), kb = *(const LAS f32x4*)(KD + d * 8 + 4);
          const float gm = GD[d]; const f32x4 x = s0[dd];
          o[0] += x * qa.x; o[1] += x * qa.y; o[2] += x * qa.z; o[3] += x * qa.w; o[4] += x * qb.x; o[5] += x * qb.y; o[6] += x * qb.z; o[7] += x * qb.w;
          f32x4 sn = x * gm; sn += v[0] * ka.x; sn += v[1] * ka.y; sn += v[2] * ka.z; sn += v[3] * ka.w; sn += v[4] * kb.x; sn += v[5] * kb.y; sn += v[6] * kb.z; sn += v[7] * kb.w;
          *(f32x4*)(S1p + (size_t)d * 512) = sn; }
#pragma unroll
      for (int t = 0; t < 8; ++t) *(LAS f32x4*)(OP + (dg * 8 + t) * 64 + 4 * eq) = o[t];
    }
    __syncthreads();
    { const int t = tid >> 6, e = tid & 63; float acc = 0.f;
#pragma unroll 8
      for (int dg = 0; dg < 32; ++dg) acc += OP[(dg * 8 + t) * 64 + e];
#pragma unroll
      for (int s = 0; s < 8; ++s) acc += PR[t * 8 + s] * VL[s * 64 + e];
      bf16* ORAW = (bf16*)(P.ws + WS_BUFA); float* SSQP = (float*)(P.ws + WS_SSQP);
      ORAW[(size_t)(row0 + t) * DM + h * 512 + es * 64 + e] = (bf16)(cvtpk2(acc, 0.f) & 0xffffu);
      const float ss = wave_sum(acc * acc);
      if (lane == 0) SSQP[((size_t)(row0 + t) * 4 + h) * 32 + es] = ss; }
    __syncthreads();
}

__device__ __forceinline__ void gate_row(const Ptrs& P, int row, int lane) {
    bf16* ORAW = (bf16*)(P.ws + WS_BUFA); const bf16* SR = (const bf16*)(P.ws + WS_SR); const float* SSQP = (const float*)(P.ws + WS_SSQP);
    const int np = row < MPR ? 32 : 8;
    float rstd[4];
#pragma unroll
    for (int h = 0; h < 4; ++h) { float v = lane < np ? SSQP[((size_t)row * 4 + h) * 32 + lane] : 0.f; v = wave_sum(v); rstd[h] = 1.0f / sqrtf(v * (1.f / 512.f) + RMS_EPS); }
#pragma unroll
    for (int j = 0; j < 4; ++j) { const size_t off = (size_t)row * DM + 512 * j + 8 * lane;
        const v4u o = *(const GAS v4u*)(ORAW + off), s = *(const GAS v4u*)(SR + off); const float rs = rstd[j];
        v4u w;
        w.x = cvtpk2(__uint_as_float(o.x << 16) * rs * __uint_as_float(s.x << 16), __uint_as_float(o.x & 0xffff0000u) * rs * __uint_as_float(s.x & 0xffff0000u));
        w.y = cvtpk2(__uint_as_float(o.y << 16) * rs * __uint_as_float(s.y << 16), __uint_as_float(o.y & 0xffff0000u) * rs * __uint_as_float(s.y & 0xffff0000u));
        w.z = cvtpk2(__uint_as_float(o.z << 16) * rs * __uint_as_float(s.z << 16), __uint_as_float(o.z & 0xffff0000u) * rs * __uint_as_float(s.z & 0xffff0000u));
        w.w = cvtpk2(__uint_as_float(o.w << 16) * rs * __uint_as_float(s.w << 16), __uint_as_float(o.w & 0xffff0000u) * rs * __uint_as_float(s.w & 0xffff0000u));
        *(GAS v4u*)(ORAW + off) = w; }
}
__device__ __forceinline__ void final_row(float* hrow, const float* gfin, int lane) {
    GAS f32x4* xr = (GAS f32x4*)hrow + lane; const GAS f32x4* gr = (const GAS f32x4*)gfin + lane;
    f32x4 v[8]; float s = 0.f;
#pragma unroll
    for (int j = 0; j < 8; ++j) { v[j] = xr[64 * j]; s += (v[j].x * v[j].x + v[j].y * v[j].y) + (v[j].z * v[j].z + v[j].w * v[j].w); }
    const float rstd = 1.0f / sqrtf(wave_sum(s) * (1.f / DM) + RMS_EPS);
#pragma unroll
    for (int j = 0; j < 8; ++j) xr[64 * j] = v[j] * rstd * gr[64 * j];
}

__device__ __forceinline__ void attn_subblock(const LAS bf16* KI, const LAS bf16* VI, int ts, const bf16* qrow, int qpos, int kpos0, float slope2, float sink2,
                                              const bf16* zrow, bf16* orow, bool store, int lane) {
    const int r = lane & 15, g = lane >> 4;
    const bf16x8 q0 = *(const bf16x8*)(qrow + 8 * g), q1 = *(const bf16x8*)(qrow + 32 + 8 * g);
    f32x4 sc[10]; float mx = -INFINITY;
#pragma unroll
    for (int i = 0; i < 10; ++i) { const LAS bf16* kr = KI + (16 * (ts + i) + r) * 80 + 8 * g;
        f32x4 a = {0.f, 0.f, 0.f, 0.f};
        a = MFMA16(*(const LAS bf16x8*)kr, q0, a); a = MFMA16(*(const LAS bf16x8*)(kr + 32), q1, a);
#pragma unroll
        for (int e = 0; e < 4; ++e) { const int kpos = kpos0 + 16 * (ts + i) + 4 * g + e; const int dist = qpos - kpos;
            const bool ok = dist >= 0 && dist <= 128 && kpos >= 0;
            const float v = ok ? a[e] - slope2 * (float)dist : -INFINITY; a[e] = v; mx = fmaxf(mx, v); }
        sc[i] = a; }
    mx = fmaxf(mx, __shfl_xor(mx, 16)); mx = fmaxf(mx, __shfl_xor(mx, 32)); mx = fmaxf(mx, sink2);
    float l = 0.f;
#pragma unroll
    for (int i = 0; i < 10; ++i)
#pragma unroll
        for (int e = 0; e < 4; ++e) { const float p = __builtin_amdgcn_exp2f(sc[i][e] - mx); sc[i][e] = p; l += p; }
    l += __shfl_xor(l, 16); l += __shfl_xor(l, 32);
    const float inv = 1.0f / (l + __builtin_amdgcn_exp2f(sink2 - mx));
    f32x4 o[4];
#pragma unroll
    for (int dt = 0; dt < 4; ++dt) o[dt] = (f32x4){0.f, 0.f, 0.f, 0.f};
#pragma unroll
    for (int ks = 0; ks < 5; ++ks) {
        v4u pp; pp.x = cvtpk2(sc[2 * ks][0], sc[2 * ks][1]); pp.y = cvtpk2(sc[2 * ks][2], sc[2 * ks][3]); pp.z = cvtpk2(sc[2 * ks + 1][0], sc[2 * ks + 1][1]); pp.w = cvtpk2(sc[2 * ks + 1][2], sc[2 * ks + 1][3]);
        const bf16x8 pb = __builtin_bit_cast(bf16x8, pp);
#pragma unroll
        for (int dt = 0; dt < 4; ++dt) { const LAS bf16* vr = VI + (16 * dt + r) * 264 + 16 * (ts + 2 * ks) + 4 * g;
            const u32x2 lo = *(const LAS u32x2*)vr, hi = *(const LAS u32x2*)(vr + 16);
            v4u va; va.x = lo.x; va.y = lo.y; va.z = hi.x; va.w = hi.y;
            o[dt] = MFMA16(__builtin_bit_cast(bf16x8, va), pb, o[dt]); } }
    if (store) {
#pragma unroll
        for (int dt = 0; dt < 4; ++dt) { const u32x2 zz = *(const GAS u32x2*)(zrow + 16 * dt + 4 * g);
            u32x2 w; w.x = cvtpk2(o[dt][0] * inv * __uint_as_float(zz.x << 16), o[dt][1] * inv * __uint_as_float(zz.x & 0xffff0000u));
            w.y = cvtpk2(o[dt][2] * inv * __uint_as_float(zz.y << 16), o[dt][3] * inv * __uint_as_float(zz.y & 0xffff0000u));
            *(GAS u32x2*)(orow + 16 * dt + 4 * g) = w; }
    }
}
__device__ __forceinline__ void attn_prompt_unit(const Ptrs& P, LAS unsigned char* lds, int u, int tid, int wave, int lane) {
    const int kvh = u & 3, qb = (u >> 2) & 15, b = u >> 6;
    LAS bf16* KI = (LAS bf16*)lds;
    LAS bf16* VI = (LAS bf16*)(lds + 40960);
    const bf16* KB = (const bf16*)(P.ws + WS_KB); const bf16* VT2 = (const bf16*)(P.ws + WS_VT2); const bf16* QZ = (const bf16*)(P.ws + WS_QZ); bf16* A3 = (bf16*)(P.ws + WS_SR);
    const int kpos0 = (qb - 1) * 128;
    for (int i = tid; i < 2048; i += NWAVES * 64) { const int j = i >> 3, ch = i & 7; const int kpos = kpos0 + j;
        v4u v = {0u, 0u, 0u, 0u}; if (kpos >= 0) v = *(const GAS v4u*)(KB + (size_t)(b * 2048 + kpos) * 256 + kvh * 64 + ch * 8);
        *(LAS v4u*)(KI + j * 80 + ch * 8) = v; }
    for (int i = tid; i < 2048; i += NWAVES * 64) { const int d = i >> 5, ch = i & 31; const int kpos = kpos0 + ch * 8;
        v4u v = {0u, 0u, 0u, 0u}; if (kpos >= 0) v = *(const GAS v4u*)(VT2 + (size_t)(kvh * 64 + d) * MT + b * 2048 + kpos);
        *(LAS v4u*)(VI + d * 264 + ch * 8) = v; }
    __syncthreads();
    const int hh = kvh * 8 + wave;
    const float slope2 = __builtin_amdgcn_exp2f(-0.25f * (float)(hh + 1)) * LOG2E, sink2 = P.sinks[hh] * LOG2E;
#pragma unroll 1
    for (int qs = 0; qs < 8; ++qs) { const int qpos = qb * 128 + 16 * qs + (lane & 15); const size_t row = (size_t)b * 2048 + qpos;
        attn_subblock(KI, VI, qs < 6 ? qs : 6, QZ + row * 4096 + hh * 64, qpos, kpos0, slope2, sink2, QZ + row * 4096 + 2048 + hh * 64, A3 + row * DM + hh * 64, true, lane); }
    __syncthreads();
}
__device__ __forceinline__ void attn_sample_unit(const Ptrs& P, LAS unsigned char* lds, int u, int tid, int wave, int lane) {
    const int kvh = u & 3, b = u >> 2;
    LAS bf16* KI = (LAS bf16*)lds;
    LAS bf16* VI = (LAS bf16*)(lds + 40960);
    const bf16* KB = (const bf16*)(P.ws + WS_KB); const bf16* VT2 = (const bf16*)(P.ws + WS_VT2); const bf16* QZ = (const bf16*)(P.ws + WS_QZ); bf16* A3 = (bf16*)(P.ws + WS_SR);
    for (int i = tid; i < 160 * 64; i += NWAVES * 64) { const int j = i >> 6, d = i & 63; float kv = 0.f, vv = 0.f;
        if (j < 128) { kv = P.ck[((size_t)(b * 128 + j) * 4 + kvh) * 64 + d]; vv = P.cv[((size_t)(b * 128 + j) * 4 + kvh) * 64 + d]; }
        else if (j < 136) { kv = bf2f(KB[(size_t)(MPR + b * 8 + j - 128) * 256 + kvh * 64 + d]); vv = bf2f(VT2[(size_t)(kvh * 64 + d) * MT + MPR + b * 8 + j - 128]); }
        KI[j * 80 + d] = (bf16)(cvtpk2(kv, 0.f) & 0xffffu); VI[d * 264 + j] = (bf16)(cvtpk2(vv, 0.f) & 0xffffu); }
    __syncthreads();
    const int hh = kvh * 8 + wave;
    const float slope2 = __builtin_amdgcn_exp2f(-0.25f * (float)(hh + 1)) * LOG2E, sink2 = P.sinks[hh] * LOG2E;
    const int n = lane & 15, qi = n < 8 ? n : 7; const size_t row = (size_t)MPR + b * 8 + qi;
    attn_subblock(KI, VI, 0, QZ + row * 4096 + hh * 64, 128 + qi, 0, slope2, sink2, QZ + row * 4096 + 2048 + hh * 64, A3 + row * DM + hh * 64, n < 8, lane);
    __syncthreads();
}
constexpr int SG_A = 0, SG_B = 10240, SG_STAGE = 30720, SG_RS = 2 * SG_STAGE;
template <bool NAT>
__device__ __forceinline__ void sgemm_core(LAS unsigned char* lds, const bf16* A, const bf16* B, f32x4 (&acc)[2][2], int tid, int wave, int lane) {
    const int wm = wave >> 2, wn = wave & 3, r = lane & 15, g = lane >> 4, lr = tid >> 3, ch = tid & 7;
    const GAS v4u* ga = (const GAS v4u*)(A + (size_t)lr * 2048 + ch * 8); const GAS v4u* gb0 = (const GAS v4u*)(B + (size_t)lr * 2048 + ch * 8); const GAS v4u* gb1 = (const GAS v4u*)(B + (size_t)(64 + lr) * 2048 + ch * 8);
    v4u ra0, rb0, rc0, ra1, rb1, rc1;
#pragma unroll
    for (int i = 0; i < 2; ++i)
#pragma unroll
        for (int j = 0; j < 2; ++j) acc[i][j] = (f32x4){0.f, 0.f, 0.f, 0.f};
#define SG_LD(s, kt) do { ra##s = ga[(kt) * 8]; rb##s = gb0[(kt) * 8]; rc##s = gb1[(kt) * 8]; } while (0)
#define SG_ST(s, stg) do { *(LAS v4u*)(lds + (stg) * SG_STAGE + SG_A + lr * 160 + ch * 16) = ra##s; *(LAS v4u*)(lds + (stg) * SG_STAGE + SG_B + lr * 160 + ch * 16) = rb##s; \
                           *(LAS v4u*)(lds + (stg) * SG_STAGE + SG_B + (64 + lr) * 160 + ch * 16) = rc##s; } while (0)
#define SG_COMPUTE(stg) do { _Pragma("unroll") for (int kk = 0; kk < 2; ++kk) { bf16x8 af[2], bfr[2]; \
        _Pragma("unroll") for (int i = 0; i < 2; ++i) af[i] = *(const LAS bf16x8*)(lds + (stg) * SG_STAGE + SG_A + (32 * wm + 16 * i + r) * 160 + (32 * kk + 8 * g) * 2); \
        _Pragma("unroll") for (int j = 0; j < 2; ++j) bfr[j] = *(const LAS bf16x8*)(lds + (stg) * SG_STAGE + SG_B + (32 * wn + 16 * j + r) * 160 + (32 * kk + 8 * g) * 2); \
        _Pragma("unroll") for (int i = 0; i < 2; ++i) _Pragma("unroll") for (int j = 0; j < 2; ++j) acc[i][j] = NAT ? MFMA16(af[i], bfr[j], acc[i][j]) : MFMA16(bfr[j], af[i], acc[i][j]); } } while (0)
    SG_LD(0, 0); SG_LD(1, 1); SG_ST(0, 0); SG_LD(0, 2);
    __syncthreads();
#pragma unroll 1
    for (int kt = 0; kt < 32; kt += 2) {
        SG_COMPUTE(0); SG_ST(1, 1); if (kt + 3 < 32) SG_LD(1, kt + 3);
        __syncthreads();
        SG_COMPUTE(1); if (kt + 2 < 32) SG_ST(0, 0); if (kt + 4 < 32) SG_LD(0, kt + 4);
        __syncthreads();
    }
#undef SG_LD
#undef SG_ST
#undef SG_COMPUTE
}
template <bool SILU>
__device__ __forceinline__ void sg_store_bf16(const f32x4 (&acc)[2][2], bf16* dst, int ld, int wave, int lane, float rs0, float rs1) {
    const int wm = wave >> 2, wn = wave & 3, r = lane & 15, g = lane >> 4;
#pragma unroll
    for (int i = 0; i < 2; ++i)
#pragma unroll
        for (int j = 0; j < 2; ++j) { f32x4 v = acc[i][j] * (i ? rs1 : rs0);
            if (SILU) { v[0] = pg8::silu_f(v[0]); v[1] = pg8::silu_f(v[1]); v[2] = pg8::silu_f(v[2]); v[3] = pg8::silu_f(v[3]); }
            u32x2 w; w.x = cvtpk2(v[0], v[1]); w.y = cvtpk2(v[2], v[3]);
            *(GAS u32x2*)(dst + (size_t)(32 * wm + 16 * i + r) * ld + 32 * wn + 16 * j + 4 * g) = w; }
}
__device__ __forceinline__ void s_in_a_block(const Ptrs& P, LAS unsigned char* lds, int rb, int nbk, int tid, int wave, int lane) {
    const bf16* A = (const bf16*)(P.ws + WS_BUFA) + (size_t)(MPR + 64 * rb) * DM; const bf16* B = (const bf16*)(P.ws + WS_WINA) + (size_t)(128 * nbk) * DM;
    f32x4 acc[2][2];
    if (nbk >= 16 && nbk < 32) {
        sgemm_core<true>(lds, A, B, acc, tid, wave, lane);
        const int wm = wave >> 2, wn = wave & 3, r = lane & 15, g = lane >> 4; bf16* VT = (bf16*)(P.ws + WS_VT);
#pragma unroll
        for (int i = 0; i < 2; ++i)
#pragma unroll
            for (int j = 0; j < 2; ++j) { u32x2 w; w.x = cvtpk2(acc[i][j][0], acc[i][j][1]); w.y = cvtpk2(acc[i][j][2], acc[i][j][3]);
                *(GAS u32x2*)(VT + (size_t)((nbk - 16) * 128 + 32 * wn + 16 * j + r) * MT + MPR + 64 * rb + 32 * wm + 16 * i + 4 * g) = w; }
    } else {
        sgemm_core<false>(lds, A, B, acc, tid, wave, lane);
        if (nbk < 16) sg_store_bf16<false>(acc, (bf16*)(P.ws + WS_QK) + (size_t)(MPR + 64 * rb) * DM + nbk * 128, DM, wave, lane, 1.f, 1.f);
        else sg_store_bf16<true>(acc, (bf16*)(P.ws + WS_SR) + (size_t)(MPR + 64 * rb) * DM + (nbk - 32) * 128, DM, wave, lane, 1.f, 1.f);
    }
}
template <bool WITH_B16>
__device__ __forceinline__ void s_out_block(const Ptrs& P, LAS unsigned char* lds, const bf16* Abase, const bf16* Wt, const float* res, int rb, int nb, int tid, int wave, int lane) {
    f32x4 acc[2][2];
    sgemm_core<false>(lds, Abase + (size_t)(64 * rb) * DM, Wt + (size_t)(128 * nb) * DM, acc, tid, wave, lane);
    const int wm = wave >> 2, wn = wave & 3, r = lane & 15, g = lane >> 4;
    float* out = P.out + OUT_Y + (size_t)MPR * DM; bf16* H1b = (bf16*)(P.ws + WS_SR) + (size_t)MPR * DM; float* SSQ2 = (float*)(P.ws + WS_SSQP);
#pragma unroll
    for (int i = 0; i < 2; ++i) { const int row = 64 * rb + 32 * wm + 16 * i + r; float ss = 0.f;
#pragma unroll
        for (int j = 0; j < 2; ++j) { const size_t off = (size_t)row * DM + 128 * nb + 32 * wn + 16 * j + 4 * g;
            const f32x4 v = *(const GAS f32x4*)(res + off) + acc[i][j]; *(GAS f32x4*)(out + off) = v;
            if (WITH_B16) { u32x2 w; w.x = cvtpk2(v[0], v[1]); w.y = cvtpk2(v[2], v[3]); *(GAS u32x2*)(H1b + off) = w; ss += (v[0] * v[0] + v[1] * v[1]) + (v[2] * v[2] + v[3] * v[3]); } }
        if (WITH_B16) { ss += __shfl_xor(ss, 16); ss += __shfl_xor(ss, 32); if (g == 0) SSQ2[(size_t)row * 64 + nb * 4 + wn] = ss; } }
}
__device__ __forceinline__ void s_in_b_block(const Ptrs& P, LAS unsigned char* lds, int rb, int nbk, int tid, int wave, int lane) {
    const bf16* A = (const bf16*)(P.ws + WS_SR) + (size_t)(MPR + 64 * rb) * DM; const bf16* B = (const bf16*)(P.ws + WS_WINB) + (size_t)(128 * nbk) * DM;
    LAS float* RS = (LAS float*)(lds + SG_RS);
    { const int row = tid >> 3, part = tid & 7; const float* sp = (const float*)(P.ws + WS_SSQP) + (size_t)(64 * rb + row) * 64 + part * 8;
      const f32x4 a = *(const GAS f32x4*)sp, b = *(const GAS f32x4*)(sp + 4); float s = (a[0] + a[1]) + (a[2] + a[3]) + (b[0] + b[1]) + (b[2] + b[3]);
      s += __shfl_xor(s, 1); s += __shfl_xor(s, 2); s += __shfl_xor(s, 4);
      if (part == 0) RS[row] = 1.0f / sqrtf(s * (1.f / DM) + RMS_EPS); }
    f32x4 acc[2][2];
    const int wm = wave >> 2, wn = wave & 3, r = lane & 15, g = lane >> 4;
    if (nbk >= 34) {
        sgemm_core<true>(lds, A, B, acc, tid, wave, lane);
        bf16* VT2 = (bf16*)(P.ws + WS_VT2); float* vws = P.out + OUT_VWS;
#pragma unroll
        for (int i = 0; i < 2; ++i) { const f32x4 rs = *(const LAS f32x4*)(RS + 32 * wm + 16 * i + 4 * g);
#pragma unroll
            for (int j = 0; j < 2; ++j) { const f32x4 v = acc[i][j] * rs; const int col = (nbk - 34) * 128 + 32 * wn + 16 * j + r; const int srow = 64 * rb + 32 * wm + 16 * i + 4 * g;
                u32x2 w; w.x = cvtpk2(v[0], v[1]); w.y = cvtpk2(v[2], v[3]);
                *(GAS u32x2*)(VT2 + (size_t)col * MT + MPR + srow) = w;
#pragma unroll
                for (int e = 0; e < 4; ++e) { const int s = srow + e; vws[((size_t)(s >> 3) * 128 + 120 + (s & 7)) * 256 + col] = v[e]; } } }
    } else {
        sgemm_core<false>(lds, A, B, acc, tid, wave, lane);
        const float rs0 = RS[32 * wm + r], rs1 = RS[32 * wm + 16 + r];
        if (nbk < 16) sg_store_bf16<false>(acc, (bf16*)(P.ws + WS_QZ) + (size_t)(MPR + 64 * rb) * 4096 + nbk * 128, 4096, wave, lane, rs0, rs1);
        else if (nbk < 32) sg_store_bf16<true>(acc, (bf16*)(P.ws + WS_QZ) + (size_t)(MPR + 64 * rb) * 4096 + nbk * 128, 4096, wave, lane, rs0, rs1);
        else { sg_store_bf16<false>(acc, (bf16*)(P.ws + WS_KB) + (size_t)(MPR + 64 * rb) * 256 + (nbk - 32) * 128, 256, wave, lane, rs0, rs1);
            float* kws = P.out + OUT_KWS;
#pragma unroll
            for (int i = 0; i < 2; ++i) { const int s = 64 * rb + 32 * wm + 16 * i + r; float* d = kws + ((size_t)(s >> 3) * 128 + 120 + (s & 7)) * 256 + (nbk - 32) * 128 + 32 * wn + 4 * g;
#pragma unroll
                for (int j = 0; j < 2; ++j) *(GAS f32x4*)(d + 16 * j) = acc[i][j] * (i ? rs1 : rs0); } }
    }
}
#ifndef MK_N_LAUNCHES
#define MK_N_LAUNCHES 1
#endif
#ifndef DUP_PHASE
#define DUP_PHASE -1
#endif
#define REPS(k) for (int rep_ = 0; rep_ < ((DUP_PHASE) == (k) ? 2 : 1); ++rep_)
constexpr int N_PHASES = 12;
constexpr int N_LAUNCHES = MK_N_LAUNCHES;
struct Args { Ptrs p; int ph_lo, ph_hi; };
static_assert(sizeof(Args) == 20 * 8 + 8, "Args has no padding");

__global__ void __launch_bounds__(NWAVES * 64, 2) yoco_fwd(Args args) {
    extern __shared__ __attribute__((aligned(16))) unsigned char lds_raw[];
    LAS unsigned char* lds = (LAS unsigned char*)lds_raw;
    volatile LAS unsigned* MISC = (volatile LAS unsigned*)(lds + MISC_OFF);
    const int tid = threadIdx.x, lane = tid & 63, wave = __builtin_amdgcn_readfirstlane(tid >> 6);
    const int G = gridDim.x, c = blockIdx.x;
    const int vcu = (G % 8 == 0) ? (c % 8) * (G / 8) + c / 8 : c;
    const Ptrs& P = args.p;
    gu32* ctl = (gu32*)(P.ws + WS_CTL);
    for (int u = tid; u < (LDS_BYTES - LDSCTL_OFF) / 4; u += NWAVES * 64) ((LAS unsigned*)(lds + LDSCTL_OFF))[u] = 0u;
    __syncthreads();
    XcdBarrier bar; bar.bar = (unsigned*)(ctl + CW_BAR); bar.x = 0; bar.st = nullptr;
    if (N_LAUNCHES == 1) bar = xcd_barrier_post((unsigned*)(ctl + CW_BAR), MISC + 8);
    const int lo = args.ph_lo, hi = args.ph_hi;
#define IN(k) (lo <= (k) && (k) < hi)
#define SEAM(k) do { if (IN(k) && IN((k) + 1)) xcd_barrier(bar); } while (0)
    const int gw = vcu * NWAVES + wave, NGW = G * NWAVES;

    if (IN(0)) { p0_prologue(P, lds, vcu, G, tid, wave, lane); SEAM(0); }

    if (IN(1)) {
        pg8::SchedInA S{G, c, (const char*)(P.ws + WS_BUFA), (const char*)(P.ws + WS_WINA)};
        pg8::EpiInA E{(pg8::bf16_t*)(P.ws + WS_QK), (pg8::bf16_t*)(P.ws + WS_SR), (pg8::bf16_t*)(P.ws + WS_VT), MT};
        pg8::gemm_phase<pg8::EpiInA, pg8::SchedInA, true, true>(lds, 2048, S, E);
        for (int task = c * NWAVES + wave; task < MT / 16; task += NGW)
            glow_task((const bf16*)(P.ws + WS_BUFA), (const bf16*)(P.ws + WS_WINA) + (size_t)6144 * DM, (float*)(P.ws + WS_GLOW), task, lane);
        SEAM(1);
    }

    if (IN(2)) {
        for (int blk = c; blk < 192; blk += G) s_in_a_block(P, lds, blk / 48, blk % 48, tid, wave, lane);
        for (int u = c; u < 512; u += G) gla_prep_unit(P, lds, u, tid, wave, lane);
        SEAM(2);
    }

    if (IN(3)) {
        if (G >= 128) {
            if (c < 64) { const int xcd = c & 7, idx = c >> 3; gla_scan_unit(P, lds, xcd * 2 + (idx >> 2), idx & 3, tid, wave, lane); }
            else for (int t = c - 64; t < 1024; t += G - 64) gla_sample_unit(P, lds, t, tid, wave, lane);
        } else {
            for (int u = c; u < 64; u += G) gla_scan_unit(P, lds, u >> 2, u & 3, tid, wave, lane);
            for (int t = c; t < 1024; t += G) gla_sample_unit(P, lds, t, tid, wave, lane);
        }
        SEAM(3);
    }

    if (IN(4)) { for (int m = gw; m < MT; m += NGW) gate_row(P, m, lane); SEAM(4); }

    if (IN(5)) {
        pg8::SchedOut S{G, c, (const char*)(P.ws + WS_BUFA), (const char*)(P.ws + WS_WOA)};
        pg8::EpiRes E{P.x_prompt, nullptr, P.out + OUT_Y};
        pg8::gemm_phase<pg8::EpiRes, pg8::SchedOut, true, true>(lds, 2048, S, E);
        SEAM(5);
    }

    if (IN(6)) {
        const int NS = G >= 128 ? 64 : 0;
        if (c < NS) { for (int blk = c; blk < 64; blk += NS) s_out_block<true>(P, lds, (const bf16*)(P.ws + WS_BUFA) + (size_t)MPR * DM, (const bf16*)(P.ws + WS_WOA), P.x_sample, blk >> 4, blk & 15, tid, wave, lane); }
        else { if (NS == 0) for (int blk = c; blk < 64; blk += G) s_out_block<true>(P, lds, (const bf16*)(P.ws + WS_BUFA) + (size_t)MPR * DM, (const bf16*)(P.ws + WS_WOA), P.x_sample, blk >> 4, blk & 15, tid, wave, lane);
            bf16* H1N = (bf16*)(P.ws + WS_BUFA);
            for (int m = (c - NS) * NWAVES + wave; m < MPR; m += (G - NS) * NWAVES) rms_row_to_bf16(P.out + OUT_Y + (size_t)m * DM, H1N + (size_t)m * DM, lane); }
        SEAM(6);
    }

    if (IN(7)) {
        pg8::SchedInB S{G, c, (const char*)(P.ws + WS_BUFA), (const char*)(P.ws + WS_WINB)};
        pg8::EpiInB E{(pg8::bf16_t*)(P.ws + WS_QZ), (pg8::bf16_t*)(P.ws + WS_KB), (pg8::bf16_t*)(P.ws + WS_VT2), MT, P.out + OUT_KWP, P.out + OUT_VWP, P.out + OUT_KWS, P.out + OUT_VWS};
        pg8::gemm_phase<pg8::EpiInB, pg8::SchedInB, true, true>(lds, 2048, S, E);
        for (int blk = (c + G - (64 % G)) % G; blk < 144; blk += G) s_in_b_block(P, lds, blk / 36, blk % 36, tid, wave, lane);
        SEAM(7);
    }

    if (IN(8)) {
        for (int u = c; u < 256; u += G) attn_prompt_unit(P, lds, u, tid, wave, lane);
        for (int u = c; u < 128; u += G) attn_sample_unit(P, lds, u, tid, wave, lane);
        SEAM(8);
    }

    if (IN(9)) {
        pg8::SchedOut S{G, c, (const char*)(P.ws + WS_SR), (const char*)(P.ws + WS_WOB)};
        pg8::EpiRes E{P.out + OUT_Y, nullptr, P.out + OUT_Y};
        pg8::gemm_phase<pg8::EpiRes, pg8::SchedOut, true, true>(lds, 2048, S, E);
        SEAM(9);
    }

    if (IN(10)) {
        const int NS = G >= 128 ? 64 : 0;
        if (c < NS) { for (int blk = c; blk < 64; blk += NS) s_out_block<false>(P, lds, (const bf16*)(P.ws + WS_SR) + (size_t)MPR * DM, (const bf16*)(P.ws + WS_WOB), P.out + OUT_Y + (size_t)MPR * DM, blk >> 4, blk & 15, tid, wave, lane); }
        else { if (NS == 0) for (int blk = c; blk < 64; blk += G) s_out_block<false>(P, lds, (const bf16*)(P.ws + WS_SR) + (size_t)MPR * DM, (const bf16*)(P.ws + WS_WOB), P.out + OUT_Y + (size_t)MPR * DM, blk >> 4, blk & 15, tid, wave, lane);
            for (int m = (c - NS) * NWAVES + wave; m < MPR; m += (G - NS) * NWAVES) final_row(P.out + OUT_Y + (size_t)m * DM, P.g_final, lane); }
        SEAM(10);
    }

    if (IN(11)) { for (int m = MPR + gw; m < MT; m += NGW) final_row(P.out + OUT_Y + (size_t)m * DM, P.g_final, lane); }
#undef IN
#undef SEAM
}

extern "C" void kernel_launch(void* const* d_in, const int* in_sizes, int n_in, void* d_out, int out_size, void* d_ws, size_t ws_size, hipStream_t stream) {
    static int grid = 0;
    if (grid == 0) {
        if (n_in != 18 || (size_t)out_size != OUT_TOTAL || ws_size < WS_END) { fprintf(stderr, "kernel_launch: unexpected shapes (n_in %d, out %d, ws %zu); nothing launched\n", n_in, out_size, ws_size); grid = -1; return; }
        int dev = 0, cus = 0, per_cu = 0;
        if (hipGetDevice(&dev) != hipSuccess || hipDeviceGetAttribute(&cus, hipDeviceAttributeMultiprocessorCount, dev) != hipSuccess) { grid = -1; return; }
        if (hipFuncSetAttribute((const void*)yoco_fwd, hipFuncAttributeMaxDynamicSharedMemorySize, LDS_BYTES) != hipSuccess) { fprintf(stderr, "kernel_launch: hipFuncSetAttribute failed\n"); grid = -1; return; }
        if (hipOccupancyMaxActiveBlocksPerMultiprocessor(&per_cu, (const void*)yoco_fwd, NWAVES * 64, LDS_BYTES) != hipSuccess || per_cu < 1)
            fprintf(stderr, "kernel_launch: note: occupancy query reports %d workgroups per CU\n", per_cu);
        (void)hipGetLastError();
        grid = cus;
    }
    if (grid < 0) return;
    (void)hipMemsetAsync((char*)d_ws + WS_CTL, 0, CTL_ZERO_BYTES, stream);
    Args a{};
    const float** pp = (const float**)&a.p;
    for (int i = 0; i < 18; ++i) pp[i] = (const float*)d_in[i];
    a.p.out = (float*)d_out; a.p.ws = (unsigned char*)d_ws;
    for (int li = 0; li < N_LAUNCHES; ++li) {
        a.ph_lo = (N_LAUNCHES == 1) ? 0 : li; a.ph_hi = (N_LAUNCHES == 1) ? N_PHASES : li + 1;
        hipLaunchKernelGGL(yoco_fwd, dim3(grid), dim3(NWAVES * 64), LDS_BYTES, stream, a);
    }
}
```

```cpp
#include <hip/hip_runtime.h>
#include <cstdio>
#include <cstdint>
#include <cmath>
namespace pg8 {
#define PG8_LAS __attribute__((address_space(3)))
typedef unsigned short bf16_t;
typedef short bf16x8 __attribute__((ext_vector_type(8)));
typedef float f32x4 __attribute__((ext_vector_type(4)));
typedef unsigned u32x4 __attribute__((ext_vector_type(4)));
constexpr int BM = 256, BK = 64, HALF = 128, HTB = HALF * BK * 2  , STAGE_BYTES = 8 * HTB, NXCD = 8, WGM = 8;

__host__ __device__ __forceinline__ int lds_byte(int r, int c) { const int st = (r >> 4) * 2 + (c >> 5), rr = r & 15, cc = c & 31, ob = rr * 64 + cc * 2; return st * 1024 + (ob ^ (((ob >> 9) & 1) << 5)); }
__host__ __device__ __forceinline__ void stage_rc(int b, int& R, int& C) { const int st = b / 1024, sb = b % 1024, swz = sb ^ (((sb >> 9) & 1) << 5); R = (st >> 1) * 16 + swz / 64; C = (st & 1) * 32 + (swz % 64) / 2; }
__host__ __device__ __forceinline__ int perm32(int rho) { const int n = rho >> 4, i = rho & 15; return 8 * (i >> 2) + 4 * n + (i & 3); }

struct Unit { const char* a; const char* b; int pm, pn, kind; };
__device__ __forceinline__ void tile_map(int L, int nM, int nN, int& pm, int& pn) {
    const int nwg = nM * nN; int wgid = L; { const int q = nwg / NXCD, r = nwg % NXCD, xcd = wgid % NXCD, off = wgid / NXCD; wgid = (xcd < r ? xcd * (q + 1) : r * (q + 1) + (xcd - r) * q) + off; }
    const int nig = WGM * nN, gid = wgid / nig, fm = gid * WGM, gsz = (nM - fm) < WGM ? (nM - fm) : WGM;
    pm = fm + ((wgid % nig) % gsz); pn = (wgid % nig) / gsz;
}
typedef float f32x2_t __attribute__((ext_vector_type(2))); typedef __bf16 bf16x2_t __attribute__((ext_vector_type(2)));
__device__ __forceinline__ unsigned cvtpk(float lo, float hi) { f32x2_t v = {lo, hi}; bf16x2_t b = __builtin_convertvector(v, bf16x2_t); return __builtin_bit_cast(unsigned, b); }
__device__ __forceinline__ float silu_f(float v) { return v / (1.0f + __expf(-v)); }

template <bool SILU>
__device__ __forceinline__ void store_tile_bf16(const f32x4 (&acc)[2][2][4][2], bf16_t* base, int ldc, int row_t, int col_t, int wr, int wc, int fr, int fq) {
    const int row0 = row_t + wr * 64 + fr, col0 = col_t + wc * 32 + 8 * fq;
#pragma unroll
    for (int ai = 0; ai < 2; ++ai)
#pragma unroll
        for (int m = 0; m < 4; ++m) { bf16_t* rowp = base + (size_t)(row0 + ai * HALF + m * 16) * ldc + col0;
#pragma unroll
            for (int bj = 0; bj < 2; ++bj) { f32x4 v0 = acc[ai][bj][m][0], v1 = acc[ai][bj][m][1];
                if (SILU) { v0[0] = silu_f(v0[0]); v0[1] = silu_f(v0[1]); v0[2] = silu_f(v0[2]); v0[3] = silu_f(v0[3]); v1[0] = silu_f(v1[0]); v1[1] = silu_f(v1[1]); v1[2] = silu_f(v1[2]); v1[3] = silu_f(v1[3]); }
                u32x4 w; w.x = cvtpk(v0[0], v0[1]); w.y = cvtpk(v0[2], v0[3]); w.z = cvtpk(v1[0], v1[1]); w.w = cvtpk(v1[2], v1[3]);
                *(u32x4*)(rowp + bj * HALF) = w; } }
}

struct EpiInA {
    static constexpr bool PERM = true, AFTER_DRAIN = false;
    bf16_t* QK; bf16_t* SR; bf16_t* VT; int MT;
    __device__ __forceinline__ void operator()(const f32x4 (&acc)[2][2][4][2], const Unit& u, int wr, int wc, int fr, int fq) const {
        if (u.kind == 0) store_tile_bf16<false>(acc, QK, 2048, u.pm * BM, u.pn * BM, wr, wc, fr, fq);
        else if (u.kind == 1) store_tile_bf16<true>(acc, SR, 2048, u.pm * BM, (u.pn - 8) * BM, wr, wc, fr, fq);
        else store_tile_bf16<false>(acc, VT, MT, u.pm * BM, u.pn * BM, wr, wc, fr, fq);
    }
};

struct EpiInB {
    static constexpr bool PERM = true, AFTER_DRAIN = false;
    bf16_t* QZ; bf16_t* KB; bf16_t* VT2; int MT; float* kwp; float* vwp; float* kws; float* vws;
    __device__ __forceinline__ static float* win_row(int t, float* wp, float* wsmp) {
        if (t < 8192) { const int pos = t & 2047; if (pos < 1920) return nullptr; return wp + ((size_t)(t >> 11) * 128 + (pos - 1920)) * 256; }
        const int s = t - 8192; return wsmp + ((size_t)(s >> 3) * 128 + 120 + (s & 7)) * 256;
    }
    __device__ __forceinline__ void operator()(const f32x4 (&acc)[2][2][4][2], const Unit& u, int wr, int wc, int fr, int fq) const {
        if (u.kind == 0) { store_tile_bf16<false>(acc, QZ, 4096, u.pm * BM, u.pn * BM, wr, wc, fr, fq); return; }
        if (u.kind == 1) { store_tile_bf16<true>(acc, QZ, 4096, u.pm * BM, u.pn * BM, wr, wc, fr, fq); return; }
        if (u.kind == 2) {
            store_tile_bf16<false>(acc, KB, 256, u.pm * BM, 0, wr, wc, fr, fq);
            if ((u.pm & 7) == 7 || u.pm == 32) {
                const int row0 = u.pm * BM + wr * 64 + fr, col0 = wc * 32 + 8 * fq;
#pragma unroll
                for (int ai = 0; ai < 2; ++ai)
#pragma unroll
                    for (int m = 0; m < 4; ++m) { float* d = win_row(row0 + ai * HALF + m * 16, kwp, kws);
                        if (d) {
#pragma unroll
                            for (int bj = 0; bj < 2; ++bj) { *(f32x4*)(d + col0 + bj * HALF) = acc[ai][bj][m][0]; *(f32x4*)(d + col0 + bj * HALF + 4) = acc[ai][bj][m][1]; } } }
            }
            return;
        }
        store_tile_bf16<false>(acc, VT2, MT, 0, u.pn * BM, wr, wc, fr, fq);
        if ((u.pn & 7) == 7 || u.pn == 32) {
            const int row0 = wr * 64 + fr, col0 = u.pn * BM + wc * 32 + 8 * fq;
#pragma unroll
            for (int bj = 0; bj < 2; ++bj)
#pragma unroll
                for (int n = 0; n < 2; ++n)
#pragma unroll
                    for (int j = 0; j < 4; ++j) { float* d = win_row(col0 + bj * HALF + 4 * n + j, vwp, vws);
                        if (d) {
#pragma unroll
                            for (int ai = 0; ai < 2; ++ai)
#pragma unroll
                                for (int m = 0; m < 4; ++m) d[row0 + ai * HALF + m * 16] = acc[ai][bj][m][n][j]; } }
        }
    }
};

struct EpiRes {
    static constexpr bool PERM = false, AFTER_DRAIN = false;
    const float* res; const float* res2; float* out;
    __device__ __forceinline__ void operator()(const f32x4 (&acc)[2][2][4][2], const Unit& u, int wr, int wc, int fr, int fq) const {
        const int row0 = u.pm * BM + wr * 64 + fr, col0 = u.pn * BM + wc * 32 + 4 * fq;
        const float* rb = (res2 != nullptr && u.pm == 32) ? res2 - (size_t)8192 * 2048 : res;
#pragma unroll
        for (int ai = 0; ai < 2; ++ai)
#pragma unroll
            for (int m = 0; m < 4; ++m) { const size_t off = (size_t)(row0 + ai * HALF + m * 16) * 2048 + col0;
#pragma unroll
                for (int bj = 0; bj < 2; ++bj)
#pragma unroll
                    for (int n = 0; n < 2; ++n) { const f32x4 r = *(const f32x4*)(rb + off + bj * HALF + n * 16); *(f32x4*)(out + off + bj * HALF + n * 16) = r + acc[ai][bj][m][n]; } }
    }
};

struct SchedInA {
    int G, c; const char* XN; const char* W;
    __device__ __forceinline__ bool next(int i, Unit& u) const {
        const int L = i * G + c; const size_t P = (size_t)BM * 2048 * 2;
        if (L < 512) { tile_map(L, 32, 16, u.pm, u.pn); u.kind = u.pn < 8 ? 0 : 1; u.a = XN + u.pm * P; u.b = W + (u.pn < 8 ? u.pn : u.pn + 8) * P; return true; }
        if (L < 768) { tile_map(L - 512, 8, 32, u.pm, u.pn); u.kind = 2; u.a = W + (8 + u.pm) * P; u.b = XN + u.pn * P; return true; }
        return false;
    }
    __device__ __forceinline__ void a_ready(const Unit&) const {}
    __device__ __forceinline__ void done(const Unit&) const {}
};
struct SchedInB {
    int G, c; const char* XN; const char* W;
    __device__ __forceinline__ bool next(int i, Unit& u) const {
        const int L = i * G + c; const size_t P = (size_t)BM * 2048 * 2;
        if (L < 544) { tile_map(L, 32, 17, u.pm, u.pn); u.kind = u.pn < 8 ? 0 : (u.pn < 16 ? 1 : 2); u.a = XN + u.pm * P; u.b = W + u.pn * P; return true; }
        if (L < 576) { u.pm = 0; u.pn = L - 544; u.kind = 3; u.a = W + 17 * P; u.b = XN + u.pn * P; return true; }
        return false;
    }
    __device__ __forceinline__ void a_ready(const Unit&) const {}
    __device__ __forceinline__ void done(const Unit&) const {}
};
struct SchedOut {
    int G, c; const char* A; const char* W;
    __device__ __forceinline__ bool next(int i, Unit& u) const {
        const int L = i * G + c; const size_t P = (size_t)BM * 2048 * 2;
        if (L >= 256) return false;
        tile_map(L, 32, 8, u.pm, u.pn); u.kind = 0; u.a = A + u.pm * P; u.b = W + u.pn * P; return true;
    }
    __device__ __forceinline__ void a_ready(const Unit&) const {}
    __device__ __forceinline__ void done(const Unit&) const {}
};
template <class Epi, class Sched, bool ALIGN_EPI = false, bool SP2 = false>
__device__ __forceinline__ void gemm_phase(PG8_LAS unsigned char* lds, const int K_, const Sched& S, const Epi& E) {
    const int tid = threadIdx.x, wid = __builtin_amdgcn_readfirstlane(tid >> 6), lane = tid & 63, wr = wid >> 2, wc = wid & 3, fr = lane & 15, fq = lane >> 4;
    const int K = K_, nt = K / BK;
    unsigned voffA[2], voffB[2];
#pragma unroll
    for (int i = 0; i < 2; ++i) { int R, C; stage_rc(tid * 16 + i * 8192, R, C); const int Rb = Epi::PERM ? ((R & ~31) + perm32(R & 31)) : R;
        voffA[i] = (unsigned)(R * K + C) * 2u; voffB[i] = (unsigned)(Rb * K + C) * 2u; }
    const size_t kstep = (size_t)(BK * 2);
    const size_t hstep = (size_t)HALF * K * 2;
    const unsigned ldsw = (unsigned)wid * 1024u;
    const int aoff = lds_byte(wr * 64 + fr, fq * 8), boff = lds_byte(wc * 32 + fr, fq * 8);
#define PG8_SA(b, h) (((b) * 2 + (h)) * HTB)
#define PG8_SB(b, h) ((4 + (b) * 2 + (h)) * HTB)
#define PG8_STAGE(bufoff, gbase, voff) do { _Pragma("unroll") for (int _i = 0; _i < 2; ++_i) \
        __builtin_amdgcn_global_load_lds((const unsigned*)((const char*)(gbase) + (voff)[_i]), (PG8_LAS unsigned*)(lds + (bufoff) + ldsw + _i * 8192), 16, 0, 0); } while (0)
#define PG8_LDA(dst, b, h) do { _Pragma("unroll") for (int m = 0; m < 4; ++m) _Pragma("unroll") for (int k = 0; k < 2; ++k) dst[m][k] = *(const PG8_LAS bf16x8*)(lds + PG8_SA(b, h) + aoff + m * 2048 + k * 1024); } while (0)
#define PG8_LDB(dst, b, h) do { _Pragma("unroll") for (int n = 0; n < 2; ++n) _Pragma("unroll") for (int k = 0; k < 2; ++k) dst[n][k] = *(const PG8_LAS bf16x8*)(lds + PG8_SB(b, h) + boff + n * 2048 + k * 1024); } while (0)
#define PG8_MMA(ai, bj, At, Bt) do { __builtin_amdgcn_s_setprio(1); _Pragma("unroll") for (int m = 0; m < 4; ++m) _Pragma("unroll") for (int n = 0; n < 2; ++n) _Pragma("unroll") for (int k = 0; k < 2; ++k) \
        acc[ai][bj][m][n] = __builtin_amdgcn_mfma_f32_16x16x32_bf16(Bt[n][k], At[m][k], acc[ai][bj][m][n], 0, 0, 0); __builtin_amdgcn_s_setprio(0); } while (0)
#define PG8_WAIT_V(n) asm volatile("s_waitcnt vmcnt(" #n ")" ::: "memory")
#define PG8_WAIT_L(n) asm volatile("s_waitcnt lgkmcnt(" #n ")" ::: "memory")
#define PG8_BAR __builtin_amdgcn_s_barrier()
#define PG8_SCHED __builtin_amdgcn_sched_barrier(0)
    Unit cur, nxt; int ui = 0;
    if (!S.next(0, cur)) return;
    f32x4 acc[2][2][4][2];
#pragma unroll
    for (int a = 0; a < 2; ++a)
#pragma unroll
        for (int b = 0; b < 2; ++b)
#pragma unroll
            for (int m = 0; m < 4; ++m)
#pragma unroll
                for (int n = 0; n < 2; ++n) acc[a][b][m][n] = (f32x4){0.f, 0.f, 0.f, 0.f};
    bf16x8 At[4][2], B0[2][2], B1[2][2];
    const char* cA = cur.a; const char* cB = cur.b;
    S.a_ready(cur);
    if constexpr (SP2) {
        PG8_STAGE(PG8_SB(0, 0), cB, voffB); PG8_STAGE(PG8_SB(0, 1), cB + hstep, voffB); PG8_STAGE(PG8_SA(0, 0), cA, voffA); PG8_STAGE(PG8_SA(0, 1), cA + hstep, voffA);
        if (wr == 1) PG8_BAR;
        PG8_WAIT_V(2); PG8_BAR;
        PG8_STAGE(PG8_SB(1, 0), cB + kstep, voffB); PG8_STAGE(PG8_SA(1, 0), cA + kstep, voffA); PG8_STAGE(PG8_SB(1, 1), cB + hstep + kstep, voffB);
        PG8_WAIT_V(6); PG8_BAR;
    } else {
        PG8_STAGE(PG8_SB(0, 0), cB, voffB); PG8_STAGE(PG8_SA(0, 0), cA, voffA); PG8_STAGE(PG8_SB(0, 1), cB + hstep, voffB); PG8_STAGE(PG8_SA(0, 1), cA + hstep, voffA);
        if (wr == 1) PG8_BAR;
        PG8_WAIT_V(4); PG8_BAR;
        PG8_STAGE(PG8_SB(1, 0), cB + kstep, voffB); PG8_STAGE(PG8_SA(1, 0), cA + kstep, voffA); PG8_STAGE(PG8_SB(1, 1), cB + hstep + kstep, voffB);
        PG8_WAIT_V(6); PG8_BAR;
    }
    for (;;) {
        const bool has_next = S.next(ui + 1, nxt);
        const char* nA = has_next ? nxt.a : cA; const char* nB = has_next ? nxt.b : cB;
        for (int t = 0; t < nt; t += 2) {
            const bool last = (t == nt - 2);
            const char* a1 = cA + (size_t)(t + 1) * kstep;
            const char* a2 = last ? nA : cA + (size_t)(t + 2) * kstep; const char* b2 = last ? nB : cB + (size_t)(t + 2) * kstep;
            const char* a3 = a2 + kstep; const char* b3 = b2 + kstep;
            if (last && has_next) S.a_ready(nxt);
            if constexpr (SP2) {
            PG8_LDB(B0, 0, 0); PG8_LDB(B1, 0, 1); PG8_SCHED; PG8_LDA(At, 0, 0); PG8_STAGE(PG8_SA(1, 1), a1 + hstep, voffA);
            PG8_WAIT_V(8); PG8_WAIT_L(0); PG8_BAR; PG8_MMA(0, 0, At, B0); PG8_MMA(0, 1, At, B1); PG8_BAR; PG8_SCHED;
            PG8_LDA(At, 0, 1); PG8_STAGE(PG8_SB(0, 0), b2, voffB); PG8_STAGE(PG8_SB(0, 1), b2 + hstep, voffB); PG8_STAGE(PG8_SA(0, 0), a2, voffA);
            PG8_WAIT_V(8); PG8_WAIT_L(0); PG8_BAR; PG8_MMA(1, 0, At, B0); PG8_MMA(1, 1, At, B1); PG8_BAR; PG8_SCHED;
            PG8_LDB(B0, 1, 0); PG8_LDB(B1, 1, 1); PG8_SCHED; PG8_LDA(At, 1, 0); PG8_STAGE(PG8_SA(0, 1), a2 + hstep, voffA);
            PG8_WAIT_V(8); PG8_WAIT_L(0); PG8_BAR; PG8_MMA(0, 0, At, B0); PG8_MMA(0, 1, At, B1); PG8_BAR; PG8_SCHED;
            PG8_LDA(At, 1, 1); PG8_STAGE(PG8_SB(1, 0), b3, voffB); PG8_STAGE(PG8_SB(1, 1), b3 + hstep, voffB); PG8_STAGE(PG8_SA(1, 0), a3, voffA);
            PG8_WAIT_V(8); PG8_WAIT_L(0); PG8_BAR; PG8_MMA(1, 0, At, B0); PG8_MMA(1, 1, At, B1); PG8_BAR; PG8_SCHED;
            } else {
            PG8_LDB(B0, 0, 0); PG8_SCHED; PG8_LDA(At, 0, 0); PG8_STAGE(PG8_SA(1, 1), a1 + hstep, voffA);
            PG8_WAIT_L(8); PG8_BAR; PG8_WAIT_L(0); PG8_MMA(0, 0, At, B0); PG8_BAR; PG8_SCHED;
            PG8_LDB(B1, 0, 1); PG8_STAGE(PG8_SB(0, 0), b2, voffB);
            PG8_BAR; PG8_WAIT_L(0); PG8_MMA(0, 1, At, B1); PG8_BAR;
            PG8_LDA(At, 0, 1); PG8_STAGE(PG8_SA(0, 0), a2, voffA);
            PG8_BAR; PG8_WAIT_L(0); PG8_MMA(1, 0, At, B0); PG8_BAR; PG8_SCHED;
            PG8_STAGE(PG8_SB(0, 1), b2 + hstep, voffB);
            PG8_WAIT_V(6); PG8_BAR; PG8_MMA(1, 1, At, B1); PG8_BAR;
            PG8_LDB(B0, 1, 0); PG8_SCHED; PG8_LDA(At, 1, 0); PG8_STAGE(PG8_SA(0, 1), a2 + hstep, voffA);
            PG8_WAIT_L(8); PG8_BAR; PG8_WAIT_L(0); PG8_MMA(0, 0, At, B0); PG8_BAR; PG8_SCHED;
            PG8_LDB(B1, 1, 1); PG8_STAGE(PG8_SB(1, 0), b3, voffB);
            PG8_BAR; PG8_WAIT_L(0); PG8_MMA(0, 1, At, B1); PG8_BAR;
            PG8_LDA(At, 1, 1); PG8_STAGE(PG8_SA(1, 0), a3, voffA);
            PG8_BAR; PG8_WAIT_L(0); PG8_MMA(1, 0, At, B0); PG8_BAR; PG8_SCHED;
            PG8_STAGE(PG8_SB(1, 1), b3 + hstep, voffB);
            PG8_WAIT_V(6); PG8_BAR; PG8_MMA(1, 1, At, B1); PG8_BAR;
            }
        }
        if constexpr (ALIGN_EPI) { if (wr == 0) PG8_BAR; }
        if constexpr (!Epi::AFTER_DRAIN) { E(acc, cur, wr, wc, fr, fq); S.done(cur); }
        if (!has_next) break;
#pragma unroll
        for (int a = 0; a < 2; ++a)
#pragma unroll
            for (int b = 0; b < 2; ++b)
#pragma unroll
                for (int m = 0; m < 4; ++m)
#pragma unroll
                    for (int n = 0; n < 2; ++n) acc[a][b][m][n] = (f32x4){0.f, 0.f, 0.f, 0.f};
        cur = nxt; cA = nA; cB = nB; ++ui;
        if constexpr (ALIGN_EPI) { if (wr == 1) PG8_BAR; }
    }
    PG8_WAIT_V(0);
    if constexpr (!ALIGN_EPI) { if (wr == 0) PG8_BAR; }
    PG8_BAR;
    if constexpr (Epi::AFTER_DRAIN) { E.fused(acc, cur, wr, wc, fr, fq, lds, wid, lane); S.done(cur); }
#undef PG8_SA
#undef PG8_SB
#undef PG8_STAGE
#undef PG8_LDA
#undef PG8_LDB
#undef PG8_MMA
#undef PG8_WAIT_V
#undef PG8_WAIT_L
#undef PG8_BAR
#undef PG8_SCHED
}
}
#define GAS __attribute__((address_space(1)))
#define LAS __attribute__((address_space(3)))
typedef unsigned short bf16;
typedef unsigned v4u __attribute__((ext_vector_type(4)));
typedef float f32x4 __attribute__((ext_vector_type(4)));
typedef short bf16x8 __attribute__((ext_vector_type(8)));
typedef GAS unsigned gu32;
typedef GAS unsigned long long gu64;
#define RLX_AGENT __ATOMIC_RELAXED, __HIP_MEMORY_SCOPE_AGENT
#define LDS_WAIT() asm volatile("s_waitcnt lgkmcnt(0)" ::: "memory")
#define VM_WAIT() asm volatile("s_waitcnt vmcnt(0)" ::: "memory")
__device__ __forceinline__ unsigned long long rt() { return __builtin_amdgcn_s_memrealtime(); }
__device__ __forceinline__ unsigned f2bf(float f) { unsigned u = __builtin_bit_cast(unsigned, f); return (u + 0x7fffu + ((u >> 16) & 1u)) >> 16; }
__device__ __forceinline__ unsigned pk2(float lo, float hi) { return f2bf(lo) | (f2bf(hi) << 16); }

#define XB_TMO      128
#define XB_XCNT(j)  (256  + 64 * (j))
#define XB_XSUB(j)  (1280 + 64 * (j))
#define XB_XGEN(j)  (2304 + 64 * (j))
#define XB_TOP      3328
#define XB_TOPGEN   3392
#define XCD_BAR_WORDS 3456
#define XB_SPIN_CAP (1u << 18)

__device__ __forceinline__ unsigned xb_ld(unsigned* p)              { return __hip_atomic_load(p, __ATOMIC_RELAXED, __HIP_MEMORY_SCOPE_AGENT); }
__device__ __forceinline__ unsigned xb_add(unsigned* p, unsigned v) { return __hip_atomic_fetch_add(p, v, __ATOMIC_RELAXED, __HIP_MEMORY_SCOPE_AGENT); }
__device__ __forceinline__ unsigned xb_xcc_id() { return (unsigned)__builtin_amdgcn_s_getreg((3 << 11) | 20) & 0xFu; }
#define XB_SPIN(cond, bar) do { unsigned _sp = 0; while (cond) { __builtin_amdgcn_s_sleep(1); \
    if ((++_sp & 255u) == 0u) { if (xb_ld(&(bar)[XB_TMO])) break; if (_sp > XB_SPIN_CAP) { atomicAdd(&(bar)[XB_TMO], 1u); break; } } } } while (0)

struct XcdBarrier {
    unsigned* bar; unsigned x;
    volatile LAS unsigned* st;
};

__device__ __forceinline__ XcdBarrier xcd_barrier_post(unsigned* bar, volatile LAS unsigned* st) {
    XcdBarrier b; b.bar = bar; b.x = xb_xcc_id(); b.st = st;
    if (threadIdx.x == 0) (void)xb_add(&bar[XB_XCNT(b.x)], 1u);
    return b;
}
__device__ __forceinline__ void xcd_barrier_complete(unsigned* bar, unsigned x, unsigned& nloc, unsigned& nx) {
    const unsigned G = gridDim.x * gridDim.y * gridDim.z;
    unsigned sum, cnt, mine, sp = 0u;
    for (;;) {
        sum = 0u; cnt = 0u; mine = 0u;
#pragma unroll
        for (unsigned j = 0; j < 16; ++j) { const unsigned c = xb_ld(&bar[XB_XCNT(j)]); sum += c; cnt += (c > 0u) ? 1u : 0u; mine = (j == x) ? c : mine; }
        if (sum == G) break;
        __builtin_amdgcn_s_sleep(1);
        if ((++sp & 255u) == 0u) { if (xb_ld(&bar[XB_TMO])) break; if (sp > XB_SPIN_CAP) { atomicAdd(&bar[XB_TMO], 1u); break; } }
    }
    nloc = mine > 0u ? mine : 1u; nx = cnt > 0u ? cnt : 1u;
}

__device__ __forceinline__ void xcd_barrier(const XcdBarrier& b) {
    asm volatile("s_waitcnt vmcnt(0)" ::: "memory");
    __syncthreads();
    if (threadIdx.x == 0) {
        unsigned* bar = b.bar;
        __builtin_amdgcn_s_waitcnt(0);
        unsigned nloc = b.st[0], nx = b.st[1];
        if (nloc == 0u) { xcd_barrier_complete(bar, b.x, nloc, nx); b.st[0] = nloc; b.st[1] = nx; }
        const unsigned old = xb_add(&bar[XB_XSUB(b.x)], 1u);
        const unsigned gen = old / nloc;
        if (old + 1u == (gen + 1u) * nloc) {
            __builtin_amdgcn_fence(__ATOMIC_RELEASE, "agent");
            asm volatile("s_waitcnt vmcnt(0)" ::: "memory");
            const unsigned og = xb_add(&bar[XB_TOP], 1u);
            const unsigned tg = og / nx;
            if (og + 1u == (tg + 1u) * nx) xb_add(&bar[XB_TOPGEN], 1u);
            else XB_SPIN(xb_ld(&bar[XB_TOPGEN]) == tg, bar);
            __builtin_amdgcn_fence(__ATOMIC_ACQUIRE, "agent");
            xb_add(&bar[XB_XGEN(b.x)], 1u);
            asm volatile("s_waitcnt vmcnt(0)" ::: "memory");
        } else {
            XB_SPIN(xb_ld(&bar[XB_XGEN(b.x)]) == gen, bar);
            __builtin_amdgcn_fence(__ATOMIC_ACQUIRE, "agent");
            asm volatile("s_waitcnt vmcnt(0)" ::: "memory");
        }
    }
    __syncthreads();
}
constexpr int NWAVES = 8;
constexpr int MPR = 8192, MSM = 256, MT = MPR + MSM;
constexpr int DM = 2048;
constexpr float RMS_EPS = 1e-6f;
constexpr float LOG2E = 1.4426950408889634f;
constexpr size_t MiB = 1u << 20;
constexpr size_t WS_CTL = 0, CTL_ZERO_BYTES = 64 * 1024;
constexpr size_t WS_WINA = 1 * MiB;
constexpr size_t WS_WOA = 26 * MiB;
constexpr size_t WS_WINB = 34 * MiB;
constexpr size_t WS_WOB = 52 * MiB;
constexpr size_t WS_BUFA = 60 * MiB;
constexpr size_t WS_QK = 93 * MiB;
constexpr size_t WS_VT = 126 * MiB;
constexpr size_t WS_QZ = 93 * MiB;
constexpr size_t WS_SR = 159 * MiB;
constexpr size_t WS_REC = 192 * MiB;
constexpr size_t WS_KB = 192 * MiB;
constexpr size_t WS_VT2 = 198 * MiB;
constexpr size_t WS_GLOW = 234 * MiB;
constexpr size_t WS_SSQP = 235 * MiB;
constexpr size_t WS_END = 240 * MiB;
constexpr int CW_BAR = 1024;
constexpr int HREC = 33792, REC_PO = 33792, REC_H1 = 41984, REC_BYTES = 75776, REC_DMA = 41984, H_QT = 0, H_KT = 16384, H_G = 32768;
static_assert(512 * (size_t)REC_BYTES <= 42 * MiB && REC_DMA % 1024 == 0, "record");
__device__ __forceinline__ int qt_off(int t, int dl) {
    const int d5 = dl & 31; const int p = d5 < 16 ? ((d5 >> 2) << 3) + (d5 & 3) : (((d5 - 16) >> 2) << 3) + 4 + (d5 & 3);
    const int chunk = ((dl >> 5) << 2) + (p >> 3); return t * 256 + ((chunk ^ (t & 15)) << 4) + ((p & 7) << 1); }
__device__ __forceinline__ int qt_chunk(int t, int c) { return t * 256 + ((c ^ (t & 15)) << 4); }
__device__ __forceinline__ int kt_chunk(int d, int c) { return d * 128 + ((c ^ ((d >> 1) & 7)) << 4); }
constexpr size_t OUT_Y = 0, OUT_GLAP = 17301504, OUT_GLAS = 19398656, OUT_KWP = 36175872, OUT_VWP = 36306944, OUT_KWS = 36438016, OUT_VWS = 37486592, OUT_TOTAL = 38535168;
constexpr int RING_BYTES = 131072, LDS_BYTES = 163840, LDSCTL_OFF = LDS_BYTES - 1024, MISC_OFF = LDSCTL_OFF + 320;

__device__ __forceinline__ float bf2f(unsigned short u) { return __uint_as_float(((unsigned)u) << 16); }
__device__ __forceinline__ unsigned cvtpk2(float lo, float hi) { return pg8::cvtpk(lo, hi); }
__device__ __forceinline__ float wave_sum(float v) {
#pragma unroll
    for (int o = 1; o < 64; o <<= 1) v += __shfl_xor(v, o);
    return v;
}
#define MFMA16(a, b, c) __builtin_amdgcn_mfma_f32_16x16x32_bf16((a), (b), (c), 0, 0, 0)
typedef unsigned u32x2 __attribute__((ext_vector_type(2)));

struct Ptrs {
    const float *x_prompt, *x_sample, *state, *ck, *cv, *g_norm_a, *w_in_a, *w_gate_up, *b_gate, *g_onorm, *w_out_a, *g_norm_kv, *w_kv, *g_norm_b, *w_in_b, *sinks, *w_out_b, *g_final;
    float* out; unsigned char* ws;
};

__device__ __forceinline__ void p0_transpose_item(const float* W, int ldw, int ncol0, int nvalid, const float* gain, int scale_cols, float scale, bf16* WT, int row_off, LAS float* scr, int kb, int nb, int lane) {
    const int k0 = 64 * kb, n0 = 32 * nb, nl = lane & 31; const bool ok = (n0 + nl) < nvalid; const float cs = (n0 + nl) < scale_cols ? scale : 1.0f;
#pragma unroll 8
    for (int i = 0; i < 32; ++i) { const int kk = 2 * i + (lane >> 5); float v = ok ? W[(size_t)(k0 + kk) * ldw + ncol0 + n0 + nl] : 0.f; if (gain) v *= gain[k0 + kk]; scr[kk * 33 + nl] = v * cs; }
    LDS_WAIT(); asm volatile("" ::: "memory");
    const int c = lane & 7;
#pragma unroll
    for (int j = 0; j < 4; ++j) { const int n = (lane >> 3) + 8 * j; const LAS float* s = scr + (8 * c) * 33 + n;
        v4u o; o.x = cvtpk2(s[0 * 33], s[1 * 33]); o.y = cvtpk2(s[2 * 33], s[3 * 33]); o.z = cvtpk2(s[4 * 33], s[5 * 33]); o.w = cvtpk2(s[6 * 33], s[7 * 33]);
        if (n0 + n < nvalid) *(GAS v4u*)(WT + (size_t)(row_off + n0 + n) * 2048 + k0 + 8 * c) = o; }
    LDS_WAIT(); asm volatile("" ::: "memory");
}
__device__ __forceinline__ void rms_row_to_bf16(const float* xrow, bf16* orow, int lane) {
    const GAS f32x4* xr = (const GAS f32x4*)xrow + lane;
    f32x4 v[8]; float s = 0.f;
#pragma unroll
    for (int j = 0; j < 8; ++j) { v[j] = xr[64 * j]; s += (v[j].x * v[j].x + v[j].y * v[j].y) + (v[j].z * v[j].z + v[j].w * v[j].w); }
    const float rstd = 1.0f / sqrtf(wave_sum(s) * (1.f / DM) + RMS_EPS);
    GAS u32x2* o8 = (GAS u32x2*)orow + lane;
#pragma unroll
    for (int j = 0; j < 8; ++j) { u32x2 w; w.x = cvtpk2(v[j].x * rstd, v[j].y * rstd); w.y = cvtpk2(v[j].z * rstd, v[j].w * rstd); o8[64 * j] = w; }
}
__device__ __forceinline__ void p0_transpose_big(const float* W, int ldw, const float* gain, float cs, bf16* WT, int row_off, LAS unsigned char* scr, int kb, int nb, int lane) {
    const int k0 = 64 * kb, n0 = 128 * nb, hl = lane >> 5, nl = lane & 31;
    const GAS f32x4* src = (const GAS f32x4*)(W + (size_t)(k0 + 32 * hl) * ldw + n0 + 4 * nl);
    f32x4 v[32];
#pragma unroll
    for (int i = 0; i < 32; ++i) v[i] = src[(size_t)i * (ldw / 4)];
    f32x4 gk[8];
#pragma unroll
    for (int i = 0; i < 8; ++i) gk[i] = gain ? *(const GAS f32x4*)(gain + k0 + 32 * hl + 4 * i) * cs : (f32x4){cs, cs, cs, cs};
#pragma unroll
    for (int j = 0; j < 4; ++j) { const int n = 4 * nl + j;
#pragma unroll
        for (int q = 0; q < 4; ++q) { v4u o;
            o.x = cvtpk2(v[8 * q + 0][j] * gk[2 * q][0], v[8 * q + 1][j] * gk[2 * q][1]); o.y = cvtpk2(v[8 * q + 2][j] * gk[2 * q][2], v[8 * q + 3][j] * gk[2 * q][3]);
            o.z = cvtpk2(v[8 * q + 4][j] * gk[2 * q + 1][0], v[8 * q + 5][j] * gk[2 * q + 1][1]); o.w = cvtpk2(v[8 * q + 6][j] * gk[2 * q + 1][2], v[8 * q + 7][j] * gk[2 * q + 1][3]);
            *(LAS v4u*)(scr + n * 128 + (((4 * hl + q) ^ (n & 7)) << 4)) = o; } }
    LDS_WAIT(); asm volatile("" ::: "memory");
#pragma unroll
    for (int it = 0; it < 16; ++it) { const int idx = it * 64 + lane, n = idx >> 3, ch = idx & 7;
        const v4u o = *(const LAS v4u*)(scr + n * 128 + ((ch ^ (n & 7)) << 4));
        *(GAS v4u*)(WT + (size_t)(row_off + n0 + n) * 2048 + k0 + 8 * ch) = o; }
    LDS_WAIT(); asm volatile("" ::: "memory");
}
__device__ __forceinline__ void convert_weights(const Ptrs& P, LAS unsigned char* lds, int group, int gwi, int ngw, int wave, int lane) {
    LAS unsigned char* scr = lds + wave * 16384;
    bf16* WinaT = (bf16*)(P.ws + WS_WINA); bf16* WoaT = (bf16*)(P.ws + WS_WOA); bf16* WinbT = (bf16*)(P.ws + WS_WINB); bf16* WobT = (bf16*)(P.ws + WS_WOB);
    constexpr int I0 = 32 * 48, I1 = 32, I2 = 32 * 16, I3 = 32 * 32, I4 = 32 * 4, I5 = 32 * 16;
    if (group == 0) {
        for (int r = gwi; r < I0; r += ngw) { const int nb = r % 48; p0_transpose_big(P.w_in_a, 6160, P.g_norm_a, nb < 8 ? 0.0625f : 1.f, WinaT, 0, scr, r / 48, nb, lane); }
        for (int it = ngw - 1 - gwi; it < I1; it += ngw) p0_transpose_item(P.w_in_a, 6160, 6144, 16, P.g_norm_a, 0, 1.f, WinaT, 6144, (LAS float*)scr, it, 0, lane);
    } else {
        for (int it = gwi; it < I2 + I3 + I4 + I5; it += ngw) {
            int r = it;
            if (r < I2) { p0_transpose_big(P.w_out_a, 2048, P.g_onorm, 1.f, WoaT, 0, scr, r / 16, r % 16, lane); continue; } r -= I2;
            if (r < I3) { const int nb = r % 32; p0_transpose_big(P.w_in_b, 4096, P.g_norm_b, nb < 16 ? 0.125f * LOG2E : 1.f, WinbT, 0, scr, r / 32, nb, lane); continue; } r -= I3;
            if (r < I4) { p0_transpose_big(P.w_kv, 512, P.g_norm_kv, 1.f, WinbT, 4096, scr, r / 4, r % 4, lane); continue; } r -= I4;
            p0_transpose_big(P.w_out_b, 2048, nullptr, 1.f, WobT, 0, scr, r / 16, r % 16, lane);
        }
    }
}
__device__ __forceinline__ void p0_prologue(const Ptrs& P, LAS unsigned char* lds, int vcu, int G, int tid, int wave, int lane) {
    const int gw = vcu * NWAVES + wave, NGW = G * NWAVES;
    convert_weights(P, lds, 0, gw, NGW, wave, lane);
    if (G < 256) convert_weights(P, lds, 1, gw, NGW, wave, lane);
    bf16* XN = (bf16*)(P.ws + WS_BUFA);
    for (int m = gw; m < MT; m += NGW) rms_row_to_bf16(m < MPR ? P.x_prompt + (size_t)m * DM : P.x_sample + (size_t)(m - MPR) * DM, XN + (size_t)m * DM, lane);
    const int gt = vcu * (NWAVES * 64) + tid, NGT = G * NWAVES * 64;
    for (int i = gt; i < 32 * 120 * 64; i += NGT) { const int b = i / (120 * 64), rem = i % (120 * 64);
        ((f32x4*)(P.out + OUT_KWS))[(size_t)b * 128 * 64 + rem] = ((const f32x4*)P.ck)[(size_t)b * 128 * 64 + 8 * 64 + rem];
        ((f32x4*)(P.out + OUT_VWS))[(size_t)b * 128 * 64 + rem] = ((const f32x4*)P.cv)[(size_t)b * 128 * 64 + 8 * 64 + rem]; }
}

__device__ __forceinline__ void glow_task(const bf16* XN, const bf16* WgT, float* GLOW, int task, int lane) {
    const int r = lane & 15, g = lane >> 4, row0 = task * 16;
    const bf16* ap = XN + (size_t)(row0 + r) * DM + g * 8; const bf16* bp = WgT + (size_t)r * DM + g * 8;
    f32x4 acc = {0.f, 0.f, 0.f, 0.f};
#pragma unroll 8
    for (int kk = 0; kk < 64; ++kk) { const bf16x8 a = *(const bf16x8*)(ap + kk * 32); const bf16x8 b = *(const bf16x8*)(bp + kk * 32); acc = MFMA16(a, b, acc); }
#pragma unroll
    for (int i = 0; i < 4; ++i) GLOW[(size_t)(row0 + 4 * g + i) * 16 + r] = acc[i];
}

__device__ __forceinline__ void gla_prep_unit(const Ptrs& P, LAS unsigned char* lds, int u, int tid, int wave, int lane) {
    const int c = u & 31, h = (u >> 5) & 3, b = u >> 7;
    const int d = tid & 255, th = tid >> 8, hh = d >> 7, dl = d & 127;
    LAS unsigned char* QI = lds;
    LAS unsigned char* KI = lds + 32768;
    LAS float* GL = (LAS float*)(lds + 65536);
    LAS float* TOT = (LAS float*)(lds + 65536 + 4096);
    const int row0 = b * 2048 + c * 64;
    const float* GLOW = (const float*)(P.ws + WS_GLOW);
    const bf16* QK = (const bf16*)(P.ws + WS_QK);
    unsigned char* rec = P.ws + WS_REC + (size_t)u * REC_BYTES;
    unsigned char* rech = rec + (hh ? REC_H1 : 0);
#pragma unroll
    for (int i = 0; i < 4; ++i) { const int idx = tid + 512 * i, t = idx >> 5, ch = idx & 31;
        const v4u q = *(const GAS v4u*)(QK + (size_t)(row0 + t) * DM + h * 256 + ch * 8), k = *(const GAS v4u*)(QK + (size_t)(row0 + t) * DM + 1024 + h * 256 + ch * 8);
        *(LAS v4u*)(QI + t * 512 + ch * 16) = q; *(LAS v4u*)(KI + t * 512 + ch * 16) = k; }
    if (tid < 256) ((LAS f32x4*)GL)[tid] = ((const f32x4*)(GLOW + (size_t)row0 * 16))[tid];
    float wg[16];
#pragma unroll
    for (int r = 0; r < 16; ++r) wg[r] = P.w_gate_up[r * 1024 + h * 256 + d];
    const float bias = P.b_gate[h * 256 + d];
    __syncthreads();
    float bl[32]; float run = 0.f;
#pragma unroll
    for (int tt = 0; tt < 32; ++tt) { const int t = th * 32 + tt; const LAS f32x4* gr = (const LAS f32x4*)(GL + t * 16);
        const f32x4 g0 = gr[0], g1 = gr[1], g2 = gr[2], g3 = gr[3];
        float z = bias + g0.x * wg[0] + g0.y * wg[1] + g0.z * wg[2] + g0.w * wg[3] + g1.x * wg[4] + g1.y * wg[5] + g1.z * wg[6] + g1.w * wg[7]
                       + g2.x * wg[8] + g2.y * wg[9] + g2.z * wg[10] + g2.w * wg[11] + g3.x * wg[12] + g3.y * wg[13] + g3.z * wg[14] + g3.w * wg[15];
        const float ls = fminf(z, 0.f) - __logf(1.0f + __expf(-fabsf(z)));
        run += ls * 0.0625f; bl[tt] = run; }
    TOT[th * 256 + d] = run;
    unsigned short qr[32], kr[32];
#pragma unroll
    for (int tt = 0; tt < 32; ++tt) { qr[tt] = *(const LAS unsigned short*)(QI + (th * 32 + tt) * 512 + d * 2); kr[tt] = *(const LAS unsigned short*)(KI + (th * 32 + tt) * 512 + d * 2); }
    __syncthreads();
    const float tot0 = TOT[d], tot1 = TOT[256 + d], blast = tot0 + tot1, base = th ? tot0 : 0.f;
    unsigned kt[16];
#pragma unroll
    for (int tt = 0; tt < 32; tt += 2) {
        float kv2[2];
#pragma unroll
        for (int k2 = 0; k2 < 2; ++k2) { const int t = th * 32 + tt + k2; const float bt = base + bl[tt + k2];
            const float e1 = __expf(bt - blast), e2 = __builtin_amdgcn_rcpf(e1);
            const float qv = bf2f(qr[tt + k2]) * e1, kv = bf2f(kr[tt + k2]) * e2; kv2[k2] = kv;
            const int off = hh * 16384 + qt_off(t, dl);
            *(LAS unsigned short*)(QI + off) = (unsigned short)(cvtpk2(qv, 0.f) & 0xffffu); *(LAS unsigned short*)(KI + off) = (unsigned short)(cvtpk2(kv, 0.f) & 0xffffu); }
        kt[tt >> 1] = cvtpk2(kv2[0], kv2[1]); }
#pragma unroll
    for (int i = 0; i < 4; ++i) { v4u o; o.x = kt[4 * i]; o.y = kt[4 * i + 1]; o.z = kt[4 * i + 2]; o.w = kt[4 * i + 3]; *(GAS v4u*)(rech + H_KT + kt_chunk(dl, 4 * th + i)) = o; }
    if (th == 0) ((GAS float*)(rech + H_G))[dl] = __expf(blast);
    __syncthreads();
    { const int r = lane & 15, g = lane >> 4, mt = wave >> 1, st0 = 2 * (wave & 1);
      f32x4 a0 = {0.f, 0.f, 0.f, 0.f}, a1 = {0.f, 0.f, 0.f, 0.f};
      bf16x8 bq[8], k0[8], k1[8];
#pragma unroll
      for (int kk = 0; kk < 8; ++kk) { const int ho = (kk >> 2) * 16384, cc = 4 * (kk & 3) + g;
          bq[kk] = *(const LAS bf16x8*)(QI + ho + qt_chunk(16 * mt + r, cc)); k0[kk] = *(const LAS bf16x8*)(KI + ho + qt_chunk(16 * st0 + r, cc)); k1[kk] = *(const LAS bf16x8*)(KI + ho + qt_chunk(16 * st0 + 16 + r, cc)); }
#pragma unroll
      for (int kk = 0; kk < 8; ++kk) { a0 = MFMA16(k0[kk], bq[kk], a0); a1 = MFMA16(k1[kk], bq[kk], a1); }
      const int t = 16 * mt + r;
#pragma unroll
      for (int j = 0; j < 2; ++j) { const f32x4 a = j ? a1 : a0; const int s0 = 16 * (st0 + j) + 4 * g;
          u32x2 w; w.x = cvtpk2(s0 + 0 <= t ? a[0] : 0.f, s0 + 1 <= t ? a[1] : 0.f); w.y = cvtpk2(s0 + 2 <= t ? a[2] : 0.f, s0 + 3 <= t ? a[3] : 0.f);
          *(GAS u32x2*)(rec + REC_PO + kt_chunk(t, s0 >> 3) + (s0 & 7) * 2) = w; } }
#pragma unroll
    for (int i = 0; i < 4; ++i) { const int idx = tid + 512 * i; ((GAS v4u*)(rec + ((idx >> 10) ? REC_H1 : 0) + H_QT))[idx & 1023] = ((const LAS v4u*)QI)[idx]; }
    __syncthreads();
}

constexpr int SC_BUF = REC_DMA, SC_PIECES = REC_DMA / 1024, SC_OT = 3 * REC_DMA;
static_assert(SC_OT + 2 * 16384 <= LDSCTL_OFF, "scan LDS map");
__device__ __forceinline__ void gla_scan_unit(const Ptrs& P, LAS unsigned char* lds, int bh, int dh, int eq, int tid, int wave, int lane, int nch = 32) {
    const int b = bh >> 2, h = bh & 3, r = lane & 15, g = lane >> 4, rr = (r >> 1) & 7;
    const int ecol = h * 512 + eq * 128 + 16 * wave;
    const bf16* VT = (const bf16*)(P.ws + WS_VT);
    bf16* OB = (bf16*)(P.ws + (dh ? WS_QK : WS_BUFA)) + (size_t)(b * 2048) * DM + h * 512 + eq * 128;
    const unsigned char* rec0 = P.ws + WS_REC + (size_t)(bh * 32) * REC_BYTES + (dh ? REC_PO : 0);
    const unsigned HO = dh ? 8192u : 0u, PO = dh ? 0u : 33792u;
    f32x4 S[8];
#pragma unroll
    for (int i = 0; i < 8; ++i) S[i] = (f32x4){0.f, 0.f, 0.f, 0.f};
    const bf16* vtp = VT + (size_t)(ecol + r) * MT + b * 2048 + 8 * g;
#define SC_DMA(cc, bufo_) do { const unsigned char* src_ = rec0 + (size_t)(cc) * REC_BYTES + lane * 16; \
        _Pragma("unroll") for (int j_ = 0; j_ < 6; ++j_) { const int i_ = wave + NWAVES * j_; \
            if (i_ < SC_PIECES) __builtin_amdgcn_global_load_lds((const GAS unsigned*)(src_ + i_ * 1024), (LAS unsigned*)(lds + (bufo_) + i_ * 1024), 16, 0, 0); } } while (0)
#define SC_OSTORE(cc) do { const LAS unsigned char* ot_ = lds + SC_OT + ((cc) & 1) * 16384; \
        _Pragma("unroll") for (int j_ = 0; j_ < 2; ++j_) { const int idx_ = tid + 512 * j_, row_ = idx_ >> 4, q_ = idx_ & 15; \
            const v4u v_ = *(const LAS v4u*)(ot_ + row_ * 256 + ((q_ ^ (row_ & 15)) << 4)); \
            *(GAS v4u*)(OB + (size_t)((cc) * 64 + row_) * DM + q_ * 8) = v_; } } while (0)
    bf16x8 vc0 = *(const bf16x8*)vtp, vc1 = *(const bf16x8*)(vtp + 32), vn0 = vc0, vn1 = vc1;
    SC_DMA(0, 0u); SC_DMA(1, (unsigned)SC_BUF);
    __syncthreads();
    unsigned bo0 = 0u, bo1 = SC_BUF, bo2 = 2u * SC_BUF;
#pragma unroll 1
    for (int c = 0; c < nch; ++c) {
        bf16x8 vf[2]; vf[0] = vc0; vf[1] = vc1;
        { const bf16* vp_ = vtp + (c + 1 < 32 ? c + 1 : 31) * 64;
          asm volatile("global_load_dwordx4 %0, %2, off\n\tglobal_load_dwordx4 %1, %2, off offset:64" : "=&v"(vn0), "=&v"(vn1) : "v"(vp_) : "memory"); }
        if (c > 0) SC_OSTORE(c - 1);
        const unsigned bufo = bo0;
        const unsigned qbase = bufo + HO + H_QT + (unsigned)(r * 256 + ((r >> 2) << 6) + ((g ^ (r & 3)) << 4));
        const unsigned kbase = bufo + HO + H_KT + (unsigned)(r * 128 + ((rr >> 2) << 6) + ((g ^ (rr & 3)) << 4));
        const unsigned pbase = bufo + PO + (unsigned)(r * 128 + ((dh ^ (rr >> 2)) << 6) + ((g ^ (rr & 3)) << 4));
        const unsigned gbase = bufo + HO + H_G + (unsigned)(g * 16);
#define SC_FENCE() __builtin_amdgcn_sched_barrier(0)
#define SC_BQ(k2, tt) (*(const LAS bf16x8*)(lds + ((qbase ^ ((k2) << 6)) + (tt) * 4096)))
#define SC_KF(i, ks) (*(const LAS bf16x8*)(lds + ((kbase ^ ((ks) << 6)) + (i) * 2048)))
#define SC_AF(k2) __builtin_bit_cast(bf16x8, (v4u){cvtpk2(S[2 * (k2)][0], S[2 * (k2)][1]), cvtpk2(S[2 * (k2)][2], S[2 * (k2)][3]), cvtpk2(S[2 * (k2) + 1][0], S[2 * (k2) + 1][1]), cvtpk2(S[2 * (k2) + 1][2], S[2 * (k2) + 1][3])})
        f32x4 gm[4]; bf16x8 qa[8], qb[8];
#pragma unroll
        for (int i = 0; i < 4; ++i) gm[i] = *(const LAS f32x4*)(lds + (gbase + i * 64));
#pragma unroll
        for (int tt = 0; tt < 4; ++tt) { qa[tt] = SC_BQ(0, tt); qa[4 + tt] = SC_BQ(1, tt); }
        SC_FENCE();
#pragma unroll
        for (int i = 0; i < 4; ++i) S[i] = S[i] * gm[i];
#pragma unroll
        for (int i = 0; i < 4; ++i) gm[i] = *(const LAS f32x4*)(lds + (gbase + (4 + i) * 64));
#pragma unroll
        for (int tt = 0; tt < 4; ++tt) { qb[tt] = SC_BQ(2, tt); qb[4 + tt] = SC_BQ(3, tt); }
        bf16x8 pq[4];
#pragma unroll
        for (int tt = 0; tt < 4; ++tt) pq[tt] = *(const LAS bf16x8*)(lds + (pbase + tt * 2048));
        SC_FENCE();
        f32x4 Z[4];
#pragma unroll
        for (int tt = 0; tt < 4; ++tt) Z[tt] = (f32x4){0.f, 0.f, 0.f, 0.f};
        { const bf16x8 a0 = SC_AF(0), a1 = SC_AF(1);
#pragma unroll
          for (int tt = 0; tt < 4; ++tt) Z[tt] = MFMA16(a0, qa[tt], Z[tt]);
#pragma unroll
          for (int tt = 0; tt < 4; ++tt) Z[tt] = MFMA16(a1, qa[4 + tt], Z[tt]); }
#pragma unroll
        for (int i = 0; i < 4; ++i) S[4 + i] = S[4 + i] * gm[i];
#pragma unroll
        for (int i = 0; i < 4; ++i) { qa[2 * i] = SC_KF(i, 0); qa[2 * i + 1] = SC_KF(i, 1); }
        SC_FENCE();
        asm volatile("s_waitcnt vmcnt(0)" : "+v"(vn0), "+v"(vn1) :: "memory");
        SC_DMA((c + 2 < 32 ? c + 2 : 31), bo2);
        SC_FENCE();
        { const bf16x8 a2 = SC_AF(2), a3 = SC_AF(3);
#pragma unroll
          for (int tt = 0; tt < 4; ++tt) Z[tt] = MFMA16(a2, qb[tt], Z[tt]);
#pragma unroll
          for (int tt = 0; tt < 4; ++tt) Z[tt] = MFMA16(a3, qb[4 + tt], Z[tt]);
#pragma unroll
          for (int tt = 0; tt < 4; ++tt) Z[tt] = MFMA16(dh ? vf[1] : vf[0], pq[tt], Z[tt]); }
#pragma unroll
        for (int i = 0; i < 4; ++i) { qb[2 * i] = SC_KF(4 + i, 0); qb[2 * i + 1] = SC_KF(4 + i, 1); }
        SC_FENCE();
#pragma unroll
        for (int i = 0; i < 4; ++i) { S[i] = MFMA16(qa[2 * i], vf[0], S[i]); S[i] = MFMA16(qa[2 * i + 1], vf[1], S[i]); }
#pragma unroll
        for (int i = 0; i < 4; ++i) { S[4 + i] = MFMA16(qb[2 * i], vf[0], S[4 + i]); S[4 + i] = MFMA16(qb[2 * i + 1], vf[1], S[4 + i]); }
#undef SC_FENCE
#undef SC_BQ
#undef SC_KF
#undef SC_AF
        { LAS unsigned char* ot = lds + SC_OT + (c & 1) * 16384 + (g & 1) * 8;
#pragma unroll
          for (int tt = 0; tt < 4; ++tt) { u32x2 w; w.x = cvtpk2(Z[tt][0], Z[tt][1]); w.y = cvtpk2(Z[tt][2], Z[tt][3]);
              *(LAS u32x2*)(ot + (16 * tt + r) * 256 + (((2 * wave + (g >> 1)) ^ r) << 4)) = w; } }
        asm volatile("s_waitcnt lgkmcnt(0)" ::: "memory"); __builtin_amdgcn_s_barrier(); asm volatile("" ::: "memory");
        vc0 = vn0; vc1 = vn1;
        { const unsigned t_ = bo0; bo0 = bo1; bo1 = bo2; bo2 = t_; }
    }
    SC_OSTORE(nch - 1);
#undef SC_OSTORE
#undef SC_DMA
    asm volatile("s_waitcnt vmcnt(0)" ::: "memory"); __syncthreads();
    float* SO = P.out + OUT_GLAP + ((size_t)bh * 256 + 128 * dh + 4 * g) * 512 + eq * 128 + 16 * wave + r;
#pragma unroll
    for (int i = 0; i < 8; ++i) { float* so = SO + (size_t)i * 16 * 512; asm volatile("" : "+v"(so));
        so[0] = S[i][0]; so[512] = S[i][1]; so[1024] = S[i][2]; so[1536] = S[i][3]; }
}

__device__ __forceinline__ void gla_sample_unit(const Ptrs& P, LAS unsigned char* lds, int u, int tid, int wave, int lane) {
    const int h = u & 3, b = u >> 2;
    LAS float* GL = (LAS float*)lds;
    LAS float* QD = (LAS float*)(lds + 1024);
    LAS float* KD = (LAS float*)(lds + 1024 + 8192);
    LAS float* GD = (LAS float*)(lds + 1024 + 16384);
    LAS float* PR = (LAS float*)(lds + 18432);
    LAS float* RED = (LAS float*)(lds + 18688);
    LAS float* VL = (LAS float*)(lds + 20480);
    LAS float* OP = (LAS float*)(lds + 36864);
    const int row0 = MPR + b * 8;
    const bf16* QK = (const bf16*)(P.ws + WS_QK); const bf16* VT = (const bf16*)(P.ws + WS_VT); const float* GLOW = (const float*)(P.ws + WS_GLOW);
    const int eq = tid & 127, dq = tid >> 7;
    const size_t sbase = ((size_t)(b * 4 + h) * 256 + 64 * dq) * 512 + 4 * eq;
    const float* S0p = P.state + sbase; float* S1p = P.out + OUT_GLAS + sbase;
    if (tid < 32) ((LAS f32x4*)GL)[tid] = ((const f32x4*)(GLOW + (size_t)row0 * 16))[tid];
    { const v4u vv = *(const GAS v4u*)(VT + (size_t)(h * 512 + tid) * MT + row0);
      VL[0 * 512 + tid] = __uint_as_float(vv.x << 16); VL[1 * 512 + tid] = __uint_as_float(vv.x & 0xffff0000u); VL[2 * 512 + tid] = __uint_as_float(vv.y << 16); VL[3 * 512 + tid] = __uint_as_float(vv.y & 0xffff0000u);
      VL[4 * 512 + tid] = __uint_as_float(vv.z << 16); VL[5 * 512 + tid] = __uint_as_float(vv.z & 0xffff0000u); VL[6 * 512 + tid] = __uint_as_float(vv.w << 16); VL[7 * 512 + tid] = __uint_as_float(vv.w & 0xffff0000u); }
    __syncthreads();
    if (tid < 256) {
        const int d = tid;
        float wg[16];
#pragma unroll
        for (int r = 0; r < 16; ++r) wg[r] = P.w_gate_up[r * 1024 + h * 256 + d];
        const float bias = P.b_gate[h * 256 + d];
        float bc[8], q[8], k[8]; float run = 0.f;
#pragma unroll
        for (int t = 0; t < 8; ++t) { q[t] = bf2f(QK[(size_t)(row0 + t) * DM + h * 256 + d]); k[t] = bf2f(QK[(size_t)(row0 + t) * DM + 1024 + h * 256 + d]); }
#pragma unroll
        for (int t = 0; t < 8; ++t) { const LAS f32x4* gr = (const LAS f32x4*)(GL + t * 16); const f32x4 g0 = gr[0], g1 = gr[1], g2 = gr[2], g3 = gr[3];
            float z = bias + g0.x * wg[0] + g0.y * wg[1] + g0.z * wg[2] + g0.w * wg[3] + g1.x * wg[4] + g1.y * wg[5] + g1.z * wg[6] + g1.w * wg[7]
                           + g2.x * wg[8] + g2.y * wg[9] + g2.z * wg[10] + g2.w * wg[11] + g3.x * wg[12] + g3.y * wg[13] + g3.z * wg[14] + g3.w * wg[15];
            const float ls = fminf(z, 0.f) - __logf(1.0f + __expf(-fabsf(z)));
            run += ls * 0.0625f; bc[t] = run; }
        const float blast = bc[7];
#pragma unroll
        for (int t = 0; t < 8; ++t) { QD[d * 8 + t] = q[t] * __expf(bc[t]); KD[d * 8 + t] = k[t] * __expf(blast - bc[t]); }
        GD[d] = __expf(blast);
        int idx = 0;
#pragma unroll
        for (int t = 0; t < 8; ++t)
#pragma unroll
            for (int s = 0; s <= t; ++s) { float v = q[t] * k[s] * __expf(bc[t] - bc[s]); v = wave_sum(v); if (lane == 0) RED[wave * 36 + idx] = v; ++idx; }
    }
    __syncthreads();
    if (tid < 64) { const int t = tid >> 3, s = tid & 7; float v = 0.f; if (s <= t) { const int idx = t * (t + 1) / 2 + s; v = RED[idx] + RED[36 + idx] + RED[72 + idx] + RED[108 + idx]; } PR[t * 8 + s] = v; }
    { f32x4 sa[4], sb[4];
#pragma unroll
      for (int i = 0; i < 4; ++i) sa[i] = *(const GAS f32x4*)(S0p + (size_t)i * 512);
      f32x4 v[8], o[8];
#pragma unroll
      for (int s = 0; s < 8; ++s) v[s] = *(const LAS f32x4*)(VL + s * 512 + 4 * eq);
#pragma unroll
      for (int t = 0; t < 8; ++t) o[t] = (f32x4){0.f, 0.f, 0.f, 0.f};
#define GS_STEP(cur, nxt, d0, more) do { if (more) { _Pragma("unroll") for (int i = 0; i < 4; ++i) nxt[i] = *(const GAS f32x4*)(S0p + (size_t)((d0) + 4 + i) * 512); } \
        _Pragma("unroll") for (int i = 0; i < 4; ++i) { const int dd = 64 * dq + (d0) + i; \
          const f32x4 qa = *(const LAS f32x4*)(QD + dd * 8), qb = *(const LAS f32x4*)(QD + dd * 8 + 4), ka = *(const LAS f32x4*)(KD + dd * 8), kb = *(const LAS f32x4*)(KD + dd * 8 + 4); \
          const float gm = GD[dd]; const f32x4 x = cur[i]; \
          o[0] += x * qa.x; o[1] += x * qa.y; o[2] += x * qa.z; o[3] += x * qa.w; o[4] += x * qb.x; o[5] += x * qb.y; o[6] += x * qb.z; o[7] += x * qb.w; \
          f32x4 sn = x * gm; sn += v[0] * ka.x; sn += v[1] * ka.y; sn += v[2] * ka.z; sn += v[3] * ka.w; sn += v[4] * kb.x; sn += v[5] * kb.y; sn += v[6] * kb.z; sn += v[7] * kb.w; \
          *(GAS f32x4*)(S1p + (size_t)((d0) + i) * 512) = sn; } } while (0)
#pragma unroll 1
      for (int d0 = 0; d0 < 64; d0 += 8) { GS_STEP(sa, sb, d0, true); GS_STEP(sb, sa, d0 + 4, d0 + 8 < 64); }
#undef GS_STEP
#pragma unroll
      for (int t = 0; t < 8; ++t) *(LAS f32x4*)(OP + (dq * 8 + t) * 512 + 4 * eq) = o[t];
    }
    __syncthreads();
    { const int t = tid >> 6, el = tid & 63; bf16* ORAW = (bf16*)(P.ws + WS_BUFA);
#pragma unroll
      for (int j = 0; j < 8; ++j) { const int e = el + 64 * j; float acc = (OP[(0 * 8 + t) * 512 + e] + OP[(1 * 8 + t) * 512 + e]) + (OP[(2 * 8 + t) * 512 + e] + OP[(3 * 8 + t) * 512 + e]);
#pragma unroll
          for (int s = 0; s < 8; ++s) acc += PR[t * 8 + s] * VL[s * 512 + e];
          ORAW[(size_t)(row0 + t) * DM + h * 512 + e] = (bf16)(cvtpk2(acc, 0.f) & 0xffffu); } }
    __syncthreads();
}

__device__ __forceinline__ void gate_row(const Ptrs& P, int row, int lane, bf16* DST) {
    const bf16* O0 = (const bf16*)(P.ws + WS_BUFA); const bf16* O1 = (const bf16*)(P.ws + WS_QK); const bf16* SR = (const bf16*)(P.ws + WS_SR);
    const bool two = row < MPR;
#pragma unroll
    for (int j = 0; j < 4; ++j) { const size_t off = (size_t)row * DM + 512 * j + 8 * lane;
        const v4u a = *(const GAS v4u*)(O0 + off), s = *(const GAS v4u*)(SR + off); v4u bq = {0u, 0u, 0u, 0u}; if (two) bq = *(const GAS v4u*)(O1 + off);
        float o[8];
        o[0] = __uint_as_float(a.x << 16) + __uint_as_float(bq.x << 16); o[1] = __uint_as_float(a.x & 0xffff0000u) + __uint_as_float(bq.x & 0xffff0000u);
        o[2] = __uint_as_float(a.y << 16) + __uint_as_float(bq.y << 16); o[3] = __uint_as_float(a.y & 0xffff0000u) + __uint_as_float(bq.y & 0xffff0000u);
        o[4] = __uint_as_float(a.z << 16) + __uint_as_float(bq.z << 16); o[5] = __uint_as_float(a.z & 0xffff0000u) + __uint_as_float(bq.z & 0xffff0000u);
        o[6] = __uint_as_float(a.w << 16) + __uint_as_float(bq.w << 16); o[7] = __uint_as_float(a.w & 0xffff0000u) + __uint_as_float(bq.w & 0xffff0000u);
        float ss = ((o[0] * o[0] + o[1] * o[1]) + (o[2] * o[2] + o[3] * o[3])) + ((o[4] * o[4] + o[5] * o[5]) + (o[6] * o[6] + o[7] * o[7]));
        const float rs = 1.0f / sqrtf(wave_sum(ss) * (1.f / 512.f) + RMS_EPS);
        v4u w;
        w.x = cvtpk2(o[0] * rs * __uint_as_float(s.x << 16), o[1] * rs * __uint_as_float(s.x & 0xffff0000u));
        w.y = cvtpk2(o[2] * rs * __uint_as_float(s.y << 16), o[3] * rs * __uint_as_float(s.y & 0xffff0000u));
        w.z = cvtpk2(o[4] * rs * __uint_as_float(s.z << 16), o[5] * rs * __uint_as_float(s.z & 0xffff0000u));
        w.w = cvtpk2(o[6] * rs * __uint_as_float(s.w << 16), o[7] * rs * __uint_as_float(s.w & 0xffff0000u));
        *(GAS v4u*)(DST + off) = w; }
}
__device__ __forceinline__ void final_row(float* hrow, const float* gfin, int lane, float* drow) {
    GAS f32x4* xr = (GAS f32x4*)hrow + lane; GAS f32x4* dr = (GAS f32x4*)drow + lane; const GAS f32x4* gr = (const GAS f32x4*)gfin + lane;
    f32x4 v[8]; float s = 0.f;
#pragma unroll
    for (int j = 0; j < 8; ++j) { v[j] = xr[64 * j]; s += (v[j].x * v[j].x + v[j].y * v[j].y) + (v[j].z * v[j].z + v[j].w * v[j].w); }
    const float rstd = 1.0f / sqrtf(wave_sum(s) * (1.f / DM) + RMS_EPS);
#pragma unroll
    for (int j = 0; j < 8; ++j) dr[64 * j] = v[j] * rstd * gr[64 * j];
}

__device__ __forceinline__ void attn_subblock(const LAS bf16* KI, const LAS bf16* VI, int ts, const bf16* qrow, int qpos, int kpos0, float slope2, float sink2,
                                              const bf16* zrow, bf16* orow, bool store, int lane) {
    const int r = lane & 15, g = lane >> 4;
    const bf16x8 q0 = *(const bf16x8*)(qrow + 8 * g), q1 = *(const bf16x8*)(qrow + 32 + 8 * g);
    f32x4 sc[10]; float mx = -INFINITY;
#pragma unroll
    for (int i = 0; i < 10; ++i) { const LAS bf16* kr = KI + (16 * (ts + i) + r) * 80 + 8 * g;
        f32x4 a = {0.f, 0.f, 0.f, 0.f};
        a = MFMA16(*(const LAS bf16x8*)kr, q0, a); a = MFMA16(*(const LAS bf16x8*)(kr + 32), q1, a);
#pragma unroll
        for (int e = 0; e < 4; ++e) { const int kpos = kpos0 + 16 * (ts + i) + 4 * g + e; const int dist = qpos - kpos;
            const bool ok = dist >= 0 && dist <= 128 && kpos >= 0;
            const float v = ok ? a[e] - slope2 * (float)dist : -INFINITY; a[e] = v; mx = fmaxf(mx, v); }
        sc[i] = a; }
    mx = fmaxf(mx, __shfl_xor(mx, 16)); mx = fmaxf(mx, __shfl_xor(mx, 32)); mx = fmaxf(mx, sink2);
    float l = 0.f;
#pragma unroll
    for (int i = 0; i < 10; ++i)
#pragma unroll
        for (int e = 0; e < 4; ++e) { const float p = __builtin_amdgcn_exp2f(sc[i][e] - mx); sc[i][e] = p; l += p; }
    l += __shfl_xor(l, 16); l += __shfl_xor(l, 32);
    const float inv = 1.0f / (l + __builtin_amdgcn_exp2f(sink2 - mx));
    f32x4 o[4];
#pragma unroll
    for (int dt = 0; dt < 4; ++dt) o[dt] = (f32x4){0.f, 0.f, 0.f, 0.f};
#pragma unroll
    for (int ks = 0; ks < 5; ++ks) {
        v4u pp; pp.x = cvtpk2(sc[2 * ks][0], sc[2 * ks][1]); pp.y = cvtpk2(sc[2 * ks][2], sc[2 * ks][3]); pp.z = cvtpk2(sc[2 * ks + 1][0], sc[2 * ks + 1][1]); pp.w = cvtpk2(sc[2 * ks + 1][2], sc[2 * ks + 1][3]);
        const bf16x8 pb = __builtin_bit_cast(bf16x8, pp);
#pragma unroll
        for (int dt = 0; dt < 4; ++dt) { const LAS bf16* vr = VI + (16 * dt + r) * 264 + 16 * (ts + 2 * ks) + 4 * g;
            const u32x2 lo = *(const LAS u32x2*)vr, hi = *(const LAS u32x2*)(vr + 16);
            v4u va; va.x = lo.x; va.y = lo.y; va.z = hi.x; va.w = hi.y;
            o[dt] = MFMA16(__builtin_bit_cast(bf16x8, va), pb, o[dt]); } }
    if (store) {
#pragma unroll
        for (int dt = 0; dt < 4; ++dt) { const u32x2 zz = *(const GAS u32x2*)(zrow + 16 * dt + 4 * g);
            u32x2 w; w.x = cvtpk2(o[dt][0] * inv * __uint_as_float(zz.x << 16), o[dt][1] * inv * __uint_as_float(zz.x & 0xffff0000u));
            w.y = cvtpk2(o[dt][2] * inv * __uint_as_float(zz.y << 16), o[dt][3] * inv * __uint_as_float(zz.y & 0xffff0000u));
            *(GAS u32x2*)(orow + 16 * dt + 4 * g) = w; }
    }
}
__device__ __forceinline__ void attn_prompt_unit(const Ptrs& P, LAS unsigned char* lds, int u, int tid, int wave, int lane) {
    const int kvh = u & 3, qb = (u >> 2) & 15, b = u >> 6;
    LAS bf16* KI = (LAS bf16*)lds;
    LAS bf16* VI = (LAS bf16*)(lds + 40960);
    const bf16* KB = (const bf16*)(P.ws + WS_KB); const bf16* VT2 = (const bf16*)(P.ws + WS_VT2); const bf16* QZ = (const bf16*)(P.ws + WS_QZ); bf16* A3 = (bf16*)(P.ws + WS_SR);
    const int kpos0 = (qb - 1) * 128;
    for (int i = tid; i < 2048; i += NWAVES * 64) { const int j = i >> 3, ch = i & 7; const int kpos = kpos0 + j;
        v4u v = {0u, 0u, 0u, 0u}; if (kpos >= 0) v = *(const GAS v4u*)(KB + (size_t)(b * 2048 + kpos) * 256 + kvh * 64 + ch * 8);
        *(LAS v4u*)(KI + j * 80 + ch * 8) = v; }
    for (int i = tid; i < 2048; i += NWAVES * 64) { const int d = i >> 5, ch = i & 31; const int kpos = kpos0 + ch * 8;
        v4u v = {0u, 0u, 0u, 0u}; if (kpos >= 0) v = *(const GAS v4u*)(VT2 + (size_t)(kvh * 64 + d) * MT + b * 2048 + kpos);
        *(LAS v4u*)(VI + d * 264 + ch * 8) = v; }
    __syncthreads();
    const int hh = kvh * 8 + wave;
    const float slope2 = __builtin_amdgcn_exp2f(-0.25f * (float)(hh + 1)) * LOG2E, sink2 = P.sinks[hh] * LOG2E;
#pragma unroll 1
    for (int qs = 0; qs < 8; ++qs) { const int qpos = qb * 128 + 16 * qs + (lane & 15); const size_t row = (size_t)b * 2048 + qpos;
        attn_subblock(KI, VI, qs < 6 ? qs : 6, QZ + row * 4096 + hh * 64, qpos, kpos0, slope2, sink2, QZ + row * 4096 + 2048 + hh * 64, A3 + row * DM + hh * 64, true, lane); }
    __syncthreads();
}
__device__ __forceinline__ void attn_sample_unit(const Ptrs& P, LAS unsigned char* lds, int u, int tid, int wave, int lane) {
    const int kvh = u & 3, b = u >> 2;
    LAS bf16* KI = (LAS bf16*)lds;
    LAS bf16* VI = (LAS bf16*)(lds + 40960);
    const bf16* KB = (const bf16*)(P.ws + WS_KB); const bf16* VT2 = (const bf16*)(P.ws + WS_VT2); const bf16* QZ = (const bf16*)(P.ws + WS_QZ); bf16* A3 = (bf16*)(P.ws + WS_SR);
    for (int i = tid; i < 160 * 64; i += NWAVES * 64) { const int j = i >> 6, d = i & 63; float kv = 0.f, vv = 0.f;
        if (j < 128) { kv = P.ck[((size_t)(b * 128 + j) * 4 + kvh) * 64 + d]; vv = P.cv[((size_t)(b * 128 + j) * 4 + kvh) * 64 + d]; }
        else if (j < 136) { kv = bf2f(KB[(size_t)(MPR + b * 8 + j - 128) * 256 + kvh * 64 + d]); vv = bf2f(VT2[(size_t)(kvh * 64 + d) * MT + MPR + b * 8 + j - 128]); }
        KI[j * 80 + d] = (bf16)(cvtpk2(kv, 0.f) & 0xffffu); VI[d * 264 + j] = (bf16)(cvtpk2(vv, 0.f) & 0xffffu); }
    __syncthreads();
    const int hh = kvh * 8 + wave;
    const float slope2 = __builtin_amdgcn_exp2f(-0.25f * (float)(hh + 1)) * LOG2E, sink2 = P.sinks[hh] * LOG2E;
    const int n = lane & 15, qi = n < 8 ? n : 7; const size_t row = (size_t)MPR + b * 8 + qi;
    attn_subblock(KI, VI, 0, QZ + row * 4096 + hh * 64, 128 + qi, 0, slope2, sink2, QZ + row * 4096 + 2048 + hh * 64, A3 + row * DM + hh * 64, n < 8, lane);
    __syncthreads();
}
constexpr int SG_A = 0, SG_B = 10240, SG_STAGE = 30720, SG_RS = 2 * SG_STAGE;
template <bool NAT>
__device__ __forceinline__ void sgemm_core(LAS unsigned char* lds, const bf16* A, const bf16* B, f32x4 (&acc)[2][2], int tid, int wave, int lane) {
    const int wm = wave >> 2, wn = wave & 3, r = lane & 15, g = lane >> 4, lr = tid >> 3, ch = tid & 7;
    const GAS v4u* ga = (const GAS v4u*)(A + (size_t)lr * 2048 + ch * 8); const GAS v4u* gb0 = (const GAS v4u*)(B + (size_t)lr * 2048 + ch * 8); const GAS v4u* gb1 = (const GAS v4u*)(B + (size_t)(64 + lr) * 2048 + ch * 8);
    v4u ra0, rb0, rc0, ra1, rb1, rc1;
#pragma unroll
    for (int i = 0; i < 2; ++i)
#pragma unroll
        for (int j = 0; j < 2; ++j) acc[i][j] = (f32x4){0.f, 0.f, 0.f, 0.f};
#define SG_LD(s, kt) do { ra##s = ga[(kt) * 8]; rb##s = gb0[(kt) * 8]; rc##s = gb1[(kt) * 8]; } while (0)
#define SG_ST(s, stg) do { *(LAS v4u*)(lds + (stg) * SG_STAGE + SG_A + lr * 160 + ch * 16) = ra##s; *(LAS v4u*)(lds + (stg) * SG_STAGE + SG_B + lr * 160 + ch * 16) = rb##s; \
                           *(LAS v4u*)(lds + (stg) * SG_STAGE + SG_B + (64 + lr) * 160 + ch * 16) = rc##s; } while (0)
#define SG_COMPUTE(stg) do { _Pragma("unroll") for (int kk = 0; kk < 2; ++kk) { bf16x8 af[2], bfr[2]; \
        _Pragma("unroll") for (int i = 0; i < 2; ++i) af[i] = *(const LAS bf16x8*)(lds + (stg) * SG_STAGE + SG_A + (32 * wm + 16 * i + r) * 160 + (32 * kk + 8 * g) * 2); \
        _Pragma("unroll") for (int j = 0; j < 2; ++j) bfr[j] = *(const LAS bf16x8*)(lds + (stg) * SG_STAGE + SG_B + (32 * wn + 16 * j + r) * 160 + (32 * kk + 8 * g) * 2); \
        _Pragma("unroll") for (int i = 0; i < 2; ++i) _Pragma("unroll") for (int j = 0; j < 2; ++j) acc[i][j] = NAT ? MFMA16(af[i], bfr[j], acc[i][j]) : MFMA16(bfr[j], af[i], acc[i][j]); } } while (0)
    SG_LD(0, 0); SG_LD(1, 1); SG_ST(0, 0); SG_LD(0, 2);
    __syncthreads();
#pragma unroll 1
    for (int kt = 0; kt < 32; kt += 2) {
        SG_COMPUTE(0); SG_ST(1, 1); if (kt + 3 < 32) SG_LD(1, kt + 3);
        __syncthreads();
        SG_COMPUTE(1); if (kt + 2 < 32) SG_ST(0, 0); if (kt + 4 < 32) SG_LD(0, kt + 4);
        __syncthreads();
    }
#undef SG_LD
#undef SG_ST
#undef SG_COMPUTE
}
template <bool SILU>
__device__ __forceinline__ void sg_store_bf16(const f32x4 (&acc)[2][2], bf16* dst, int ld, int wave, int lane, float rs0, float rs1) {
    const int wm = wave >> 2, wn = wave & 3, r = lane & 15, g = lane >> 4;
#pragma unroll
    for (int i = 0; i < 2; ++i)
#pragma unroll
        for (int j = 0; j < 2; ++j) { f32x4 v = acc[i][j] * (i ? rs1 : rs0);
            if (SILU) { v[0] = pg8::silu_f(v[0]); v[1] = pg8::silu_f(v[1]); v[2] = pg8::silu_f(v[2]); v[3] = pg8::silu_f(v[3]); }
            u32x2 w; w.x = cvtpk2(v[0], v[1]); w.y = cvtpk2(v[2], v[3]);
            *(GAS u32x2*)(dst + (size_t)(32 * wm + 16 * i + r) * ld + 32 * wn + 16 * j + 4 * g) = w; }
}
__device__ __forceinline__ void s_in_a_block(const Ptrs& P, LAS unsigned char* lds, int rb, int nbk, int tid, int wave, int lane) {
    const bf16* A = (const bf16*)(P.ws + WS_BUFA) + (size_t)(MPR + 64 * rb) * DM; const bf16* B = (const bf16*)(P.ws + WS_WINA) + (size_t)(128 * nbk) * DM;
    f32x4 acc[2][2];
    if (nbk >= 16 && nbk < 32) {
        sgemm_core<true>(lds, A, B, acc, tid, wave, lane);
        const int wm = wave >> 2, wn = wave & 3, r = lane & 15, g = lane >> 4; bf16* VT = (bf16*)(P.ws + WS_VT);
#pragma unroll
        for (int i = 0; i < 2; ++i)
#pragma unroll
            for (int j = 0; j < 2; ++j) { u32x2 w; w.x = cvtpk2(acc[i][j][0], acc[i][j][1]); w.y = cvtpk2(acc[i][j][2], acc[i][j][3]);
                *(GAS u32x2*)(VT + (size_t)((nbk - 16) * 128 + 32 * wn + 16 * j + r) * MT + MPR + 64 * rb + 32 * wm + 16 * i + 4 * g) = w; }
    } else {
        sgemm_core<false>(lds, A, B, acc, tid, wave, lane);
        if (nbk < 16) sg_store_bf16<false>(acc, (bf16*)(P.ws + WS_QK) + (size_t)(MPR + 64 * rb) * DM + nbk * 128, DM, wave, lane, 1.f, 1.f);
        else sg_store_bf16<true>(acc, (bf16*)(P.ws + WS_SR) + (size_t)(MPR + 64 * rb) * DM + (nbk - 32) * 128, DM, wave, lane, 1.f, 1.f);
    }
}
template <bool WITH_B16>
__device__ __forceinline__ void s_out_block(const Ptrs& P, LAS unsigned char* lds, const bf16* Abase, const bf16* Wt, const float* res, int rb, int nb, int tid, int wave, int lane) {
    f32x4 acc[2][2];
    sgemm_core<false>(lds, Abase + (size_t)(64 * rb) * DM, Wt + (size_t)(128 * nb) * DM, acc, tid, wave, lane);
    const int wm = wave >> 2, wn = wave & 3, r = lane & 15, g = lane >> 4;
    float* out = P.out + OUT_Y + (size_t)MPR * DM; bf16* H1b = (bf16*)(P.ws + WS_SR) + (size_t)MPR * DM; float* SSQ2 = (float*)(P.ws + WS_SSQP);
#pragma unroll
    for (int i = 0; i < 2; ++i) { const int row = 64 * rb + 32 * wm + 16 * i + r; float ss = 0.f;
#pragma unroll
        for (int j = 0; j < 2; ++j) { const size_t off = (size_t)row * DM + 128 * nb + 32 * wn + 16 * j + 4 * g;
            const f32x4 v = *(const GAS f32x4*)(res + off) + acc[i][j]; *(GAS f32x4*)(out + off) = v;
            if (WITH_B16) { u32x2 w; w.x = cvtpk2(v[0], v[1]); w.y = cvtpk2(v[2], v[3]); *(GAS u32x2*)(H1b + off) = w; ss += (v[0] * v[0] + v[1] * v[1]) + (v[2] * v[2] + v[3] * v[3]); } }
        if (WITH_B16) { ss += __shfl_xor(ss, 16); ss += __shfl_xor(ss, 32); if (g == 0) SSQ2[(size_t)row * 64 + nb * 4 + wn] = ss; } }
}
__device__ __forceinline__ void s_in_b_block(const Ptrs& P, LAS unsigned char* lds, int rb, int nbk, int tid, int wave, int lane) {
    const bf16* A = (const bf16*)(P.ws + WS_SR) + (size_t)(MPR + 64 * rb) * DM; const bf16* B = (const bf16*)(P.ws + WS_WINB) + (size_t)(128 * nbk) * DM;
    LAS float* RS = (LAS float*)(lds + SG_RS);
    { const int row = tid >> 3, part = tid & 7; const float* sp = (const float*)(P.ws + WS_SSQP) + (size_t)(64 * rb + row) * 64 + part * 8;
      const f32x4 a = *(const GAS f32x4*)sp, b = *(const GAS f32x4*)(sp + 4); float s = (a[0] + a[1]) + (a[2] + a[3]) + (b[0] + b[1]) + (b[2] + b[3]);
      s += __shfl_xor(s, 1); s += __shfl_xor(s, 2); s += __shfl_xor(s, 4);
      if (part == 0) RS[row] = 1.0f / sqrtf(s * (1.f / DM) + RMS_EPS); }
    f32x4 acc[2][2];
    const int wm = wave >> 2, wn = wave & 3, r = lane & 15, g = lane >> 4;
    if (nbk >= 34) {
        sgemm_core<true>(lds, A, B, acc, tid, wave, lane);
        bf16* VT2 = (bf16*)(P.ws + WS_VT2); float* vws = P.out + OUT_VWS;
#pragma unroll
        for (int i = 0; i < 2; ++i) { const f32x4 rs = *(const LAS f32x4*)(RS + 32 * wm + 16 * i + 4 * g);
#pragma unroll
            for (int j = 0; j < 2; ++j) { const f32x4 v = acc[i][j] * rs; const int col = (nbk - 34) * 128 + 32 * wn + 16 * j + r; const int srow = 64 * rb + 32 * wm + 16 * i + 4 * g;
                u32x2 w; w.x = cvtpk2(v[0], v[1]); w.y = cvtpk2(v[2], v[3]);
                *(GAS u32x2*)(VT2 + (size_t)col * MT + MPR + srow) = w;
#pragma unroll
                for (int e = 0; e < 4; ++e) { const int s = srow + e; vws[((size_t)(s >> 3) * 128 + 120 + (s & 7)) * 256 + col] = v[e]; } } }
    } else {
        sgemm_core<false>(lds, A, B, acc, tid, wave, lane);
        const float rs0 = RS[32 * wm + r], rs1 = RS[32 * wm + 16 + r];
        if (nbk < 16) sg_store_bf16<false>(acc, (bf16*)(P.ws + WS_QZ) + (size_t)(MPR + 64 * rb) * 4096 + nbk * 128, 4096, wave, lane, rs0, rs1);
        else if (nbk < 32) sg_store_bf16<true>(acc, (bf16*)(P.ws + WS_QZ) + (size_t)(MPR + 64 * rb) * 4096 + nbk * 128, 4096, wave, lane, rs0, rs1);
        else { sg_store_bf16<false>(acc, (bf16*)(P.ws + WS_KB) + (size_t)(MPR + 64 * rb) * 256 + (nbk - 32) * 128, 256, wave, lane, rs0, rs1);
            float* kws = P.out + OUT_KWS;
#pragma unroll
            for (int i = 0; i < 2; ++i) { const int s = 64 * rb + 32 * wm + 16 * i + r; float* d = kws + ((size_t)(s >> 3) * 128 + 120 + (s & 7)) * 256 + (nbk - 32) * 128 + 32 * wn + 4 * g;
#pragma unroll
                for (int j = 0; j < 2; ++j) *(GAS f32x4*)(d + 16 * j) = acc[i][j] * (i ? rs1 : rs0); } }
    }
}
#ifndef MK_N_LAUNCHES
#define MK_N_LAUNCHES 1
#endif
#ifndef DUP_PHASE
#define DUP_PHASE -1
#endif
#define REPS(k) for (int rep_ = 0; rep_ < ((DUP_PHASE) == (k) ? 2 : 1); ++rep_)
constexpr int N_PHASES = 12;
constexpr int N_LAUNCHES = MK_N_LAUNCHES;
struct Args { Ptrs p; int ph_lo, ph_hi, sub, pad; };
static_assert(sizeof(Args) == 20 * 8 + 16, "Args has no padding");

__global__ void __launch_bounds__(NWAVES * 64, 2) yoco_fwd(Args args) {
    extern __shared__ __attribute__((aligned(16))) unsigned char lds_raw[];
    LAS unsigned char* lds = (LAS unsigned char*)lds_raw;
    volatile LAS unsigned* MISC = (volatile LAS unsigned*)(lds + MISC_OFF);
    const int tid = threadIdx.x, lane = tid & 63, wave = __builtin_amdgcn_readfirstlane(tid >> 6);
    const int G = gridDim.x, c = blockIdx.x;
    const int vcu = (G % 8 == 0) ? (c % 8) * (G / 8) + c / 8 : c;
    const Ptrs& P = args.p;
    gu32* ctl = (gu32*)(P.ws + WS_CTL);
    for (int u = tid; u < (LDS_BYTES - LDSCTL_OFF) / 4; u += NWAVES * 64) ((LAS unsigned*)(lds + LDSCTL_OFF))[u] = 0u;
    __syncthreads();
    XcdBarrier bar; bar.bar = (unsigned*)(ctl + CW_BAR); bar.x = 0; bar.st = nullptr;
    const int lo = args.ph_lo, hi = args.ph_hi;
    if (hi - lo > 1) bar = xcd_barrier_post((unsigned*)(ctl + CW_BAR), MISC + 8);
#define IN(k) (lo <= (k) && (k) < hi)
#define SEAM(k) do { if (IN(k) && IN((k) + 1)) xcd_barrier(bar); } while (0)
    const int gw = vcu * NWAVES + wave, NGW = G * NWAVES;

    if (IN(0)) { REPS(0) p0_prologue(P, lds, vcu, G, tid, wave, lane); SEAM(0); }

    if (IN(1)) {
        pg8::SchedInA S{G, c, (const char*)(P.ws + WS_BUFA), (const char*)(P.ws + WS_WINA)};
        pg8::EpiInA E{(pg8::bf16_t*)(P.ws + WS_QK), (pg8::bf16_t*)(P.ws + WS_SR), (pg8::bf16_t*)(P.ws + WS_VT), MT};
        REPS(1) pg8::gemm_phase<pg8::EpiInA, pg8::SchedInA, true, true>(lds, 2048, S, E);
        for (int task = c * NWAVES + wave; task < MT / 16; task += NGW)
            glow_task((const bf16*)(P.ws + WS_BUFA), (const bf16*)(P.ws + WS_WINA) + (size_t)6144 * DM, (float*)(P.ws + WS_GLOW), task, lane);
        SEAM(1);
    }

    if (IN(2)) {
        REPS(20) for (int blk = c; blk < 192; blk += G) s_in_a_block(P, lds, blk / 48, blk % 48, tid, wave, lane);
        if (G == 256) { REPS(2) for (int j = 0; j < 2; ++j) gla_prep_unit(P, lds, (2 * (c & 7) + j) * 32 + (c >> 3), tid, wave, lane); }
        else for (int u = c; u < 512; u += G) gla_prep_unit(P, lds, u, tid, wave, lane);
        SEAM(2);
    }

    if (IN(3)) {
        if (G >= 256) {
            const int sub = args.sub;
            if (c < 128) { const int xcd = c & 7, idx = c >> 3; if (sub == 0 || sub == 1) gla_scan_unit(P, lds, xcd * 2 + (idx >> 3), (idx >> 2) & 1, idx & 3, tid, wave, lane); }
            else { if (sub == 0 || sub == 2) gla_sample_unit(P, lds, c - 128, tid, wave, lane);
                if (sub == 0 || sub == 3) convert_weights(P, lds, 1, (c - 128) * NWAVES + wave, (G - 128) * NWAVES, wave, lane); }
        } else {
            for (int u = c; u < 128; u += G) gla_scan_unit(P, lds, u >> 3, (u >> 2) & 1, u & 3, tid, wave, lane);
            for (int t = c; t < 128; t += G) gla_sample_unit(P, lds, t, tid, wave, lane);
        }
        SEAM(3);
    }

    if (IN(4)) { if (DUP_PHASE == 4) for (int m = gw; m < MT; m += NGW) gate_row(P, m, lane, (bf16*)(P.ws + WS_REC));
        for (int m = gw; m < MT; m += NGW) gate_row(P, m, lane, (bf16*)(P.ws + WS_BUFA)); SEAM(4); }

    if (IN(5)) {
        pg8::SchedOut S{G, c, (const char*)(P.ws + WS_BUFA), (const char*)(P.ws + WS_WOA)};
        pg8::EpiRes E{P.x_prompt, nullptr, P.out + OUT_Y};
        REPS(5) pg8::gemm_phase<pg8::EpiRes, pg8::SchedOut, true, true>(lds, 2048, S, E);
        SEAM(5);
    }

    if (IN(6)) {
        const int NS = G >= 128 ? 64 : 0;
        REPS(6) if (c < NS) { for (int blk = c; blk < 64; blk += NS) s_out_block<true>(P, lds, (const bf16*)(P.ws + WS_BUFA) + (size_t)MPR * DM, (const bf16*)(P.ws + WS_WOA), P.x_sample, blk >> 4, blk & 15, tid, wave, lane); }
        else { if (NS == 0) for (int blk = c; blk < 64; blk += G) s_out_block<true>(P, lds, (const bf16*)(P.ws + WS_BUFA) + (size_t)MPR * DM, (const bf16*)(P.ws + WS_WOA), P.x_sample, blk >> 4, blk & 15, tid, wave, lane);
            bf16* H1N = (bf16*)(P.ws + WS_BUFA);
            for (int m = (c - NS) * NWAVES + wave; m < MPR; m += (G - NS) * NWAVES) rms_row_to_bf16(P.out + OUT_Y + (size_t)m * DM, H1N + (size_t)m * DM, lane); }
        SEAM(6);
    }

    if (IN(7)) {
        pg8::SchedInB S{G, c, (const char*)(P.ws + WS_BUFA), (const char*)(P.ws + WS_WINB)};
        pg8::EpiInB E{(pg8::bf16_t*)(P.ws + WS_QZ), (pg8::bf16_t*)(P.ws + WS_KB), (pg8::bf16_t*)(P.ws + WS_VT2), MT, P.out + OUT_KWP, P.out + OUT_VWP, P.out + OUT_KWS, P.out + OUT_VWS};
        REPS(7) pg8::gemm_phase<pg8::EpiInB, pg8::SchedInB, true, true>(lds, 2048, S, E);
        REPS(70) for (int blk = (c + G - (64 % G)) % G; blk < 144; blk += G) s_in_b_block(P, lds, blk / 36, blk % 36, tid, wave, lane);
        SEAM(7);
    }

    if (IN(8)) {
        REPS(8) for (int u = c; u < 256; u += G) attn_prompt_unit(P, lds, u, tid, wave, lane);
        REPS(80) for (int u = c; u < 128; u += G) attn_sample_unit(P, lds, u, tid, wave, lane);
        SEAM(8);
    }

    if (IN(9)) {
        pg8::SchedOut S{G, c, (const char*)(P.ws + WS_SR), (const char*)(P.ws + WS_WOB)};
        pg8::EpiRes E{P.out + OUT_Y, nullptr, P.out + OUT_Y};
        pg8::gemm_phase<pg8::EpiRes, pg8::SchedOut, true, true>(lds, 2048, S, E);
        SEAM(9);
    }

    if (IN(10)) {
        const int NS = G >= 128 ? 64 : 0;
        if (c < NS) { for (int blk = c; blk < 64; blk += NS) s_out_block<false>(P, lds, (const bf16*)(P.ws + WS_SR) + (size_t)MPR * DM, (const bf16*)(P.ws + WS_WOB), P.out + OUT_Y + (size_t)MPR * DM, blk >> 4, blk & 15, tid, wave, lane); }
        else { if (NS == 0) for (int blk = c; blk < 64; blk += G) s_out_block<false>(P, lds, (const bf16*)(P.ws + WS_SR) + (size_t)MPR * DM, (const bf16*)(P.ws + WS_WOB), P.out + OUT_Y + (size_t)MPR * DM, blk >> 4, blk & 15, tid, wave, lane);
            if (DUP_PHASE == 10) for (int m = (c - NS) * NWAVES + wave; m < MPR; m += (G - NS) * NWAVES) final_row(P.out + OUT_Y + (size_t)m * DM, P.g_final, lane, (float*)(P.ws + WS_QK) + (size_t)m * DM);
            for (int m = (c - NS) * NWAVES + wave; m < MPR; m += (G - NS) * NWAVES) final_row(P.out + OUT_Y + (size_t)m * DM, P.g_final, lane, P.out + OUT_Y + (size_t)m * DM); }
        SEAM(10);
    }

    if (IN(11)) { for (int m = MPR + gw; m < MT; m += NGW) final_row(P.out + OUT_Y + (size_t)m * DM, P.g_final, lane, P.out + OUT_Y + (size_t)m * DM);
        if (DUP_PHASE == 90) for (int i_ = 0; i_ < 10; ++i_) xcd_barrier(bar); }
#undef IN
#undef SEAM
}

extern "C" void kernel_launch(void* const* d_in, const int* in_sizes, int n_in, void* d_out, int out_size, void* d_ws, size_t ws_size, hipStream_t stream) {
    static int grid = 0;
    if (grid == 0) {
        if (n_in != 18 || (size_t)out_size != OUT_TOTAL || ws_size < WS_END) { fprintf(stderr, "kernel_launch: unexpected shapes (n_in %d, out %d, ws %zu); nothing launched\n", n_in, out_size, ws_size); grid = -1; return; }
        int dev = 0, cus = 0, per_cu = 0;
        if (hipGetDevice(&dev) != hipSuccess || hipDeviceGetAttribute(&cus, hipDeviceAttributeMultiprocessorCount, dev) != hipSuccess) { grid = -1; return; }
        if (hipFuncSetAttribute((const void*)yoco_fwd, hipFuncAttributeMaxDynamicSharedMemorySize, LDS_BYTES) != hipSuccess) { fprintf(stderr, "kernel_launch: hipFuncSetAttribute failed\n"); grid = -1; return; }
        if (hipOccupancyMaxActiveBlocksPerMultiprocessor(&per_cu, (const void*)yoco_fwd, NWAVES * 64, LDS_BYTES) != hipSuccess || per_cu < 1)
            fprintf(stderr, "kernel_launch: note: occupancy query reports %d workgroups per CU\n", per_cu);
        (void)hipGetLastError();
        grid = cus;
    }
    if (grid < 0) return;
    (void)hipMemsetAsync((char*)d_ws + WS_CTL, 0, CTL_ZERO_BYTES, stream);
    Args a{};
    const float** pp = (const float**)&a.p;
    for (int i = 0; i < 18; ++i) pp[i] = (const float*)d_in[i];
    a.p.out = (float*)d_out; a.p.ws = (unsigned char*)d_ws;
#if defined(PROBE_PHASE)
    { a.ph_lo = PROBE_PHASE; a.ph_hi = PROBE_PHASE + 1; a.sub = PROBE_SUB; hipLaunchKernelGGL(yoco_fwd, dim3(grid), dim3(NWAVES * 64), LDS_BYTES, stream, a); }
#endif
    a.sub = 0;
    for (int li = 0; li < N_LAUNCHES; ++li) {
        a.ph_lo = (N_LAUNCHES == 1) ? 0 : li; a.ph_hi = (N_LAUNCHES == 1) ? N_PHASES : li + 1;
        hipLaunchKernelGGL(yoco_fwd, dim3(grid), dim3(NWAVES * 64), LDS_BYTES, stream, a);
    }
}
```

```cpp
#include <hip/hip_runtime.h>
#include <cstdio>
#include <cstdint>
#include <cmath>
namespace pg8 {
#define PG8_LAS __attribute__((address_space(3)))
typedef unsigned short bf16_t;
typedef short bf16x8 __attribute__((ext_vector_type(8)));
typedef float f32x4 __attribute__((ext_vector_type(4)));
typedef unsigned u32x4 __attribute__((ext_vector_type(4)));
constexpr int BM = 256, BK = 64, HALF = 128, HTB = HALF * BK * 2  , STAGE_BYTES = 8 * HTB, NXCD = 8, WGM = 8;

__host__ __device__ __forceinline__ int lds_byte(int r, int c) { const int st = (r >> 4) * 2 + (c >> 5), rr = r & 15, cc = c & 31, ob = rr * 64 + cc * 2; return st * 1024 + (ob ^ (((ob >> 9) & 1) << 5)); }
__host__ __device__ __forceinline__ void stage_rc(int b, int& R, int& C) { const int st = b / 1024, sb = b % 1024, swz = sb ^ (((sb >> 9) & 1) << 5); R = (st >> 1) * 16 + swz / 64; C = (st & 1) * 32 + (swz % 64) / 2; }
__host__ __device__ __forceinline__ int perm32(int rho) { const int n = rho >> 4, i = rho & 15; return 8 * (i >> 2) + 4 * n + (i & 3); }

struct Unit { const char* a; const char* b; int pm, pn, kind, par; };
__device__ __forceinline__ void tile_map(int L, int nM, int nN, int& pm, int& pn) {
    const int nwg = nM * nN; int wgid = L; { const int q = nwg / NXCD, r = nwg % NXCD, xcd = wgid % NXCD, off = wgid / NXCD; wgid = (xcd < r ? xcd * (q + 1) : r * (q + 1) + (xcd - r) * q) + off; }
    const int nig = WGM * nN, gid = wgid / nig, fm = gid * WGM, gsz = (nM - fm) < WGM ? (nM - fm) : WGM;
    pm = fm + ((wgid % nig) % gsz); pn = (wgid % nig) / gsz;
}
typedef float f32x2_t __attribute__((ext_vector_type(2))); typedef __bf16 bf16x2_t __attribute__((ext_vector_type(2)));
__device__ __forceinline__ unsigned cvtpk(float lo, float hi) { f32x2_t v = {lo, hi}; bf16x2_t b = __builtin_convertvector(v, bf16x2_t); return __builtin_bit_cast(unsigned, b); }
__device__ __forceinline__ float silu_f(float v) { return v / (1.0f + __expf(-v)); }

template <bool SILU>
__device__ __forceinline__ void store_tile_bf16(const f32x4 (&acc)[2][2][4][2], bf16_t* base, int ldc, int row_t, int col_t, int wr, int wc, int fr, int fq, const PG8_LAS float* rtab = nullptr) {
    const int row0 = row_t + wr * 64 + fr, col0 = col_t + wc * 32 + 8 * fq;
#pragma unroll
    for (int ai = 0; ai < 2; ++ai)
#pragma unroll
        for (int m = 0; m < 4; ++m) { bf16_t* rowp = base + (size_t)(row0 + ai * HALF + m * 16) * ldc + col0; const float rsc = rtab ? rtab[wr * 64 + fr + ai * HALF + m * 16] : 1.0f;
#pragma unroll
            for (int bj = 0; bj < 2; ++bj) { f32x4 v0 = acc[ai][bj][m][0] * rsc, v1 = acc[ai][bj][m][1] * rsc;
                if (SILU) { v0[0] = silu_f(v0[0]); v0[1] = silu_f(v0[1]); v0[2] = silu_f(v0[2]); v0[3] = silu_f(v0[3]); v1[0] = silu_f(v1[0]); v1[1] = silu_f(v1[1]); v1[2] = silu_f(v1[2]); v1[3] = silu_f(v1[3]); }
                u32x4 w; w.x = cvtpk(v0[0], v0[1]); w.y = cvtpk(v0[2], v0[3]); w.z = cvtpk(v1[0], v1[1]); w.w = cvtpk(v1[2], v1[3]);
                *(u32x4*)(rowp + bj * HALF) = w; } }
}

struct EpiInA {
    static constexpr bool PERM = true, AFTER_DRAIN = false;
    bf16_t* QK; bf16_t* SR; bf16_t* VT; int MT;
    __device__ __forceinline__ void operator()(const f32x4 (&acc)[2][2][4][2], const Unit& u, int wr, int wc, int fr, int fq) const {
        if (u.kind == 0) store_tile_bf16<false>(acc, QK, 2048, u.pm * BM, u.pn * BM, wr, wc, fr, fq);
        else if (u.kind == 1) store_tile_bf16<true>(acc, SR, 2048, u.pm * BM, (u.pn - 8) * BM, wr, wc, fr, fq);
        else store_tile_bf16<false>(acc, VT, MT, u.pm * BM, u.pn * BM, wr, wc, fr, fq);
    }
};

struct EpiInB {
    static constexpr bool PERM = true, AFTER_DRAIN = false;
    bf16_t* QZ; bf16_t* KB; bf16_t* VT2; int MT; float* kwp; float* vwp; float* kws; float* vws; const PG8_LAS float* tab;
    __device__ __forceinline__ static float* win_row(int t, float* wp, float* wsmp) {
        if (t < 8192) { const int pos = t & 2047; if (pos < 1920) return nullptr; return wp + ((size_t)(t >> 11) * 128 + (pos - 1920)) * 256; }
        const int s = t - 8192; return wsmp + ((size_t)(s >> 3) * 128 + 120 + (s & 7)) * 256;
    }
    __device__ __forceinline__ void operator()(const f32x4 (&acc)[2][2][4][2], const Unit& u, int wr, int wc, int fr, int fq) const {
        const PG8_LAS float* T = tab + (u.par << 8);
        if (u.kind == 0) { store_tile_bf16<false>(acc, QZ, 4096, u.pm * BM, u.pn * BM, wr, wc, fr, fq, T); return; }
        if (u.kind == 1) { store_tile_bf16<true>(acc, QZ, 4096, u.pm * BM, u.pn * BM, wr, wc, fr, fq, T); return; }
        if (u.kind == 2) {
            store_tile_bf16<false>(acc, KB, 256, u.pm * BM, 0, wr, wc, fr, fq, T);
            if ((u.pm & 7) == 7) {
                const int row0 = u.pm * BM + wr * 64 + fr, col0 = wc * 32 + 8 * fq;
#pragma unroll
                for (int ai = 0; ai < 2; ++ai)
#pragma unroll
                    for (int m = 0; m < 4; ++m) { float* d = win_row(row0 + ai * HALF + m * 16, kwp, kws); const float rsc = T[wr * 64 + fr + ai * HALF + m * 16];
                        if (d) {
#pragma unroll
                            for (int bj = 0; bj < 2; ++bj) { *(f32x4*)(d + col0 + bj * HALF) = acc[ai][bj][m][0] * rsc; *(f32x4*)(d + col0 + bj * HALF + 4) = acc[ai][bj][m][1] * rsc; } } }
            }
            return;
        }
        const int row0 = wr * 64 + fr, colb = wc * 32 + 8 * fq;
        f32x4 cs[2][2];
#pragma unroll
        for (int bj = 0; bj < 2; ++bj) { cs[bj][0] = *(const PG8_LAS f32x4*)(T + colb + bj * HALF); cs[bj][1] = *(const PG8_LAS f32x4*)(T + colb + bj * HALF + 4); }
#pragma unroll
        for (int ai = 0; ai < 2; ++ai)
#pragma unroll
            for (int m = 0; m < 4; ++m) { bf16_t* rowp = VT2 + (size_t)(row0 + ai * HALF + m * 16) * MT + u.pn * BM + colb;
#pragma unroll
                for (int bj = 0; bj < 2; ++bj) { const f32x4 v0 = acc[ai][bj][m][0] * cs[bj][0], v1 = acc[ai][bj][m][1] * cs[bj][1];
                    u32x4 w; w.x = cvtpk(v0[0], v0[1]); w.y = cvtpk(v0[2], v0[3]); w.z = cvtpk(v1[0], v1[1]); w.w = cvtpk(v1[2], v1[3]);
                    *(u32x4*)(rowp + bj * HALF) = w; } }
        if ((u.pn & 7) == 7) {
            const int col0 = u.pn * BM + colb;
#pragma unroll
            for (int bj = 0; bj < 2; ++bj)
#pragma unroll
                for (int n = 0; n < 2; ++n)
#pragma unroll
                    for (int j = 0; j < 4; ++j) { float* d = win_row(col0 + bj * HALF + 4 * n + j, vwp, vws);
                        if (d) {
#pragma unroll
                            for (int ai = 0; ai < 2; ++ai)
#pragma unroll
                                for (int m = 0; m < 4; ++m) d[row0 + ai * HALF + m * 16] = acc[ai][bj][m][n][j] * cs[bj][n][j]; } }
        }
    }
};

struct EpiOutA {
    static constexpr bool PERM = false, AFTER_DRAIN = false;
    const float* x; bf16_t* H1b; float* SSQ1;
    __device__ __forceinline__ void operator()(const f32x4 (&acc)[2][2][4][2], const Unit& u, int wr, int wc, int fr, int fq) const {
        const int row0 = u.pm * BM + wr * 64 + fr, col0 = u.pn * BM + wc * 32 + 4 * fq;
#pragma unroll
        for (int ai = 0; ai < 2; ++ai)
#pragma unroll
            for (int m = 0; m < 4; ++m) { const int row = row0 + ai * HALF + m * 16; const size_t off = (size_t)row * 2048 + col0; float ss = 0.f;
#pragma unroll
                for (int bj = 0; bj < 2; ++bj)
#pragma unroll
                    for (int n = 0; n < 2; ++n) { const f32x4 v = *(const f32x4*)(x + off + bj * HALF + n * 16) + acc[ai][bj][m][n];
                        typedef unsigned u32x2_t __attribute__((ext_vector_type(2))); u32x2_t w; w.x = cvtpk(v[0], v[1]); w.y = cvtpk(v[2], v[3]);
                        *(u32x2_t*)(H1b + off + bj * HALF + n * 16) = w; ss += (v[0] * v[0] + v[1] * v[1]) + (v[2] * v[2] + v[3] * v[3]); }
                ss += __shfl_xor(ss, 16); ss += __shfl_xor(ss, 32);
                if (fq == 0) SSQ1[(size_t)row * 32 + u.pn * 4 + wc] = ss; }
    }
};
struct EpiOutB {
    static constexpr bool PERM = false, AFTER_DRAIN = false;
    const bf16_t* H1b; float* out;
    __device__ __forceinline__ void operator()(const f32x4 (&acc)[2][2][4][2], const Unit& u, int wr, int wc, int fr, int fq) const {
        const int row0 = u.pm * BM + wr * 64 + fr, col0 = u.pn * BM + wc * 32 + 4 * fq;
#pragma unroll
        for (int ai = 0; ai < 2; ++ai)
#pragma unroll
            for (int m = 0; m < 4; ++m) { const size_t off = (size_t)(row0 + ai * HALF + m * 16) * 2048 + col0;
#pragma unroll
                for (int bj = 0; bj < 2; ++bj)
#pragma unroll
                    for (int n = 0; n < 2; ++n) { typedef unsigned u32x2_t __attribute__((ext_vector_type(2))); const u32x2_t hb = *(const u32x2_t*)(H1b + off + bj * HALF + n * 16);
                        f32x4 r; r[0] = __uint_as_float(hb.x << 16); r[1] = __uint_as_float(hb.x & 0xffff0000u); r[2] = __uint_as_float(hb.y << 16); r[3] = __uint_as_float(hb.y & 0xffff0000u);
                        *(f32x4*)(out + off + bj * HALF + n * 16) = r + acc[ai][bj][m][n]; } }
    }
};

struct SchedInA {
    int G, c; const char* XN; const char* W;
    __device__ __forceinline__ bool next(int i, Unit& u) const {
        const int L = i * G + c; const size_t P = (size_t)BM * 2048 * 2;
        if (L < 512) { u.par = 0; tile_map(L, 32, 16, u.pm, u.pn); u.kind = u.pn < 8 ? 0 : 1; u.a = XN + u.pm * P; u.b = W + (u.pn < 8 ? u.pn : u.pn + 8) * P; return true; }
        if (L < 768) { u.par = 0; tile_map(L - 512, 8, 32, u.pm, u.pn); u.kind = 2; u.a = W + (8 + u.pm) * P; u.b = XN + u.pn * P; return true; }
        return false;
    }
    __device__ __forceinline__ void a_ready(const Unit&) const {}
    __device__ __forceinline__ void done(const Unit&) const {}
};
struct SchedInB {
    int G, c; const char* XN; const char* W; const float* SSQ1; PG8_LAS float* tab;
    __device__ __forceinline__ bool next(int i, Unit& u) const {
        const int L = i * G + c; const size_t P = (size_t)BM * 2048 * 2; u.par = i & 1;
        if (L < 544) { tile_map(L, 32, 17, u.pm, u.pn); u.kind = u.pn < 8 ? 0 : (u.pn < 16 ? 1 : 2); u.a = XN + u.pm * P; u.b = W + u.pn * P; return true; }
        if (L < 576) { u.pm = 0; u.pn = L - 544; u.kind = 3; u.a = W + 17 * P; u.b = XN + u.pn * P; return true; }
        return false;
    }
    __device__ __forceinline__ void a_ready(const Unit& u) const {
        int t = threadIdx.x; asm volatile("" : "+v"(t));
        const int row = t >> 1, hf = t & 1, panel = u.kind == 3 ? u.pn : u.pm;
        const float* p = SSQ1 + ((size_t)panel * BM + row) * 32 + hf * 16;
        const f32x4 a0 = *(const f32x4*)p, a1 = *(const f32x4*)(p + 4), a2 = *(const f32x4*)(p + 8), a3 = *(const f32x4*)(p + 12);
        float s = ((a0[0] + a0[1]) + (a0[2] + a0[3])) + ((a1[0] + a1[1]) + (a1[2] + a1[3])) + ((a2[0] + a2[1]) + (a2[2] + a2[3])) + ((a3[0] + a3[1]) + (a3[2] + a3[3]));
        s += __shfl_xor(s, 1);
        if (hf == 0) tab[(u.par << 8) + row] = 1.0f / sqrtf(s * (1.0f / 2048.0f) + 1e-6f);
    }
    __device__ __forceinline__ void done(const Unit&) const {}
};
struct SchedOut {
    int G, c; const char* A; const char* W;
    __device__ __forceinline__ bool next(int i, Unit& u) const {
        const int L = i * G + c; const size_t P = (size_t)BM * 2048 * 2;
        if (L >= 256) return false;
        tile_map(L, 32, 8, u.pm, u.pn); u.kind = 0; u.par = 0; u.a = A + u.pm * P; u.b = W + u.pn * P; return true;
    }
    __device__ __forceinline__ void a_ready(const Unit&) const {}
    __device__ __forceinline__ void done(const Unit&) const {}
};
template <class Epi, class Sched, bool ALIGN_EPI = false, bool SP2 = false>
__device__ __forceinline__ void gemm_phase(PG8_LAS unsigned char* lds, const int K_, const Sched& S, const Epi& E) {
    const int tid = threadIdx.x, wid = __builtin_amdgcn_readfirstlane(tid >> 6), lane = tid & 63, wr = wid >> 2, wc = wid & 3, fr = lane & 15, fq = lane >> 4;
    const int K = K_, nt = K / BK;
    unsigned voffA[2], voffB[2];
#pragma unroll
    for (int i = 0; i < 2; ++i) { int R, C; stage_rc(tid * 16 + i * 8192, R, C); const int Rb = Epi::PERM ? ((R & ~31) + perm32(R & 31)) : R;
        voffA[i] = (unsigned)(R * K + C) * 2u; voffB[i] = (unsigned)(Rb * K + C) * 2u; }
    const size_t kstep = (size_t)(BK * 2);
    const size_t hstep = (size_t)HALF * K * 2;
    const unsigned ldsw = (unsigned)wid * 1024u;
    const int aoff = lds_byte(wr * 64 + fr, fq * 8), boff = lds_byte(wc * 32 + fr, fq * 8);
#define PG8_SA(b, h) (((b) * 2 + (h)) * HTB)
#define PG8_SB(b, h) ((4 + (b) * 2 + (h)) * HTB)
#define PG8_STAGE(bufoff, gbase, voff) do { _Pragma("unroll") for (int _i = 0; _i < 2; ++_i) \
        __builtin_amdgcn_global_load_lds((const unsigned*)((const char*)(gbase) + (voff)[_i]), (PG8_LAS unsigned*)(lds + (bufoff) + ldsw + _i * 8192), 16, 0, 0); } while (0)
#define PG8_LDA(dst, b, h) do { _Pragma("unroll") for (int m = 0; m < 4; ++m) _Pragma("unroll") for (int k = 0; k < 2; ++k) dst[m][k] = *(const PG8_LAS bf16x8*)(lds + PG8_SA(b, h) + aoff + m * 2048 + k * 1024); } while (0)
#define PG8_LDB(dst, b, h) do { _Pragma("unroll") for (int n = 0; n < 2; ++n) _Pragma("unroll") for (int k = 0; k < 2; ++k) dst[n][k] = *(const PG8_LAS bf16x8*)(lds + PG8_SB(b, h) + boff + n * 2048 + k * 1024); } while (0)
#define PG8_MMA(ai, bj, At, Bt) do { __builtin_amdgcn_s_setprio(1); _Pragma("unroll") for (int m = 0; m < 4; ++m) _Pragma("unroll") for (int n = 0; n < 2; ++n) _Pragma("unroll") for (int k = 0; k < 2; ++k) \
        acc[ai][bj][m][n] = __builtin_amdgcn_mfma_f32_16x16x32_bf16(Bt[n][k], At[m][k], acc[ai][bj][m][n], 0, 0, 0); __builtin_amdgcn_s_setprio(0); } while (0)
#define PG8_WAIT_V(n) asm volatile("s_waitcnt vmcnt(" #n ")" ::: "memory")
#define PG8_WAIT_L(n) asm volatile("s_waitcnt lgkmcnt(" #n ")" ::: "memory")
#define PG8_BAR __builtin_amdgcn_s_barrier()
#define PG8_SCHED __builtin_amdgcn_sched_barrier(0)
    Unit cur, nxt; int ui = 0;
    if (!S.next(0, cur)) return;
    f32x4 acc[2][2][4][2];
#pragma unroll
    for (int a = 0; a < 2; ++a)
#pragma unroll
        for (int b = 0; b < 2; ++b)
#pragma unroll
            for (int m = 0; m < 4; ++m)
#pragma unroll
                for (int n = 0; n < 2; ++n) acc[a][b][m][n] = (f32x4){0.f, 0.f, 0.f, 0.f};
    bf16x8 At[4][2], B0[2][2], B1[2][2];
    const char* cA = cur.a; const char* cB = cur.b;
    S.a_ready(cur);
    if constexpr (SP2) {
        PG8_STAGE(PG8_SB(0, 0), cB, voffB); PG8_STAGE(PG8_SB(0, 1), cB + hstep, voffB); PG8_STAGE(PG8_SA(0, 0), cA, voffA); PG8_STAGE(PG8_SA(0, 1), cA + hstep, voffA);
        if (wr == 1) PG8_BAR;
        PG8_WAIT_V(2); PG8_BAR;
        PG8_STAGE(PG8_SB(1, 0), cB + kstep, voffB); PG8_STAGE(PG8_SA(1, 0), cA + kstep, voffA); PG8_STAGE(PG8_SB(1, 1), cB + hstep + kstep, voffB);
        PG8_WAIT_V(6); PG8_BAR;
    } else {
        PG8_STAGE(PG8_SB(0, 0), cB, voffB); PG8_STAGE(PG8_SA(0, 0), cA, voffA); PG8_STAGE(PG8_SB(0, 1), cB + hstep, voffB); PG8_STAGE(PG8_SA(0, 1), cA + hstep, voffA);
        if (wr == 1) PG8_BAR;
        PG8_WAIT_V(4); PG8_BAR;
        PG8_STAGE(PG8_SB(1, 0), cB + kstep, voffB); PG8_STAGE(PG8_SA(1, 0), cA + kstep, voffA); PG8_STAGE(PG8_SB(1, 1), cB + hstep + kstep, voffB);
        PG8_WAIT_V(6); PG8_BAR;
    }
    for (;;) {
        const bool has_next = S.next(ui + 1, nxt);
        const char* nA = has_next ? nxt.a : cA; const char* nB = has_next ? nxt.b : cB;
        for (int t = 0; t < nt; t += 2) {
            const bool last = (t == nt - 2);
            const char* a1 = cA + (size_t)(t + 1) * kstep;
            const char* a2 = last ? nA : cA + (size_t)(t + 2) * kstep; const char* b2 = last ? nB : cB + (size_t)(t + 2) * kstep;
            const char* a3 = a2 + kstep; const char* b3 = b2 + kstep;
            if (last && has_next) S.a_ready(nxt);
            if constexpr (SP2) {
            PG8_LDB(B0, 0, 0); PG8_LDB(B1, 0, 1); PG8_SCHED; PG8_LDA(At, 0, 0); PG8_STAGE(PG8_SA(1, 1), a1 + hstep, voffA);
            PG8_WAIT_V(8); PG8_WAIT_L(0); PG8_BAR; PG8_MMA(0, 0, At, B0); PG8_MMA(0, 1, At, B1); PG8_BAR; PG8_SCHED;
            PG8_LDA(At, 0, 1); PG8_STAGE(PG8_SB(0, 0), b2, voffB); PG8_STAGE(PG8_SB(0, 1), b2 + hstep, voffB); PG8_STAGE(PG8_SA(0, 0), a2, voffA);
            PG8_WAIT_V(8); PG8_WAIT_L(0); PG8_BAR; PG8_MMA(1, 0, At, B0); PG8_MMA(1, 1, At, B1); PG8_BAR; PG8_SCHED;
            PG8_LDB(B0, 1, 0); PG8_LDB(B1, 1, 1); PG8_SCHED; PG8_LDA(At, 1, 0); PG8_STAGE(PG8_SA(0, 1), a2 + hstep, voffA);
            PG8_WAIT_V(8); PG8_WAIT_L(0); PG8_BAR; PG8_MMA(0, 0, At, B0); PG8_MMA(0, 1, At, B1); PG8_BAR; PG8_SCHED;
            PG8_LDA(At, 1, 1); PG8_STAGE(PG8_SB(1, 0), b3, voffB); PG8_STAGE(PG8_SB(1, 1), b3 + hstep, voffB); PG8_STAGE(PG8_SA(1, 0), a3, voffA);
            PG8_WAIT_V(8); PG8_WAIT_L(0); PG8_BAR; PG8_MMA(1, 0, At, B0); PG8_MMA(1, 1, At, B1); PG8_BAR; PG8_SCHED;
            } else {
            PG8_LDB(B0, 0, 0); PG8_SCHED; PG8_LDA(At, 0, 0); PG8_STAGE(PG8_SA(1, 1), a1 + hstep, voffA);
            PG8_WAIT_L(8); PG8_BAR; PG8_WAIT_L(0); PG8_MMA(0, 0, At, B0); PG8_BAR; PG8_SCHED;
            PG8_LDB(B1, 0, 1); PG8_STAGE(PG8_SB(0, 0), b2, voffB);
            PG8_BAR; PG8_WAIT_L(0); PG8_MMA(0, 1, At, B1); PG8_BAR;
            PG8_LDA(At, 0, 1); PG8_STAGE(PG8_SA(0, 0), a2, voffA);
            PG8_BAR; PG8_WAIT_L(0); PG8_MMA(1, 0, At, B0); PG8_BAR; PG8_SCHED;
            PG8_STAGE(PG8_SB(0, 1), b2 + hstep, voffB);
            PG8_WAIT_V(6); PG8_BAR; PG8_MMA(1, 1, At, B1); PG8_BAR;
            PG8_LDB(B0, 1, 0); PG8_SCHED; PG8_LDA(At, 1, 0); PG8_STAGE(PG8_SA(0, 1), a2 + hstep, voffA);
            PG8_WAIT_L(8); PG8_BAR; PG8_WAIT_L(0); PG8_MMA(0, 0, At, B0); PG8_BAR; PG8_SCHED;
            PG8_LDB(B1, 1, 1); PG8_STAGE(PG8_SB(1, 0), b3, voffB);
            PG8_BAR; PG8_WAIT_L(0); PG8_MMA(0, 1, At, B1); PG8_BAR;
            PG8_LDA(At, 1, 1); PG8_STAGE(PG8_SA(1, 0), a3, voffA);
            PG8_BAR; PG8_WAIT_L(0); PG8_MMA(1, 0, At, B0); PG8_BAR; PG8_SCHED;
            PG8_STAGE(PG8_SB(1, 1), b3 + hstep, voffB);
            PG8_WAIT_V(6); PG8_BAR; PG8_MMA(1, 1, At, B1); PG8_BAR;
            }
        }
        if constexpr (ALIGN_EPI) { if (wr == 0) PG8_BAR; }
        if constexpr (!Epi::AFTER_DRAIN) { E(acc, cur, wr, wc, fr, fq); S.done(cur); }
        if (!has_next) break;
#pragma unroll
        for (int a = 0; a < 2; ++a)
#pragma unroll
            for (int b = 0; b < 2; ++b)
#pragma unroll
                for (int m = 0; m < 4; ++m)
#pragma unroll
                    for (int n = 0; n < 2; ++n) acc[a][b][m][n] = (f32x4){0.f, 0.f, 0.f, 0.f};
        cur = nxt; cA = nA; cB = nB; ++ui;
        if constexpr (ALIGN_EPI) { if (wr == 1) PG8_BAR; }
    }
    PG8_WAIT_V(0);
    if constexpr (!ALIGN_EPI) { if (wr == 0) PG8_BAR; }
    PG8_BAR;
    if constexpr (Epi::AFTER_DRAIN) { E.fused(acc, cur, wr, wc, fr, fq, lds, wid, lane); S.done(cur); }
#undef PG8_SA
#undef PG8_SB
#undef PG8_STAGE
#undef PG8_LDA
#undef PG8_LDB
#undef PG8_MMA
#undef PG8_WAIT_V
#undef PG8_WAIT_L
#undef PG8_BAR
#undef PG8_SCHED
}
}
#define GAS __attribute__((address_space(1)))
#define LAS __attribute__((address_space(3)))
typedef unsigned short bf16;
typedef unsigned v4u __attribute__((ext_vector_type(4)));
typedef float f32x4 __attribute__((ext_vector_type(4)));
typedef short bf16x8 __attribute__((ext_vector_type(8)));
typedef GAS unsigned gu32;
typedef GAS unsigned long long gu64;
#define RLX_AGENT __ATOMIC_RELAXED, __HIP_MEMORY_SCOPE_AGENT
#define LDS_WAIT() asm volatile("s_waitcnt lgkmcnt(0)" ::: "memory")
#define VM_WAIT() asm volatile("s_waitcnt vmcnt(0)" ::: "memory")
__device__ __forceinline__ unsigned long long rt() { return __builtin_amdgcn_s_memrealtime(); }
__device__ __forceinline__ unsigned f2bf(float f) { unsigned u = __builtin_bit_cast(unsigned, f); return (u + 0x7fffu + ((u >> 16) & 1u)) >> 16; }
__device__ __forceinline__ unsigned pk2(float lo, float hi) { return f2bf(lo) | (f2bf(hi) << 16); }

#define XB_TMO      128
#define XB_XCNT(j)  (256  + 64 * (j))
#define XB_XSUB(j)  (1280 + 64 * (j))
#define XB_XGEN(j)  (2304 + 64 * (j))
#define XB_TOP      3328
#define XB_TOPGEN   3392
#define XCD_BAR_WORDS 3456
#define XB_SPIN_CAP (1u << 18)

__device__ __forceinline__ unsigned xb_ld(unsigned* p)              { return __hip_atomic_load(p, __ATOMIC_RELAXED, __HIP_MEMORY_SCOPE_AGENT); }
__device__ __forceinline__ unsigned xb_add(unsigned* p, unsigned v) { return __hip_atomic_fetch_add(p, v, __ATOMIC_RELAXED, __HIP_MEMORY_SCOPE_AGENT); }
__device__ __forceinline__ unsigned xb_xcc_id() { return (unsigned)__builtin_amdgcn_s_getreg((3 << 11) | 20) & 0xFu; }
#define XB_SPIN(cond, bar) do { unsigned _sp = 0; while (cond) { __builtin_amdgcn_s_sleep(1); \
    if ((++_sp & 255u) == 0u) { if (xb_ld(&(bar)[XB_TMO])) break; if (_sp > XB_SPIN_CAP) { atomicAdd(&(bar)[XB_TMO], 1u); break; } } } } while (0)

struct XcdBarrier {
    unsigned* bar; unsigned x;
    volatile LAS unsigned* st;
};

__device__ __forceinline__ XcdBarrier xcd_barrier_post(unsigned* bar, volatile LAS unsigned* st) {
    XcdBarrier b; b.bar = bar; b.x = xb_xcc_id(); b.st = st;
    if (threadIdx.x == 0) (void)xb_add(&bar[XB_XCNT(b.x)], 1u);
    return b;
}
__device__ __forceinline__ void xcd_barrier_complete(unsigned* bar, unsigned x, unsigned& nloc, unsigned& nx) {
    const unsigned G = gridDim.x * gridDim.y * gridDim.z;
    unsigned sum, cnt, mine, sp = 0u;
    for (;;) {
        sum = 0u; cnt = 0u; mine = 0u;
#pragma unroll
        for (unsigned j = 0; j < 16; ++j) { const unsigned c = xb_ld(&bar[XB_XCNT(j)]); sum += c; cnt += (c > 0u) ? 1u : 0u; mine = (j == x) ? c : mine; }
        if (sum == G) break;
        __builtin_amdgcn_s_sleep(1);
        if ((++sp & 255u) == 0u) { if (xb_ld(&bar[XB_TMO])) break; if (sp > XB_SPIN_CAP) { atomicAdd(&bar[XB_TMO], 1u); break; } }
    }
    nloc = mine > 0u ? mine : 1u; nx = cnt > 0u ? cnt : 1u;
}

__device__ __forceinline__ void xcd_barrier(const XcdBarrier& b) {
    asm volatile("s_waitcnt vmcnt(0)" ::: "memory");
    __syncthreads();
    if (threadIdx.x == 0) {
        unsigned* bar = b.bar;
        __builtin_amdgcn_s_waitcnt(0);
        unsigned nloc = b.st[0], nx = b.st[1];
        if (nloc == 0u) { xcd_barrier_complete(bar, b.x, nloc, nx); b.st[0] = nloc; b.st[1] = nx; }
        const unsigned old = xb_add(&bar[XB_XSUB(b.x)], 1u);
        const unsigned gen = old / nloc;
        if (old + 1u == (gen + 1u) * nloc) {
            __builtin_amdgcn_fence(__ATOMIC_RELEASE, "agent");
            asm volatile("s_waitcnt vmcnt(0)" ::: "memory");
            const unsigned og = xb_add(&bar[XB_TOP], 1u);
            const unsigned tg = og / nx;
            if (og + 1u == (tg + 1u) * nx) xb_add(&bar[XB_TOPGEN], 1u);
            else XB_SPIN(xb_ld(&bar[XB_TOPGEN]) == tg, bar);
            __builtin_amdgcn_fence(__ATOMIC_ACQUIRE, "agent");
            xb_add(&bar[XB_XGEN(b.x)], 1u);
            asm volatile("s_waitcnt vmcnt(0)" ::: "memory");
        } else {
            XB_SPIN(xb_ld(&bar[XB_XGEN(b.x)]) == gen, bar);
            __builtin_amdgcn_fence(__ATOMIC_ACQUIRE, "agent");
            asm volatile("s_waitcnt vmcnt(0)" ::: "memory");
        }
    }
    __syncthreads();
}
constexpr int NWAVES = 8;
constexpr int MPR = 8192, MSM = 256, MT = MPR + MSM;
constexpr int DM = 2048;
constexpr float RMS_EPS = 1e-6f;
constexpr float LOG2E = 1.4426950408889634f;
constexpr size_t MiB = 1u << 20;
constexpr size_t WS_CTL = 0, CTL_ZERO_BYTES = 64 * 1024;
constexpr size_t WS_WINA = 1 * MiB;
constexpr size_t WS_WOA = 26 * MiB;
constexpr size_t WS_WINB = 34 * MiB;
constexpr size_t WS_WOB = 52 * MiB;
constexpr size_t WS_BUFA = 60 * MiB;
constexpr size_t WS_QK = 93 * MiB;
constexpr size_t WS_VT = 126 * MiB;
constexpr size_t WS_QZ = 93 * MiB;
constexpr size_t WS_SR = 159 * MiB;
constexpr size_t WS_REC = 192 * MiB;
constexpr size_t WS_KB = 192 * MiB;
constexpr size_t WS_VT2 = 198 * MiB;
constexpr size_t WS_GLOW = 234 * MiB;
constexpr size_t WS_SSQP = 235 * MiB;
constexpr size_t WS_SSQ1 = 236 * MiB;
constexpr int TAB_OFF = 131072;
constexpr size_t WS_END = 240 * MiB;
constexpr int CW_BAR = 1024;
constexpr int HREC = 33792, REC_PO = 33792, REC_H1 = 41984, REC_BYTES = 75776, REC_DMA = 41984, H_QT = 0, H_KT = 16384, H_G = 32768;
static_assert(512 * (size_t)REC_BYTES <= 42 * MiB && REC_DMA % 1024 == 0, "record");
__device__ __forceinline__ int qt_off(int t, int dl) {
    const int d5 = dl & 31; const int p = d5 < 16 ? ((d5 >> 2) << 3) + (d5 & 3) : (((d5 - 16) >> 2) << 3) + 4 + (d5 & 3);
    const int chunk = ((dl >> 5) << 2) + (p >> 3); return t * 256 + ((chunk ^ (t & 15)) << 4) + ((p & 7) << 1); }
__device__ __forceinline__ int qt_chunk(int t, int c) { return t * 256 + ((c ^ (t & 15)) << 4); }
__device__ __forceinline__ int kt_chunk(int d, int c) { return d * 128 + ((c ^ ((d >> 1) & 7)) << 4); }
constexpr size_t OUT_Y = 0, OUT_GLAP = 17301504, OUT_GLAS = 19398656, OUT_KWP = 36175872, OUT_VWP = 36306944, OUT_KWS = 36438016, OUT_VWS = 37486592, OUT_TOTAL = 38535168;
constexpr int RING_BYTES = 131072, LDS_BYTES = 163840, LDSCTL_OFF = LDS_BYTES - 1024, MISC_OFF = LDSCTL_OFF + 320;

__device__ __forceinline__ float bf2f(unsigned short u) { return __uint_as_float(((unsigned)u) << 16); }
__device__ __forceinline__ unsigned cvtpk2(float lo, float hi) { return pg8::cvtpk(lo, hi); }
__device__ __forceinline__ float wave_sum(float v) {
#pragma unroll
    for (int o = 1; o < 64; o <<= 1) v += __shfl_xor(v, o);
    return v;
}
#define MFMA16(a, b, c) __builtin_amdgcn_mfma_f32_16x16x32_bf16((a), (b), (c), 0, 0, 0)
typedef unsigned u32x2 __attribute__((ext_vector_type(2)));

struct Ptrs {
    const float *x_prompt, *x_sample, *state, *ck, *cv, *g_norm_a, *w_in_a, *w_gate_up, *b_gate, *g_onorm, *w_out_a, *g_norm_kv, *w_kv, *g_norm_b, *w_in_b, *sinks, *w_out_b, *g_final;
    float* out; unsigned char* ws;
};

__device__ __forceinline__ void p0_transpose_item(const float* W, int ldw, int ncol0, int nvalid, const float* gain, int scale_cols, float scale, bf16* WT, int row_off, LAS float* scr, int kb, int nb, int lane) {
    const int k0 = 64 * kb, n0 = 32 * nb, nl = lane & 31; const bool ok = (n0 + nl) < nvalid; const float cs = (n0 + nl) < scale_cols ? scale : 1.0f;
#pragma unroll 8
    for (int i = 0; i < 32; ++i) { const int kk = 2 * i + (lane >> 5); float v = ok ? W[(size_t)(k0 + kk) * ldw + ncol0 + n0 + nl] : 0.f; if (gain) v *= gain[k0 + kk]; scr[kk * 33 + nl] = v * cs; }
    LDS_WAIT(); asm volatile("" ::: "memory");
    const int c = lane & 7;
#pragma unroll
    for (int j = 0; j < 4; ++j) { const int n = (lane >> 3) + 8 * j; const LAS float* s = scr + (8 * c) * 33 + n;
        v4u o; o.x = cvtpk2(s[0 * 33], s[1 * 33]); o.y = cvtpk2(s[2 * 33], s[3 * 33]); o.z = cvtpk2(s[4 * 33], s[5 * 33]); o.w = cvtpk2(s[6 * 33], s[7 * 33]);
        if (n0 + n < nvalid) *(GAS v4u*)(WT + (size_t)(row_off + n0 + n) * 2048 + k0 + 8 * c) = o; }
    LDS_WAIT(); asm volatile("" ::: "memory");
}
__device__ __forceinline__ void rms_row_to_bf16(const float* xrow, bf16* orow, int lane) {
    const GAS f32x4* xr = (const GAS f32x4*)xrow + lane;
    f32x4 v[8]; float s = 0.f;
#pragma unroll
    for (int j = 0; j < 8; ++j) { v[j] = xr[64 * j]; s += (v[j].x * v[j].x + v[j].y * v[j].y) + (v[j].z * v[j].z + v[j].w * v[j].w); }
    const float rstd = 1.0f / sqrtf(wave_sum(s) * (1.f / DM) + RMS_EPS);
    GAS u32x2* o8 = (GAS u32x2*)orow + lane;
#pragma unroll
    for (int j = 0; j < 8; ++j) { u32x2 w; w.x = cvtpk2(v[j].x * rstd, v[j].y * rstd); w.y = cvtpk2(v[j].z * rstd, v[j].w * rstd); o8[64 * j] = w; }
}
__device__ __forceinline__ void p0_transpose_big(const float* W, int ldw, const float* gain, float cs, bf16* WT, int row_off, LAS unsigned char* scr, int kb, int nb, int lane) {
    const int k0 = 64 * kb, n0 = 128 * nb, hl = lane >> 5, nl = lane & 31;
    const GAS f32x4* src = (const GAS f32x4*)(W + (size_t)(k0 + 32 * hl) * ldw + n0 + 4 * nl);
    f32x4 v[32];
#pragma unroll
    for (int i = 0; i < 32; ++i) v[i] = src[(size_t)i * (ldw / 4)];
    f32x4 gk[8];
#pragma unroll
    for (int i = 0; i < 8; ++i) gk[i] = gain ? *(const GAS f32x4*)(gain + k0 + 32 * hl + 4 * i) * cs : (f32x4){cs, cs, cs, cs};
#pragma unroll
    for (int j = 0; j < 4; ++j) { const int n = 4 * nl + j;
#pragma unroll
        for (int q = 0; q < 4; ++q) { v4u o;
            o.x = cvtpk2(v[8 * q + 0][j] * gk[2 * q][0], v[8 * q + 1][j] * gk[2 * q][1]); o.y = cvtpk2(v[8 * q + 2][j] * gk[2 * q][2], v[8 * q + 3][j] * gk[2 * q][3]);
            o.z = cvtpk2(v[8 * q + 4][j] * gk[2 * q + 1][0], v[8 * q + 5][j] * gk[2 * q + 1][1]); o.w = cvtpk2(v[8 * q + 6][j] * gk[2 * q + 1][2], v[8 * q + 7][j] * gk[2 * q + 1][3]);
            *(LAS v4u*)(scr + n * 128 + (((4 * hl + q) ^ (n & 7)) << 4)) = o; } }
    LDS_WAIT(); asm volatile("" ::: "memory");
#pragma unroll
    for (int it = 0; it < 16; ++it) { const int idx = it * 64 + lane, n = idx >> 3, ch = idx & 7;
        const v4u o = *(const LAS v4u*)(scr + n * 128 + ((ch ^ (n & 7)) << 4));
        *(GAS v4u*)(WT + (size_t)(row_off + n0 + n) * 2048 + k0 + 8 * ch) = o; }
    LDS_WAIT(); asm volatile("" ::: "memory");
}
__device__ __forceinline__ void convert_weights(const Ptrs& P, LAS unsigned char* lds, int group, int gwi, int ngw, int iend, int wave, int lane) {
    LAS unsigned char* scr = lds + wave * 16384;
    bf16* WinaT = (bf16*)(P.ws + WS_WINA); bf16* WoaT = (bf16*)(P.ws + WS_WOA); bf16* WinbT = (bf16*)(P.ws + WS_WINB); bf16* WobT = (bf16*)(P.ws + WS_WOB);
    constexpr int I0 = 32 * 48, I1 = 32, I2 = 32 * 16, I3 = 32 * 32, I4 = 32 * 4, I5 = 32 * 16;
    if (group == 0) {
        for (int r = gwi; r < I0; r += ngw) { const int nb = r % 48; p0_transpose_big(P.w_in_a, 6160, P.g_norm_a, nb < 8 ? 0.0625f : 1.f, WinaT, 0, scr, r / 48, nb, lane); }
        for (int it = ngw - 1 - gwi; it < I1; it += ngw) p0_transpose_item(P.w_in_a, 6160, 6144, 16, P.g_norm_a, 0, 1.f, WinaT, 6144, (LAS float*)scr, it, 0, lane);
    } else {
        for (int it = gwi; it < iend; it += ngw) {
            int r = it;
            if (r < I2) { p0_transpose_big(P.w_out_a, 2048, P.g_onorm, 1.f, WoaT, 0, scr, r / 16, r % 16, lane); continue; } r -= I2;
            if (r < I3) { const int nb = r % 32; p0_transpose_big(P.w_in_b, 4096, P.g_norm_b, nb < 16 ? 0.125f * LOG2E : 1.f, WinbT, 0, scr, r / 32, nb, lane); continue; } r -= I3;
            if (r < I4) { p0_transpose_big(P.w_kv, 512, P.g_norm_kv, 1.f, WinbT, 4096, scr, r / 4, r % 4, lane); continue; } r -= I4;
            p0_transpose_big(P.w_out_b, 2048, nullptr, 1.f, WobT, 0, scr, r / 16, r % 16, lane);
        }
    }
}
__device__ __forceinline__ void p0_prologue(const Ptrs& P, LAS unsigned char* lds, int vcu, int G, int tid, int wave, int lane) {
    const int gw = vcu * NWAVES + wave, NGW = G * NWAVES;
    convert_weights(P, lds, 0, gw, NGW, 0, wave, lane);
    if (G < 256) convert_weights(P, lds, 1, gw, NGW, 2176, wave, lane);
    bf16* XN = (bf16*)(P.ws + WS_BUFA);
    for (int m = gw; m < MT; m += NGW) rms_row_to_bf16(m < MPR ? P.x_prompt + (size_t)m * DM : P.x_sample + (size_t)(m - MPR) * DM, XN + (size_t)m * DM, lane);
    const int gt = vcu * (NWAVES * 64) + tid, NGT = G * NWAVES * 64;
    for (int i = gt; i < 32 * 120 * 64; i += NGT) { const int b = i / (120 * 64), rem = i % (120 * 64);
        ((f32x4*)(P.out + OUT_KWS))[(size_t)b * 128 * 64 + rem] = ((const f32x4*)P.ck)[(size_t)b * 128 * 64 + 8 * 64 + rem];
        ((f32x4*)(P.out + OUT_VWS))[(size_t)b * 128 * 64 + rem] = ((const f32x4*)P.cv)[(size_t)b * 128 * 64 + 8 * 64 + rem]; }
}

__device__ __forceinline__ void glow_task(const bf16* XN, const bf16* WgT, float* GLOW, int task, int lane) {
    const int r = lane & 15, g = lane >> 4, row0 = task * 16;
    const bf16* ap = XN + (size_t)(row0 + r) * DM + g * 8; const bf16* bp = WgT + (size_t)r * DM + g * 8;
    f32x4 acc = {0.f, 0.f, 0.f, 0.f};
#pragma unroll 8
    for (int kk = 0; kk < 64; ++kk) { const bf16x8 a = *(const bf16x8*)(ap + kk * 32); const bf16x8 b = *(const bf16x8*)(bp + kk * 32); acc = MFMA16(a, b, acc); }
#pragma unroll
    for (int i = 0; i < 4; ++i) GLOW[(size_t)(row0 + 4 * g + i) * 16 + r] = acc[i];
}

__device__ __forceinline__ void gla_prep_unit(const Ptrs& P, LAS unsigned char* lds, int u, int tid, int wave, int lane) {
    const int c = u & 31, h = (u >> 5) & 3, b = u >> 7;
    const int d = tid & 255, th = tid >> 8, hh = d >> 7, dl = d & 127;
    LAS unsigned char* QI = lds;
    LAS unsigned char* KI = lds + 32768;
    LAS float* GL = (LAS float*)(lds + 65536);
    LAS float* TOT = (LAS float*)(lds + 65536 + 4096);
    const int row0 = b * 2048 + c * 64;
    const float* GLOW = (const float*)(P.ws + WS_GLOW);
    const bf16* QK = (const bf16*)(P.ws + WS_QK);
    unsigned char* rec = P.ws + WS_REC + (size_t)u * REC_BYTES;
    unsigned char* rech = rec + (hh ? REC_H1 : 0);
#pragma unroll
    for (int i = 0; i < 4; ++i) { const int idx = tid + 512 * i, t = idx >> 5, ch = idx & 31;
        const v4u q = *(const GAS v4u*)(QK + (size_t)(row0 + t) * DM + h * 256 + ch * 8), k = *(const GAS v4u*)(QK + (size_t)(row0 + t) * DM + 1024 + h * 256 + ch * 8);
        *(LAS v4u*)(QI + t * 512 + ch * 16) = q; *(LAS v4u*)(KI + t * 512 + ch * 16) = k; }
    if (tid < 256) ((LAS f32x4*)GL)[tid] = ((const f32x4*)(GLOW + (size_t)row0 * 16))[tid];
    float wg[16];
#pragma unroll
    for (int r = 0; r < 16; ++r) wg[r] = P.w_gate_up[r * 1024 + h * 256 + d];
    const float bias = P.b_gate[h * 256 + d];
    __syncthreads();
    float bl[32]; float run = 0.f;
#pragma unroll
    for (int tt = 0; tt < 32; ++tt) { const int t = th * 32 + tt; const LAS f32x4* gr = (const LAS f32x4*)(GL + t * 16);
        const f32x4 g0 = gr[0], g1 = gr[1], g2 = gr[2], g3 = gr[3];
        float z = bias + g0.x * wg[0] + g0.y * wg[1] + g0.z * wg[2] + g0.w * wg[3] + g1.x * wg[4] + g1.y * wg[5] + g1.z * wg[6] + g1.w * wg[7]
                       + g2.x * wg[8] + g2.y * wg[9] + g2.z * wg[10] + g2.w * wg[11] + g3.x * wg[12] + g3.y * wg[13] + g3.z * wg[14] + g3.w * wg[15];
        const float ls = fminf(z, 0.f) - __logf(1.0f + __expf(-fabsf(z)));
        run += ls * 0.0625f; bl[tt] = run; }
    TOT[th * 256 + d] = run;
    unsigned short qr[32], kr[32];
#pragma unroll
    for (int tt = 0; tt < 32; ++tt) { qr[tt] = *(const LAS unsigned short*)(QI + (th * 32 + tt) * 512 + d * 2); kr[tt] = *(const LAS unsigned short*)(KI + (th * 32 + tt) * 512 + d * 2); }
    __syncthreads();
    const float tot0 = TOT[d], tot1 = TOT[256 + d], blast = tot0 + tot1, base = th ? tot0 : 0.f;
    unsigned kt[16];
#pragma unroll
    for (int tt = 0; tt < 32; tt += 2) {
        float kv2[2];
#pragma unroll
        for (int k2 = 0; k2 < 2; ++k2) { const int t = th * 32 + tt + k2; const float bt = base + bl[tt + k2];
            const float e1 = __expf(bt - blast), e2 = __builtin_amdgcn_rcpf(e1);
            const float qv = bf2f(qr[tt + k2]) * e1, kv = bf2f(kr[tt + k2]) * e2; kv2[k2] = kv;
            const int off = hh * 16384 + qt_off(t, dl);
            *(LAS unsigned short*)(QI + off) = (unsigned short)(cvtpk2(qv, 0.f) & 0xffffu); *(LAS unsigned short*)(KI + off) = (unsigned short)(cvtpk2(kv, 0.f) & 0xffffu); }
        kt[tt >> 1] = cvtpk2(kv2[0], kv2[1]); }
#pragma unroll
    for (int i = 0; i < 4; ++i) { v4u o; o.x = kt[4 * i]; o.y = kt[4 * i + 1]; o.z = kt[4 * i + 2]; o.w = kt[4 * i + 3]; *(GAS v4u*)(rech + H_KT + kt_chunk(dl, 4 * th + i)) = o; }
    if (th == 0) ((GAS float*)(rech + H_G))[dl] = __expf(blast);
    __syncthreads();
    { const int r = lane & 15, g = lane >> 4, mt = wave >> 1, st0 = 2 * (wave & 1);
      f32x4 a0 = {0.f, 0.f, 0.f, 0.f}, a1 = {0.f, 0.f, 0.f, 0.f};
      bf16x8 bq[8], k0[8], k1[8];
#pragma unroll
      for (int kk = 0; kk < 8; ++kk) { const int ho = (kk >> 2) * 16384, cc = 4 * (kk & 3) + g;
          bq[kk] = *(const LAS bf16x8*)(QI + ho + qt_chunk(16 * mt + r, cc)); k0[kk] = *(const LAS bf16x8*)(KI + ho + qt_chunk(16 * st0 + r, cc)); k1[kk] = *(const LAS bf16x8*)(KI + ho + qt_chunk(16 * st0 + 16 + r, cc)); }
#pragma unroll
      for (int kk = 0; kk < 8; ++kk) { a0 = MFMA16(k0[kk], bq[kk], a0); a1 = MFMA16(k1[kk], bq[kk], a1); }
      const int t = 16 * mt + r;
#pragma unroll
      for (int j = 0; j < 2; ++j) { const f32x4 a = j ? a1 : a0; const int s0 = 16 * (st0 + j) + 4 * g;
          u32x2 w; w.x = cvtpk2(s0 + 0 <= t ? a[0] : 0.f, s0 + 1 <= t ? a[1] : 0.f); w.y = cvtpk2(s0 + 2 <= t ? a[2] : 0.f, s0 + 3 <= t ? a[3] : 0.f);
          *(GAS u32x2*)(rec + REC_PO + kt_chunk(t, s0 >> 3) + (s0 & 7) * 2) = w; } }
#pragma unroll
    for (int i = 0; i < 4; ++i) { const int idx = tid + 512 * i; ((GAS v4u*)(rec + ((idx >> 10) ? REC_H1 : 0) + H_QT))[idx & 1023] = ((const LAS v4u*)QI)[idx]; }
    __syncthreads();
}

constexpr int SC_BUF = REC_DMA, SC_PIECES = REC_DMA / 1024, SC_OT = 3 * REC_DMA;
static_assert(SC_OT + 2 * 16384 <= LDSCTL_OFF, "scan LDS map");
__device__ __forceinline__ void gla_scan_unit(const Ptrs& P, LAS unsigned char* lds, int bh, int dh, int eq, int tid, int wave, int lane, int nch = 32) {
    const int b = bh >> 2, h = bh & 3, r = lane & 15, g = lane >> 4, rr = (r >> 1) & 7;
    const int ecol = h * 512 + eq * 128 + 16 * wave;
    const bf16* VT = (const bf16*)(P.ws + WS_VT);
    bf16* OB = (bf16*)(P.ws + (dh ? WS_QK : WS_BUFA)) + (size_t)(b * 2048) * DM + h * 512 + eq * 128;
    const unsigned char* rec0 = P.ws + WS_REC + (size_t)(bh * 32) * REC_BYTES + (dh ? REC_PO : 0);
    const unsigned HO = dh ? 8192u : 0u, PO = dh ? 0u : 33792u;
    f32x4 S[8];
#pragma unroll
    for (int i = 0; i < 8; ++i) S[i] = (f32x4){0.f, 0.f, 0.f, 0.f};
    const bf16* vtp = VT + (size_t)(ecol + r) * MT + b * 2048 + 8 * g;
#define SC_DMA(cc, bufo_) do { const unsigned char* src_ = rec0 + (size_t)(cc) * REC_BYTES + lane * 16; \
        _Pragma("unroll") for (int j_ = 0; j_ < 6; ++j_) { const int i_ = wave + NWAVES * j_; \
            if (i_ < SC_PIECES) __builtin_amdgcn_global_load_lds((const GAS unsigned*)(src_ + i_ * 1024), (LAS unsigned*)(lds + (bufo_) + i_ * 1024), 16, 0, 0); } } while (0)
#define SC_OSTORE(cc) do { const LAS unsigned char* ot_ = lds + SC_OT + ((cc) & 1) * 16384; \
        _Pragma("unroll") for (int j_ = 0; j_ < 2; ++j_) { const int idx_ = tid + 512 * j_, row_ = idx_ >> 4, q_ = idx_ & 15; \
            const v4u v_ = *(const LAS v4u*)(ot_ + row_ * 256 + ((q_ ^ (row_ & 15)) << 4)); \
            *(GAS v4u*)(OB + (size_t)((cc) * 64 + row_) * DM + q_ * 8) = v_; } } while (0)
    bf16x8 vc0 = *(const bf16x8*)vtp, vc1 = *(const bf16x8*)(vtp + 32), vn0 = vc0, vn1 = vc1;
    SC_DMA(0, 0u); SC_DMA(1, (unsigned)SC_BUF);
    __syncthreads();
    unsigned bo0 = 0u, bo1 = SC_BUF, bo2 = 2u * SC_BUF;
#pragma unroll 1
    for (int c = 0; c < nch; ++c) {
        bf16x8 vf[2]; vf[0] = vc0; vf[1] = vc1;
        { const bf16* vp_ = vtp + (c + 1 < 32 ? c + 1 : 31) * 64;
          asm volatile("global_load_dwordx4 %0, %2, off\n\tglobal_load_dwordx4 %1, %2, off offset:64" : "=&v"(vn0), "=&v"(vn1) : "v"(vp_) : "memory"); }
        if (c > 0) SC_OSTORE(c - 1);
        const unsigned bufo = bo0;
        const unsigned qbase = bufo + HO + H_QT + (unsigned)(r * 256 + ((r >> 2) << 6) + ((g ^ (r & 3)) << 4));
        const unsigned kbase = bufo + HO + H_KT + (unsigned)(r * 128 + ((rr >> 2) << 6) + ((g ^ (rr & 3)) << 4));
        const unsigned pbase = bufo + PO + (unsigned)(r * 128 + ((dh ^ (rr >> 2)) << 6) + ((g ^ (rr & 3)) << 4));
        const unsigned gbase = bufo + HO + H_G + (unsigned)(g * 16);
#define SC_FENCE() __builtin_amdgcn_sched_barrier(0)
#define SC_BQ(k2, tt) (*(const LAS bf16x8*)(lds + ((qbase ^ ((k2) << 6)) + (tt) * 4096)))
#define SC_KF(i, ks) (*(const LAS bf16x8*)(lds + ((kbase ^ ((ks) << 6)) + (i) * 2048)))
#define SC_AF(k2) __builtin_bit_cast(bf16x8, (v4u){cvtpk2(S[2 * (k2)][0], S[2 * (k2)][1]), cvtpk2(S[2 * (k2)][2], S[2 * (k2)][3]), cvtpk2(S[2 * (k2) + 1][0], S[2 * (k2) + 1][1]), cvtpk2(S[2 * (k2) + 1][2], S[2 * (k2) + 1][3])})
        f32x4 gm[4]; bf16x8 qa[8], qb[8];
#pragma unroll
        for (int i = 0; i < 4; ++i) gm[i] = *(const LAS f32x4*)(lds + (gbase + i * 64));
#pragma unroll
        for (int tt = 0; tt < 4; ++tt) { qa[tt] = SC_BQ(0, tt); qa[4 + tt] = SC_BQ(1, tt); }
        SC_FENCE();
#pragma unroll
        for (int i = 0; i < 4; ++i) S[i] = S[i] * gm[i];
#pragma unroll
        for (int i = 0; i < 4; ++i) gm[i] = *(const LAS f32x4*)(lds + (gbase + (4 + i) * 64));
#pragma unroll
        for (int tt = 0; tt < 4; ++tt) { qb[tt] = SC_BQ(2, tt); qb[4 + tt] = SC_BQ(3, tt); }
        bf16x8 pq[4];
#pragma unroll
        for (int tt = 0; tt < 4; ++tt) pq[tt] = *(const LAS bf16x8*)(lds + (pbase + tt * 2048));
        SC_FENCE();
        f32x4 Z[4];
#pragma unroll
        for (int tt = 0; tt < 4; ++tt) Z[tt] = (f32x4){0.f, 0.f, 0.f, 0.f};
        { const bf16x8 a0 = SC_AF(0), a1 = SC_AF(1);
#pragma unroll
          for (int tt = 0; tt < 4; ++tt) Z[tt] = MFMA16(a0, qa[tt], Z[tt]);
#pragma unroll
          for (int tt = 0; tt < 4; ++tt) Z[tt] = MFMA16(a1, qa[4 + tt], Z[tt]); }
#pragma unroll
        for (int i = 0; i < 4; ++i) S[4 + i] = S[4 + i] * gm[i];
#pragma unroll
        for (int i = 0; i < 4; ++i) { qa[2 * i] = SC_KF(i, 0); qa[2 * i + 1] = SC_KF(i, 1); }
        SC_FENCE();
        asm volatile("s_waitcnt vmcnt(0)" : "+v"(vn0), "+v"(vn1) :: "memory");
        SC_DMA((c + 2 < 32 ? c + 2 : 31), bo2);
        SC_FENCE();
        { const bf16x8 a2 = SC_AF(2), a3 = SC_AF(3);
#pragma unroll
          for (int tt = 0; tt < 4; ++tt) Z[tt] = MFMA16(a2, qb[tt], Z[tt]);
#pragma unroll
          for (int tt = 0; tt < 4; ++tt) Z[tt] = MFMA16(a3, qb[4 + tt], Z[tt]);
#pragma unroll
          for (int tt = 0; tt < 4; ++tt) Z[tt] = MFMA16(dh ? vf[1] : vf[0], pq[tt], Z[tt]); }
#pragma unroll
        for (int i = 0; i < 4; ++i) { qb[2 * i] = SC_KF(4 + i, 0); qb[2 * i + 1] = SC_KF(4 + i, 1); }
        SC_FENCE();
#pragma unroll
        for (int i = 0; i < 4; ++i) { S[i] = MFMA16(qa[2 * i], vf[0], S[i]); S[i] = MFMA16(qa[2 * i + 1], vf[1], S[i]); }
#pragma unroll
        for (int i = 0; i < 4; ++i) { S[4 + i] = MFMA16(qb[2 * i], vf[0], S[4 + i]); S[4 + i] = MFMA16(qb[2 * i + 1], vf[1], S[4 + i]); }
#undef SC_FENCE
#undef SC_BQ
#undef SC_KF
#undef SC_AF
        { LAS unsigned char* ot = lds + SC_OT + (c & 1) * 16384 + (g & 1) * 8;
#pragma unroll
          for (int tt = 0; tt < 4; ++tt) { u32x2 w; w.x = cvtpk2(Z[tt][0], Z[tt][1]); w.y = cvtpk2(Z[tt][2], Z[tt][3]);
              *(LAS u32x2*)(ot + (16 * tt + r) * 256 + (((2 * wave + (g >> 1)) ^ r) << 4)) = w; } }
        asm volatile("s_waitcnt lgkmcnt(0)" ::: "memory"); __builtin_amdgcn_s_barrier(); asm volatile("" ::: "memory");
        vc0 = vn0; vc1 = vn1;
        { const unsigned t_ = bo0; bo0 = bo1; bo1 = bo2; bo2 = t_; }
    }
    SC_OSTORE(nch - 1);
#undef SC_OSTORE
#undef SC_DMA
    asm volatile("s_waitcnt vmcnt(0)" ::: "memory"); __syncthreads();
    float* SO = P.out + OUT_GLAP + ((size_t)bh * 256 + 128 * dh + 4 * g) * 512 + eq * 128 + 16 * wave + r;
#pragma unroll
    for (int i = 0; i < 8; ++i) { float* so = SO + (size_t)i * 16 * 512; asm volatile("" : "+v"(so));
        so[0] = S[i][0]; so[512] = S[i][1]; so[1024] = S[i][2]; so[1536] = S[i][3]; }
}

__device__ __forceinline__ void gla_sample_unit(const Ptrs& P, LAS unsigned char* lds, int u, int tid, int wave, int lane) {
    const int h = u & 3, b = u >> 2;
    LAS float* GL = (LAS float*)lds;
    LAS float* QD = (LAS float*)(lds + 1024);
    LAS float* KD = (LAS float*)(lds + 1024 + 8192);
    LAS float* GD = (LAS float*)(lds + 1024 + 16384);
    LAS float* PR = (LAS float*)(lds + 18432);
    LAS float* RED = (LAS float*)(lds + 18688);
    LAS float* VL = (LAS float*)(lds + 20480);
    LAS float* OP = (LAS float*)(lds + 36864);
    const int row0 = MPR + b * 8;
    const bf16* QK = (const bf16*)(P.ws + WS_QK); const bf16* VT = (const bf16*)(P.ws + WS_VT); const float* GLOW = (const float*)(P.ws + WS_GLOW);
    const int eq = tid & 127, dq = tid >> 7;
    const size_t sbase = ((size_t)(b * 4 + h) * 256 + 64 * dq) * 512 + 4 * eq;
    const float* S0p = P.state + sbase; float* S1p = P.out + OUT_GLAS + sbase;
    if (tid < 32) ((LAS f32x4*)GL)[tid] = ((const f32x4*)(GLOW + (size_t)row0 * 16))[tid];
    { const v4u vv = *(const GAS v4u*)(VT + (size_t)(h * 512 + tid) * MT + row0);
      VL[0 * 512 + tid] = __uint_as_float(vv.x << 16); VL[1 * 512 + tid] = __uint_as_float(vv.x & 0xffff0000u); VL[2 * 512 + tid] = __uint_as_float(vv.y << 16); VL[3 * 512 + tid] = __uint_as_float(vv.y & 0xffff0000u);
      VL[4 * 512 + tid] = __uint_as_float(vv.z << 16); VL[5 * 512 + tid] = __uint_as_float(vv.z & 0xffff0000u); VL[6 * 512 + tid] = __uint_as_float(vv.w << 16); VL[7 * 512 + tid] = __uint_as_float(vv.w & 0xffff0000u); }
    __syncthreads();
    if (tid < 256) {
        const int d = tid;
        float wg[16];
#pragma unroll
        for (int r = 0; r < 16; ++r) wg[r] = P.w_gate_up[r * 1024 + h * 256 + d];
        const float bias = P.b_gate[h * 256 + d];
        float bc[8], q[8], k[8]; float run = 0.f;
#pragma unroll
        for (int t = 0; t < 8; ++t) { q[t] = bf2f(QK[(size_t)(row0 + t) * DM + h * 256 + d]); k[t] = bf2f(QK[(size_t)(row0 + t) * DM + 1024 + h * 256 + d]); }
#pragma unroll
        for (int t = 0; t < 8; ++t) { const LAS f32x4* gr = (const LAS f32x4*)(GL + t * 16); const f32x4 g0 = gr[0], g1 = gr[1], g2 = gr[2], g3 = gr[3];
            float z = bias + g0.x * wg[0] + g0.y * wg[1] + g0.z * wg[2] + g0.w * wg[3] + g1.x * wg[4] + g1.y * wg[5] + g1.z * wg[6] + g1.w * wg[7]
                           + g2.x * wg[8] + g2.y * wg[9] + g2.z * wg[10] + g2.w * wg[11] + g3.x * wg[12] + g3.y * wg[13] + g3.z * wg[14] + g3.w * wg[15];
            const float ls = fminf(z, 0.f) - __logf(1.0f + __expf(-fabsf(z)));
            run += ls * 0.0625f; bc[t] = run; }
        const float blast = bc[7];
#pragma unroll
        for (int t = 0; t < 8; ++t) { QD[d * 8 + t] = q[t] * __expf(bc[t]); KD[d * 8 + t] = k[t] * __expf(blast - bc[t]); }
        GD[d] = __expf(blast);
        int idx = 0;
#pragma unroll
        for (int t = 0; t < 8; ++t)
#pragma unroll
            for (int s = 0; s <= t; ++s) { float v = q[t] * k[s] * __expf(bc[t] - bc[s]); v = wave_sum(v); if (lane == 0) RED[wave * 36 + idx] = v; ++idx; }
    }
    __syncthreads();
    if (tid < 64) { const int t = tid >> 3, s = tid & 7; float v = 0.f; if (s <= t) { const int idx = t * (t + 1) / 2 + s; v = RED[idx] + RED[36 + idx] + RED[72 + idx] + RED[108 + idx]; } PR[t * 8 + s] = v; }
    { f32x4 sa[4], sb[4];
#pragma unroll
      for (int i = 0; i < 4; ++i) sa[i] = *(const GAS f32x4*)(S0p + (size_t)i * 512);
      f32x4 v[8], o[8];
#pragma unroll
      for (int s = 0; s < 8; ++s) v[s] = *(const LAS f32x4*)(VL + s * 512 + 4 * eq);
#pragma unroll
      for (int t = 0; t < 8; ++t) o[t] = (f32x4){0.f, 0.f, 0.f, 0.f};
#define GS_STEP(cur, nxt, d0, more) do { if (more) { _Pragma("unroll") for (int i = 0; i < 4; ++i) nxt[i] = *(const GAS f32x4*)(S0p + (size_t)((d0) + 4 + i) * 512); } \
        _Pragma("unroll") for (int i = 0; i < 4; ++i) { const int dd = 64 * dq + (d0) + i; \
          const f32x4 qa = *(const LAS f32x4*)(QD + dd * 8), qb = *(const LAS f32x4*)(QD + dd * 8 + 4), ka = *(const LAS f32x4*)(KD + dd * 8), kb = *(const LAS f32x4*)(KD + dd * 8 + 4); \
          const float gm = GD[dd]; const f32x4 x = cur[i]; \
          o[0] += x * qa.x; o[1] += x * qa.y; o[2] += x * qa.z; o[3] += x * qa.w; o[4] += x * qb.x; o[5] += x * qb.y; o[6] += x * qb.z; o[7] += x * qb.w; \
          f32x4 sn = x * gm; sn += v[0] * ka.x; sn += v[1] * ka.y; sn += v[2] * ka.z; sn += v[3] * ka.w; sn += v[4] * kb.x; sn += v[5] * kb.y; sn += v[6] * kb.z; sn += v[7] * kb.w; \
          *(GAS f32x4*)(S1p + (size_t)((d0) + i) * 512) = sn; } } while (0)
#pragma unroll 1
      for (int d0 = 0; d0 < 64; d0 += 8) { GS_STEP(sa, sb, d0, true); GS_STEP(sb, sa, d0 + 4, d0 + 8 < 64); }
#undef GS_STEP
#pragma unroll
      for (int t = 0; t < 8; ++t) *(LAS f32x4*)(OP + (dq * 8 + t) * 512 + 4 * eq) = o[t];
    }
    __syncthreads();
    { const int t = tid >> 6, el = tid & 63; bf16* A2 = (bf16*)(P.ws + WS_BUFA); const bf16* SR = (const bf16*)(P.ws + WS_SR);
      float ov[8]; float ss = 0.f;
#pragma unroll
      for (int j = 0; j < 8; ++j) { const int e = el + 64 * j; float acc = (OP[(0 * 8 + t) * 512 + e] + OP[(1 * 8 + t) * 512 + e]) + (OP[(2 * 8 + t) * 512 + e] + OP[(3 * 8 + t) * 512 + e]);
#pragma unroll
          for (int s = 0; s < 8; ++s) acc += PR[t * 8 + s] * VL[s * 512 + e];
          ov[j] = acc; ss += acc * acc; }
      const float rs = 1.0f / sqrtf(wave_sum(ss) * (1.f / 512.f) + RMS_EPS);
#pragma unroll
      for (int j = 0; j < 8; ++j) { const size_t off = (size_t)(row0 + t) * DM + h * 512 + el + 64 * j; A2[off] = (bf16)(cvtpk2(ov[j] * rs * bf2f(SR[off]), 0.f) & 0xffffu); } }
    __syncthreads();
}

__device__ __forceinline__ void gate_row(const Ptrs& P, int row, int lane, bf16* DST) {
    const bf16* O0 = (const bf16*)(P.ws + WS_BUFA); const bf16* O1 = (const bf16*)(P.ws + WS_QK); const bf16* SR = (const bf16*)(P.ws + WS_SR);
    const bool two = true;
    v4u a[4], bq[4], s[4];
#pragma unroll
    for (int j = 0; j < 4; ++j) { const size_t off = (size_t)row * DM + 512 * j + 8 * lane;
        a[j] = *(const GAS v4u*)(O0 + off); s[j] = *(const GAS v4u*)(SR + off); bq[j] = (v4u){0u, 0u, 0u, 0u}; if (two) bq[j] = *(const GAS v4u*)(O1 + off); }
#pragma unroll
    for (int j = 0; j < 4; ++j) { const size_t off = (size_t)row * DM + 512 * j + 8 * lane;
        float o[8];
        o[0] = __uint_as_float(a[j].x << 16) + __uint_as_float(bq[j].x << 16); o[1] = __uint_as_float(a[j].x & 0xffff0000u) + __uint_as_float(bq[j].x & 0xffff0000u);
        o[2] = __uint_as_float(a[j].y << 16) + __uint_as_float(bq[j].y << 16); o[3] = __uint_as_float(a[j].y & 0xffff0000u) + __uint_as_float(bq[j].y & 0xffff0000u);
        o[4] = __uint_as_float(a[j].z << 16) + __uint_as_float(bq[j].z << 16); o[5] = __uint_as_float(a[j].z & 0xffff0000u) + __uint_as_float(bq[j].z & 0xffff0000u);
        o[6] = __uint_as_float(a[j].w << 16) + __uint_as_float(bq[j].w << 16); o[7] = __uint_as_float(a[j].w & 0xffff0000u) + __uint_as_float(bq[j].w & 0xffff0000u);
        float ss = ((o[0] * o[0] + o[1] * o[1]) + (o[2] * o[2] + o[3] * o[3])) + ((o[4] * o[4] + o[5] * o[5]) + (o[6] * o[6] + o[7] * o[7]));
        const float rs = 1.0f / sqrtf(wave_sum(ss) * (1.f / 512.f) + RMS_EPS);
        v4u w;
        w.x = cvtpk2(o[0] * rs * __uint_as_float(s[j].x << 16), o[1] * rs * __uint_as_float(s[j].x & 0xffff0000u));
        w.y = cvtpk2(o[2] * rs * __uint_as_float(s[j].y << 16), o[3] * rs * __uint_as_float(s[j].y & 0xffff0000u));
        w.z = cvtpk2(o[4] * rs * __uint_as_float(s[j].z << 16), o[5] * rs * __uint_as_float(s[j].z & 0xffff0000u));
        w.w = cvtpk2(o[6] * rs * __uint_as_float(s[j].w << 16), o[7] * rs * __uint_as_float(s[j].w & 0xffff0000u));
        *(GAS v4u*)(DST + off) = w; }
}
__device__ __forceinline__ void final_row(float* hrow, const float* gfin, int lane, float* drow) {
    GAS f32x4* xr = (GAS f32x4*)hrow + lane; GAS f32x4* dr = (GAS f32x4*)drow + lane; const GAS f32x4* gr = (const GAS f32x4*)gfin + lane;
    f32x4 v[8]; float s = 0.f;
#pragma unroll
    for (int j = 0; j < 8; ++j) { v[j] = xr[64 * j]; s += (v[j].x * v[j].x + v[j].y * v[j].y) + (v[j].z * v[j].z + v[j].w * v[j].w); }
    const float rstd = 1.0f / sqrtf(wave_sum(s) * (1.f / DM) + RMS_EPS);
#pragma unroll
    for (int j = 0; j < 8; ++j) dr[64 * j] = v[j] * rstd * gr[64 * j];
}

__device__ __forceinline__ void attn_subblock(const LAS bf16* KI, const LAS bf16* VI, int ts, const bf16* qrow, int qpos, int kpos0, float slope2, float sink2,
                                              const bf16* zrow, bf16* orow, bool store, int lane) {
    const int r = lane & 15, g = lane >> 4;
    const bf16x8 q0 = *(const bf16x8*)(qrow + 8 * g), q1 = *(const bf16x8*)(qrow + 32 + 8 * g);
    f32x4 sc[10]; float mx = -INFINITY;
#pragma unroll
    for (int i = 0; i < 10; ++i) { const LAS bf16* kr = KI + (16 * (ts + i) + r) * 80 + 8 * g;
        f32x4 a = {0.f, 0.f, 0.f, 0.f};
        a = MFMA16(*(const LAS bf16x8*)kr, q0, a); a = MFMA16(*(const LAS bf16x8*)(kr + 32), q1, a);
#pragma unroll
        for (int e = 0; e < 4; ++e) { const int kpos = kpos0 + 16 * (ts + i) + 4 * g + e; const int dist = qpos - kpos;
            const bool ok = dist >= 0 && dist <= 128 && kpos >= 0;
            const float v = ok ? a[e] - slope2 * (float)dist : -INFINITY; a[e] = v; mx = fmaxf(mx, v); }
        sc[i] = a; }
    mx = fmaxf(mx, __shfl_xor(mx, 16)); mx = fmaxf(mx, __shfl_xor(mx, 32)); mx = fmaxf(mx, sink2);
    float l = 0.f;
#pragma unroll
    for (int i = 0; i < 10; ++i)
#pragma unroll
        for (int e = 0; e < 4; ++e) { const float p = __builtin_amdgcn_exp2f(sc[i][e] - mx); sc[i][e] = p; l += p; }
    l += __shfl_xor(l, 16); l += __shfl_xor(l, 32);
    const float inv = 1.0f / (l + __builtin_amdgcn_exp2f(sink2 - mx));
    f32x4 o[4];
#pragma unroll
    for (int dt = 0; dt < 4; ++dt) o[dt] = (f32x4){0.f, 0.f, 0.f, 0.f};
#pragma unroll
    for (int ks = 0; ks < 5; ++ks) {
        v4u pp; pp.x = cvtpk2(sc[2 * ks][0], sc[2 * ks][1]); pp.y = cvtpk2(sc[2 * ks][2], sc[2 * ks][3]); pp.z = cvtpk2(sc[2 * ks + 1][0], sc[2 * ks + 1][1]); pp.w = cvtpk2(sc[2 * ks + 1][2], sc[2 * ks + 1][3]);
        const bf16x8 pb = __builtin_bit_cast(bf16x8, pp);
#pragma unroll
        for (int dt = 0; dt < 4; ++dt) { const LAS bf16* vr = VI + (16 * dt + r) * 264 + 16 * (ts + 2 * ks) + 4 * g;
            const u32x2 lo = *(const LAS u32x2*)vr, hi = *(const LAS u32x2*)(vr + 16);
            v4u va; va.x = lo.x; va.y = lo.y; va.z = hi.x; va.w = hi.y;
            o[dt] = MFMA16(__builtin_bit_cast(bf16x8, va), pb, o[dt]); } }
    if (store) {
#pragma unroll
        for (int dt = 0; dt < 4; ++dt) { const u32x2 zz = *(const GAS u32x2*)(zrow + 16 * dt + 4 * g);
            u32x2 w; w.x = cvtpk2(o[dt][0] * inv * __uint_as_float(zz.x << 16), o[dt][1] * inv * __uint_as_float(zz.x & 0xffff0000u));
            w.y = cvtpk2(o[dt][2] * inv * __uint_as_float(zz.y << 16), o[dt][3] * inv * __uint_as_float(zz.y & 0xffff0000u));
            *(GAS u32x2*)(orow + 16 * dt + 4 * g) = w; }
    }
}
__device__ __forceinline__ void attn_prompt_unit(const Ptrs& P, LAS unsigned char* lds, int u, int tid, int wave, int lane) {
    const int kvh = u & 3, qb = (u >> 2) & 15, b = u >> 6;
    LAS bf16* KI = (LAS bf16*)lds;
    LAS bf16* VI = (LAS bf16*)(lds + 40960);
    const bf16* KB = (const bf16*)(P.ws + WS_KB); const bf16* VT2 = (const bf16*)(P.ws + WS_VT2); const bf16* QZ = (const bf16*)(P.ws + WS_QZ); bf16* A3 = (bf16*)(P.ws + WS_BUFA);
    const int kpos0 = (qb - 1) * 128;
    for (int i = tid; i < 2048; i += NWAVES * 64) { const int j = i >> 3, ch = i & 7; const int kpos = kpos0 + j;
        v4u v = {0u, 0u, 0u, 0u}; if (kpos >= 0) v = *(const GAS v4u*)(KB + (size_t)(b * 2048 + kpos) * 256 + kvh * 64 + ch * 8);
        *(LAS v4u*)(KI + j * 80 + ch * 8) = v; }
    for (int i = tid; i < 2048; i += NWAVES * 64) { const int d = i >> 5, ch = i & 31; const int kpos = kpos0 + ch * 8;
        v4u v = {0u, 0u, 0u, 0u}; if (kpos >= 0) v = *(const GAS v4u*)(VT2 + (size_t)(kvh * 64 + d) * MT + b * 2048 + kpos);
        *(LAS v4u*)(VI + d * 264 + ch * 8) = v; }
    __syncthreads();
    const int hh = kvh * 8 + wave;
    const float slope2 = __builtin_amdgcn_exp2f(-0.25f * (float)(hh + 1)) * LOG2E, sink2 = P.sinks[hh] * LOG2E;
#pragma unroll 1
    for (int qs = 0; qs < 8; ++qs) { const int qpos = qb * 128 + 16 * qs + (lane & 15); const size_t row = (size_t)b * 2048 + qpos;
        attn_subblock(KI, VI, qs < 6 ? qs : 6, QZ + row * 4096 + hh * 64, qpos, kpos0, slope2, sink2, QZ + row * 4096 + 2048 + hh * 64, A3 + row * DM + hh * 64, true, lane); }
    __syncthreads();
}
__device__ __forceinline__ void attn_sample_unit(const Ptrs& P, LAS unsigned char* lds, int u, int tid, int wave, int lane) {
    const int kvh = u & 3, b = u >> 2;
    LAS bf16* KI = (LAS bf16*)lds;
    LAS bf16* VI = (LAS bf16*)(lds + 40960);
    const bf16* KB = (const bf16*)(P.ws + WS_KB); const bf16* VT2 = (const bf16*)(P.ws + WS_VT2); const bf16* QZ = (const bf16*)(P.ws + WS_QZ); bf16* A3 = (bf16*)(P.ws + WS_BUFA);
    for (int i = tid; i < 160 * 64; i += NWAVES * 64) { const int j = i >> 6, d = i & 63; float kv = 0.f, vv = 0.f;
        if (j < 128) { kv = P.ck[((size_t)(b * 128 + j) * 4 + kvh) * 64 + d]; vv = P.cv[((size_t)(b * 128 + j) * 4 + kvh) * 64 + d]; }
        else if (j < 136) { kv = bf2f(KB[(size_t)(MPR + b * 8 + j - 128) * 256 + kvh * 64 + d]); vv = bf2f(VT2[(size_t)(kvh * 64 + d) * MT + MPR + b * 8 + j - 128]); }
        KI[j * 80 + d] = (bf16)(cvtpk2(kv, 0.f) & 0xffffu); VI[d * 264 + j] = (bf16)(cvtpk2(vv, 0.f) & 0xffffu); }
    __syncthreads();
    const int hh = kvh * 8 + wave;
    const float slope2 = __builtin_amdgcn_exp2f(-0.25f * (float)(hh + 1)) * LOG2E, sink2 = P.sinks[hh] * LOG2E;
    const int n = lane & 15, qi = n < 8 ? n : 7; const size_t row = (size_t)MPR + b * 8 + qi;
    attn_subblock(KI, VI, 0, QZ + row * 4096 + hh * 64, 128 + qi, 0, slope2, sink2, QZ + row * 4096 + 2048 + hh * 64, A3 + row * DM + hh * 64, n < 8, lane);
    __syncthreads();
}
constexpr int SG_A = 0, SG_B = 10240, SG_STAGE = 30720, SG_RS = 2 * SG_STAGE;
template <bool NAT>
__device__ __forceinline__ void sgemm_core(LAS unsigned char* lds, const bf16* A, const bf16* B, f32x4 (&acc)[2][2], int tid, int wave, int lane) {
    const int wm = wave >> 2, wn = wave & 3, r = lane & 15, g = lane >> 4, lr = tid >> 3, ch = tid & 7;
    const GAS v4u* ga = (const GAS v4u*)(A + (size_t)lr * 2048 + ch * 8); const GAS v4u* gb0 = (const GAS v4u*)(B + (size_t)lr * 2048 + ch * 8); const GAS v4u* gb1 = (const GAS v4u*)(B + (size_t)(64 + lr) * 2048 + ch * 8);
    v4u ra0, rb0, rc0, ra1, rb1, rc1;
#pragma unroll
    for (int i = 0; i < 2; ++i)
#pragma unroll
        for (int j = 0; j < 2; ++j) acc[i][j] = (f32x4){0.f, 0.f, 0.f, 0.f};
#define SG_LD(s, kt) do { ra##s = ga[(kt) * 8]; rb##s = gb0[(kt) * 8]; rc##s = gb1[(kt) * 8]; } while (0)
#define SG_ST(s, stg) do { *(LAS v4u*)(lds + (stg) * SG_STAGE + SG_A + lr * 160 + ch * 16) = ra##s; *(LAS v4u*)(lds + (stg) * SG_STAGE + SG_B + lr * 160 + ch * 16) = rb##s; \
                           *(LAS v4u*)(lds + (stg) * SG_STAGE + SG_B + (64 + lr) * 160 + ch * 16) = rc##s; } while (0)
#define SG_COMPUTE(stg) do { _Pragma("unroll") for (int kk = 0; kk < 2; ++kk) { bf16x8 af[2], bfr[2]; \
        _Pragma("unroll") for (int i = 0; i < 2; ++i) af[i] = *(const LAS bf16x8*)(lds + (stg) * SG_STAGE + SG_A + (32 * wm + 16 * i + r) * 160 + (32 * kk + 8 * g) * 2); \
        _Pragma("unroll") for (int j = 0; j < 2; ++j) bfr[j] = *(const LAS bf16x8*)(lds + (stg) * SG_STAGE + SG_B + (32 * wn + 16 * j + r) * 160 + (32 * kk + 8 * g) * 2); \
        _Pragma("unroll") for (int i = 0; i < 2; ++i) _Pragma("unroll") for (int j = 0; j < 2; ++j) acc[i][j] = NAT ? MFMA16(af[i], bfr[j], acc[i][j]) : MFMA16(bfr[j], af[i], acc[i][j]); } } while (0)
    SG_LD(0, 0); SG_LD(1, 1); SG_ST(0, 0); SG_LD(0, 2);
    __syncthreads();
#pragma unroll 1
    for (int kt = 0; kt < 32; kt += 2) {
        SG_COMPUTE(0); SG_ST(1, 1); if (kt + 3 < 32) SG_LD(1, kt + 3);
        __syncthreads();
        SG_COMPUTE(1); if (kt + 2 < 32) SG_ST(0, 0); if (kt + 4 < 32) SG_LD(0, kt + 4);
        __syncthreads();
    }
#undef SG_LD
#undef SG_ST
#undef SG_COMPUTE
}
template <bool SILU>
__device__ __forceinline__ void sg_store_bf16(const f32x4 (&acc)[2][2], bf16* dst, int ld, int wave, int lane, float rs0, float rs1) {
    const int wm = wave >> 2, wn = wave & 3, r = lane & 15, g = lane >> 4;
#pragma unroll
    for (int i = 0; i < 2; ++i)
#pragma unroll
        for (int j = 0; j < 2; ++j) { f32x4 v = acc[i][j] * (i ? rs1 : rs0);
            if (SILU) { v[0] = pg8::silu_f(v[0]); v[1] = pg8::silu_f(v[1]); v[2] = pg8::silu_f(v[2]); v[3] = pg8::silu_f(v[3]); }
            u32x2 w; w.x = cvtpk2(v[0], v[1]); w.y = cvtpk2(v[2], v[3]);
            *(GAS u32x2*)(dst + (size_t)(32 * wm + 16 * i + r) * ld + 32 * wn + 16 * j + 4 * g) = w; }
}
__device__ __forceinline__ void s_in_a_block(const Ptrs& P, LAS unsigned char* lds, int rb, int nbk, int tid, int wave, int lane) {
    const bf16* A = (const bf16*)(P.ws + WS_BUFA) + (size_t)(MPR + 64 * rb) * DM; const bf16* B = (const bf16*)(P.ws + WS_WINA) + (size_t)(128 * nbk) * DM;
    f32x4 acc[2][2];
    if (nbk >= 16 && nbk < 32) {
        sgemm_core<true>(lds, A, B, acc, tid, wave, lane);
        const int wm = wave >> 2, wn = wave & 3, r = lane & 15, g = lane >> 4; bf16* VT = (bf16*)(P.ws + WS_VT);
#pragma unroll
        for (int i = 0; i < 2; ++i)
#pragma unroll
            for (int j = 0; j < 2; ++j) { u32x2 w; w.x = cvtpk2(acc[i][j][0], acc[i][j][1]); w.y = cvtpk2(acc[i][j][2], acc[i][j][3]);
                *(GAS u32x2*)(VT + (size_t)((nbk - 16) * 128 + 32 * wn + 16 * j + r) * MT + MPR + 64 * rb + 32 * wm + 16 * i + 4 * g) = w; }
    } else {
        sgemm_core<false>(lds, A, B, acc, tid, wave, lane);
        if (nbk < 16) sg_store_bf16<false>(acc, (bf16*)(P.ws + WS_QK) + (size_t)(MPR + 64 * rb) * DM + nbk * 128, DM, wave, lane, 1.f, 1.f);
        else sg_store_bf16<true>(acc, (bf16*)(P.ws + WS_SR) + (size_t)(MPR + 64 * rb) * DM + (nbk - 32) * 128, DM, wave, lane, 1.f, 1.f);
    }
}
template <bool WITH_B16>
__device__ __forceinline__ void s_out_block(const Ptrs& P, LAS unsigned char* lds, const bf16* Abase, const bf16* Wt, const float* res, int rb, int nb, int tid, int wave, int lane) {
    f32x4 acc[2][2];
    sgemm_core<false>(lds, Abase + (size_t)(64 * rb) * DM, Wt + (size_t)(128 * nb) * DM, acc, tid, wave, lane);
    const int wm = wave >> 2, wn = wave & 3, r = lane & 15, g = lane >> 4;
    float* out = P.out + OUT_Y + (size_t)MPR * DM; bf16* H1b = (bf16*)(P.ws + WS_SR) + (size_t)MPR * DM; float* SSQ2 = (float*)(P.ws + WS_SSQP);
#pragma unroll
    for (int i = 0; i < 2; ++i) { const int row = 64 * rb + 32 * wm + 16 * i + r; float ss = 0.f;
#pragma unroll
        for (int j = 0; j < 2; ++j) { const size_t off = (size_t)row * DM + 128 * nb + 32 * wn + 16 * j + 4 * g;
            const f32x4 v = *(const GAS f32x4*)(res + off) + acc[i][j]; *(GAS f32x4*)(out + off) = v;
            if (WITH_B16) { u32x2 w; w.x = cvtpk2(v[0], v[1]); w.y = cvtpk2(v[2], v[3]); *(GAS u32x2*)(H1b + off) = w; ss += (v[0] * v[0] + v[1] * v[1]) + (v[2] * v[2] + v[3] * v[3]); } }
        if (WITH_B16) { ss += __shfl_xor(ss, 16); ss += __shfl_xor(ss, 32); if (g == 0) SSQ2[(size_t)row * 64 + nb * 4 + wn] = ss; } }
}
__device__ __forceinline__ void s_in_b_block(const Ptrs& P, LAS unsigned char* lds, int rb, int nbk, int tid, int wave, int lane) {
    const bf16* A = (const bf16*)(P.ws + WS_SR) + (size_t)(MPR + 64 * rb) * DM; const bf16* B = (const bf16*)(P.ws + WS_WINB) + (size_t)(128 * nbk) * DM;
    LAS float* RS = (LAS float*)(lds + SG_RS);
    { const int row = tid >> 3, part = tid & 7; const float* sp = (const float*)(P.ws + WS_SSQP) + (size_t)(64 * rb + row) * 64 + part * 8;
      const f32x4 a = *(const GAS f32x4*)sp, b = *(const GAS f32x4*)(sp + 4); float s = (a[0] + a[1]) + (a[2] + a[3]) + (b[0] + b[1]) + (b[2] + b[3]);
      s += __shfl_xor(s, 1); s += __shfl_xor(s, 2); s += __shfl_xor(s, 4);
      if (part == 0) RS[row] = 1.0f / sqrtf(s * (1.f / DM) + RMS_EPS); }
    f32x4 acc[2][2];
    const int wm = wave >> 2, wn = wave & 3, r = lane & 15, g = lane >> 4;
    if (nbk >= 34) {
        sgemm_core<true>(lds, A, B, acc, tid, wave, lane);
        bf16* VT2 = (bf16*)(P.ws + WS_VT2); float* vws = P.out + OUT_VWS;
#pragma unroll
        for (int i = 0; i < 2; ++i) { const f32x4 rs = *(const LAS f32x4*)(RS + 32 * wm + 16 * i + 4 * g);
#pragma unroll
            for (int j = 0; j < 2; ++j) { const f32x4 v = acc[i][j] * rs; const int col = (nbk - 34) * 128 + 32 * wn + 16 * j + r; const int srow = 64 * rb + 32 * wm + 16 * i + 4 * g;
                u32x2 w; w.x = cvtpk2(v[0], v[1]); w.y = cvtpk2(v[2], v[3]);
                *(GAS u32x2*)(VT2 + (size_t)col * MT + MPR + srow) = w;
#pragma unroll
                for (int e = 0; e < 4; ++e) { const int s = srow + e; vws[((size_t)(s >> 3) * 128 + 120 + (s & 7)) * 256 + col] = v[e]; } } }
    } else {
        sgemm_core<false>(lds, A, B, acc, tid, wave, lane);
        const float rs0 = RS[32 * wm + r], rs1 = RS[32 * wm + 16 + r];
        if (nbk < 16) sg_store_bf16<false>(acc, (bf16*)(P.ws + WS_QZ) + (size_t)(MPR + 64 * rb) * 4096 + nbk * 128, 4096, wave, lane, rs0, rs1);
        else if (nbk < 32) sg_store_bf16<true>(acc, (bf16*)(P.ws + WS_QZ) + (size_t)(MPR + 64 * rb) * 4096 + nbk * 128, 4096, wave, lane, rs0, rs1);
        else { sg_store_bf16<false>(acc, (bf16*)(P.ws + WS_KB) + (size_t)(MPR + 64 * rb) * 256 + (nbk - 32) * 128, 256, wave, lane, rs0, rs1);
            float* kws = P.out + OUT_KWS;
#pragma unroll
            for (int i = 0; i < 2; ++i) { const int s = 64 * rb + 32 * wm + 16 * i + r; float* d = kws + ((size_t)(s >> 3) * 128 + 120 + (s & 7)) * 256 + (nbk - 32) * 128 + 32 * wn + 4 * g;
#pragma unroll
                for (int j = 0; j < 2; ++j) *(GAS f32x4*)(d + 16 * j) = acc[i][j] * (i ? rs1 : rs0); } }
    }
}
#ifndef MK_N_LAUNCHES
#define MK_N_LAUNCHES 1
#endif
#ifndef DUP_PHASE
#define DUP_PHASE -1
#endif
#define REPS(k) for (int rep_ = 0; rep_ < ((DUP_PHASE) == (k) ? 2 : 1); ++rep_)
constexpr int N_PHASES = 11;
constexpr int N_LAUNCHES = MK_N_LAUNCHES;
struct Args { Ptrs p; int ph_lo, ph_hi, sub, pad; };
static_assert(sizeof(Args) == 20 * 8 + 16, "Args has no padding");

__global__ void __launch_bounds__(NWAVES * 64, 2) yoco_fwd(Args args) {
    extern __shared__ __attribute__((aligned(16))) unsigned char lds_raw[];
    LAS unsigned char* lds = (LAS unsigned char*)lds_raw;
    volatile LAS unsigned* MISC = (volatile LAS unsigned*)(lds + MISC_OFF);
    const int tid = threadIdx.x, lane = tid & 63, wave = __builtin_amdgcn_readfirstlane(tid >> 6);
    const int G = gridDim.x, c = blockIdx.x;
    const int vcu = (G % 8 == 0) ? (c % 8) * (G / 8) + c / 8 : c;
    const Ptrs& P = args.p;
    gu32* ctl = (gu32*)(P.ws + WS_CTL);
    for (int u = tid; u < (LDS_BYTES - LDSCTL_OFF) / 4; u += NWAVES * 64) ((LAS unsigned*)(lds + LDSCTL_OFF))[u] = 0u;
    __syncthreads();
    XcdBarrier bar; bar.bar = (unsigned*)(ctl + CW_BAR); bar.x = 0; bar.st = nullptr;
    const int lo = args.ph_lo, hi = args.ph_hi;
    if (hi - lo > 1) bar = xcd_barrier_post((unsigned*)(ctl + CW_BAR), MISC + 8);
#define IN(k) (lo <= (k) && (k) < hi)
#define SEAM(k) do { if (IN(k) && IN((k) + 1)) xcd_barrier(bar); } while (0)
    const int gw = vcu * NWAVES + wave, NGW = G * NWAVES;

    if (IN(0)) { REPS(0) p0_prologue(P, lds, vcu, G, tid, wave, lane); SEAM(0); }

    if (IN(1)) {
        pg8::SchedInA S{G, c, (const char*)(P.ws + WS_BUFA), (const char*)(P.ws + WS_WINA)};
        pg8::EpiInA E{(pg8::bf16_t*)(P.ws + WS_QK), (pg8::bf16_t*)(P.ws + WS_SR), (pg8::bf16_t*)(P.ws + WS_VT), MT};
        REPS(1) pg8::gemm_phase<pg8::EpiInA, pg8::SchedInA, true, true>(lds, 2048, S, E);
        for (int task = c * NWAVES + wave; task < MT / 16; task += NGW)
            glow_task((const bf16*)(P.ws + WS_BUFA), (const bf16*)(P.ws + WS_WINA) + (size_t)6144 * DM, (float*)(P.ws + WS_GLOW), task, lane);
        SEAM(1);
    }

    if (IN(2)) {
        REPS(20) for (int blk = c; blk < 192; blk += G) s_in_a_block(P, lds, blk / 48, blk % 48, tid, wave, lane);
        if (G == 256) { REPS(2) for (int j = 0; j < 2; ++j) gla_prep_unit(P, lds, (2 * (c & 7) + j) * 32 + (c >> 3), tid, wave, lane); }
        else for (int u = c; u < 512; u += G) gla_prep_unit(P, lds, u, tid, wave, lane);
        SEAM(2);
    }

    if (IN(3)) {
        if (G >= 256) {
            const int sub = args.sub;
            constexpr int CV_A = 1632;
            if (c < 128) { const int xcd = c & 7, idx = c >> 3; if (sub == 0 || sub == 1) gla_scan_unit(P, lds, xcd * 2 + (idx >> 3), (idx >> 2) & 1, idx & 3, tid, wave, lane);
                if (sub == 0 || sub == 3) convert_weights(P, lds, 1, CV_A + c * NWAVES + wave, 128 * NWAVES, 2176, wave, lane); }
            else { if (sub == 0 || sub == 2) gla_sample_unit(P, lds, c - 128, tid, wave, lane);
                if (sub == 0 || sub == 3) convert_weights(P, lds, 1, (c - 128) * NWAVES + wave, 128 * NWAVES, CV_A, wave, lane); }
        } else {
            for (int u = c; u < 128; u += G) gla_scan_unit(P, lds, u >> 3, (u >> 2) & 1, u & 3, tid, wave, lane);
            for (int t = c; t < 128; t += G) gla_sample_unit(P, lds, t, tid, wave, lane);
        }
        SEAM(3);
    }

    if (IN(4)) {
        const int NS = G >= 128 ? 64 : 0;
        if (c < NS) { for (int blk = c; blk < 64; blk += NS) s_out_block<true>(P, lds, (const bf16*)(P.ws + WS_BUFA) + (size_t)MPR * DM, (const bf16*)(P.ws + WS_WOA), P.x_sample, blk >> 4, blk & 15, tid, wave, lane); }
        else { for (int m = (c - NS) * NWAVES + wave; m < MPR; m += (G - NS) * NWAVES) gate_row(P, m, lane, (bf16*)(P.ws + WS_BUFA));
            if (NS == 0) { __syncthreads(); for (int blk = c; blk < 64; blk += G) s_out_block<true>(P, lds, (const bf16*)(P.ws + WS_BUFA) + (size_t)MPR * DM, (const bf16*)(P.ws + WS_WOA), P.x_sample, blk >> 4, blk & 15, tid, wave, lane); } }
        SEAM(4);
    }

    if (IN(5)) {
        pg8::SchedOut S{G, c, (const char*)(P.ws + WS_BUFA), (const char*)(P.ws + WS_WOA)};
        pg8::EpiOutA E{P.x_prompt, (pg8::bf16_t*)(P.ws + WS_SR), (float*)(P.ws + WS_SSQ1)};
        pg8::gemm_phase<pg8::EpiOutA, pg8::SchedOut, true, true>(lds, 2048, S, E);
        SEAM(5);
    }

    if (IN(6)) {
        pg8::SchedInB S{G, c, (const char*)(P.ws + WS_SR), (const char*)(P.ws + WS_WINB), (const float*)(P.ws + WS_SSQ1), (LAS float*)(lds + TAB_OFF)};
        pg8::EpiInB E{(pg8::bf16_t*)(P.ws + WS_QZ), (pg8::bf16_t*)(P.ws + WS_KB), (pg8::bf16_t*)(P.ws + WS_VT2), MT, P.out + OUT_KWP, P.out + OUT_VWP, P.out + OUT_KWS, P.out + OUT_VWS, (const LAS float*)(lds + TAB_OFF)};
        pg8::gemm_phase<pg8::EpiInB, pg8::SchedInB, true, true>(lds, 2048, S, E);
        for (int blk = (c + G - (64 % G)) % G; blk < 144; blk += G) s_in_b_block(P, lds, blk / 36, blk % 36, tid, wave, lane);
        SEAM(6);
    }

    if (IN(7)) {
        for (int u = c; u < 256; u += G) attn_prompt_unit(P, lds, u, tid, wave, lane);
        for (int u = c; u < 128; u += G) attn_sample_unit(P, lds, u, tid, wave, lane);
        SEAM(7);
    }

    if (IN(8)) {
        pg8::SchedOut S{G, c, (const char*)(P.ws + WS_BUFA), (const char*)(P.ws + WS_WOB)};
        pg8::EpiOutB E{(const pg8::bf16_t*)(P.ws + WS_SR), P.out + OUT_Y};
        pg8::gemm_phase<pg8::EpiOutB, pg8::SchedOut, true, true>(lds, 2048, S, E);
        SEAM(8);
    }

    if (IN(9)) {
        const int NS = G >= 128 ? 64 : 0;
        if (c < NS) { for (int blk = c; blk < 64; blk += NS) s_out_block<false>(P, lds, (const bf16*)(P.ws + WS_BUFA) + (size_t)MPR * DM, (const bf16*)(P.ws + WS_WOB), P.out + OUT_Y + (size_t)MPR * DM, blk >> 4, blk & 15, tid, wave, lane); }
        else { if (NS == 0) for (int blk = c; blk < 64; blk += G) s_out_block<false>(P, lds, (const bf16*)(P.ws + WS_BUFA) + (size_t)MPR * DM, (const bf16*)(P.ws + WS_WOB), P.out + OUT_Y + (size_t)MPR * DM, blk >> 4, blk & 15, tid, wave, lane);
            for (int m = (c - NS) * NWAVES + wave; m < MPR; m += (G - NS) * NWAVES) final_row(P.out + OUT_Y + (size_t)m * DM, P.g_final, lane, P.out + OUT_Y + (size_t)m * DM); }
        SEAM(9);
    }

    if (IN(10)) { for (int m = MPR + gw; m < MT; m += NGW) final_row(P.out + OUT_Y + (size_t)m * DM, P.g_final, lane, P.out + OUT_Y + (size_t)m * DM); }
#undef IN
#undef SEAM
}

extern "C" void kernel_launch(void* const* d_in, const int* in_sizes, int n_in, void* d_out, int out_size, void* d_ws, size_t ws_size, hipStream_t stream) {
    static int grid = 0;
    if (grid == 0) {
        if (n_in != 18 || (size_t)out_size != OUT_TOTAL || ws_size < WS_END) { fprintf(stderr, "kernel_launch: unexpected shapes (n_in %d, out %d, ws %zu); nothing launched\n", n_in, out_size, ws_size); grid = -1; return; }
        int dev = 0, cus = 0, per_cu = 0;
        if (hipGetDevice(&dev) != hipSuccess || hipDeviceGetAttribute(&cus, hipDeviceAttributeMultiprocessorCount, dev) != hipSuccess) { grid = -1; return; }
        if (hipFuncSetAttribute((const void*)yoco_fwd, hipFuncAttributeMaxDynamicSharedMemorySize, LDS_BYTES) != hipSuccess) { fprintf(stderr, "kernel_launch: hipFuncSetAttribute failed\n"); grid = -1; return; }
        if (hipOccupancyMaxActiveBlocksPerMultiprocessor(&per_cu, (const void*)yoco_fwd, NWAVES * 64, LDS_BYTES) != hipSuccess || per_cu < 1)
            fprintf(stderr, "kernel_launch: note: occupancy query reports %d workgroups per CU\n", per_cu);
        (void)hipGetLastError();
        grid = cus;
    }
    if (grid < 0) return;
    (void)hipMemsetAsync((char*)d_ws + WS_CTL, 0, CTL_ZERO_BYTES, stream);
    Args a{};
    const float** pp = (const float**)&a.p;
    for (int i = 0; i < 18; ++i) pp[i] = (const float*)d_in[i];
    a.p.out = (float*)d_out; a.p.ws = (unsigned char*)d_ws;
#if defined(PROBE_PHASE)
    { a.ph_lo = PROBE_PHASE; a.ph_hi = PROBE_PHASE + 1; a.sub = PROBE_SUB; hipLaunchKernelGGL(yoco_fwd, dim3(grid), dim3(NWAVES * 64), LDS_BYTES, stream, a); }
#endif
    a.sub = 0;
    for (int li = 0; li < N_LAUNCHES; ++li) {
        a.ph_lo = (N_LAUNCHES == 1) ? 0 : li; a.ph_hi = (N_LAUNCHES == 1) ? N_PHASES : li + 1;
        hipLaunchKernelGGL(yoco_fwd, dim3(grid), dim3(NWAVES * 64), LDS_BYTES, stream, a);
    }
}
```

```cpp
#include <hip/hip_runtime.h>
#include <cstdio>
#include <cstdint>
#include <cmath>
namespace pg8 {
#define PG8_LAS __attribute__((address_space(3)))
typedef unsigned short bf16_t;
typedef short bf16x8 __attribute__((ext_vector_type(8)));
typedef float f32x4 __attribute__((ext_vector_type(4)));
typedef unsigned u32x4 __attribute__((ext_vector_type(4)));
constexpr int BM = 256, BK = 64, HALF = 128, HTB = HALF * BK * 2  , STAGE_BYTES = 8 * HTB, NXCD = 8, WGM = 8;

__host__ __device__ __forceinline__ int lds_byte(int r, int c) { const int st = (r >> 4) * 2 + (c >> 5), rr = r & 15, cc = c & 31, ob = rr * 64 + cc * 2; return st * 1024 + (ob ^ (((ob >> 9) & 1) << 5)); }
__host__ __device__ __forceinline__ void stage_rc(int b, int& R, int& C) { const int st = b / 1024, sb = b % 1024, swz = sb ^ (((sb >> 9) & 1) << 5); R = (st >> 1) * 16 + swz / 64; C = (st & 1) * 32 + (swz % 64) / 2; }
__host__ __device__ __forceinline__ int perm32(int rho) { const int n = rho >> 4, i = rho & 15; return 8 * (i >> 2) + 4 * n + (i & 3); }

struct Unit { const char* a; const char* b; int pm, pn, kind, par; };
__device__ __forceinline__ void tile_map(int L, int nM, int nN, int& pm, int& pn) {
    const int nwg = nM * nN; int wgid = L; { const int q = nwg / NXCD, r = nwg % NXCD, xcd = wgid % NXCD, off = wgid / NXCD; wgid = (xcd < r ? xcd * (q + 1) : r * (q + 1) + (xcd - r) * q) + off; }
    const int nig = WGM * nN, gid = wgid / nig, fm = gid * WGM, gsz = (nM - fm) < WGM ? (nM - fm) : WGM;
    pm = fm + ((wgid % nig) % gsz); pn = (wgid % nig) / gsz;
}
typedef float f32x2_t __attribute__((ext_vector_type(2))); typedef __bf16 bf16x2_t __attribute__((ext_vector_type(2)));
__device__ __forceinline__ unsigned cvtpk(float lo, float hi) { f32x2_t v = {lo, hi}; bf16x2_t b = __builtin_convertvector(v, bf16x2_t); return __builtin_bit_cast(unsigned, b); }
__device__ __forceinline__ float silu_f(float v) { return v / (1.0f + __expf(-v)); }

template <bool SILU>
__device__ __forceinline__ void store_tile_bf16(const f32x4 (&acc)[2][2][4][2], bf16_t* base, int ldc, int row_t, int col_t, int wr, int wc, int fr, int fq, const PG8_LAS float* rtab = nullptr) {
    const int row0 = row_t + wr * 64 + fr, col0 = col_t + wc * 32 + 8 * fq;
#pragma unroll
    for (int ai = 0; ai < 2; ++ai)
#pragma unroll
        for (int m = 0; m < 4; ++m) { bf16_t* rowp = base + (size_t)(row0 + ai * HALF + m * 16) * ldc + col0; const float rsc = rtab ? rtab[wr * 64 + fr + ai * HALF + m * 16] : 1.0f;
#pragma unroll
            for (int bj = 0; bj < 2; ++bj) { f32x4 v0 = acc[ai][bj][m][0] * rsc, v1 = acc[ai][bj][m][1] * rsc;
                if (SILU) { v0[0] = silu_f(v0[0]); v0[1] = silu_f(v0[1]); v0[2] = silu_f(v0[2]); v0[3] = silu_f(v0[3]); v1[0] = silu_f(v1[0]); v1[1] = silu_f(v1[1]); v1[2] = silu_f(v1[2]); v1[3] = silu_f(v1[3]); }
                u32x4 w; w.x = cvtpk(v0[0], v0[1]); w.y = cvtpk(v0[2], v0[3]); w.z = cvtpk(v1[0], v1[1]); w.w = cvtpk(v1[2], v1[3]);
                *(u32x4*)(rowp + bj * HALF) = w; } }
}

struct EpiInA {
    static constexpr bool PERM = true, AFTER_DRAIN = false;
    bf16_t* QK; bf16_t* SR; bf16_t* VT; int MT;
    __device__ __forceinline__ void operator()(const f32x4 (&acc)[2][2][4][2], const Unit& u, int wr, int wc, int fr, int fq) const {
        if (u.kind == 0) store_tile_bf16<false>(acc, QK, 2048, u.pm * BM, u.pn * BM, wr, wc, fr, fq);
        else if (u.kind == 1) store_tile_bf16<true>(acc, SR, 2048, u.pm * BM, (u.pn - 8) * BM, wr, wc, fr, fq);
        else store_tile_bf16<false>(acc, VT, MT, u.pm * BM, u.pn * BM, wr, wc, fr, fq);
    }
};

struct EpiInB {
    static constexpr bool PERM = true, AFTER_DRAIN = false;
    bf16_t* QZ; bf16_t* KB; bf16_t* VT2; int MT; float* kwp; float* vwp; float* kws; float* vws; const PG8_LAS float* tab;
    __device__ __forceinline__ static float* win_row(int t, float* wp, float* wsmp) {
        if (t < 8192) { const int pos = t & 2047; if (pos < 1920) return nullptr; return wp + ((size_t)(t >> 11) * 128 + (pos - 1920)) * 256; }
        const int s = t - 8192; return wsmp + ((size_t)(s >> 3) * 128 + 120 + (s & 7)) * 256;
    }
    __device__ __forceinline__ void operator()(const f32x4 (&acc)[2][2][4][2], const Unit& u, int wr, int wc, int fr, int fq) const {
        const PG8_LAS float* T = tab + (u.par << 8);
        if (u.kind == 0) { store_tile_bf16<false>(acc, QZ, 4096, u.pm * BM, u.pn * BM, wr, wc, fr, fq, T); return; }
        if (u.kind == 1) { store_tile_bf16<true>(acc, QZ, 4096, u.pm * BM, u.pn * BM, wr, wc, fr, fq, T); return; }
        if (u.kind == 2) {
            store_tile_bf16<false>(acc, KB, 256, u.pm * BM, 0, wr, wc, fr, fq, T);
            if ((u.pm & 7) == 7) {
                const int row0 = u.pm * BM + wr * 64 + fr, col0 = wc * 32 + 8 * fq;
#pragma unroll
                for (int ai = 0; ai < 2; ++ai)
#pragma unroll
                    for (int m = 0; m < 4; ++m) { float* d = win_row(row0 + ai * HALF + m * 16, kwp, kws); const float rsc = T[wr * 64 + fr + ai * HALF + m * 16];
                        if (d) {
#pragma unroll
                            for (int bj = 0; bj < 2; ++bj) { *(f32x4*)(d + col0 + bj * HALF) = acc[ai][bj][m][0] * rsc; *(f32x4*)(d + col0 + bj * HALF + 4) = acc[ai][bj][m][1] * rsc; } } }
            }
            return;
        }
        const int row0 = wr * 64 + fr, colb = wc * 32 + 8 * fq;
        f32x4 cs[2][2];
#pragma unroll
        for (int bj = 0; bj < 2; ++bj) { cs[bj][0] = *(const PG8_LAS f32x4*)(T + colb + bj * HALF); cs[bj][1] = *(const PG8_LAS f32x4*)(T + colb + bj * HALF + 4); }
#pragma unroll
        for (int ai = 0; ai < 2; ++ai)
#pragma unroll
            for (int m = 0; m < 4; ++m) { bf16_t* rowp = VT2 + (size_t)(row0 + ai * HALF + m * 16) * MT + u.pn * BM + colb;
#pragma unroll
                for (int bj = 0; bj < 2; ++bj) { const f32x4 v0 = acc[ai][bj][m][0] * cs[bj][0], v1 = acc[ai][bj][m][1] * cs[bj][1];
                    u32x4 w; w.x = cvtpk(v0[0], v0[1]); w.y = cvtpk(v0[2], v0[3]); w.z = cvtpk(v1[0], v1[1]); w.w = cvtpk(v1[2], v1[3]);
                    *(u32x4*)(rowp + bj * HALF) = w; } }
        if ((u.pn & 7) == 7) {
            const int col0 = u.pn * BM + colb;
#pragma unroll
            for (int bj = 0; bj < 2; ++bj)
#pragma unroll
                for (int n = 0; n < 2; ++n)
#pragma unroll
                    for (int j = 0; j < 4; ++j) { float* d = win_row(col0 + bj * HALF + 4 * n + j, vwp, vws);
                        if (d) {
#pragma unroll
                            for (int ai = 0; ai < 2; ++ai)
#pragma unroll
                                for (int m = 0; m < 4; ++m) d[row0 + ai * HALF + m * 16] = acc[ai][bj][m][n][j] * cs[bj][n][j]; } }
        }
    }
};

struct EpiOutA {
    static constexpr bool PERM = false, AFTER_DRAIN = false;
    const float* x; bf16_t* H1b; float* SSQ1;
    __device__ __forceinline__ void operator()(const f32x4 (&acc)[2][2][4][2], const Unit& u, int wr, int wc, int fr, int fq) const {
        typedef unsigned u32x2_t __attribute__((ext_vector_type(2)));
        const int row0 = u.pm * BM + wr * 64 + fr, col0 = u.pn * BM + wc * 32 + 4 * fq;
        const float* xb = x + (size_t)row0 * 2048 + col0; bf16_t* hb = H1b + (size_t)row0 * 2048 + col0;
        f32x4 xr[3][4];
#define EOA_LD(slot, gi) do { const size_t o_ = (size_t)(((gi) >> 2) * HALF + ((gi) & 3) * 16) * 2048; xr[slot][0] = *(const f32x4*)(xb + o_); xr[slot][1] = *(const f32x4*)(xb + o_ + 16); xr[slot][2] = *(const f32x4*)(xb + o_ + HALF); xr[slot][3] = *(const f32x4*)(xb + o_ + HALF + 16); } while (0)
        EOA_LD(0, 0); EOA_LD(1, 1);
#pragma unroll
        for (int gi = 0; gi < 8; ++gi) { const int ai = gi >> 2, m = gi & 3;
            if (gi + 2 < 8) EOA_LD((gi + 2) % 3, gi + 2);
            const size_t o = (size_t)(ai * HALF + m * 16) * 2048; float ss = 0.f;
#pragma unroll
            for (int bj = 0; bj < 2; ++bj)
#pragma unroll
                for (int n = 0; n < 2; ++n) { const f32x4 v = xr[gi % 3][bj * 2 + n] + acc[ai][bj][m][n];
                    u32x2_t w; w.x = cvtpk(v[0], v[1]); w.y = cvtpk(v[2], v[3]);
                    *(u32x2_t*)(hb + o + bj * HALF + n * 16) = w; ss += (v[0] * v[0] + v[1] * v[1]) + (v[2] * v[2] + v[3] * v[3]); }
            ss += __shfl_xor(ss, 16); ss += __shfl_xor(ss, 32);
            if (fq == 0) SSQ1[(size_t)(row0 + ai * HALF + m * 16) * 32 + u.pn * 4 + wc] = ss; }
#undef EOA_LD
    }
};
struct EpiOutB {
    static constexpr bool PERM = false, AFTER_DRAIN = false;
    const bf16_t* H1b; float* out;
    __device__ __forceinline__ void operator()(const f32x4 (&acc)[2][2][4][2], const Unit& u, int wr, int wc, int fr, int fq) const {
        typedef unsigned u32x2_t __attribute__((ext_vector_type(2)));
        const int row0 = u.pm * BM + wr * 64 + fr, col0 = u.pn * BM + wc * 32 + 4 * fq;
        const bf16_t* hb = H1b + (size_t)row0 * 2048 + col0; float* ob = out + (size_t)row0 * 2048 + col0;
        u32x2_t hr[3][4];
#define EOB_LD(slot, gi) do { const size_t o_ = (size_t)(((gi) >> 2) * HALF + ((gi) & 3) * 16) * 2048; hr[slot][0] = *(const u32x2_t*)(hb + o_); hr[slot][1] = *(const u32x2_t*)(hb + o_ + 16); hr[slot][2] = *(const u32x2_t*)(hb + o_ + HALF); hr[slot][3] = *(const u32x2_t*)(hb + o_ + HALF + 16); } while (0)
        EOB_LD(0, 0); EOB_LD(1, 1);
#pragma unroll
        for (int gi = 0; gi < 8; ++gi) { const int ai = gi >> 2, m = gi & 3;
            if (gi + 2 < 8) EOB_LD((gi + 2) % 3, gi + 2);
            const size_t o = (size_t)(ai * HALF + m * 16) * 2048;
#pragma unroll
            for (int bj = 0; bj < 2; ++bj)
#pragma unroll
                for (int n = 0; n < 2; ++n) { const u32x2_t h = hr[gi % 3][bj * 2 + n];
                    f32x4 r; r[0] = __uint_as_float(h.x << 16); r[1] = __uint_as_float(h.x & 0xffff0000u); r[2] = __uint_as_float(h.y << 16); r[3] = __uint_as_float(h.y & 0xffff0000u);
                    *(f32x4*)(ob + o + bj * HALF + n * 16) = r + acc[ai][bj][m][n]; } }
#undef EOB_LD
    }
};

struct SchedInA {
    int G, c; const char* XN; const char* W;
    __device__ __forceinline__ bool next(int i, Unit& u) const {
        const int L = i * G + c; const size_t P = (size_t)BM * 2048 * 2;
        if (L < 512) { u.par = 0; tile_map(L, 32, 16, u.pm, u.pn); u.kind = u.pn < 8 ? 0 : 1; u.a = XN + u.pm * P; u.b = W + (u.pn < 8 ? u.pn : u.pn + 8) * P; return true; }
        if (L < 768) { u.par = 0; tile_map(L - 512, 8, 32, u.pm, u.pn); u.kind = 2; u.a = W + (8 + u.pm) * P; u.b = XN + u.pn * P; return true; }
        return false;
    }
    __device__ __forceinline__ void a_ready(const Unit&) const {}
    __device__ __forceinline__ void done(const Unit&) const {}
};
struct SchedInB {
    int G, c; const char* XN; const char* W; const float* SSQ1; PG8_LAS float* tab;
    __device__ __forceinline__ bool next(int i, Unit& u) const {
        const int L = i * G + c; const size_t P = (size_t)BM * 2048 * 2; u.par = i & 1;
        if (L < 544) { tile_map(L, 32, 17, u.pm, u.pn); u.kind = u.pn < 8 ? 0 : (u.pn < 16 ? 1 : 2); u.a = XN + u.pm * P; u.b = W + u.pn * P; return true; }
        if (L < 576) { u.pm = 0; u.pn = L - 544; u.kind = 3; u.a = W + 17 * P; u.b = XN + u.pn * P; return true; }
        return false;
    }
    __device__ __forceinline__ void a_ready(const Unit& u) const {
        int t = threadIdx.x; asm volatile("" : "+v"(t));
        const int row = t >> 1, hf = t & 1, panel = u.kind == 3 ? u.pn : u.pm;
        const float* p = SSQ1 + ((size_t)panel * BM + row) * 32 + hf * 16;
        const f32x4 a0 = *(const f32x4*)p, a1 = *(const f32x4*)(p + 4), a2 = *(const f32x4*)(p + 8), a3 = *(const f32x4*)(p + 12);
        float s = ((a0[0] + a0[1]) + (a0[2] + a0[3])) + ((a1[0] + a1[1]) + (a1[2] + a1[3])) + ((a2[0] + a2[1]) + (a2[2] + a2[3])) + ((a3[0] + a3[1]) + (a3[2] + a3[3]));
        s += __shfl_xor(s, 1);
        if (hf == 0) tab[(u.par << 8) + row] = 1.0f / sqrtf(s * (1.0f / 2048.0f) + 1e-6f);
    }
    __device__ __forceinline__ void done(const Unit&) const {}
};
struct SchedOut {
    int G, c; const char* A; const char* W;
    __device__ __forceinline__ bool next(int i, Unit& u) const {
        const int L = i * G + c; const size_t P = (size_t)BM * 2048 * 2;
        if (L >= 256) return false;
        tile_map(L, 32, 8, u.pm, u.pn); u.kind = 0; u.par = 0; u.a = A + u.pm * P; u.b = W + u.pn * P; return true;
    }
    __device__ __forceinline__ void a_ready(const Unit&) const {}
    __device__ __forceinline__ void done(const Unit&) const {}
};
template <class Epi, class Sched, bool ALIGN_EPI = false, bool SP2 = false>
__device__ __forceinline__ void gemm_phase(PG8_LAS unsigned char* lds, const int K_, const Sched& S, const Epi& E) {
    const int tid = threadIdx.x, wid = __builtin_amdgcn_readfirstlane(tid >> 6), lane = tid & 63, wr = wid >> 2, wc = wid & 3, fr = lane & 15, fq = lane >> 4;
    const int K = K_, nt = K / BK;
    unsigned voffA[2], voffB[2];
#pragma unroll
    for (int i = 0; i < 2; ++i) { int R, C; stage_rc(tid * 16 + i * 8192, R, C); const int Rb = Epi::PERM ? ((R & ~31) + perm32(R & 31)) : R;
        voffA[i] = (unsigned)(R * K + C) * 2u; voffB[i] = (unsigned)(Rb * K + C) * 2u; }
    const size_t kstep = (size_t)(BK * 2);
    const size_t hstep = (size_t)HALF * K * 2;
    const unsigned ldsw = (unsigned)wid * 1024u;
    const int aoff = lds_byte(wr * 64 + fr, fq * 8), boff = lds_byte(wc * 32 + fr, fq * 8);
#define PG8_SA(b, h) (((b) * 2 + (h)) * HTB)
#define PG8_SB(b, h) ((4 + (b) * 2 + (h)) * HTB)
#define PG8_STAGE(bufoff, gbase, voff) do { _Pragma("unroll") for (int _i = 0; _i < 2; ++_i) \
        __builtin_amdgcn_global_load_lds((const unsigned*)((const char*)(gbase) + (voff)[_i]), (PG8_LAS unsigned*)(lds + (bufoff) + ldsw + _i * 8192), 16, 0, 0); } while (0)
#define PG8_LDA(dst, b, h) do { _Pragma("unroll") for (int m = 0; m < 4; ++m) _Pragma("unroll") for (int k = 0; k < 2; ++k) dst[m][k] = *(const PG8_LAS bf16x8*)(lds + PG8_SA(b, h) + aoff + m * 2048 + k * 1024); } while (0)
#define PG8_LDB(dst, b, h) do { _Pragma("unroll") for (int n = 0; n < 2; ++n) _Pragma("unroll") for (int k = 0; k < 2; ++k) dst[n][k] = *(const PG8_LAS bf16x8*)(lds + PG8_SB(b, h) + boff + n * 2048 + k * 1024); } while (0)
#define PG8_MMA(ai, bj, At, Bt) do { __builtin_amdgcn_s_setprio(1); _Pragma("unroll") for (int m = 0; m < 4; ++m) _Pragma("unroll") for (int n = 0; n < 2; ++n) _Pragma("unroll") for (int k = 0; k < 2; ++k) \
        acc[ai][bj][m][n] = __builtin_amdgcn_mfma_f32_16x16x32_bf16(Bt[n][k], At[m][k], acc[ai][bj][m][n], 0, 0, 0); __builtin_amdgcn_s_setprio(0); } while (0)
#define PG8_WAIT_V(n) asm volatile("s_waitcnt vmcnt(" #n ")" ::: "memory")
#define PG8_WAIT_L(n) asm volatile("s_waitcnt lgkmcnt(" #n ")" ::: "memory")
#define PG8_BAR __builtin_amdgcn_s_barrier()
#define PG8_SCHED __builtin_amdgcn_sched_barrier(0)
    Unit cur, nxt; int ui = 0;
    if (!S.next(0, cur)) return;
    f32x4 acc[2][2][4][2];
#pragma unroll
    for (int a = 0; a < 2; ++a)
#pragma unroll
        for (int b = 0; b < 2; ++b)
#pragma unroll
            for (int m = 0; m < 4; ++m)
#pragma unroll
                for (int n = 0; n < 2; ++n) acc[a][b][m][n] = (f32x4){0.f, 0.f, 0.f, 0.f};
    bf16x8 At[4][2], B0[2][2], B1[2][2];
    const char* cA = cur.a; const char* cB = cur.b;
    S.a_ready(cur);
    if constexpr (SP2) {
        PG8_STAGE(PG8_SB(0, 0), cB, voffB); PG8_STAGE(PG8_SB(0, 1), cB + hstep, voffB); PG8_STAGE(PG8_SA(0, 0), cA, voffA); PG8_STAGE(PG8_SA(0, 1), cA + hstep, voffA);
        if (wr == 1) PG8_BAR;
        PG8_WAIT_V(2); PG8_BAR;
        PG8_STAGE(PG8_SB(1, 0), cB + kstep, voffB); PG8_STAGE(PG8_SA(1, 0), cA + kstep, voffA); PG8_STAGE(PG8_SB(1, 1), cB + hstep + kstep, voffB);
        PG8_WAIT_V(6); PG8_BAR;
    } else {
        PG8_STAGE(PG8_SB(0, 0), cB, voffB); PG8_STAGE(PG8_SA(0, 0), cA, voffA); PG8_STAGE(PG8_SB(0, 1), cB + hstep, voffB); PG8_STAGE(PG8_SA(0, 1), cA + hstep, voffA);
        if (wr == 1) PG8_BAR;
        PG8_WAIT_V(4); PG8_BAR;
        PG8_STAGE(PG8_SB(1, 0), cB + kstep, voffB); PG8_STAGE(PG8_SA(1, 0), cA + kstep, voffA); PG8_STAGE(PG8_SB(1, 1), cB + hstep + kstep, voffB);
        PG8_WAIT_V(6); PG8_BAR;
    }
    for (;;) {
        const bool has_next = S.next(ui + 1, nxt);
        const char* nA = has_next ? nxt.a : cA; const char* nB = has_next ? nxt.b : cB;
        for (int t = 0; t < nt; t += 2) {
            const bool last = (t == nt - 2);
            const char* a1 = cA + (size_t)(t + 1) * kstep;
            const char* a2 = last ? nA : cA + (size_t)(t + 2) * kstep; const char* b2 = last ? nB : cB + (size_t)(t + 2) * kstep;
            const char* a3 = a2 + kstep; const char* b3 = b2 + kstep;
            if (last && has_next) S.a_ready(nxt);
            if constexpr (SP2) {
            PG8_LDB(B0, 0, 0); PG8_LDB(B1, 0, 1); PG8_SCHED; PG8_LDA(At, 0, 0); PG8_STAGE(PG8_SA(1, 1), a1 + hstep, voffA);
            PG8_WAIT_V(8); PG8_WAIT_L(0); PG8_BAR; PG8_MMA(0, 0, At, B0); PG8_MMA(0, 1, At, B1); PG8_BAR; PG8_SCHED;
            PG8_LDA(At, 0, 1); PG8_STAGE(PG8_SB(0, 0), b2, voffB); PG8_STAGE(PG8_SB(0, 1), b2 + hstep, voffB); PG8_STAGE(PG8_SA(0, 0), a2, voffA);
            PG8_WAIT_V(8); PG8_WAIT_L(0); PG8_BAR; PG8_MMA(1, 0, At, B0); PG8_MMA(1, 1, At, B1); PG8_BAR; PG8_SCHED;
            PG8_LDB(B0, 1, 0); PG8_LDB(B1, 1, 1); PG8_SCHED; PG8_LDA(At, 1, 0); PG8_STAGE(PG8_SA(0, 1), a2 + hstep, voffA);
            PG8_WAIT_V(8); PG8_WAIT_L(0); PG8_BAR; PG8_MMA(0, 0, At, B0); PG8_MMA(0, 1, At, B1); PG8_BAR; PG8_SCHED;
            PG8_LDA(At, 1, 1); PG8_STAGE(PG8_SB(1, 0), b3, voffB); PG8_STAGE(PG8_SB(1, 1), b3 + hstep, voffB); PG8_STAGE(PG8_SA(1, 0), a3, voffA);
            PG8_WAIT_V(8); PG8_WAIT_L(0); PG8_BAR; PG8_MMA(1, 0, At, B0); PG8_MMA(1, 1, At, B1); PG8_BAR; PG8_SCHED;
            } else {
            PG8_LDB(B0, 0, 0); PG8_SCHED; PG8_LDA(At, 0, 0); PG8_STAGE(PG8_SA(1, 1), a1 + hstep, voffA);
            PG8_WAIT_L(8); PG8_BAR; PG8_WAIT_L(0); PG8_MMA(0, 0, At, B0); PG8_BAR; PG8_SCHED;
            PG8_LDB(B1, 0, 1); PG8_STAGE(PG8_SB(0, 0), b2, voffB);
            PG8_BAR; PG8_WAIT_L(0); PG8_MMA(0, 1, At, B1); PG8_BAR;
            PG8_LDA(At, 0, 1); PG8_STAGE(PG8_SA(0, 0), a2, voffA);
            PG8_BAR; PG8_WAIT_L(0); PG8_MMA(1, 0, At, B0); PG8_BAR; PG8_SCHED;
            PG8_STAGE(PG8_SB(0, 1), b2 + hstep, voffB);
            PG8_WAIT_V(6); PG8_BAR; PG8_MMA(1, 1, At, B1); PG8_BAR;
            PG8_LDB(B0, 1, 0); PG8_SCHED; PG8_LDA(At, 1, 0); PG8_STAGE(PG8_SA(0, 1), a2 + hstep, voffA);
            PG8_WAIT_L(8); PG8_BAR; PG8_WAIT_L(0); PG8_MMA(0, 0, At, B0); PG8_BAR; PG8_SCHED;
            PG8_LDB(B1, 1, 1); PG8_STAGE(PG8_SB(1, 0), b3, voffB);
            PG8_BAR; PG8_WAIT_L(0); PG8_MMA(0, 1, At, B1); PG8_BAR;
            PG8_LDA(At, 1, 1); PG8_STAGE(PG8_SA(1, 0), a3, voffA);
            PG8_BAR; PG8_WAIT_L(0); PG8_MMA(1, 0, At, B0); PG8_BAR; PG8_SCHED;
            PG8_STAGE(PG8_SB(1, 1), b3 + hstep, voffB);
            PG8_WAIT_V(6); PG8_BAR; PG8_MMA(1, 1, At, B1); PG8_BAR;
            }
        }
        if constexpr (ALIGN_EPI) { if (wr == 0) PG8_BAR; }
        if constexpr (!Epi::AFTER_DRAIN) { E(acc, cur, wr, wc, fr, fq); S.done(cur); }
        if (!has_next) break;
#pragma unroll
        for (int a = 0; a < 2; ++a)
#pragma unroll
            for (int b = 0; b < 2; ++b)
#pragma unroll
                for (int m = 0; m < 4; ++m)
#pragma unroll
                    for (int n = 0; n < 2; ++n) acc[a][b][m][n] = (f32x4){0.f, 0.f, 0.f, 0.f};
        cur = nxt; cA = nA; cB = nB; ++ui;
        if constexpr (ALIGN_EPI) { if (wr == 1) PG8_BAR; }
    }
    PG8_WAIT_V(0);
    if constexpr (!ALIGN_EPI) { if (wr == 0) PG8_BAR; }
    PG8_BAR;
    if constexpr (Epi::AFTER_DRAIN) { E.fused(acc, cur, wr, wc, fr, fq, lds, wid, lane); S.done(cur); }
#undef PG8_SA
#undef PG8_SB
#undef PG8_STAGE
#undef PG8_LDA
#undef PG8_LDB
#undef PG8_MMA
#undef PG8_WAIT_V
#undef PG8_WAIT_L
#undef PG8_BAR
#undef PG8_SCHED
}
}
#define GAS __attribute__((address_space(1)))
#define LAS __attribute__((address_space(3)))
typedef unsigned short bf16;
typedef unsigned v4u __attribute__((ext_vector_type(4)));
typedef float f32x4 __attribute__((ext_vector_type(4)));
typedef short bf16x8 __attribute__((ext_vector_type(8)));
typedef GAS unsigned gu32;
typedef GAS unsigned long long gu64;
#define RLX_AGENT __ATOMIC_RELAXED, __HIP_MEMORY_SCOPE_AGENT
#define LDS_WAIT() asm volatile("s_waitcnt lgkmcnt(0)" ::: "memory")
#define VM_WAIT() asm volatile("s_waitcnt vmcnt(0)" ::: "memory")
__device__ __forceinline__ unsigned long long rt() { return __builtin_amdgcn_s_memrealtime(); }
__device__ __forceinline__ unsigned f2bf(float f) { unsigned u = __builtin_bit_cast(unsigned, f); return (u + 0x7fffu + ((u >> 16) & 1u)) >> 16; }
__device__ __forceinline__ unsigned pk2(float lo, float hi) { return f2bf(lo) | (f2bf(hi) << 16); }

#define XB_TMO      128
#define XB_XCNT(j)  (256  + 64 * (j))
#define XB_XSUB(j)  (1280 + 64 * (j))
#define XB_XGEN(j)  (2304 + 64 * (j))
#define XB_TOP      3328
#define XB_TOPGEN   3392
#define XCD_BAR_WORDS 3456
#define XB_SPIN_CAP (1u << 18)

__device__ __forceinline__ unsigned xb_ld(unsigned* p)              { return __hip_atomic_load(p, __ATOMIC_RELAXED, __HIP_MEMORY_SCOPE_AGENT); }
__device__ __forceinline__ unsigned xb_add(unsigned* p, unsigned v) { return __hip_atomic_fetch_add(p, v, __ATOMIC_RELAXED, __HIP_MEMORY_SCOPE_AGENT); }
__device__ __forceinline__ unsigned xb_xcc_id() { return (unsigned)__builtin_amdgcn_s_getreg((3 << 11) | 20) & 0xFu; }
#define XB_SPIN(cond, bar) do { unsigned _sp = 0; while (cond) { __builtin_amdgcn_s_sleep(1); \
    if ((++_sp & 255u) == 0u) { if (xb_ld(&(bar)[XB_TMO])) break; if (_sp > XB_SPIN_CAP) { atomicAdd(&(bar)[XB_TMO], 1u); break; } } } } while (0)

struct XcdBarrier {
    unsigned* bar; unsigned x;
    volatile LAS unsigned* st;
};

__device__ __forceinline__ XcdBarrier xcd_barrier_post(unsigned* bar, volatile LAS unsigned* st) {
    XcdBarrier b; b.bar = bar; b.x = xb_xcc_id(); b.st = st;
    if (threadIdx.x == 0) (void)xb_add(&bar[XB_XCNT(b.x)], 1u);
    return b;
}
__device__ __forceinline__ void xcd_barrier_complete(unsigned* bar, unsigned x, unsigned& nloc, unsigned& nx) {
    const unsigned G = gridDim.x * gridDim.y * gridDim.z;
    unsigned sum, cnt, mine, sp = 0u;
    for (;;) {
        sum = 0u; cnt = 0u; mine = 0u;
#pragma unroll
        for (unsigned j = 0; j < 16; ++j) { const unsigned c = xb_ld(&bar[XB_XCNT(j)]); sum += c; cnt += (c > 0u) ? 1u : 0u; mine = (j == x) ? c : mine; }
        if (sum == G) break;
        __builtin_amdgcn_s_sleep(1);
        if ((++sp & 255u) == 0u) { if (xb_ld(&bar[XB_TMO])) break; if (sp > XB_SPIN_CAP) { atomicAdd(&bar[XB_TMO], 1u); break; } }
    }
    nloc = mine > 0u ? mine : 1u; nx = cnt > 0u ? cnt : 1u;
}

__device__ __forceinline__ void xcd_barrier(const XcdBarrier& b) {
    asm volatile("s_waitcnt vmcnt(0)" ::: "memory");
    __syncthreads();
    if (threadIdx.x == 0) {
        unsigned* bar = b.bar;
        __builtin_amdgcn_s_waitcnt(0);
        unsigned nloc = b.st[0], nx = b.st[1];
        if (nloc == 0u) { xcd_barrier_complete(bar, b.x, nloc, nx); b.st[0] = nloc; b.st[1] = nx; }
        const unsigned old = xb_add(&bar[XB_XSUB(b.x)], 1u);
        const unsigned gen = old / nloc;
        if (old + 1u == (gen + 1u) * nloc) {
            __builtin_amdgcn_fence(__ATOMIC_RELEASE, "agent");
            asm volatile("s_waitcnt vmcnt(0)" ::: "memory");
            const unsigned og = xb_add(&bar[XB_TOP], 1u);
            const unsigned tg = og / nx;
            if (og + 1u == (tg + 1u) * nx) xb_add(&bar[XB_TOPGEN], 1u);
            else XB_SPIN(xb_ld(&bar[XB_TOPGEN]) == tg, bar);
            __builtin_amdgcn_fence(__ATOMIC_ACQUIRE, "agent");
            xb_add(&bar[XB_XGEN(b.x)], 1u);
            asm volatile("s_waitcnt vmcnt(0)" ::: "memory");
        } else {
            XB_SPIN(xb_ld(&bar[XB_XGEN(b.x)]) == gen, bar);
            __builtin_amdgcn_fence(__ATOMIC_ACQUIRE, "agent");
            asm volatile("s_waitcnt vmcnt(0)" ::: "memory");
        }
    }
    __syncthreads();
}
constexpr int NWAVES = 8;
constexpr int MPR = 8192, MSM = 256, MT = MPR + MSM;
constexpr int DM = 2048;
constexpr float RMS_EPS = 1e-6f;
constexpr float LOG2E = 1.4426950408889634f;
constexpr size_t MiB = 1u << 20;
constexpr size_t WS_CTL = 0, CTL_ZERO_BYTES = 64 * 1024;
constexpr size_t WS_WINA = 1 * MiB;
constexpr size_t WS_WOA = 26 * MiB;
constexpr size_t WS_WINB = 34 * MiB;
constexpr size_t WS_WOB = 52 * MiB;
constexpr size_t WS_BUFA = 60 * MiB;
constexpr size_t WS_QK = 93 * MiB;
constexpr size_t WS_VT = 126 * MiB;
constexpr size_t WS_QZ = 93 * MiB;
constexpr size_t WS_SR = 159 * MiB;
constexpr size_t WS_REC = 192 * MiB;
constexpr size_t WS_KB = 192 * MiB;
constexpr size_t WS_VT2 = 198 * MiB;
constexpr size_t WS_GLOW = 234 * MiB;
constexpr size_t WS_SSQP = 235 * MiB;
constexpr size_t WS_SSQ1 = 236 * MiB;
constexpr int TAB_OFF = 131072;
constexpr size_t WS_END = 240 * MiB;
constexpr int CW_BAR = 1024;
constexpr int HREC = 33792, REC_PO = 33792, REC_H1 = 41984, REC_BYTES = 75776, REC_DMA = 41984, H_QT = 0, H_KT = 16384, H_G = 32768;
static_assert(512 * (size_t)REC_BYTES <= 42 * MiB && REC_DMA % 1024 == 0, "record");
__device__ __forceinline__ int qt_off(int t, int dl) {
    const int d5 = dl & 31; const int p = d5 < 16 ? ((d5 >> 2) << 3) + (d5 & 3) : (((d5 - 16) >> 2) << 3) + 4 + (d5 & 3);
    const int chunk = ((dl >> 5) << 2) + (p >> 3); return t * 256 + ((chunk ^ (t & 15)) << 4) + ((p & 7) << 1); }
__device__ __forceinline__ int qt_chunk(int t, int c) { return t * 256 + ((c ^ (t & 15)) << 4); }
__device__ __forceinline__ int kt_chunk(int d, int c) { return d * 128 + ((c ^ ((d >> 1) & 7)) << 4); }
constexpr size_t OUT_Y = 0, OUT_GLAP = 17301504, OUT_GLAS = 19398656, OUT_KWP = 36175872, OUT_VWP = 36306944, OUT_KWS = 36438016, OUT_VWS = 37486592, OUT_TOTAL = 38535168;
constexpr int RING_BYTES = 131072, LDS_BYTES = 163840, LDSCTL_OFF = LDS_BYTES - 1024, MISC_OFF = LDSCTL_OFF + 320;

__device__ __forceinline__ float bf2f(unsigned short u) { return __uint_as_float(((unsigned)u) << 16); }
__device__ __forceinline__ unsigned cvtpk2(float lo, float hi) { return pg8::cvtpk(lo, hi); }
__device__ __forceinline__ float wave_sum(float v) {
#pragma unroll
    for (int o = 1; o < 64; o <<= 1) v += __shfl_xor(v, o);
    return v;
}
#define MFMA16(a, b, c) __builtin_amdgcn_mfma_f32_16x16x32_bf16((a), (b), (c), 0, 0, 0)
typedef unsigned u32x2 __attribute__((ext_vector_type(2)));

struct Ptrs {
    const float *x_prompt, *x_sample, *state, *ck, *cv, *g_norm_a, *w_in_a, *w_gate_up, *b_gate, *g_onorm, *w_out_a, *g_norm_kv, *w_kv, *g_norm_b, *w_in_b, *sinks, *w_out_b, *g_final;
    float* out; unsigned char* ws;
};

__device__ __forceinline__ void p0_transpose_item(const float* W, int ldw, int ncol0, int nvalid, const float* gain, int scale_cols, float scale, bf16* WT, int row_off, LAS float* scr, int kb, int nb, int lane) {
    const int k0 = 64 * kb, n0 = 32 * nb, nl = lane & 31; const bool ok = (n0 + nl) < nvalid; const float cs = (n0 + nl) < scale_cols ? scale : 1.0f;
#pragma unroll 8
    for (int i = 0; i < 32; ++i) { const int kk = 2 * i + (lane >> 5); float v = ok ? W[(size_t)(k0 + kk) * ldw + ncol0 + n0 + nl] : 0.f; if (gain) v *= gain[k0 + kk]; scr[kk * 33 + nl] = v * cs; }
    LDS_WAIT(); asm volatile("" ::: "memory");
    const int c = lane & 7;
#pragma unroll
    for (int j = 0; j < 4; ++j) { const int n = (lane >> 3) + 8 * j; const LAS float* s = scr + (8 * c) * 33 + n;
        v4u o; o.x = cvtpk2(s[0 * 33], s[1 * 33]); o.y = cvtpk2(s[2 * 33], s[3 * 33]); o.z = cvtpk2(s[4 * 33], s[5 * 33]); o.w = cvtpk2(s[6 * 33], s[7 * 33]);
        if (n0 + n < nvalid) *(GAS v4u*)(WT + (size_t)(row_off + n0 + n) * 2048 + k0 + 8 * c) = o; }
    LDS_WAIT(); asm volatile("" ::: "memory");
}
__device__ __forceinline__ void rms_row_to_bf16(const float* xrow, bf16* orow, int lane) {
    const GAS f32x4* xr = (const GAS f32x4*)xrow + lane;
    f32x4 v[8]; float s = 0.f;
#pragma unroll
    for (int j = 0; j < 8; ++j) { v[j] = xr[64 * j]; s += (v[j].x * v[j].x + v[j].y * v[j].y) + (v[j].z * v[j].z + v[j].w * v[j].w); }
    const float rstd = 1.0f / sqrtf(wave_sum(s) * (1.f / DM) + RMS_EPS);
    GAS u32x2* o8 = (GAS u32x2*)orow + lane;
#pragma unroll
    for (int j = 0; j < 8; ++j) { u32x2 w; w.x = cvtpk2(v[j].x * rstd, v[j].y * rstd); w.y = cvtpk2(v[j].z * rstd, v[j].w * rstd); o8[64 * j] = w; }
}
__device__ __forceinline__ void p0_transpose_big(const float* W, int ldw, const float* gain, float cs, bf16* WT, int row_off, LAS unsigned char* scr, int kb, int nb, int lane) {
    const int k0 = 64 * kb, n0 = 128 * nb, hl = lane >> 5, nl = lane & 31;
    const GAS f32x4* src = (const GAS f32x4*)(W + (size_t)(k0 + 32 * hl) * ldw + n0 + 4 * nl);
    f32x4 v[32];
#pragma unroll
    for (int i = 0; i < 32; ++i) v[i] = src[(size_t)i * (ldw / 4)];
    f32x4 gk[8];
#pragma unroll
    for (int i = 0; i < 8; ++i) gk[i] = gain ? *(const GAS f32x4*)(gain + k0 + 32 * hl + 4 * i) * cs : (f32x4){cs, cs, cs, cs};
#pragma unroll
    for (int j = 0; j < 4; ++j) { const int n = 4 * nl + j;
#pragma unroll
        for (int q = 0; q < 4; ++q) { v4u o;
            o.x = cvtpk2(v[8 * q + 0][j] * gk[2 * q][0], v[8 * q + 1][j] * gk[2 * q][1]); o.y = cvtpk2(v[8 * q + 2][j] * gk[2 * q][2], v[8 * q + 3][j] * gk[2 * q][3]);
            o.z = cvtpk2(v[8 * q + 4][j] * gk[2 * q + 1][0], v[8 * q + 5][j] * gk[2 * q + 1][1]); o.w = cvtpk2(v[8 * q + 6][j] * gk[2 * q + 1][2], v[8 * q + 7][j] * gk[2 * q + 1][3]);
            *(LAS v4u*)(scr + n * 128 + (((4 * hl + q) ^ (n & 7)) << 4)) = o; } }
    LDS_WAIT(); asm volatile("" ::: "memory");
#pragma unroll
    for (int it = 0; it < 16; ++it) { const int idx = it * 64 + lane, n = idx >> 3, ch = idx & 7;
        const v4u o = *(const LAS v4u*)(scr + n * 128 + ((ch ^ (n & 7)) << 4));
        *(GAS v4u*)(WT + (size_t)(row_off + n0 + n) * 2048 + k0 + 8 * ch) = o; }
    LDS_WAIT(); asm volatile("" ::: "memory");
}
__device__ __forceinline__ void convert_weights(const Ptrs& P, LAS unsigned char* lds, int group, int gwi, int ngw, int iend, int wave, int lane) {
    LAS unsigned char* scr = lds + wave * 16384;
    bf16* WinaT = (bf16*)(P.ws + WS_WINA); bf16* WoaT = (bf16*)(P.ws + WS_WOA); bf16* WinbT = (bf16*)(P.ws + WS_WINB); bf16* WobT = (bf16*)(P.ws + WS_WOB);
    constexpr int I0 = 32 * 48, I1 = 32, I2 = 32 * 16, I3 = 32 * 32, I4 = 32 * 4, I5 = 32 * 16;
    if (group == 0) {
        for (int r = gwi; r < I0; r += ngw) { const int nb = r % 48; p0_transpose_big(P.w_in_a, 6160, P.g_norm_a, nb < 8 ? 0.0625f : 1.f, WinaT, 0, scr, r / 48, nb, lane); }
        for (int it = ngw - 1 - gwi; it < I1; it += ngw) p0_transpose_item(P.w_in_a, 6160, 6144, 16, P.g_norm_a, 0, 1.f, WinaT, 6144, (LAS float*)scr, it, 0, lane);
    } else {
        for (int it = gwi; it < iend; it += ngw) {
            int r = it;
            if (r < I2) { p0_transpose_big(P.w_out_a, 2048, P.g_onorm, 1.f, WoaT, 0, scr, r / 16, r % 16, lane); continue; } r -= I2;
            if (r < I3) { const int nb = r % 32; p0_transpose_big(P.w_in_b, 4096, P.g_norm_b, nb < 16 ? 0.125f * LOG2E : 1.f, WinbT, 0, scr, r / 32, nb, lane); continue; } r -= I3;
            if (r < I4) { p0_transpose_big(P.w_kv, 512, P.g_norm_kv, 1.f, WinbT, 4096, scr, r / 4, r % 4, lane); continue; } r -= I4;
            p0_transpose_big(P.w_out_b, 2048, nullptr, 1.f, WobT, 0, scr, r / 16, r % 16, lane);
        }
    }
}
__device__ __forceinline__ void p0_prologue(const Ptrs& P, LAS unsigned char* lds, int vcu, int G, int tid, int wave, int lane) {
    const int gw = vcu * NWAVES + wave, NGW = G * NWAVES;
    convert_weights(P, lds, 0, gw, NGW, 0, wave, lane);
    if (G < 256) convert_weights(P, lds, 1, gw, NGW, 2176, wave, lane);
    bf16* XN = (bf16*)(P.ws + WS_BUFA);
    for (int m = gw; m < MT; m += NGW) rms_row_to_bf16(m < MPR ? P.x_prompt + (size_t)m * DM : P.x_sample + (size_t)(m - MPR) * DM, XN + (size_t)m * DM, lane);
    const int gt = vcu * (NWAVES * 64) + tid, NGT = G * NWAVES * 64;
    for (int i = gt; i < 32 * 120 * 64; i += NGT) { const int b = i / (120 * 64), rem = i % (120 * 64);
        ((f32x4*)(P.out + OUT_KWS))[(size_t)b * 128 * 64 + rem] = ((const f32x4*)P.ck)[(size_t)b * 128 * 64 + 8 * 64 + rem];
        ((f32x4*)(P.out + OUT_VWS))[(size_t)b * 128 * 64 + rem] = ((const f32x4*)P.cv)[(size_t)b * 128 * 64 + 8 * 64 + rem]; }
}

__device__ __forceinline__ void glow_task(const bf16* XN, const bf16* WgT, float* GLOW, int task, int lane) {
    const int r = lane & 15, g = lane >> 4, row0 = task * 16;
    const bf16* ap = XN + (size_t)(row0 + r) * DM + g * 8; const bf16* bp = WgT + (size_t)r * DM + g * 8;
    f32x4 acc = {0.f, 0.f, 0.f, 0.f};
#pragma unroll 8
    for (int kk = 0; kk < 64; ++kk) { const bf16x8 a = *(const bf16x8*)(ap + kk * 32); const bf16x8 b = *(const bf16x8*)(bp + kk * 32); acc = MFMA16(a, b, acc); }
#pragma unroll
    for (int i = 0; i < 4; ++i) GLOW[(size_t)(row0 + 4 * g + i) * 16 + r] = acc[i];
}

__device__ __forceinline__ void gla_prep_unit(const Ptrs& P, LAS unsigned char* lds, int u, int tid, int wave, int lane) {
    const int c = u & 31, h = (u >> 5) & 3, b = u >> 7;
    const int d = tid & 255, th = tid >> 8, hh = d >> 7, dl = d & 127;
    LAS unsigned char* QI = lds;
    LAS unsigned char* KI = lds + 32768;
    LAS float* GL = (LAS float*)(lds + 65536);
    LAS float* TOT = (LAS float*)(lds + 65536 + 4096);
    const int row0 = b * 2048 + c * 64;
    const float* GLOW = (const float*)(P.ws + WS_GLOW);
    const bf16* QK = (const bf16*)(P.ws + WS_QK);
    unsigned char* rec = P.ws + WS_REC + (size_t)u * REC_BYTES;
    unsigned char* rech = rec + (hh ? REC_H1 : 0);
#pragma unroll
    for (int i = 0; i < 4; ++i) { const int idx = tid + 512 * i, t = idx >> 5, ch = idx & 31;
        const v4u q = *(const GAS v4u*)(QK + (size_t)(row0 + t) * DM + h * 256 + ch * 8), k = *(const GAS v4u*)(QK + (size_t)(row0 + t) * DM + 1024 + h * 256 + ch * 8);
        *(LAS v4u*)(QI + t * 512 + ch * 16) = q; *(LAS v4u*)(KI + t * 512 + ch * 16) = k; }
    if (tid < 256) ((LAS f32x4*)GL)[tid] = ((const f32x4*)(GLOW + (size_t)row0 * 16))[tid];
    float wg[16];
#pragma unroll
    for (int r = 0; r < 16; ++r) wg[r] = P.w_gate_up[r * 1024 + h * 256 + d];
    const float bias = P.b_gate[h * 256 + d];
    __syncthreads();
    float bl[32]; float run = 0.f;
#pragma unroll
    for (int tt = 0; tt < 32; ++tt) { const int t = th * 32 + tt; const LAS f32x4* gr = (const LAS f32x4*)(GL + t * 16);
        const f32x4 g0 = gr[0], g1 = gr[1], g2 = gr[2], g3 = gr[3];
        float z = bias + g0.x * wg[0] + g0.y * wg[1] + g0.z * wg[2] + g0.w * wg[3] + g1.x * wg[4] + g1.y * wg[5] + g1.z * wg[6] + g1.w * wg[7]
                       + g2.x * wg[8] + g2.y * wg[9] + g2.z * wg[10] + g2.w * wg[11] + g3.x * wg[12] + g3.y * wg[13] + g3.z * wg[14] + g3.w * wg[15];
        const float ls = fminf(z, 0.f) - __logf(1.0f + __expf(-fabsf(z)));
        run += ls * 0.0625f; bl[tt] = run; }
    TOT[th * 256 + d] = run;
    unsigned short qr[32], kr[32];
#pragma unroll
    for (int tt = 0; tt < 32; ++tt) { qr[tt] = *(const LAS unsigned short*)(QI + (th * 32 + tt) * 512 + d * 2); kr[tt] = *(const LAS unsigned short*)(KI + (th * 32 + tt) * 512 + d * 2); }
    __syncthreads();
    const float tot0 = TOT[d], tot1 = TOT[256 + d], blast = tot0 + tot1, base = th ? tot0 : 0.f;
    unsigned kt[16];
#pragma unroll
    for (int tt = 0; tt < 32; tt += 2) {
        float kv2[2];
#pragma unroll
        for (int k2 = 0; k2 < 2; ++k2) { const int t = th * 32 + tt + k2; const float bt = base + bl[tt + k2];
            const float e1 = __expf(bt - blast), e2 = __builtin_amdgcn_rcpf(e1);
            const float qv = bf2f(qr[tt + k2]) * e1, kv = bf2f(kr[tt + k2]) * e2; kv2[k2] = kv;
            const int off = hh * 16384 + qt_off(t, dl);
            *(LAS unsigned short*)(QI + off) = (unsigned short)(cvtpk2(qv, 0.f) & 0xffffu); *(LAS unsigned short*)(KI + off) = (unsigned short)(cvtpk2(kv, 0.f) & 0xffffu); }
        kt[tt >> 1] = cvtpk2(kv2[0], kv2[1]); }
#pragma unroll
    for (int i = 0; i < 4; ++i) { v4u o; o.x = kt[4 * i]; o.y = kt[4 * i + 1]; o.z = kt[4 * i + 2]; o.w = kt[4 * i + 3]; *(GAS v4u*)(rech + H_KT + kt_chunk(dl, 4 * th + i)) = o; }
    if (th == 0) ((GAS float*)(rech + H_G))[dl] = __expf(blast);
    __syncthreads();
    { const int r = lane & 15, g = lane >> 4, mt = wave >> 1, st0 = 2 * (wave & 1);
      f32x4 a0 = {0.f, 0.f, 0.f, 0.f}, a1 = {0.f, 0.f, 0.f, 0.f};
      bf16x8 bq[8], k0[8], k1[8];
#pragma unroll
      for (int kk = 0; kk < 8; ++kk) { const int ho = (kk >> 2) * 16384, cc = 4 * (kk & 3) + g;
          bq[kk] = *(const LAS bf16x8*)(QI + ho + qt_chunk(16 * mt + r, cc)); k0[kk] = *(const LAS bf16x8*)(KI + ho + qt_chunk(16 * st0 + r, cc)); k1[kk] = *(const LAS bf16x8*)(KI + ho + qt_chunk(16 * st0 + 16 + r, cc)); }
#pragma unroll
      for (int kk = 0; kk < 8; ++kk) { a0 = MFMA16(k0[kk], bq[kk], a0); a1 = MFMA16(k1[kk], bq[kk], a1); }
      const int t = 16 * mt + r;
#pragma unroll
      for (int j = 0; j < 2; ++j) { const f32x4 a = j ? a1 : a0; const int s0 = 16 * (st0 + j) + 4 * g;
          u32x2 w; w.x = cvtpk2(s0 + 0 <= t ? a[0] : 0.f, s0 + 1 <= t ? a[1] : 0.f); w.y = cvtpk2(s0 + 2 <= t ? a[2] : 0.f, s0 + 3 <= t ? a[3] : 0.f);
          *(GAS u32x2*)(rec + REC_PO + kt_chunk(t, s0 >> 3) + (s0 & 7) * 2) = w; } }
#pragma unroll
    for (int i = 0; i < 4; ++i) { const int idx = tid + 512 * i; ((GAS v4u*)(rec + ((idx >> 10) ? REC_H1 : 0) + H_QT))[idx & 1023] = ((const LAS v4u*)QI)[idx]; }
    __syncthreads();
}

constexpr int SC_BUF = REC_DMA, SC_PIECES = REC_DMA / 1024, SC_OT = 3 * REC_DMA;
static_assert(SC_OT + 2 * 16384 <= LDSCTL_OFF, "scan LDS map");
__device__ __forceinline__ void gla_scan_unit(const Ptrs& P, LAS unsigned char* lds, int bh, int dh, int eq, int tid, int wave, int lane, int nch = 32) {
    const int b = bh >> 2, h = bh & 3, r = lane & 15, g = lane >> 4, rr = (r >> 1) & 7;
    const int ecol = h * 512 + eq * 128 + 16 * wave;
    const bf16* VT = (const bf16*)(P.ws + WS_VT);
    bf16* OB = (bf16*)(P.ws + (dh ? WS_QK : WS_BUFA)) + (size_t)(b * 2048) * DM + h * 512 + eq * 128;
    const unsigned char* rec0 = P.ws + WS_REC + (size_t)(bh * 32) * REC_BYTES + (dh ? REC_PO : 0);
    const unsigned HO = dh ? 8192u : 0u, PO = dh ? 0u : 33792u;
    f32x4 S[8];
#pragma unroll
    for (int i = 0; i < 8; ++i) S[i] = (f32x4){0.f, 0.f, 0.f, 0.f};
    const bf16* vtp = VT + (size_t)(ecol + r) * MT + b * 2048 + 8 * g;
#define SC_DMA(cc, bufo_) do { const unsigned char* src_ = rec0 + (size_t)(cc) * REC_BYTES + lane * 16; \
        _Pragma("unroll") for (int j_ = 0; j_ < 6; ++j_) { const int i_ = wave + NWAVES * j_; \
            if (i_ < SC_PIECES) __builtin_amdgcn_global_load_lds((const GAS unsigned*)(src_ + i_ * 1024), (LAS unsigned*)(lds + (bufo_) + i_ * 1024), 16, 0, 0); } } while (0)
#define SC_OSTORE(cc) do { const LAS unsigned char* ot_ = lds + SC_OT + ((cc) & 1) * 16384; \
        _Pragma("unroll") for (int j_ = 0; j_ < 2; ++j_) { const int idx_ = tid + 512 * j_, row_ = idx_ >> 4, q_ = idx_ & 15; \
            const v4u v_ = *(const LAS v4u*)(ot_ + row_ * 256 + ((q_ ^ (row_ & 15)) << 4)); \
            *(GAS v4u*)(OB + (size_t)((cc) * 64 + row_) * DM + q_ * 8) = v_; } } while (0)
    bf16x8 vc0 = *(const bf16x8*)vtp, vc1 = *(const bf16x8*)(vtp + 32), vn0 = vc0, vn1 = vc1;
    SC_DMA(0, 0u); SC_DMA(1, (unsigned)SC_BUF);
    __syncthreads();
    unsigned bo0 = 0u, bo1 = SC_BUF, bo2 = 2u * SC_BUF;
#pragma unroll 1
    for (int c = 0; c < nch; ++c) {
        bf16x8 vf[2]; vf[0] = vc0; vf[1] = vc1;
        { const bf16* vp_ = vtp + (c + 1 < 32 ? c + 1 : 31) * 64;
          asm volatile("global_load_dwordx4 %0, %2, off\n\tglobal_load_dwordx4 %1, %2, off offset:64" : "=&v"(vn0), "=&v"(vn1) : "v"(vp_) : "memory"); }
        if (c > 0) SC_OSTORE(c - 1);
        const unsigned bufo = bo0;
        const unsigned qbase = bufo + HO + H_QT + (unsigned)(r * 256 + ((r >> 2) << 6) + ((g ^ (r & 3)) << 4));
        const unsigned kbase = bufo + HO + H_KT + (unsigned)(r * 128 + ((rr >> 2) << 6) + ((g ^ (rr & 3)) << 4));
        const unsigned pbase = bufo + PO + (unsigned)(r * 128 + ((dh ^ (rr >> 2)) << 6) + ((g ^ (rr & 3)) << 4));
        const unsigned gbase = bufo + HO + H_G + (unsigned)(g * 16);
#define SC_FENCE() __builtin_amdgcn_sched_barrier(0)
#define SC_BQ(k2, tt) (*(const LAS bf16x8*)(lds + ((qbase ^ ((k2) << 6)) + (tt) * 4096)))
#define SC_KF(i, ks) (*(const LAS bf16x8*)(lds + ((kbase ^ ((ks) << 6)) + (i) * 2048)))
#define SC_AF(k2) __builtin_bit_cast(bf16x8, (v4u){cvtpk2(S[2 * (k2)][0], S[2 * (k2)][1]), cvtpk2(S[2 * (k2)][2], S[2 * (k2)][3]), cvtpk2(S[2 * (k2) + 1][0], S[2 * (k2) + 1][1]), cvtpk2(S[2 * (k2) + 1][2], S[2 * (k2) + 1][3])})
        f32x4 gm[4]; bf16x8 qa[8], qb[8];
#pragma unroll
        for (int i = 0; i < 4; ++i) gm[i] = *(const LAS f32x4*)(lds + (gbase + i * 64));
#pragma unroll
        for (int tt = 0; tt < 4; ++tt) { qa[tt] = SC_BQ(0, tt); qa[4 + tt] = SC_BQ(1, tt); }
        SC_FENCE();
#pragma unroll
        for (int i = 0; i < 4; ++i) S[i] = S[i] * gm[i];
#pragma unroll
        for (int i = 0; i < 4; ++i) gm[i] = *(const LAS f32x4*)(lds + (gbase + (4 + i) * 64));
#pragma unroll
        for (int tt = 0; tt < 4; ++tt) { qb[tt] = SC_BQ(2, tt); qb[4 + tt] = SC_BQ(3, tt); }
        bf16x8 pq[4];
#pragma unroll
        for (int tt = 0; tt < 4; ++tt) pq[tt] = *(const LAS bf16x8*)(lds + (pbase + tt * 2048));
        SC_FENCE();
        f32x4 Z[4];
#pragma unroll
        for (int tt = 0; tt < 4; ++tt) Z[tt] = (f32x4){0.f, 0.f, 0.f, 0.f};
        { const bf16x8 a0 = SC_AF(0), a1 = SC_AF(1);
#pragma unroll
          for (int tt = 0; tt < 4; ++tt) Z[tt] = MFMA16(a0, qa[tt], Z[tt]);
#pragma unroll
          for (int tt = 0; tt < 4; ++tt) Z[tt] = MFMA16(a1, qa[4 + tt], Z[tt]); }
#pragma unroll
        for (int i = 0; i < 4; ++i) S[4 + i] = S[4 + i] * gm[i];
#pragma unroll
        for (int i = 0; i < 4; ++i) { qa[2 * i] = SC_KF(i, 0); qa[2 * i + 1] = SC_KF(i, 1); }
        SC_FENCE();
        asm volatile("s_waitcnt vmcnt(0)" : "+v"(vn0), "+v"(vn1) :: "memory");
        SC_DMA((c + 2 < 32 ? c + 2 : 31), bo2);
        SC_FENCE();
        { const bf16x8 a2 = SC_AF(2), a3 = SC_AF(3);
#pragma unroll
          for (int tt = 0; tt < 4; ++tt) Z[tt] = MFMA16(a2, qb[tt], Z[tt]);
#pragma unroll
          for (int tt = 0; tt < 4; ++tt) Z[tt] = MFMA16(a3, qb[4 + tt], Z[tt]);
#pragma unroll
          for (int tt = 0; tt < 4; ++tt) Z[tt] = MFMA16(dh ? vf[1] : vf[0], pq[tt], Z[tt]); }
#pragma unroll
        for (int i = 0; i < 4; ++i) { qb[2 * i] = SC_KF(4 + i, 0); qb[2 * i + 1] = SC_KF(4 + i, 1); }
        SC_FENCE();
#pragma unroll
        for (int i = 0; i < 4; ++i) { S[i] = MFMA16(qa[2 * i], vf[0], S[i]); S[i] = MFMA16(qa[2 * i + 1], vf[1], S[i]); }
#pragma unroll
        for (int i = 0; i < 4; ++i) { S[4 + i] = MFMA16(qb[2 * i], vf[0], S[4 + i]); S[4 + i] = MFMA16(qb[2 * i + 1], vf[1], S[4 + i]); }
#undef SC_FENCE
#undef SC_BQ
#undef SC_KF
#undef SC_AF
        { LAS unsigned char* ot = lds + SC_OT + (c & 1) * 16384 + (g & 1) * 8;
#pragma unroll
          for (int tt = 0; tt < 4; ++tt) { u32x2 w; w.x = cvtpk2(Z[tt][0], Z[tt][1]); w.y = cvtpk2(Z[tt][2], Z[tt][3]);
              *(LAS u32x2*)(ot + (16 * tt + r) * 256 + (((2 * wave + (g >> 1)) ^ r) << 4)) = w; } }
        asm volatile("s_waitcnt lgkmcnt(0)" ::: "memory"); __builtin_amdgcn_s_barrier(); asm volatile("" ::: "memory");
        vc0 = vn0; vc1 = vn1;
        { const unsigned t_ = bo0; bo0 = bo1; bo1 = bo2; bo2 = t_; }
    }
    SC_OSTORE(nch - 1);
#undef SC_OSTORE
#undef SC_DMA
    asm volatile("s_waitcnt vmcnt(0)" ::: "memory"); __syncthreads();
    float* SO = P.out + OUT_GLAP + ((size_t)bh * 256 + 128 * dh + 4 * g) * 512 + eq * 128 + 16 * wave + r;
#pragma unroll
    for (int i = 0; i < 8; ++i) { float* so = SO + (size_t)i * 16 * 512; asm volatile("" : "+v"(so));
        so[0] = S[i][0]; so[512] = S[i][1]; so[1024] = S[i][2]; so[1536] = S[i][3]; }
}

__device__ __forceinline__ void gla_sample_unit(const Ptrs& P, LAS unsigned char* lds, int u, int tid, int wave, int lane) {
    const int h = u & 3, b = u >> 2;
    LAS float* GL = (LAS float*)lds;
    LAS float* QD = (LAS float*)(lds + 1024);
    LAS float* KD = (LAS float*)(lds + 1024 + 8192);
    LAS float* GD = (LAS float*)(lds + 1024 + 16384);
    LAS float* PR = (LAS float*)(lds + 18432);
    LAS float* RED = (LAS float*)(lds + 18688);
    LAS float* VL = (LAS float*)(lds + 20480);
    LAS float* OP = (LAS float*)(lds + 36864);
    const int row0 = MPR + b * 8;
    const bf16* QK = (const bf16*)(P.ws + WS_QK); const bf16* VT = (const bf16*)(P.ws + WS_VT); const float* GLOW = (const float*)(P.ws + WS_GLOW);
    const int eq = tid & 127, dq = tid >> 7;
    const size_t sbase = ((size_t)(b * 4 + h) * 256 + 64 * dq) * 512 + 4 * eq;
    const float* S0p = P.state + sbase; float* S1p = P.out + OUT_GLAS + sbase;
    if (tid < 32) ((LAS f32x4*)GL)[tid] = ((const f32x4*)(GLOW + (size_t)row0 * 16))[tid];
    { const v4u vv = *(const GAS v4u*)(VT + (size_t)(h * 512 + tid) * MT + row0);
      VL[0 * 512 + tid] = __uint_as_float(vv.x << 16); VL[1 * 512 + tid] = __uint_as_float(vv.x & 0xffff0000u); VL[2 * 512 + tid] = __uint_as_float(vv.y << 16); VL[3 * 512 + tid] = __uint_as_float(vv.y & 0xffff0000u);
      VL[4 * 512 + tid] = __uint_as_float(vv.z << 16); VL[5 * 512 + tid] = __uint_as_float(vv.z & 0xffff0000u); VL[6 * 512 + tid] = __uint_as_float(vv.w << 16); VL[7 * 512 + tid] = __uint_as_float(vv.w & 0xffff0000u); }
    __syncthreads();
    if (tid < 256) {
        const int d = tid;
        float wg[16];
#pragma unroll
        for (int r = 0; r < 16; ++r) wg[r] = P.w_gate_up[r * 1024 + h * 256 + d];
        const float bias = P.b_gate[h * 256 + d];
        float bc[8], q[8], k[8]; float run = 0.f;
#pragma unroll
        for (int t = 0; t < 8; ++t) { q[t] = bf2f(QK[(size_t)(row0 + t) * DM + h * 256 + d]); k[t] = bf2f(QK[(size_t)(row0 + t) * DM + 1024 + h * 256 + d]); }
#pragma unroll
        for (int t = 0; t < 8; ++t) { const LAS f32x4* gr = (const LAS f32x4*)(GL + t * 16); const f32x4 g0 = gr[0], g1 = gr[1], g2 = gr[2], g3 = gr[3];
            float z = bias + g0.x * wg[0] + g0.y * wg[1] + g0.z * wg[2] + g0.w * wg[3] + g1.x * wg[4] + g1.y * wg[5] + g1.z * wg[6] + g1.w * wg[7]
                           + g2.x * wg[8] + g2.y * wg[9] + g2.z * wg[10] + g2.w * wg[11] + g3.x * wg[12] + g3.y * wg[13] + g3.z * wg[14] + g3.w * wg[15];
            const float ls = fminf(z, 0.f) - __logf(1.0f + __expf(-fabsf(z)));
            run += ls * 0.0625f; bc[t] = run; }
        const float blast = bc[7];
#pragma unroll
        for (int t = 0; t < 8; ++t) { QD[d * 8 + t] = q[t] * __expf(bc[t]); KD[d * 8 + t] = k[t] * __expf(blast - bc[t]); }
        GD[d] = __expf(blast);
        int idx = 0;
#pragma unroll
        for (int t = 0; t < 8; ++t)
#pragma unroll
            for (int s = 0; s <= t; ++s) { float v = q[t] * k[s] * __expf(bc[t] - bc[s]); v = wave_sum(v); if (lane == 0) RED[wave * 36 + idx] = v; ++idx; }
    }
    __syncthreads();
    if (tid < 64) { const int t = tid >> 3, s = tid & 7; float v = 0.f; if (s <= t) { const int idx = t * (t + 1) / 2 + s; v = RED[idx] + RED[36 + idx] + RED[72 + idx] + RED[108 + idx]; } PR[t * 8 + s] = v; }
    { f32x4 sa[4], sb[4];
#pragma unroll
      for (int i = 0; i < 4; ++i) sa[i] = *(const GAS f32x4*)(S0p + (size_t)i * 512);
      f32x4 v[8], o[8];
#pragma unroll
      for (int s = 0; s < 8; ++s) v[s] = *(const LAS f32x4*)(VL + s * 512 + 4 * eq);
#pragma unroll
      for (int t = 0; t < 8; ++t) o[t] = (f32x4){0.f, 0.f, 0.f, 0.f};
#define GS_STEP(cur, nxt, d0, more) do { if (more) { _Pragma("unroll") for (int i = 0; i < 4; ++i) nxt[i] = *(const GAS f32x4*)(S0p + (size_t)((d0) + 4 + i) * 512); } \
        _Pragma("unroll") for (int i = 0; i < 4; ++i) { const int dd = 64 * dq + (d0) + i; \
          const f32x4 qa = *(const LAS f32x4*)(QD + dd * 8), qb = *(const LAS f32x4*)(QD + dd * 8 + 4), ka = *(const LAS f32x4*)(KD + dd * 8), kb = *(const LAS f32x4*)(KD + dd * 8 + 4); \
          const float gm = GD[dd]; const f32x4 x = cur[i]; \
          o[0] += x * qa.x; o[1] += x * qa.y; o[2] += x * qa.z; o[3] += x * qa.w; o[4] += x * qb.x; o[5] += x * qb.y; o[6] += x * qb.z; o[7] += x * qb.w; \
          f32x4 sn = x * gm; sn += v[0] * ka.x; sn += v[1] * ka.y; sn += v[2] * ka.z; sn += v[3] * ka.w; sn += v[4] * kb.x; sn += v[5] * kb.y; sn += v[6] * kb.z; sn += v[7] * kb.w; \
          *(GAS f32x4*)(S1p + (size_t)((d0) + i) * 512) = sn; } } while (0)
#pragma unroll 1
      for (int d0 = 0; d0 < 64; d0 += 8) { GS_STEP(sa, sb, d0, true); GS_STEP(sb, sa, d0 + 4, d0 + 8 < 64); }
#undef GS_STEP
#pragma unroll
      for (int t = 0; t < 8; ++t) *(LAS f32x4*)(OP + (dq * 8 + t) * 512 + 4 * eq) = o[t];
    }
    __syncthreads();
    { const int t = tid >> 6, el = tid & 63; bf16* A2 = (bf16*)(P.ws + WS_BUFA); const bf16* SR = (const bf16*)(P.ws + WS_SR);
      float ov[8]; float ss = 0.f;
#pragma unroll
      for (int j = 0; j < 8; ++j) { const int e = el + 64 * j; float acc = (OP[(0 * 8 + t) * 512 + e] + OP[(1 * 8 + t) * 512 + e]) + (OP[(2 * 8 + t) * 512 + e] + OP[(3 * 8 + t) * 512 + e]);
#pragma unroll
          for (int s = 0; s < 8; ++s) acc += PR[t * 8 + s] * VL[s * 512 + e];
          ov[j] = acc; ss += acc * acc; }
      const float rs = 1.0f / sqrtf(wave_sum(ss) * (1.f / 512.f) + RMS_EPS);
#pragma unroll
      for (int j = 0; j < 8; ++j) { const size_t off = (size_t)(row0 + t) * DM + h * 512 + el + 64 * j; A2[off] = (bf16)(cvtpk2(ov[j] * rs * bf2f(SR[off]), 0.f) & 0xffffu); } }
    __syncthreads();
}

__device__ __forceinline__ void gate_rows(const Ptrs& P, int lane, int m0, int step, int mend) {
    bf16* O0 = (bf16*)(P.ws + WS_BUFA); const bf16* O1 = (const bf16*)(P.ws + WS_QK); const bf16* SR = (const bf16*)(P.ws + WS_SR);
    v4u a0[4], b0[4], s0[4], a1[4], b1[4], s1[4];
#define GR_LD(a, bq, s, m) do { _Pragma("unroll") for (int j = 0; j < 4; ++j) { const size_t off_ = (size_t)(m) * DM + 512 * j + 8 * lane; a[j] = *(const GAS v4u*)(O0 + off_); bq[j] = *(const GAS v4u*)(O1 + off_); s[j] = *(const GAS v4u*)(SR + off_); } } while (0)
#define GR_DO(a, bq, s, m) do { _Pragma("unroll") for (int j = 0; j < 4; ++j) { const size_t off_ = (size_t)(m) * DM + 512 * j + 8 * lane; float o[8]; \
        o[0] = __uint_as_float(a[j].x << 16) + __uint_as_float(bq[j].x << 16); o[1] = __uint_as_float(a[j].x & 0xffff0000u) + __uint_as_float(bq[j].x & 0xffff0000u); \
        o[2] = __uint_as_float(a[j].y << 16) + __uint_as_float(bq[j].y << 16); o[3] = __uint_as_float(a[j].y & 0xffff0000u) + __uint_as_float(bq[j].y & 0xffff0000u); \
        o[4] = __uint_as_float(a[j].z << 16) + __uint_as_float(bq[j].z << 16); o[5] = __uint_as_float(a[j].z & 0xffff0000u) + __uint_as_float(bq[j].z & 0xffff0000u); \
        o[6] = __uint_as_float(a[j].w << 16) + __uint_as_float(bq[j].w << 16); o[7] = __uint_as_float(a[j].w & 0xffff0000u) + __uint_as_float(bq[j].w & 0xffff0000u); \
        const float ss_ = ((o[0] * o[0] + o[1] * o[1]) + (o[2] * o[2] + o[3] * o[3])) + ((o[4] * o[4] + o[5] * o[5]) + (o[6] * o[6] + o[7] * o[7])); \
        const float rs_ = 1.0f / sqrtf(wave_sum(ss_) * (1.f / 512.f) + RMS_EPS); v4u w; \
        w.x = cvtpk2(o[0] * rs_ * __uint_as_float(s[j].x << 16), o[1] * rs_ * __uint_as_float(s[j].x & 0xffff0000u)); w.y = cvtpk2(o[2] * rs_ * __uint_as_float(s[j].y << 16), o[3] * rs_ * __uint_as_float(s[j].y & 0xffff0000u)); \
        w.z = cvtpk2(o[4] * rs_ * __uint_as_float(s[j].z << 16), o[5] * rs_ * __uint_as_float(s[j].z & 0xffff0000u)); w.w = cvtpk2(o[6] * rs_ * __uint_as_float(s[j].w << 16), o[7] * rs_ * __uint_as_float(s[j].w & 0xffff0000u)); \
        *(GAS v4u*)(O0 + off_) = w; } } while (0)
    if (m0 < mend) GR_LD(a0, b0, s0, m0);
#pragma unroll 1
    for (int m = m0; m < mend; m += 2 * step) {
        if (m + step < mend) GR_LD(a1, b1, s1, m + step);
        GR_DO(a0, b0, s0, m);
        if (m + step < mend) { if (m + 2 * step < mend) GR_LD(a0, b0, s0, m + 2 * step); GR_DO(a1, b1, s1, m + step); }
    }
#undef GR_LD
#undef GR_DO
}
__device__ __forceinline__ void final_rows(float* base, const float* gfin, int lane, int m0, int step, int mend) {
    const GAS f32x4* gr = (const GAS f32x4*)gfin + lane;
    f32x4 va[8], vb[8];
    if (m0 < mend) { const GAS f32x4* xr = (const GAS f32x4*)(base + (size_t)m0 * DM) + lane;
#pragma unroll
        for (int j = 0; j < 8; ++j) va[j] = xr[64 * j]; }
#define FR_STEP(cur, nxt, m) do { const int mn_ = (m) + step; if (mn_ < mend) { const GAS f32x4* xn_ = (const GAS f32x4*)(base + (size_t)mn_ * DM) + lane; _Pragma("unroll") for (int j = 0; j < 8; ++j) nxt[j] = xn_[64 * j]; } \
        float s_ = 0.f; _Pragma("unroll") for (int j = 0; j < 8; ++j) s_ += (cur[j].x * cur[j].x + cur[j].y * cur[j].y) + (cur[j].z * cur[j].z + cur[j].w * cur[j].w); \
        const float rstd_ = 1.0f / sqrtf(wave_sum(s_) * (1.f / DM) + RMS_EPS); GAS f32x4* dr_ = (GAS f32x4*)(base + (size_t)(m) * DM) + lane; \
        _Pragma("unroll") for (int j = 0; j < 8; ++j) dr_[64 * j] = cur[j] * rstd_ * gr[64 * j]; } while (0)
#pragma unroll 1
    for (int m = m0; m < mend; m += 2 * step) { FR_STEP(va, vb, m); if (m + step < mend) FR_STEP(vb, va, m + step); }
#undef FR_STEP
}
__device__ __forceinline__ void final_row(float* hrow, const float* gfin, int lane, float* drow) {
    GAS f32x4* xr = (GAS f32x4*)hrow + lane; GAS f32x4* dr = (GAS f32x4*)drow + lane; const GAS f32x4* gr = (const GAS f32x4*)gfin + lane;
    f32x4 v[8]; float s = 0.f;
#pragma unroll
    for (int j = 0; j < 8; ++j) { v[j] = xr[64 * j]; s += (v[j].x * v[j].x + v[j].y * v[j].y) + (v[j].z * v[j].z + v[j].w * v[j].w); }
    const float rstd = 1.0f / sqrtf(wave_sum(s) * (1.f / DM) + RMS_EPS);
#pragma unroll
    for (int j = 0; j < 8; ++j) dr[64 * j] = v[j] * rstd * gr[64 * j];
}

__device__ __forceinline__ void attn_subblock(const LAS bf16* KI, const LAS bf16* VI, int ts, const bf16x8 q0, const bf16x8 q1, int qpos, int kpos0, float slope2, float sink2,
                                              const u32x2 (&zz)[4], bf16* orow, bool store, int lane) {
    const int r = lane & 15, g = lane >> 4;
    f32x4 sc[10]; float mx = -INFINITY;
    const int D = qpos - (kpos0 + 16 * ts + 4 * g); const unsigned U = (unsigned)(qpos < 128 ? qpos : 128);
    const float c0 = -slope2 * (float)D; const f32x4 cinit = {c0, c0, c0, c0};
    { bf16x8 ka[10], kb[10];
      const LAS bf16* kr0 = KI + (16 * ts + r) * 80 + 8 * g;
#pragma unroll
      for (int i = 0; i < 5; ++i) { ka[2 * i] = *(const LAS bf16x8*)(kr0 + i * 1280); ka[2 * i + 1] = *(const LAS bf16x8*)(kr0 + i * 1280 + 32); }
      __builtin_amdgcn_sched_barrier(0);
#pragma unroll
      for (int i = 0; i < 5; ++i) { kb[2 * i] = *(const LAS bf16x8*)(kr0 + (5 + i) * 1280); kb[2 * i + 1] = *(const LAS bf16x8*)(kr0 + (5 + i) * 1280 + 32); }
#pragma unroll
      for (int i = 0; i < 5; ++i) { f32x4 a = MFMA16(ka[2 * i], q0, cinit); sc[i] = MFMA16(ka[2 * i + 1], q1, a); }
      __builtin_amdgcn_sched_barrier(0);
#pragma unroll
      for (int i = 0; i < 5; ++i) { f32x4 a = MFMA16(kb[2 * i], q0, cinit); sc[5 + i] = MFMA16(kb[2 * i + 1], q1, a); } }
#pragma unroll
    for (int i = 0; i < 10; ++i) {
#pragma unroll
        for (int e = 0; e < 4; ++e) { const unsigned dist = (unsigned)(D - (16 * i + e));
            const float v = dist <= U ? __builtin_fmaf(slope2, (float)(16 * i + e), sc[i][e]) : -INFINITY; sc[i][e] = v; mx = fmaxf(mx, v); } }
    mx = fmaxf(mx, __shfl_xor(mx, 16)); mx = fmaxf(mx, __shfl_xor(mx, 32)); mx = fmaxf(mx, sink2);
    float l = 0.f;
#pragma unroll
    for (int i = 0; i < 10; ++i)
#pragma unroll
        for (int e = 0; e < 4; ++e) { const float p = __builtin_amdgcn_exp2f(sc[i][e] - mx); sc[i][e] = p; l += p; }
    l += __shfl_xor(l, 16); l += __shfl_xor(l, 32);
    const float inv = 1.0f / (l + __builtin_amdgcn_exp2f(sink2 - mx));
    f32x4 o[4];
#pragma unroll
    for (int dt = 0; dt < 4; ++dt) o[dt] = (f32x4){0.f, 0.f, 0.f, 0.f};
    { const LAS bf16* vr0 = VI + r * 264 + 16 * ts + 4 * g;
#define AT_VRD(dst, ks) do { _Pragma("unroll") for (int dt = 0; dt < 4; ++dt) { const LAS bf16* vr = vr0 + dt * 4224 + (ks) * 32; \
          const u32x2 lo = *(const LAS u32x2*)vr, hi = *(const LAS u32x2*)(vr + 16); dst[dt].x = lo.x; dst[dt].y = lo.y; dst[dt].z = hi.x; dst[dt].w = hi.y; } } while (0)
#define AT_PV(src, ks) do { v4u pp; pp.x = cvtpk2(sc[2 * (ks)][0], sc[2 * (ks)][1]); pp.y = cvtpk2(sc[2 * (ks)][2], sc[2 * (ks)][3]); pp.z = cvtpk2(sc[2 * (ks) + 1][0], sc[2 * (ks) + 1][1]); pp.w = cvtpk2(sc[2 * (ks) + 1][2], sc[2 * (ks) + 1][3]); \
          const bf16x8 pb = __builtin_bit_cast(bf16x8, pp); _Pragma("unroll") for (int dt = 0; dt < 4; ++dt) o[dt] = MFMA16(__builtin_bit_cast(bf16x8, src[dt]), pb, o[dt]); } while (0)
      v4u va[4], vb[4];
      AT_VRD(va, 0); AT_VRD(vb, 1);
      __builtin_amdgcn_sched_barrier(0);
      AT_PV(va, 0); AT_VRD(va, 2);
      __builtin_amdgcn_sched_barrier(0);
      AT_PV(vb, 1); AT_VRD(vb, 3);
      __builtin_amdgcn_sched_barrier(0);
      AT_PV(va, 2); AT_VRD(va, 4);
      __builtin_amdgcn_sched_barrier(0);
      AT_PV(vb, 3);
      __builtin_amdgcn_sched_barrier(0);
      AT_PV(va, 4);
#undef AT_VRD
#undef AT_PV
    }
    if (store) {
#pragma unroll
        for (int dt = 0; dt < 4; ++dt) {
            u32x2 w; w.x = cvtpk2(o[dt][0] * inv * __uint_as_float(zz[dt].x << 16), o[dt][1] * inv * __uint_as_float(zz[dt].x & 0xffff0000u));
            w.y = cvtpk2(o[dt][2] * inv * __uint_as_float(zz[dt].y << 16), o[dt][3] * inv * __uint_as_float(zz[dt].y & 0xffff0000u));
            *(GAS u32x2*)(orow + 16 * dt + 4 * g) = w; }
    }
}
__device__ __forceinline__ void attn_prompt_unit(const Ptrs& P, LAS unsigned char* lds, int u, int tid, int wave, int lane) {
    const int kvh = u & 3, qb = (u >> 2) & 15, b = u >> 6;
    LAS bf16* KI = (LAS bf16*)lds;
    LAS bf16* VI = (LAS bf16*)(lds + 40960);
    const bf16* KB = (const bf16*)(P.ws + WS_KB); const bf16* VT2 = (const bf16*)(P.ws + WS_VT2); const bf16* QZ = (const bf16*)(P.ws + WS_QZ); bf16* A3 = (bf16*)(P.ws + WS_BUFA);
    const int kpos0 = (qb - 1) * 128;
    for (int i = tid; i < 2048; i += NWAVES * 64) { const int j = i >> 3, ch = i & 7; const int kpos = kpos0 + j;
        v4u v = {0u, 0u, 0u, 0u}; if (kpos >= 0) v = *(const GAS v4u*)(KB + (size_t)(b * 2048 + kpos) * 256 + kvh * 64 + ch * 8);
        *(LAS v4u*)(KI + j * 80 + ch * 8) = v; }
    for (int i = tid; i < 2048; i += NWAVES * 64) { const int d = i >> 5, ch = i & 31; const int kpos = kpos0 + ch * 8;
        v4u v = {0u, 0u, 0u, 0u}; if (kpos >= 0) v = *(const GAS v4u*)(VT2 + (size_t)(kvh * 64 + d) * MT + b * 2048 + kpos);
        *(LAS v4u*)(VI + d * 264 + ch * 8) = v; }
    __syncthreads();
    const int hh = kvh * 8 + wave;
    const float slope2 = __builtin_amdgcn_exp2f(-0.25f * (float)(hh + 1)) * LOG2E, sink2 = P.sinks[hh] * LOG2E;
    { const int g = lane >> 4; const bf16* qz0 = QZ + ((size_t)b * 2048 + qb * 128 + (lane & 15)) * 4096 + hh * 64;
      bf16x8 qc0 = *(const bf16x8*)(qz0 + 8 * g), qc1 = *(const bf16x8*)(qz0 + 32 + 8 * g);
#pragma unroll 1
      for (int qs = 0; qs < 8; ++qs) { const int qpos = qb * 128 + 16 * qs + (lane & 15); const size_t row = (size_t)b * 2048 + qpos;
          const bf16* qzr = qz0 + (size_t)qs * 16 * 4096;
          u32x2 zz[4];
#pragma unroll
          for (int dt = 0; dt < 4; ++dt) zz[dt] = *(const GAS u32x2*)(qzr + 2048 + 16 * dt + 4 * g);
          const bf16* qzn = qzr + (qs < 7 ? 16 * 4096 : 0);
          const bf16x8 qn0 = *(const bf16x8*)(qzn + 8 * g), qn1 = *(const bf16x8*)(qzn + 32 + 8 * g);
          attn_subblock(KI, VI, qs < 6 ? qs : 6, qc0, qc1, qpos, kpos0, slope2, sink2, zz, A3 + row * DM + hh * 64, true, lane);
          qc0 = qn0; qc1 = qn1; } }
    __syncthreads();
}
__device__ __forceinline__ void attn_sample_unit(const Ptrs& P, LAS unsigned char* lds, int u, int tid, int wave, int lane) {
    const int kvh = u & 3, b = u >> 2;
    LAS bf16* KI = (LAS bf16*)lds;
    LAS bf16* VI = (LAS bf16*)(lds + 40960);
    const bf16* KB = (const bf16*)(P.ws + WS_KB); const bf16* VT2 = (const bf16*)(P.ws + WS_VT2); const bf16* QZ = (const bf16*)(P.ws + WS_QZ); bf16* A3 = (bf16*)(P.ws + WS_BUFA);
    for (int i = tid; i < 160 * 64; i += NWAVES * 64) { const int j = i >> 6, d = i & 63; float kv = 0.f, vv = 0.f;
        if (j < 128) { kv = P.ck[((size_t)(b * 128 + j) * 4 + kvh) * 64 + d]; vv = P.cv[((size_t)(b * 128 + j) * 4 + kvh) * 64 + d]; }
        else if (j < 136) { kv = bf2f(KB[(size_t)(MPR + b * 8 + j - 128) * 256 + kvh * 64 + d]); vv = bf2f(VT2[(size_t)(kvh * 64 + d) * MT + MPR + b * 8 + j - 128]); }
        KI[j * 80 + d] = (bf16)(cvtpk2(kv, 0.f) & 0xffffu); VI[d * 264 + j] = (bf16)(cvtpk2(vv, 0.f) & 0xffffu); }
    __syncthreads();
    const int hh = kvh * 8 + wave;
    const float slope2 = __builtin_amdgcn_exp2f(-0.25f * (float)(hh + 1)) * LOG2E, sink2 = P.sinks[hh] * LOG2E;
    const int n = lane & 15, qi = n < 8 ? n : 7; const size_t row = (size_t)MPR + b * 8 + qi;
    { const int g = lane >> 4; const bf16* qzr = QZ + row * 4096 + hh * 64; u32x2 zz[4];
#pragma unroll
      for (int dt = 0; dt < 4; ++dt) zz[dt] = *(const GAS u32x2*)(qzr + 2048 + 16 * dt + 4 * g);
      attn_subblock(KI, VI, 0, *(const bf16x8*)(qzr + 8 * g), *(const bf16x8*)(qzr + 32 + 8 * g), 128 + qi, 0, slope2, sink2, zz, A3 + row * DM + hh * 64, n < 8, lane); }
    __syncthreads();
}
constexpr int SG_A = 0, SG_B = 10240, SG_STAGE = 30720, SG_RS = 2 * SG_STAGE;
template <bool NAT>
__device__ __forceinline__ void sgemm_core(LAS unsigned char* lds, const bf16* A, const bf16* B, f32x4 (&acc)[2][2], int tid, int wave, int lane) {
    const int wm = wave >> 2, wn = wave & 3, r = lane & 15, g = lane >> 4, lr = tid >> 3, ch = tid & 7;
    const GAS v4u* ga = (const GAS v4u*)(A + (size_t)lr * 2048 + ch * 8); const GAS v4u* gb0 = (const GAS v4u*)(B + (size_t)lr * 2048 + ch * 8); const GAS v4u* gb1 = (const GAS v4u*)(B + (size_t)(64 + lr) * 2048 + ch * 8);
    v4u ra0, rb0, rc0, ra1, rb1, rc1;
#pragma unroll
    for (int i = 0; i < 2; ++i)
#pragma unroll
        for (int j = 0; j < 2; ++j) acc[i][j] = (f32x4){0.f, 0.f, 0.f, 0.f};
#define SG_LD(s, kt) do { ra##s = ga[(kt) * 8]; rb##s = gb0[(kt) * 8]; rc##s = gb1[(kt) * 8]; } while (0)
#define SG_ST(s, stg) do { *(LAS v4u*)(lds + (stg) * SG_STAGE + SG_A + lr * 160 + ch * 16) = ra##s; *(LAS v4u*)(lds + (stg) * SG_STAGE + SG_B + lr * 160 + ch * 16) = rb##s; \
                           *(LAS v4u*)(lds + (stg) * SG_STAGE + SG_B + (64 + lr) * 160 + ch * 16) = rc##s; } while (0)
#define SG_COMPUTE(stg) do { _Pragma("unroll") for (int kk = 0; kk < 2; ++kk) { bf16x8 af[2], bfr[2]; \
        _Pragma("unroll") for (int i = 0; i < 2; ++i) af[i] = *(const LAS bf16x8*)(lds + (stg) * SG_STAGE + SG_A + (32 * wm + 16 * i + r) * 160 + (32 * kk + 8 * g) * 2); \
        _Pragma("unroll") for (int j = 0; j < 2; ++j) bfr[j] = *(const LAS bf16x8*)(lds + (stg) * SG_STAGE + SG_B + (32 * wn + 16 * j + r) * 160 + (32 * kk + 8 * g) * 2); \
        _Pragma("unroll") for (int i = 0; i < 2; ++i) _Pragma("unroll") for (int j = 0; j < 2; ++j) acc[i][j] = NAT ? MFMA16(af[i], bfr[j], acc[i][j]) : MFMA16(bfr[j], af[i], acc[i][j]); } } while (0)
    SG_LD(0, 0); SG_LD(1, 1); SG_ST(0, 0); SG_LD(0, 2);
    __syncthreads();
#pragma unroll 1
    for (int kt = 0; kt < 32; kt += 2) {
        SG_COMPUTE(0); SG_ST(1, 1); if (kt + 3 < 32) SG_LD(1, kt + 3);
        __syncthreads();
        SG_COMPUTE(1); if (kt + 2 < 32) SG_ST(0, 0); if (kt + 4 < 32) SG_LD(0, kt + 4);
        __syncthreads();
    }
#undef SG_LD
#undef SG_ST
#undef SG_COMPUTE
}
template <bool SILU>
__device__ __forceinline__ void sg_store_bf16(const f32x4 (&acc)[2][2], bf16* dst, int ld, int wave, int lane, float rs0, float rs1) {
    const int wm = wave >> 2, wn = wave & 3, r = lane & 15, g = lane >> 4;
#pragma unroll
    for (int i = 0; i < 2; ++i)
#pragma unroll
        for (int j = 0; j < 2; ++j) { f32x4 v = acc[i][j] * (i ? rs1 : rs0);
            if (SILU) { v[0] = pg8::silu_f(v[0]); v[1] = pg8::silu_f(v[1]); v[2] = pg8::silu_f(v[2]); v[3] = pg8::silu_f(v[3]); }
            u32x2 w; w.x = cvtpk2(v[0], v[1]); w.y = cvtpk2(v[2], v[3]);
            *(GAS u32x2*)(dst + (size_t)(32 * wm + 16 * i + r) * ld + 32 * wn + 16 * j + 4 * g) = w; }
}
__device__ __forceinline__ void s_in_a_block(const Ptrs& P, LAS unsigned char* lds, int rb, int nbk, int tid, int wave, int lane) {
    const bf16* A = (const bf16*)(P.ws + WS_BUFA) + (size_t)(MPR + 64 * rb) * DM; const bf16* B = (const bf16*)(P.ws + WS_WINA) + (size_t)(128 * nbk) * DM;
    f32x4 acc[2][2];
    if (nbk >= 16 && nbk < 32) {
        sgemm_core<true>(lds, A, B, acc, tid, wave, lane);
        const int wm = wave >> 2, wn = wave & 3, r = lane & 15, g = lane >> 4; bf16* VT = (bf16*)(P.ws + WS_VT);
#pragma unroll
        for (int i = 0; i < 2; ++i)
#pragma unroll
            for (int j = 0; j < 2; ++j) { u32x2 w; w.x = cvtpk2(acc[i][j][0], acc[i][j][1]); w.y = cvtpk2(acc[i][j][2], acc[i][j][3]);
                *(GAS u32x2*)(VT + (size_t)((nbk - 16) * 128 + 32 * wn + 16 * j + r) * MT + MPR + 64 * rb + 32 * wm + 16 * i + 4 * g) = w; }
    } else {
        sgemm_core<false>(lds, A, B, acc, tid, wave, lane);
        if (nbk < 16) sg_store_bf16<false>(acc, (bf16*)(P.ws + WS_QK) + (size_t)(MPR + 64 * rb) * DM + nbk * 128, DM, wave, lane, 1.f, 1.f);
        else sg_store_bf16<true>(acc, (bf16*)(P.ws + WS_SR) + (size_t)(MPR + 64 * rb) * DM + (nbk - 32) * 128, DM, wave, lane, 1.f, 1.f);
    }
}
template <bool WITH_B16>
__device__ __forceinline__ void s_out_block(const Ptrs& P, LAS unsigned char* lds, const bf16* Abase, const bf16* Wt, const float* res, int rb, int nb, int tid, int wave, int lane) {
    f32x4 acc[2][2];
    sgemm_core<false>(lds, Abase + (size_t)(64 * rb) * DM, Wt + (size_t)(128 * nb) * DM, acc, tid, wave, lane);
    const int wm = wave >> 2, wn = wave & 3, r = lane & 15, g = lane >> 4;
    float* out = P.out + OUT_Y + (size_t)MPR * DM; bf16* H1b = (bf16*)(P.ws + WS_SR) + (size_t)MPR * DM; float* SSQ2 = (float*)(P.ws + WS_SSQP);
#pragma unroll
    for (int i = 0; i < 2; ++i) { const int row = 64 * rb + 32 * wm + 16 * i + r; float ss = 0.f;
#pragma unroll
        for (int j = 0; j < 2; ++j) { const size_t off = (size_t)row * DM + 128 * nb + 32 * wn + 16 * j + 4 * g;
            const f32x4 v = *(const GAS f32x4*)(res + off) + acc[i][j]; *(GAS f32x4*)(out + off) = v;
            if (WITH_B16) { u32x2 w; w.x = cvtpk2(v[0], v[1]); w.y = cvtpk2(v[2], v[3]); *(GAS u32x2*)(H1b + off) = w; ss += (v[0] * v[0] + v[1] * v[1]) + (v[2] * v[2] + v[3] * v[3]); } }
        if (WITH_B16) { ss += __shfl_xor(ss, 16); ss += __shfl_xor(ss, 32); if (g == 0) SSQ2[(size_t)row * 64 + nb * 4 + wn] = ss; } }
}
__device__ __forceinline__ void s_in_b_block(const Ptrs& P, LAS unsigned char* lds, int rb, int nbk, int tid, int wave, int lane) {
    const bf16* A = (const bf16*)(P.ws + WS_SR) + (size_t)(MPR + 64 * rb) * DM; const bf16* B = (const bf16*)(P.ws + WS_WINB) + (size_t)(128 * nbk) * DM;
    LAS float* RS = (LAS float*)(lds + SG_RS);
    { const int row = tid >> 3, part = tid & 7; const float* sp = (const float*)(P.ws + WS_SSQP) + (size_t)(64 * rb + row) * 64 + part * 8;
      const f32x4 a = *(const GAS f32x4*)sp, b = *(const GAS f32x4*)(sp + 4); float s = (a[0] + a[1]) + (a[2] + a[3]) + (b[0] + b[1]) + (b[2] + b[3]);
      s += __shfl_xor(s, 1); s += __shfl_xor(s, 2); s += __shfl_xor(s, 4);
      if (part == 0) RS[row] = 1.0f / sqrtf(s * (1.f / DM) + RMS_EPS); }
    f32x4 acc[2][2];
    const int wm = wave >> 2, wn = wave & 3, r = lane & 15, g = lane >> 4;
    if (nbk >= 34) {
        sgemm_core<true>(lds, A, B, acc, tid, wave, lane);
        bf16* VT2 = (bf16*)(P.ws + WS_VT2); float* vws = P.out + OUT_VWS;
#pragma unroll
        for (int i = 0; i < 2; ++i) { const f32x4 rs = *(const LAS f32x4*)(RS + 32 * wm + 16 * i + 4 * g);
#pragma unroll
            for (int j = 0; j < 2; ++j) { const f32x4 v = acc[i][j] * rs; const int col = (nbk - 34) * 128 + 32 * wn + 16 * j + r; const int srow = 64 * rb + 32 * wm + 16 * i + 4 * g;
                u32x2 w; w.x = cvtpk2(v[0], v[1]); w.y = cvtpk2(v[2], v[3]);
                *(GAS u32x2*)(VT2 + (size_t)col * MT + MPR + srow) = w;
#pragma unroll
                for (int e = 0; e < 4; ++e) { const int s = srow + e; vws[((size_t)(s >> 3) * 128 + 120 + (s & 7)) * 256 + col] = v[e]; } } }
    } else {
        sgemm_core<false>(lds, A, B, acc, tid, wave, lane);
        const float rs0 = RS[32 * wm + r], rs1 = RS[32 * wm + 16 + r];
        if (nbk < 16) sg_store_bf16<false>(acc, (bf16*)(P.ws + WS_QZ) + (size_t)(MPR + 64 * rb) * 4096 + nbk * 128, 4096, wave, lane, rs0, rs1);
        else if (nbk < 32) sg_store_bf16<true>(acc, (bf16*)(P.ws + WS_QZ) + (size_t)(MPR + 64 * rb) * 4096 + nbk * 128, 4096, wave, lane, rs0, rs1);
        else { sg_store_bf16<false>(acc, (bf16*)(P.ws + WS_KB) + (size_t)(MPR + 64 * rb) * 256 + (nbk - 32) * 128, 256, wave, lane, rs0, rs1);
            float* kws = P.out + OUT_KWS;
#pragma unroll
            for (int i = 0; i < 2; ++i) { const int s = 64 * rb + 32 * wm + 16 * i + r; float* d = kws + ((size_t)(s >> 3) * 128 + 120 + (s & 7)) * 256 + (nbk - 32) * 128 + 32 * wn + 4 * g;
#pragma unroll
                for (int j = 0; j < 2; ++j) *(GAS f32x4*)(d + 16 * j) = acc[i][j] * (i ? rs1 : rs0); } }
    }
}
#ifndef MK_N_LAUNCHES
#define MK_N_LAUNCHES 1
#endif
#ifndef DUP_PHASE
#define DUP_PHASE -1
#endif
#define REPS(k) for (int rep_ = 0; rep_ < ((DUP_PHASE) == (k) ? 2 : 1); ++rep_)
constexpr int N_PHASES = 11;
constexpr int N_LAUNCHES = MK_N_LAUNCHES;
struct Args { Ptrs p; int ph_lo, ph_hi, sub, pad; };
static_assert(sizeof(Args) == 20 * 8 + 16, "Args has no padding");

__global__ void __launch_bounds__(NWAVES * 64, 2) yoco_fwd(Args args) {
    extern __shared__ __attribute__((aligned(16))) unsigned char lds_raw[];
    LAS unsigned char* lds = (LAS unsigned char*)lds_raw;
    volatile LAS unsigned* MISC = (volatile LAS unsigned*)(lds + MISC_OFF);
    const int tid = threadIdx.x, lane = tid & 63, wave = __builtin_amdgcn_readfirstlane(tid >> 6);
    const int G = gridDim.x, c = blockIdx.x;
    const int vcu = (G % 8 == 0) ? (c % 8) * (G / 8) + c / 8 : c;
    const Ptrs& P = args.p;
    gu32* ctl = (gu32*)(P.ws + WS_CTL);
    for (int u = tid; u < (LDS_BYTES - LDSCTL_OFF) / 4; u += NWAVES * 64) ((LAS unsigned*)(lds + LDSCTL_OFF))[u] = 0u;
    __syncthreads();
    XcdBarrier bar; bar.bar = (unsigned*)(ctl + CW_BAR); bar.x = 0; bar.st = nullptr;
    const int lo = args.ph_lo, hi = args.ph_hi;
    if (hi - lo > 1) bar = xcd_barrier_post((unsigned*)(ctl + CW_BAR), MISC + 8);
#define IN(k) (lo <= (k) && (k) < hi)
#define SEAM(k) do { if (IN(k) && IN((k) + 1)) xcd_barrier(bar); } while (0)
    const int gw = vcu * NWAVES + wave, NGW = G * NWAVES;

    if (IN(0)) { REPS(0) p0_prologue(P, lds, vcu, G, tid, wave, lane); SEAM(0); }

    if (IN(1)) {
        pg8::SchedInA S{G, c, (const char*)(P.ws + WS_BUFA), (const char*)(P.ws + WS_WINA)};
        pg8::EpiInA E{(pg8::bf16_t*)(P.ws + WS_QK), (pg8::bf16_t*)(P.ws + WS_SR), (pg8::bf16_t*)(P.ws + WS_VT), MT};
        const bool early_glow = G == 256 && (c & 8);
        if (early_glow) { const int slot = ((c >> 4) * 8 + (c & 7)) * NWAVES + wave; if (slot < MT / 16) glow_task((const bf16*)(P.ws + WS_BUFA), (const bf16*)(P.ws + WS_WINA) + (size_t)6144 * DM, (float*)(P.ws + WS_GLOW), slot, lane); __syncthreads(); }
        REPS(1) pg8::gemm_phase<pg8::EpiInA, pg8::SchedInA, true, true>(lds, 2048, S, E);
        if (G != 256) for (int task = c * NWAVES + wave; task < MT / 16; task += NGW)
            glow_task((const bf16*)(P.ws + WS_BUFA), (const bf16*)(P.ws + WS_WINA) + (size_t)6144 * DM, (float*)(P.ws + WS_GLOW), task, lane);
        SEAM(1);
    }

    if (IN(2)) {
        REPS(20) for (int blk = c; blk < 192; blk += G) s_in_a_block(P, lds, blk / 48, blk % 48, tid, wave, lane);
        if (G == 256) { REPS(2) for (int j = 0; j < 2; ++j) gla_prep_unit(P, lds, (2 * (c & 7) + j) * 32 + (c >> 3), tid, wave, lane); }
        else for (int u = c; u < 512; u += G) gla_prep_unit(P, lds, u, tid, wave, lane);
        SEAM(2);
    }

    if (IN(3)) {
        if (G >= 256) {
            const int sub = args.sub;
            constexpr int CV_A = 1408;
            if (c < 128) { const int xcd = c & 7, idx = c >> 3; if (sub == 0 || sub == 1) gla_scan_unit(P, lds, xcd * 2 + (idx >> 3), (idx >> 2) & 1, idx & 3, tid, wave, lane);
                if (sub == 0 || sub == 3) convert_weights(P, lds, 1, CV_A + c * NWAVES + wave, 128 * NWAVES, 2176, wave, lane); }
            else { if (sub == 0 || sub == 2) gla_sample_unit(P, lds, c - 128, tid, wave, lane);
                if (sub == 0 || sub == 3) convert_weights(P, lds, 1, (c - 128) * NWAVES + wave, 128 * NWAVES, CV_A, wave, lane); }
        } else {
            for (int u = c; u < 128; u += G) gla_scan_unit(P, lds, u >> 3, (u >> 2) & 1, u & 3, tid, wave, lane);
            for (int t = c; t < 128; t += G) gla_sample_unit(P, lds, t, tid, wave, lane);
        }
        SEAM(3);
    }

    if (IN(4)) {
        const int NS = G >= 128 ? 64 : 0;
        constexpr int GR0 = 8192;
        if (c < NS) { if (args.sub != 1) for (int blk = c; blk < 64; blk += NS) s_out_block<true>(P, lds, (const bf16*)(P.ws + WS_BUFA) + (size_t)MPR * DM, (const bf16*)(P.ws + WS_WOA), P.x_sample, blk >> 4, blk & 15, tid, wave, lane);
            if (args.sub != 2) gate_rows(P, lane, GR0 + c * NWAVES + wave, NS * NWAVES, MPR); }
        else { if (args.sub != 2) gate_rows(P, lane, (c - NS) * NWAVES + wave, (G - NS) * NWAVES, NS ? GR0 : MPR);
            if (NS == 0) { __syncthreads(); for (int blk = c; blk < 64; blk += G) s_out_block<true>(P, lds, (const bf16*)(P.ws + WS_BUFA) + (size_t)MPR * DM, (const bf16*)(P.ws + WS_WOA), P.x_sample, blk >> 4, blk & 15, tid, wave, lane); } }
        SEAM(4);
    }

    if (IN(5)) {
        pg8::SchedOut S{G, c, (const char*)(P.ws + WS_BUFA), (const char*)(P.ws + WS_WOA)};
        pg8::EpiOutA E{P.x_prompt, (pg8::bf16_t*)(P.ws + WS_SR), (float*)(P.ws + WS_SSQ1)};
        pg8::gemm_phase<pg8::EpiOutA, pg8::SchedOut, true, true>(lds, 2048, S, E);
        SEAM(5);
    }

    if (IN(6)) {
        pg8::SchedInB S{G, c, (const char*)(P.ws + WS_SR), (const char*)(P.ws + WS_WINB), (const float*)(P.ws + WS_SSQ1), (LAS float*)(lds + TAB_OFF)};
        pg8::EpiInB E{(pg8::bf16_t*)(P.ws + WS_QZ), (pg8::bf16_t*)(P.ws + WS_KB), (pg8::bf16_t*)(P.ws + WS_VT2), MT, P.out + OUT_KWP, P.out + OUT_VWP, P.out + OUT_KWS, P.out + OUT_VWS, (const LAS float*)(lds + TAB_OFF)};
        pg8::gemm_phase<pg8::EpiInB, pg8::SchedInB, true, true>(lds, 2048, S, E);
        for (int blk = (c + G - (64 % G)) % G; blk < 144; blk += G) s_in_b_block(P, lds, blk / 36, blk % 36, tid, wave, lane);
        SEAM(6);
    }

    if (IN(7)) {
        for (int u = c; u < 256; u += G) attn_prompt_unit(P, lds, u, tid, wave, lane);
        for (int u = c; u < 128; u += G) attn_sample_unit(P, lds, u, tid, wave, lane);
        SEAM(7);
    }

    if (IN(8)) {
        pg8::SchedOut S{G, c, (const char*)(P.ws + WS_BUFA), (const char*)(P.ws + WS_WOB)};
        pg8::EpiOutB E{(const pg8::bf16_t*)(P.ws + WS_SR), P.out + OUT_Y};
        pg8::gemm_phase<pg8::EpiOutB, pg8::SchedOut, true, true>(lds, 2048, S, E);
        SEAM(8);
    }

    if (IN(9)) {
        const int NS = G >= 128 ? 64 : 0;
        constexpr int FR0 = 8192;
        if (c < NS) { for (int blk = c; blk < 64; blk += NS) s_out_block<false>(P, lds, (const bf16*)(P.ws + WS_BUFA) + (size_t)MPR * DM, (const bf16*)(P.ws + WS_WOB), P.out + OUT_Y + (size_t)MPR * DM, blk >> 4, blk & 15, tid, wave, lane);
            final_rows(P.out + OUT_Y, P.g_final, lane, FR0 + c * NWAVES + wave, NS * NWAVES, MPR); }
        else { if (NS == 0) for (int blk = c; blk < 64; blk += G) s_out_block<false>(P, lds, (const bf16*)(P.ws + WS_BUFA) + (size_t)MPR * DM, (const bf16*)(P.ws + WS_WOB), P.out + OUT_Y + (size_t)MPR * DM, blk >> 4, blk & 15, tid, wave, lane);
            final_rows(P.out + OUT_Y, P.g_final, lane, (c - NS) * NWAVES + wave, (G - NS) * NWAVES, NS ? FR0 : MPR); }
        SEAM(9);
    }

    if (IN(10)) { for (int m = MPR + gw; m < MT; m += NGW) final_row(P.out + OUT_Y + (size_t)m * DM, P.g_final, lane, P.out + OUT_Y + (size_t)m * DM); }
#undef IN
#undef SEAM
}

extern "C" void kernel_launch(void* const* d_in, const int* in_sizes, int n_in, void* d_out, int out_size, void* d_ws, size_t ws_size, hipStream_t stream) {
    static int grid = 0;
    if (grid == 0) {
        if (n_in != 18 || (size_t)out_size != OUT_TOTAL || ws_size < WS_END) { fprintf(stderr, "kernel_launch: unexpected shapes (n_in %d, out %d, ws %zu); nothing launched\n", n_in, out_size, ws_size); grid = -1; return; }
        int dev = 0, cus = 0, per_cu = 0;
        if (hipGetDevice(&dev) != hipSuccess || hipDeviceGetAttribute(&cus, hipDeviceAttributeMultiprocessorCount, dev) != hipSuccess) { grid = -1; return; }
        if (hipFuncSetAttribute((const void*)yoco_fwd, hipFuncAttributeMaxDynamicSharedMemorySize, LDS_BYTES) != hipSuccess) { fprintf(stderr, "kernel_launch: hipFuncSetAttribute failed\n"); grid = -1; return; }
        if (hipOccupancyMaxActiveBlocksPerMultiprocessor(&per_cu, (const void*)yoco_fwd, NWAVES * 64, LDS_BYTES) != hipSuccess || per_cu < 1)
            fprintf(stderr, "kernel_launch: note: occupancy query reports %d workgroups per CU\n", per_cu);
        (void)hipGetLastError();
        grid = cus;
    }
    if (grid < 0) return;
    (void)hipMemsetAsync((char*)d_ws + WS_CTL, 0, CTL_ZERO_BYTES, stream);
    Args a{};
    const float** pp = (const float**)&a.p;
    for (int i = 0; i < 18; ++i) pp[i] = (const float*)d_in[i];
    a.p.out = (float*)d_out; a.p.ws = (unsigned char*)d_ws;
#if defined(PROBE_PHASE)
    { a.ph_lo = PROBE_PHASE; a.ph_hi = PROBE_PHASE + 1; a.sub = PROBE_SUB; hipLaunchKernelGGL(yoco_fwd, dim3(grid), dim3(NWAVES * 64), LDS_BYTES, stream, a); }
#endif
    a.sub = 0;
    for (int li = 0; li < N_LAUNCHES; ++li) {
        a.ph_lo = (N_LAUNCHES == 1) ? 0 : li; a.ph_hi = (N_LAUNCHES == 1) ? N_PHASES : li + 1;
        hipLaunchKernelGGL(yoco_fwd, dim3(grid), dim3(NWAVES * 64), LDS_BYTES, stream, a);
    }
}
```

```cpp
#include <hip/hip_runtime.h>
#include <cstdio>
#include <cstdint>
#include <cmath>
namespace pg8 {
#define PG8_LAS __attribute__((address_space(3)))
typedef unsigned short bf16_t;
typedef short bf16x8 __attribute__((ext_vector_type(8)));
typedef float f32x4 __attribute__((ext_vector_type(4)));
typedef unsigned u32x4 __attribute__((ext_vector_type(4)));
constexpr int BM = 256, BK = 64, HALF = 128, HTB = HALF * BK * 2  , STAGE_BYTES = 8 * HTB, NXCD = 8, WGM = 8;

__host__ __device__ __forceinline__ int lds_byte(int r, int c) { const int st = (r >> 4) * 2 + (c >> 5), rr = r & 15, cc = c & 31, ob = rr * 64 + cc * 2; return st * 1024 + (ob ^ (((ob >> 9) & 1) << 5)); }
__host__ __device__ __forceinline__ void stage_rc(int b, int& R, int& C) { const int st = b / 1024, sb = b % 1024, swz = sb ^ (((sb >> 9) & 1) << 5); R = (st >> 1) * 16 + swz / 64; C = (st & 1) * 32 + (swz % 64) / 2; }
__host__ __device__ __forceinline__ int perm32(int rho) { const int n = rho >> 4, i = rho & 15; return 8 * (i >> 2) + 4 * n + (i & 3); }

struct Unit { const char* a; const char* b; int pm, pn, kind, par; };
__device__ __forceinline__ void tile_map(int L, int nM, int nN, int& pm, int& pn) {
    const int nwg = nM * nN; int wgid = L; { const int q = nwg / NXCD, r = nwg % NXCD, xcd = wgid % NXCD, off = wgid / NXCD; wgid = (xcd < r ? xcd * (q + 1) : r * (q + 1) + (xcd - r) * q) + off; }
    const int nig = WGM * nN, gid = wgid / nig, fm = gid * WGM, gsz = (nM - fm) < WGM ? (nM - fm) : WGM;
    pm = fm + ((wgid % nig) % gsz); pn = (wgid % nig) / gsz;
}
typedef float f32x2_t __attribute__((ext_vector_type(2))); typedef __bf16 bf16x2_t __attribute__((ext_vector_type(2)));
__device__ __forceinline__ unsigned cvtpk(float lo, float hi) { f32x2_t v = {lo, hi}; bf16x2_t b = __builtin_convertvector(v, bf16x2_t); return __builtin_bit_cast(unsigned, b); }
__device__ __forceinline__ float silu_f(float v) { return v / (1.0f + __expf(-v)); }

template <bool SILU>
__device__ __forceinline__ void store_tile_bf16(const f32x4 (&acc)[2][2][4][2], bf16_t* base, int ldc, int row_t, int col_t, int wr, int wc, int fr, int fq, const PG8_LAS float* rtab = nullptr) {
    const int row0 = row_t + wr * 64 + fr, col0 = col_t + wc * 32 + 8 * fq;
#pragma unroll
    for (int ai = 0; ai < 2; ++ai)
#pragma unroll
        for (int m = 0; m < 4; ++m) { bf16_t* rowp = base + (size_t)(row0 + ai * HALF + m * 16) * ldc + col0; const float rsc = rtab ? rtab[wr * 64 + fr + ai * HALF + m * 16] : 1.0f;
#pragma unroll
            for (int bj = 0; bj < 2; ++bj) { f32x4 v0 = acc[ai][bj][m][0] * rsc, v1 = acc[ai][bj][m][1] * rsc;
                if (SILU) { v0[0] = silu_f(v0[0]); v0[1] = silu_f(v0[1]); v0[2] = silu_f(v0[2]); v0[3] = silu_f(v0[3]); v1[0] = silu_f(v1[0]); v1[1] = silu_f(v1[1]); v1[2] = silu_f(v1[2]); v1[3] = silu_f(v1[3]); }
                u32x4 w; w.x = cvtpk(v0[0], v0[1]); w.y = cvtpk(v0[2], v0[3]); w.z = cvtpk(v1[0], v1[1]); w.w = cvtpk(v1[2], v1[3]);
                *(u32x4*)(rowp + bj * HALF) = w; } }
}

struct EpiInA {
    static constexpr bool PERM = true, AFTER_DRAIN = false;
    bf16_t* QK; bf16_t* SR; bf16_t* VT; int MT;
    __device__ __forceinline__ void operator()(const f32x4 (&acc)[2][2][4][2], const Unit& u, int wr, int wc, int fr, int fq) const {
        if (u.kind == 0) store_tile_bf16<false>(acc, QK, 2048, u.pm * BM, u.pn * BM, wr, wc, fr, fq);
        else if (u.kind == 1) store_tile_bf16<true>(acc, SR, 2048, u.pm * BM, (u.pn - 8) * BM, wr, wc, fr, fq);
        else store_tile_bf16<false>(acc, VT, MT, u.pm * BM, u.pn * BM, wr, wc, fr, fq);
    }
};

struct EpiInB {
    static constexpr bool PERM = true, AFTER_DRAIN = false;
    bf16_t* QZ; bf16_t* KB; bf16_t* VT2; int MT; float* kwp; float* vwp; float* kws; float* vws; const PG8_LAS float* tab;
    __device__ __forceinline__ static float* win_row(int t, float* wp, float* wsmp) {
        if (t < 8192) { const int pos = t & 2047; if (pos < 1920) return nullptr; return wp + ((size_t)(t >> 11) * 128 + (pos - 1920)) * 256; }
        const int s = t - 8192; return wsmp + ((size_t)(s >> 3) * 128 + 120 + (s & 7)) * 256;
    }
    __device__ __forceinline__ void operator()(const f32x4 (&acc)[2][2][4][2], const Unit& u, int wr, int wc, int fr, int fq) const {
        const PG8_LAS float* T = tab + (u.par << 8);
        if (u.kind == 0) { store_tile_bf16<false>(acc, QZ, 4096, u.pm * BM, u.pn * BM, wr, wc, fr, fq, T); return; }
        if (u.kind == 1) { store_tile_bf16<true>(acc, QZ, 4096, u.pm * BM, u.pn * BM, wr, wc, fr, fq, T); return; }
        if (u.kind == 2) {
            store_tile_bf16<false>(acc, KB, 256, u.pm * BM, 0, wr, wc, fr, fq, T);
            if ((u.pm & 7) == 7) {
                const int row0 = u.pm * BM + wr * 64 + fr, col0 = wc * 32 + 8 * fq;
#pragma unroll
                for (int ai = 0; ai < 2; ++ai)
#pragma unroll
                    for (int m = 0; m < 4; ++m) { float* d = win_row(row0 + ai * HALF + m * 16, kwp, kws); const float rsc = T[wr * 64 + fr + ai * HALF + m * 16];
                        if (d) {
#pragma unroll
                            for (int bj = 0; bj < 2; ++bj) { *(f32x4*)(d + col0 + bj * HALF) = acc[ai][bj][m][0] * rsc; *(f32x4*)(d + col0 + bj * HALF + 4) = acc[ai][bj][m][1] * rsc; } } }
            }
            return;
        }
        const int row0 = wr * 64 + fr, colb = wc * 32 + 8 * fq;
        f32x4 cs[2][2];
#pragma unroll
        for (int bj = 0; bj < 2; ++bj) { cs[bj][0] = *(const PG8_LAS f32x4*)(T + colb + bj * HALF); cs[bj][1] = *(const PG8_LAS f32x4*)(T + colb + bj * HALF + 4); }
#pragma unroll
        for (int ai = 0; ai < 2; ++ai)
#pragma unroll
            for (int m = 0; m < 4; ++m) { bf16_t* rowp = VT2 + (size_t)(row0 + ai * HALF + m * 16) * MT + u.pn * BM + colb;
#pragma unroll
                for (int bj = 0; bj < 2; ++bj) { const f32x4 v0 = acc[ai][bj][m][0] * cs[bj][0], v1 = acc[ai][bj][m][1] * cs[bj][1];
                    u32x4 w; w.x = cvtpk(v0[0], v0[1]); w.y = cvtpk(v0[2], v0[3]); w.z = cvtpk(v1[0], v1[1]); w.w = cvtpk(v1[2], v1[3]);
                    *(u32x4*)(rowp + bj * HALF) = w; } }
        if ((u.pn & 7) == 7) {
            const int col0 = u.pn * BM + colb;
#pragma unroll
            for (int bj = 0; bj < 2; ++bj)
#pragma unroll
                for (int n = 0; n < 2; ++n)
#pragma unroll
                    for (int j = 0; j < 4; ++j) { float* d = win_row(col0 + bj * HALF + 4 * n + j, vwp, vws);
                        if (d) {
#pragma unroll
                            for (int ai = 0; ai < 2; ++ai)
#pragma unroll
                                for (int m = 0; m < 4; ++m) d[row0 + ai * HALF + m * 16] = acc[ai][bj][m][n][j] * cs[bj][n][j]; } }
        }
    }
};

struct EpiOutA {
    static constexpr bool PERM = false, AFTER_DRAIN = false;
    const float* x; bf16_t* H1b; float* SSQ1;
    __device__ __forceinline__ void operator()(const f32x4 (&acc)[2][2][4][2], const Unit& u, int wr, int wc, int fr, int fq) const {
        typedef unsigned u32x2_t __attribute__((ext_vector_type(2)));
        const int row0 = u.pm * BM + wr * 64 + fr, col0 = u.pn * BM + wc * 32 + 4 * fq;
        const float* xb = x + (size_t)row0 * 2048 + col0; bf16_t* hb = H1b + (size_t)row0 * 2048 + col0;
        f32x4 xr[3][4];
#define EOA_LD(slot, gi) do { const size_t o_ = (size_t)(((gi) >> 2) * HALF + ((gi) & 3) * 16) * 2048; xr[slot][0] = *(const f32x4*)(xb + o_); xr[slot][1] = *(const f32x4*)(xb + o_ + 16); xr[slot][2] = *(const f32x4*)(xb + o_ + HALF); xr[slot][3] = *(const f32x4*)(xb + o_ + HALF + 16); } while (0)
        EOA_LD(0, 0); EOA_LD(1, 1);
#pragma unroll
        for (int gi = 0; gi < 8; ++gi) { const int ai = gi >> 2, m = gi & 3;
            if (gi + 2 < 8) EOA_LD((gi + 2) % 3, gi + 2);
            const size_t o = (size_t)(ai * HALF + m * 16) * 2048; float ss = 0.f;
#pragma unroll
            for (int bj = 0; bj < 2; ++bj)
#pragma unroll
                for (int n = 0; n < 2; ++n) { const f32x4 v = xr[gi % 3][bj * 2 + n] + acc[ai][bj][m][n];
                    u32x2_t w; w.x = cvtpk(v[0], v[1]); w.y = cvtpk(v[2], v[3]);
                    *(u32x2_t*)(hb + o + bj * HALF + n * 16) = w; ss += (v[0] * v[0] + v[1] * v[1]) + (v[2] * v[2] + v[3] * v[3]); }
            ss += __shfl_xor(ss, 16); ss += __shfl_xor(ss, 32);
            if (fq == 0) SSQ1[(size_t)(row0 + ai * HALF + m * 16) * 32 + u.pn * 4 + wc] = ss; }
#undef EOA_LD
    }
};
struct EpiOutB {
    static constexpr bool PERM = false, AFTER_DRAIN = false;
    const bf16_t* H1b; float* out;
    __device__ __forceinline__ void operator()(const f32x4 (&acc)[2][2][4][2], const Unit& u, int wr, int wc, int fr, int fq) const {
        typedef unsigned u32x2_t __attribute__((ext_vector_type(2)));
        const int row0 = u.pm * BM + wr * 64 + fr, col0 = u.pn * BM + wc * 32 + 4 * fq;
        const bf16_t* hb = H1b + (size_t)row0 * 2048 + col0; float* ob = out + (size_t)row0 * 2048 + col0;
        u32x2_t hr[3][4];
#define EOB_LD(slot, gi) do { const size_t o_ = (size_t)(((gi) >> 2) * HALF + ((gi) & 3) * 16) * 2048; hr[slot][0] = *(const u32x2_t*)(hb + o_); hr[slot][1] = *(const u32x2_t*)(hb + o_ + 16); hr[slot][2] = *(const u32x2_t*)(hb + o_ + HALF); hr[slot][3] = *(const u32x2_t*)(hb + o_ + HALF + 16); } while (0)
        EOB_LD(0, 0); EOB_LD(1, 1);
#pragma unroll
        for (int gi = 0; gi < 8; ++gi) { const int ai = gi >> 2, m = gi & 3;
            if (gi + 2 < 8) EOB_LD((gi + 2) % 3, gi + 2);
            const size_t o = (size_t)(ai * HALF + m * 16) * 2048;
#pragma unroll
            for (int bj = 0; bj < 2; ++bj)
#pragma unroll
                for (int n = 0; n < 2; ++n) { const u32x2_t h = hr[gi % 3][bj * 2 + n];
                    f32x4 r; r[0] = __uint_as_float(h.x << 16); r[1] = __uint_as_float(h.x & 0xffff0000u); r[2] = __uint_as_float(h.y << 16); r[3] = __uint_as_float(h.y & 0xffff0000u);
                    *(f32x4*)(ob + o + bj * HALF + n * 16) = r + acc[ai][bj][m][n]; } }
#undef EOB_LD
    }
};

struct SchedInA {
    int G, c; const char* XN; const char* W;
    __device__ __forceinline__ bool next(int i, Unit& u) const {
        const int L = i * G + c; const size_t P = (size_t)BM * 2048 * 2;
        if (L < 512) { u.par = 0; tile_map(L, 32, 16, u.pm, u.pn); u.kind = u.pn < 8 ? 0 : 1; u.a = XN + u.pm * P; u.b = W + (u.pn < 8 ? u.pn : u.pn + 8) * P; return true; }
        if (L < 768) { u.par = 0; tile_map(L - 512, 8, 32, u.pm, u.pn); u.kind = 2; u.a = W + (8 + u.pm) * P; u.b = XN + u.pn * P; return true; }
        return false;
    }
    __device__ __forceinline__ void a_ready(const Unit&) const {}
    __device__ __forceinline__ void done(const Unit&) const {}
};
struct SchedInB {
    int G, c; const char* XN; const char* W; const float* SSQ1; PG8_LAS float* tab;
    __device__ __forceinline__ bool next(int i, Unit& u) const {
        const int L = i * G + c; const size_t P = (size_t)BM * 2048 * 2; u.par = i & 1;
        if (L < 544) { tile_map(L, 32, 17, u.pm, u.pn); u.kind = u.pn < 8 ? 0 : (u.pn < 16 ? 1 : 2); u.a = XN + u.pm * P; u.b = W + u.pn * P; return true; }
        if (L < 576) { u.pm = 0; u.pn = L - 544; u.kind = 3; u.a = W + 17 * P; u.b = XN + u.pn * P; return true; }
        return false;
    }
    __device__ __forceinline__ void a_ready(const Unit& u) const {
        int t = threadIdx.x; asm volatile("" : "+v"(t));
        const int row = t >> 1, hf = t & 1, panel = u.kind == 3 ? u.pn : u.pm;
        const float* p = SSQ1 + ((size_t)panel * BM + row) * 32 + hf * 16;
        const f32x4 a0 = *(const f32x4*)p, a1 = *(const f32x4*)(p + 4), a2 = *(const f32x4*)(p + 8), a3 = *(const f32x4*)(p + 12);
        float s = ((a0[0] + a0[1]) + (a0[2] + a0[3])) + ((a1[0] + a1[1]) + (a1[2] + a1[3])) + ((a2[0] + a2[1]) + (a2[2] + a2[3])) + ((a3[0] + a3[1]) + (a3[2] + a3[3]));
        s += __shfl_xor(s, 1);
        if (hf == 0) tab[(u.par << 8) + row] = 1.0f / sqrtf(s * (1.0f / 2048.0f) + 1e-6f);
    }
    __device__ __forceinline__ void done(const Unit&) const {}
};
struct SchedOut {
    int G, c; const char* A; const char* W;
    __device__ __forceinline__ bool next(int i, Unit& u) const {
        const int L = i * G + c; const size_t P = (size_t)BM * 2048 * 2;
        if (L >= 256) return false;
        tile_map(L, 32, 8, u.pm, u.pn); u.kind = 0; u.par = 0; u.a = A + u.pm * P; u.b = W + u.pn * P; return true;
    }
    __device__ __forceinline__ void a_ready(const Unit&) const {}
    __device__ __forceinline__ void done(const Unit&) const {}
};
template <class Epi, class Sched, bool ALIGN_EPI = false, bool SP2 = false>
__device__ __forceinline__ void gemm_phase(PG8_LAS unsigned char* lds, const int K_, const Sched& S, const Epi& E) {
    const int tid = threadIdx.x, wid = __builtin_amdgcn_readfirstlane(tid >> 6), lane = tid & 63, wr = wid >> 2, wc = wid & 3, fr = lane & 15, fq = lane >> 4;
    const int K = K_, nt = K / BK;
    unsigned voffA[2], voffB[2];
#pragma unroll
    for (int i = 0; i < 2; ++i) { int R, C; stage_rc(tid * 16 + i * 8192, R, C); const int Rb = Epi::PERM ? ((R & ~31) + perm32(R & 31)) : R;
        voffA[i] = (unsigned)(R * K + C) * 2u; voffB[i] = (unsigned)(Rb * K + C) * 2u; }
    const size_t kstep = (size_t)(BK * 2);
    const size_t hstep = (size_t)HALF * K * 2;
    const unsigned ldsw = (unsigned)wid * 1024u;
    const int aoff = lds_byte(wr * 64 + fr, fq * 8), boff = lds_byte(wc * 32 + fr, fq * 8);
#define PG8_SA(b, h) (((b) * 2 + (h)) * HTB)
#define PG8_SB(b, h) ((4 + (b) * 2 + (h)) * HTB)
#define PG8_STAGE(bufoff, gbase, voff) do { _Pragma("unroll") for (int _i = 0; _i < 2; ++_i) \
        __builtin_amdgcn_global_load_lds((const unsigned*)((const char*)(gbase) + (voff)[_i]), (PG8_LAS unsigned*)(lds + (bufoff) + ldsw + _i * 8192), 16, 0, 0); } while (0)
#define PG8_LDA(dst, b, h) do { _Pragma("unroll") for (int m = 0; m < 4; ++m) _Pragma("unroll") for (int k = 0; k < 2; ++k) dst[m][k] = *(const PG8_LAS bf16x8*)(lds + PG8_SA(b, h) + aoff + m * 2048 + k * 1024); } while (0)
#define PG8_LDB(dst, b, h) do { _Pragma("unroll") for (int n = 0; n < 2; ++n) _Pragma("unroll") for (int k = 0; k < 2; ++k) dst[n][k] = *(const PG8_LAS bf16x8*)(lds + PG8_SB(b, h) + boff + n * 2048 + k * 1024); } while (0)
#define PG8_MMA(ai, bj, At, Bt) do { __builtin_amdgcn_s_setprio(1); _Pragma("unroll") for (int m = 0; m < 4; ++m) _Pragma("unroll") for (int n = 0; n < 2; ++n) _Pragma("unroll") for (int k = 0; k < 2; ++k) \
        acc[ai][bj][m][n] = __builtin_amdgcn_mfma_f32_16x16x32_bf16(Bt[n][k], At[m][k], acc[ai][bj][m][n], 0, 0, 0); __builtin_amdgcn_s_setprio(0); } while (0)
#define PG8_WAIT_V(n) asm volatile("s_waitcnt vmcnt(" #n ")" ::: "memory")
#define PG8_WAIT_L(n) asm volatile("s_waitcnt lgkmcnt(" #n ")" ::: "memory")
#define PG8_BAR __builtin_amdgcn_s_barrier()
#define PG8_SCHED __builtin_amdgcn_sched_barrier(0)
    Unit cur, nxt; int ui = 0;
    if (!S.next(0, cur)) return;
    f32x4 acc[2][2][4][2];
#pragma unroll
    for (int a = 0; a < 2; ++a)
#pragma unroll
        for (int b = 0; b < 2; ++b)
#pragma unroll
            for (int m = 0; m < 4; ++m)
#pragma unroll
                for (int n = 0; n < 2; ++n) acc[a][b][m][n] = (f32x4){0.f, 0.f, 0.f, 0.f};
    bf16x8 At[4][2], B0[2][2], B1[2][2];
    const char* cA = cur.a; const char* cB = cur.b;
    S.a_ready(cur);
    if constexpr (SP2) {
        PG8_STAGE(PG8_SB(0, 0), cB, voffB); PG8_STAGE(PG8_SB(0, 1), cB + hstep, voffB); PG8_STAGE(PG8_SA(0, 0), cA, voffA); PG8_STAGE(PG8_SA(0, 1), cA + hstep, voffA);
        if (wr == 1) PG8_BAR;
        PG8_WAIT_V(2); PG8_BAR;
        PG8_STAGE(PG8_SB(1, 0), cB + kstep, voffB); PG8_STAGE(PG8_SA(1, 0), cA + kstep, voffA); PG8_STAGE(PG8_SB(1, 1), cB + hstep + kstep, voffB);
        PG8_WAIT_V(6); PG8_BAR;
    } else {
        PG8_STAGE(PG8_SB(0, 0), cB, voffB); PG8_STAGE(PG8_SA(0, 0), cA, voffA); PG8_STAGE(PG8_SB(0, 1), cB + hstep, voffB); PG8_STAGE(PG8_SA(0, 1), cA + hstep, voffA);
        if (wr == 1) PG8_BAR;
        PG8_WAIT_V(4); PG8_BAR;
        PG8_STAGE(PG8_SB(1, 0), cB + kstep, voffB); PG8_STAGE(PG8_SA(1, 0), cA + kstep, voffA); PG8_STAGE(PG8_SB(1, 1), cB + hstep + kstep, voffB);
        PG8_WAIT_V(6); PG8_BAR;
    }
    for (;;) {
        const bool has_next = S.next(ui + 1, nxt);
        const char* nA = has_next ? nxt.a : cA; const char* nB = has_next ? nxt.b : cB;
        for (int t = 0; t < nt; t += 2) {
            const bool last = (t == nt - 2);
            const char* a1 = cA + (size_t)(t + 1) * kstep;
            const char* a2 = last ? nA : cA + (size_t)(t + 2) * kstep; const char* b2 = last ? nB : cB + (size_t)(t + 2) * kstep;
            const char* a3 = a2 + kstep; const char* b3 = b2 + kstep;
            if (last && has_next) S.a_ready(nxt);
            if constexpr (SP2) {
            PG8_LDB(B0, 0, 0); PG8_LDB(B1, 0, 1); PG8_SCHED; PG8_LDA(At, 0, 0); PG8_STAGE(PG8_SA(1, 1), a1 + hstep, voffA);
            PG8_WAIT_V(8); PG8_WAIT_L(0); PG8_BAR; PG8_MMA(0, 0, At, B0); PG8_MMA(0, 1, At, B1); PG8_BAR; PG8_SCHED;
            PG8_LDA(At, 0, 1); PG8_STAGE(PG8_SB(0, 0), b2, voffB); PG8_STAGE(PG8_SB(0, 1), b2 + hstep, voffB); PG8_STAGE(PG8_SA(0, 0), a2, voffA);
            PG8_WAIT_V(8); PG8_WAIT_L(0); PG8_BAR; PG8_MMA(1, 0, At, B0); PG8_MMA(1, 1, At, B1); PG8_BAR; PG8_SCHED;
            PG8_LDB(B0, 1, 0); PG8_LDB(B1, 1, 1); PG8_SCHED; PG8_LDA(At, 1, 0); PG8_STAGE(PG8_SA(0, 1), a2 + hstep, voffA);
            PG8_WAIT_V(8); PG8_WAIT_L(0); PG8_BAR; PG8_MMA(0, 0, At, B0); PG8_MMA(0, 1, At, B1); PG8_BAR; PG8_SCHED;
            PG8_LDA(At, 1, 1); PG8_STAGE(PG8_SB(1, 0), b3, voffB); PG8_STAGE(PG8_SB(1, 1), b3 + hstep, voffB); PG8_STAGE(PG8_SA(1, 0), a3, voffA);
            PG8_WAIT_V(8); PG8_WAIT_L(0); PG8_BAR; PG8_MMA(1, 0, At, B0); PG8_MMA(1, 1, At, B1); PG8_BAR; PG8_SCHED;
            } else {
            PG8_LDB(B0, 0, 0); PG8_SCHED; PG8_LDA(At, 0, 0); PG8_STAGE(PG8_SA(1, 1), a1 + hstep, voffA);
            PG8_WAIT_L(8); PG8_BAR; PG8_WAIT_L(0); PG8_MMA(0, 0, At, B0); PG8_BAR; PG8_SCHED;
            PG8_LDB(B1, 0, 1); PG8_STAGE(PG8_SB(0, 0), b2, voffB);
            PG8_BAR; PG8_WAIT_L(0); PG8_MMA(0, 1, At, B1); PG8_BAR;
            PG8_LDA(At, 0, 1); PG8_STAGE(PG8_SA(0, 0), a2, voffA);
            PG8_BAR; PG8_WAIT_L(0); PG8_MMA(1, 0, At, B0); PG8_BAR; PG8_SCHED;
            PG8_STAGE(PG8_SB(0, 1), b2 + hstep, voffB);
            PG8_WAIT_V(6); PG8_BAR; PG8_MMA(1, 1, At, B1); PG8_BAR;
            PG8_LDB(B0, 1, 0); PG8_SCHED; PG8_LDA(At, 1, 0); PG8_STAGE(PG8_SA(0, 1), a2 + hstep, voffA);
            PG8_WAIT_L(8); PG8_BAR; PG8_WAIT_L(0); PG8_MMA(0, 0, At, B0); PG8_BAR; PG8_SCHED;
            PG8_LDB(B1, 1, 1); PG8_STAGE(PG8_SB(1, 0), b3, voffB);
            PG8_BAR; PG8_WAIT_L(0); PG8_MMA(0, 1, At, B1); PG8_BAR;
            PG8_LDA(At, 1, 1); PG8_STAGE(PG8_SA(1, 0), a3, voffA);
            PG8_BAR; PG8_WAIT_L(0); PG8_MMA(1, 0, At, B0); PG8_BAR; PG8_SCHED;
            PG8_STAGE(PG8_SB(1, 1), b3 + hstep, voffB);
            PG8_WAIT_V(6); PG8_BAR; PG8_MMA(1, 1, At, B1); PG8_BAR;
            }
        }
        if constexpr (ALIGN_EPI) { if (wr == 0) PG8_BAR; }
        if constexpr (!Epi::AFTER_DRAIN) { E(acc, cur, wr, wc, fr, fq); S.done(cur); }
        if (!has_next) break;
#pragma unroll
        for (int a = 0; a < 2; ++a)
#pragma unroll
            for (int b = 0; b < 2; ++b)
#pragma unroll
                for (int m = 0; m < 4; ++m)
#pragma unroll
                    for (int n = 0; n < 2; ++n) acc[a][b][m][n] = (f32x4){0.f, 0.f, 0.f, 0.f};
        cur = nxt; cA = nA; cB = nB; ++ui;
        if constexpr (ALIGN_EPI) { if (wr == 1) PG8_BAR; }
    }
    PG8_WAIT_V(0);
    if constexpr (!ALIGN_EPI) { if (wr == 0) PG8_BAR; }
    PG8_BAR;
    if constexpr (Epi::AFTER_DRAIN) { E.fused(acc, cur, wr, wc, fr, fq, lds, wid, lane); S.done(cur); }
#undef PG8_SA
#undef PG8_SB
#undef PG8_STAGE
#undef PG8_LDA
#undef PG8_LDB
#undef PG8_MMA
#undef PG8_WAIT_V
#undef PG8_WAIT_L
#undef PG8_BAR
#undef PG8_SCHED
}
}
#define GAS __attribute__((address_space(1)))
#define LAS __attribute__((address_space(3)))
typedef unsigned short bf16;
typedef unsigned v4u __attribute__((ext_vector_type(4)));
typedef float f32x4 __attribute__((ext_vector_type(4)));
typedef short bf16x8 __attribute__((ext_vector_type(8)));
typedef GAS unsigned gu32;
typedef GAS unsigned long long gu64;
#define RLX_AGENT __ATOMIC_RELAXED, __HIP_MEMORY_SCOPE_AGENT
#define LDS_WAIT() asm volatile("s_waitcnt lgkmcnt(0)" ::: "memory")
#define VM_WAIT() asm volatile("s_waitcnt vmcnt(0)" ::: "memory")
__device__ __forceinline__ unsigned long long rt() { return __builtin_amdgcn_s_memrealtime(); }
__device__ __forceinline__ unsigned f2bf(float f) { unsigned u = __builtin_bit_cast(unsigned, f); return (u + 0x7fffu + ((u >> 16) & 1u)) >> 16; }
__device__ __forceinline__ unsigned pk2(float lo, float hi) { return f2bf(lo) | (f2bf(hi) << 16); }

#define XB_TMO      128
#define XB_XCNT(j)  (256  + 64 * (j))
#define XB_XSUB(j)  (1280 + 64 * (j))
#define XB_XGEN(j)  (2304 + 64 * (j))
#define XB_TOP      3328
#define XB_TOPGEN   3392
#define XCD_BAR_WORDS 3456
#define XB_SPIN_CAP (1u << 18)

__device__ __forceinline__ unsigned xb_ld(unsigned* p)              { return __hip_atomic_load(p, __ATOMIC_RELAXED, __HIP_MEMORY_SCOPE_AGENT); }
__device__ __forceinline__ unsigned xb_add(unsigned* p, unsigned v) { return __hip_atomic_fetch_add(p, v, __ATOMIC_RELAXED, __HIP_MEMORY_SCOPE_AGENT); }
__device__ __forceinline__ unsigned xb_xcc_id() { return (unsigned)__builtin_amdgcn_s_getreg((3 << 11) | 20) & 0xFu; }
#define XB_SPIN(cond, bar) do { unsigned _sp = 0; while (cond) { __builtin_amdgcn_s_sleep(1); \
    if ((++_sp & 255u) == 0u) { if (xb_ld(&(bar)[XB_TMO])) break; if (_sp > XB_SPIN_CAP) { atomicAdd(&(bar)[XB_TMO], 1u); break; } } } } while (0)

struct XcdBarrier {
    unsigned* bar; unsigned x;
    volatile LAS unsigned* st;
};

__device__ __forceinline__ XcdBarrier xcd_barrier_post(unsigned* bar, volatile LAS unsigned* st) {
    XcdBarrier b; b.bar = bar; b.x = xb_xcc_id(); b.st = st;
    if (threadIdx.x == 0) (void)xb_add(&bar[XB_XCNT(b.x)], 1u);
    return b;
}
__device__ __forceinline__ void xcd_barrier_complete(unsigned* bar, unsigned x, unsigned& nloc, unsigned& nx) {
    const unsigned G = gridDim.x * gridDim.y * gridDim.z;
    unsigned sum, cnt, mine, sp = 0u;
    for (;;) {
        sum = 0u; cnt = 0u; mine = 0u;
#pragma unroll
        for (unsigned j = 0; j < 16; ++j) { const unsigned c = xb_ld(&bar[XB_XCNT(j)]); sum += c; cnt += (c > 0u) ? 1u : 0u; mine = (j == x) ? c : mine; }
        if (sum == G) break;
        __builtin_amdgcn_s_sleep(1);
        if ((++sp & 255u) == 0u) { if (xb_ld(&bar[XB_TMO])) break; if (sp > XB_SPIN_CAP) { atomicAdd(&bar[XB_TMO], 1u); break; } }
    }
    nloc = mine > 0u ? mine : 1u; nx = cnt > 0u ? cnt : 1u;
}

__device__ __forceinline__ void xcd_barrier(const XcdBarrier& b) {
    asm volatile("s_waitcnt vmcnt(0)" ::: "memory");
    __syncthreads();
    if (threadIdx.x == 0) {
        unsigned* bar = b.bar;
        __builtin_amdgcn_s_waitcnt(0);
        unsigned nloc = b.st[0], nx = b.st[1];
        if (nloc == 0u) { xcd_barrier_complete(bar, b.x, nloc, nx); b.st[0] = nloc; b.st[1] = nx; }
        const unsigned old = xb_add(&bar[XB_XSUB(b.x)], 1u);
        const unsigned gen = old / nloc;
        if (old + 1u == (gen + 1u) * nloc) {
            __builtin_amdgcn_fence(__ATOMIC_RELEASE, "agent");
            asm volatile("s_waitcnt vmcnt(0)" ::: "memory");
            const unsigned og = xb_add(&bar[XB_TOP], 1u);
            const unsigned tg = og / nx;
            if (og + 1u == (tg + 1u) * nx) xb_add(&bar[XB_TOPGEN], 1u);
            else XB_SPIN(xb_ld(&bar[XB_TOPGEN]) == tg, bar);
            __builtin_amdgcn_fence(__ATOMIC_ACQUIRE, "agent");
            xb_add(&bar[XB_XGEN(b.x)], 1u);
            asm volatile("s_waitcnt vmcnt(0)" ::: "memory");
        } else {
            XB_SPIN(xb_ld(&bar[XB_XGEN(b.x)]) == gen, bar);
            __builtin_amdgcn_fence(__ATOMIC_ACQUIRE, "agent");
            asm volatile("s_waitcnt vmcnt(0)" ::: "memory");
        }
    }
    __syncthreads();
}
constexpr int NWAVES = 8;
constexpr int MPR = 8192, MSM = 256, MT = MPR + MSM;
constexpr int DM = 2048;
constexpr float RMS_EPS = 1e-6f;
constexpr float LOG2E = 1.4426950408889634f;
constexpr size_t MiB = 1u << 20;
constexpr size_t WS_CTL = 0, CTL_ZERO_BYTES = 64 * 1024;
constexpr size_t WS_WINA = 1 * MiB;
constexpr size_t WS_WOA = 26 * MiB;
constexpr size_t WS_WINB = 34 * MiB;
constexpr size_t WS_WOB = 52 * MiB;
constexpr size_t WS_BUFA = 60 * MiB;
constexpr size_t WS_QK = 93 * MiB;
constexpr size_t WS_VT = 126 * MiB;
constexpr size_t WS_QZ = 93 * MiB;
constexpr size_t WS_SR = 159 * MiB;
constexpr size_t WS_REC = 192 * MiB;
constexpr size_t WS_KB = 192 * MiB;
constexpr size_t WS_VT2 = 198 * MiB;
constexpr size_t WS_GLOW = 234 * MiB;
constexpr size_t WS_SSQP = 235 * MiB;
constexpr size_t WS_SSQ1 = 236 * MiB;
constexpr int TAB_OFF = 131072;
constexpr size_t WS_END = 240 * MiB;
constexpr int CW_BAR = 1024;
constexpr int HREC = 33792, REC_PO = 33792, REC_H1 = 41984, REC_BYTES = 75776, REC_DMA = 41984, H_QT = 0, H_KT = 16384, H_G = 32768;
static_assert(512 * (size_t)REC_BYTES <= 42 * MiB && REC_DMA % 1024 == 0, "record");
__device__ __forceinline__ int qt_off(int t, int dl) {
    const int d5 = dl & 31; const int p = d5 < 16 ? ((d5 >> 2) << 3) + (d5 & 3) : (((d5 - 16) >> 2) << 3) + 4 + (d5 & 3);
    const int chunk = ((dl >> 5) << 2) + (p >> 3); return t * 256 + ((chunk ^ (t & 15)) << 4) + ((p & 7) << 1); }
__device__ __forceinline__ int qt_chunk(int t, int c) { return t * 256 + ((c ^ (t & 15)) << 4); }
__device__ __forceinline__ int kt_chunk(int d, int c) { return d * 128 + ((c ^ ((d >> 1) & 7)) << 4); }
constexpr size_t OUT_Y = 0, OUT_GLAP = 17301504, OUT_GLAS = 19398656, OUT_KWP = 36175872, OUT_VWP = 36306944, OUT_KWS = 36438016, OUT_VWS = 37486592, OUT_TOTAL = 38535168;
constexpr int RING_BYTES = 131072, LDS_BYTES = 163840, LDSCTL_OFF = LDS_BYTES - 1024, MISC_OFF = LDSCTL_OFF + 320;

__device__ __forceinline__ float bf2f(unsigned short u) { return __uint_as_float(((unsigned)u) << 16); }
__device__ __forceinline__ unsigned cvtpk2(float lo, float hi) { return pg8::cvtpk(lo, hi); }
__device__ __forceinline__ float wave_sum(float v) {
#pragma unroll
    for (int o = 1; o < 64; o <<= 1) v += __shfl_xor(v, o);
    return v;
}
#define MFMA16(a, b, c) __builtin_amdgcn_mfma_f32_16x16x32_bf16((a), (b), (c), 0, 0, 0)
typedef unsigned u32x2 __attribute__((ext_vector_type(2)));

struct Ptrs {
    const float *x_prompt, *x_sample, *state, *ck, *cv, *g_norm_a, *w_in_a, *w_gate_up, *b_gate, *g_onorm, *w_out_a, *g_norm_kv, *w_kv, *g_norm_b, *w_in_b, *sinks, *w_out_b, *g_final;
    float* out; unsigned char* ws;
};

__device__ __forceinline__ void p0_transpose_item(const float* W, int ldw, int ncol0, int nvalid, const float* gain, int scale_cols, float scale, bf16* WT, int row_off, LAS float* scr, int kb, int nb, int lane) {
    const int k0 = 64 * kb, n0 = 32 * nb, nl = lane & 31; const bool ok = (n0 + nl) < nvalid; const float cs = (n0 + nl) < scale_cols ? scale : 1.0f;
#pragma unroll 8
    for (int i = 0; i < 32; ++i) { const int kk = 2 * i + (lane >> 5); float v = ok ? W[(size_t)(k0 + kk) * ldw + ncol0 + n0 + nl] : 0.f; if (gain) v *= gain[k0 + kk]; scr[kk * 33 + nl] = v * cs; }
    LDS_WAIT(); asm volatile("" ::: "memory");
    const int c = lane & 7;
#pragma unroll
    for (int j = 0; j < 4; ++j) { const int n = (lane >> 3) + 8 * j; const LAS float* s = scr + (8 * c) * 33 + n;
        v4u o; o.x = cvtpk2(s[0 * 33], s[1 * 33]); o.y = cvtpk2(s[2 * 33], s[3 * 33]); o.z = cvtpk2(s[4 * 33], s[5 * 33]); o.w = cvtpk2(s[6 * 33], s[7 * 33]);
        if (n0 + n < nvalid) *(GAS v4u*)(WT + (size_t)(row_off + n0 + n) * 2048 + k0 + 8 * c) = o; }
    LDS_WAIT(); asm volatile("" ::: "memory");
}
__device__ __forceinline__ void rms_row_to_bf16(const float* xrow, bf16* orow, int lane) {
    const GAS f32x4* xr = (const GAS f32x4*)xrow + lane;
    f32x4 v[8]; float s = 0.f;
#pragma unroll
    for (int j = 0; j < 8; ++j) { v[j] = xr[64 * j]; s += (v[j].x * v[j].x + v[j].y * v[j].y) + (v[j].z * v[j].z + v[j].w * v[j].w); }
    const float rstd = 1.0f / sqrtf(wave_sum(s) * (1.f / DM) + RMS_EPS);
    GAS u32x2* o8 = (GAS u32x2*)orow + lane;
#pragma unroll
    for (int j = 0; j < 8; ++j) { u32x2 w; w.x = cvtpk2(v[j].x * rstd, v[j].y * rstd); w.y = cvtpk2(v[j].z * rstd, v[j].w * rstd); o8[64 * j] = w; }
}
__device__ __forceinline__ void p0_transpose_big(const float* W, int ldw, const float* gain, float cs, bf16* WT, int row_off, LAS unsigned char* scr, int kb, int nb, int lane) {
    const int k0 = 64 * kb, n0 = 128 * nb, hl = lane >> 5, nl = lane & 31;
    const GAS f32x4* src = (const GAS f32x4*)(W + (size_t)(k0 + 32 * hl) * ldw + n0 + 4 * nl);
    f32x4 v[32];
#pragma unroll
    for (int i = 0; i < 32; ++i) v[i] = src[(size_t)i * (ldw / 4)];
    f32x4 gk[8];
#pragma unroll
    for (int i = 0; i < 8; ++i) gk[i] = gain ? *(const GAS f32x4*)(gain + k0 + 32 * hl + 4 * i) * cs : (f32x4){cs, cs, cs, cs};
#pragma unroll
    for (int j = 0; j < 4; ++j) { const int n = 4 * nl + j;
#pragma unroll
        for (int q = 0; q < 4; ++q) { v4u o;
            o.x = cvtpk2(v[8 * q + 0][j] * gk[2 * q][0], v[8 * q + 1][j] * gk[2 * q][1]); o.y = cvtpk2(v[8 * q + 2][j] * gk[2 * q][2], v[8 * q + 3][j] * gk[2 * q][3]);
            o.z = cvtpk2(v[8 * q + 4][j] * gk[2 * q + 1][0], v[8 * q + 5][j] * gk[2 * q + 1][1]); o.w = cvtpk2(v[8 * q + 6][j] * gk[2 * q + 1][2], v[8 * q + 7][j] * gk[2 * q + 1][3]);
            *(LAS v4u*)(scr + n * 128 + (((4 * hl + q) ^ (n & 7)) << 4)) = o; } }
    LDS_WAIT(); asm volatile("" ::: "memory");
#pragma unroll
    for (int it = 0; it < 16; ++it) { const int idx = it * 64 + lane, n = idx >> 3, ch = idx & 7;
        const v4u o = *(const LAS v4u*)(scr + n * 128 + ((ch ^ (n & 7)) << 4));
        *(GAS v4u*)(WT + (size_t)(row_off + n0 + n) * 2048 + k0 + 8 * ch) = o; }
    LDS_WAIT(); asm volatile("" ::: "memory");
}
__device__ __forceinline__ void convert_weights(const Ptrs& P, LAS unsigned char* lds, int group, int gwi, int ngw, int iend, int wave, int lane) {
    LAS unsigned char* scr = lds + wave * 16384;
    bf16* WinaT = (bf16*)(P.ws + WS_WINA); bf16* WoaT = (bf16*)(P.ws + WS_WOA); bf16* WinbT = (bf16*)(P.ws + WS_WINB); bf16* WobT = (bf16*)(P.ws + WS_WOB);
    constexpr int I0 = 32 * 48, I1 = 32, I2 = 32 * 16, I3 = 32 * 32, I4 = 32 * 4, I5 = 32 * 16;
    if (group == 0) {
        for (int r = gwi; r < I0; r += ngw) { const int nb = r % 48; p0_transpose_big(P.w_in_a, 6160, P.g_norm_a, nb < 8 ? 0.0625f : 1.f, WinaT, 0, scr, r / 48, nb, lane); }
        for (int it = ngw - 1 - gwi; it < I1; it += ngw) p0_transpose_item(P.w_in_a, 6160, 6144, 16, P.g_norm_a, 0, 1.f, WinaT, 6144, (LAS float*)scr, it, 0, lane);
    } else {
        for (int it = gwi; it < iend; it += ngw) {
            int r = it;
            if (r < I2) { p0_transpose_big(P.w_out_a, 2048, P.g_onorm, 1.f, WoaT, 0, scr, r / 16, r % 16, lane); continue; } r -= I2;
            if (r < I3) { const int nb = r % 32; p0_transpose_big(P.w_in_b, 4096, P.g_norm_b, nb < 16 ? 0.125f * LOG2E : 1.f, WinbT, 0, scr, r / 32, nb, lane); continue; } r -= I3;
            if (r < I4) { p0_transpose_big(P.w_kv, 512, P.g_norm_kv, 1.f, WinbT, 4096, scr, r / 4, r % 4, lane); continue; } r -= I4;
            p0_transpose_big(P.w_out_b, 2048, nullptr, 1.f, WobT, 0, scr, r / 16, r % 16, lane);
        }
    }
}
__device__ __forceinline__ void p0_prologue(const Ptrs& P, LAS unsigned char* lds, int vcu, int G, int tid, int wave, int lane) {
    const int gw = vcu * NWAVES + wave, NGW = G * NWAVES;
    convert_weights(P, lds, 0, gw, NGW, 0, wave, lane);
    if (G < 256) convert_weights(P, lds, 1, gw, NGW, 2176, wave, lane);
    bf16* XN = (bf16*)(P.ws + WS_BUFA);
    for (int m = gw; m < MT; m += NGW) rms_row_to_bf16(m < MPR ? P.x_prompt + (size_t)m * DM : P.x_sample + (size_t)(m - MPR) * DM, XN + (size_t)m * DM, lane);
    const int gt = vcu * (NWAVES * 64) + tid, NGT = G * NWAVES * 64;
    for (int i = gt; i < 32 * 120 * 64; i += NGT) { const int b = i / (120 * 64), rem = i % (120 * 64);
        ((f32x4*)(P.out + OUT_KWS))[(size_t)b * 128 * 64 + rem] = ((const f32x4*)P.ck)[(size_t)b * 128 * 64 + 8 * 64 + rem];
        ((f32x4*)(P.out + OUT_VWS))[(size_t)b * 128 * 64 + rem] = ((const f32x4*)P.cv)[(size_t)b * 128 * 64 + 8 * 64 + rem]; }
}

__device__ __forceinline__ void glow_task(const bf16* XN, const bf16* WgT, float* GLOW, int task, int lane) {
    const int r = lane & 15, g = lane >> 4, row0 = task * 16;
    const bf16* ap = XN + (size_t)(row0 + r) * DM + g * 8; const bf16* bp = WgT + (size_t)r * DM + g * 8;
    f32x4 acc = {0.f, 0.f, 0.f, 0.f};
#pragma unroll 8
    for (int kk = 0; kk < 64; ++kk) { const bf16x8 a = *(const bf16x8*)(ap + kk * 32); const bf16x8 b = *(const bf16x8*)(bp + kk * 32); acc = MFMA16(a, b, acc); }
#pragma unroll
    for (int i = 0; i < 4; ++i) GLOW[(size_t)(row0 + 4 * g + i) * 16 + r] = acc[i];
}

__device__ __forceinline__ void gla_prep_unit(const Ptrs& P, LAS unsigned char* lds, int u, int tid, int wave, int lane) {
    const int c = u & 31, h = (u >> 5) & 3, b = u >> 7;
    const int d = tid & 255, th = tid >> 8, hh = d >> 7, dl = d & 127;
    LAS unsigned char* QI = lds;
    LAS unsigned char* KI = lds + 32768;
    LAS float* GL = (LAS float*)(lds + 65536);
    LAS float* TOT = (LAS float*)(lds + 65536 + 4096);
    const int row0 = b * 2048 + c * 64;
    const float* GLOW = (const float*)(P.ws + WS_GLOW);
    const bf16* QK = (const bf16*)(P.ws + WS_QK);
    unsigned char* rec = P.ws + WS_REC + (size_t)u * REC_BYTES;
    unsigned char* rech = rec + (hh ? REC_H1 : 0);
#pragma unroll
    for (int i = 0; i < 4; ++i) { const int idx = tid + 512 * i, t = idx >> 5, ch = idx & 31;
        const v4u q = *(const GAS v4u*)(QK + (size_t)(row0 + t) * DM + h * 256 + ch * 8), k = *(const GAS v4u*)(QK + (size_t)(row0 + t) * DM + 1024 + h * 256 + ch * 8);
        *(LAS v4u*)(QI + t * 512 + ch * 16) = q; *(LAS v4u*)(KI + t * 512 + ch * 16) = k; }
    if (tid < 256) ((LAS f32x4*)GL)[tid] = ((const f32x4*)(GLOW + (size_t)row0 * 16))[tid];
    float wg[16];
#pragma unroll
    for (int r = 0; r < 16; ++r) wg[r] = P.w_gate_up[r * 1024 + h * 256 + d];
    const float bias = P.b_gate[h * 256 + d];
    __syncthreads();
    float bl[32]; float run = 0.f;
#pragma unroll
    for (int tt = 0; tt < 32; ++tt) { const int t = th * 32 + tt; const LAS f32x4* gr = (const LAS f32x4*)(GL + t * 16);
        const f32x4 g0 = gr[0], g1 = gr[1], g2 = gr[2], g3 = gr[3];
        float z = bias + g0.x * wg[0] + g0.y * wg[1] + g0.z * wg[2] + g0.w * wg[3] + g1.x * wg[4] + g1.y * wg[5] + g1.z * wg[6] + g1.w * wg[7]
                       + g2.x * wg[8] + g2.y * wg[9] + g2.z * wg[10] + g2.w * wg[11] + g3.x * wg[12] + g3.y * wg[13] + g3.z * wg[14] + g3.w * wg[15];
        const float ls = fminf(z, 0.f) - __logf(1.0f + __expf(-fabsf(z)));
        run += ls * 0.0625f; bl[tt] = run; }
    TOT[th * 256 + d] = run;
    unsigned short qr[32], kr[32];
#pragma unroll
    for (int tt = 0; tt < 32; ++tt) { qr[tt] = *(const LAS unsigned short*)(QI + (th * 32 + tt) * 512 + d * 2); kr[tt] = *(const LAS unsigned short*)(KI + (th * 32 + tt) * 512 + d * 2); }
    __syncthreads();
    const float tot0 = TOT[d], tot1 = TOT[256 + d], blast = tot0 + tot1, base = th ? tot0 : 0.f;
    unsigned kt[16];
#pragma unroll
    for (int tt = 0; tt < 32; tt += 2) {
        float kv2[2];
#pragma unroll
        for (int k2 = 0; k2 < 2; ++k2) { const int t = th * 32 + tt + k2; const float bt = base + bl[tt + k2];
            const float e1 = __expf(bt - blast), e2 = __builtin_amdgcn_rcpf(e1);
            const float qv = bf2f(qr[tt + k2]) * e1, kv = bf2f(kr[tt + k2]) * e2; kv2[k2] = kv;
            const int off = hh * 16384 + qt_off(t, dl);
            *(LAS unsigned short*)(QI + off) = (unsigned short)(cvtpk2(qv, 0.f) & 0xffffu); *(LAS unsigned short*)(KI + off) = (unsigned short)(cvtpk2(kv, 0.f) & 0xffffu); }
        kt[tt >> 1] = cvtpk2(kv2[0], kv2[1]); }
#pragma unroll
    for (int i = 0; i < 4; ++i) { v4u o; o.x = kt[4 * i]; o.y = kt[4 * i + 1]; o.z = kt[4 * i + 2]; o.w = kt[4 * i + 3]; *(GAS v4u*)(rech + H_KT + kt_chunk(dl, 4 * th + i)) = o; }
    if (th == 0) ((GAS float*)(rech + H_G))[dl] = __expf(blast);
    __syncthreads();
    { const int r = lane & 15, g = lane >> 4, mt = wave >> 1, st0 = 2 * (wave & 1);
      f32x4 a0 = {0.f, 0.f, 0.f, 0.f}, a1 = {0.f, 0.f, 0.f, 0.f};
      bf16x8 bq[8], k0[8], k1[8];
#pragma unroll
      for (int kk = 0; kk < 8; ++kk) { const int ho = (kk >> 2) * 16384, cc = 4 * (kk & 3) + g;
          bq[kk] = *(const LAS bf16x8*)(QI + ho + qt_chunk(16 * mt + r, cc)); k0[kk] = *(const LAS bf16x8*)(KI + ho + qt_chunk(16 * st0 + r, cc)); k1[kk] = *(const LAS bf16x8*)(KI + ho + qt_chunk(16 * st0 + 16 + r, cc)); }
#pragma unroll
      for (int kk = 0; kk < 8; ++kk) { a0 = MFMA16(k0[kk], bq[kk], a0); a1 = MFMA16(k1[kk], bq[kk], a1); }
      const int t = 16 * mt + r;
#pragma unroll
      for (int j = 0; j < 2; ++j) { const f32x4 a = j ? a1 : a0; const int s0 = 16 * (st0 + j) + 4 * g;
          u32x2 w; w.x = cvtpk2(s0 + 0 <= t ? a[0] : 0.f, s0 + 1 <= t ? a[1] : 0.f); w.y = cvtpk2(s0 + 2 <= t ? a[2] : 0.f, s0 + 3 <= t ? a[3] : 0.f);
          *(GAS u32x2*)(rec + REC_PO + kt_chunk(t, s0 >> 3) + (s0 & 7) * 2) = w; } }
#pragma unroll
    for (int i = 0; i < 4; ++i) { const int idx = tid + 512 * i; ((GAS v4u*)(rec + ((idx >> 10) ? REC_H1 : 0) + H_QT))[idx & 1023] = ((const LAS v4u*)QI)[idx]; }
    __syncthreads();
}

constexpr int SC_BUF = REC_DMA, SC_PIECES = REC_DMA / 1024, SC_OT = 3 * REC_DMA;
static_assert(SC_OT + 2 * 16384 <= LDSCTL_OFF, "scan LDS map");
__device__ __forceinline__ void gla_scan_unit(const Ptrs& P, LAS unsigned char* lds, int bh, int dh, int eq, int tid, int wave, int lane, int nch = 32) {
    const int b = bh >> 2, h = bh & 3, r = lane & 15, g = lane >> 4, rr = (r >> 1) & 7;
    const int ecol = h * 512 + eq * 128 + 16 * wave;
    const bf16* VT = (const bf16*)(P.ws + WS_VT);
    bf16* OB = (bf16*)(P.ws + (dh ? WS_QK : WS_BUFA)) + (size_t)(b * 2048) * DM + h * 512 + eq * 128;
    const unsigned char* rec0 = P.ws + WS_REC + (size_t)(bh * 32) * REC_BYTES + (dh ? REC_PO : 0);
    const unsigned HO = dh ? 8192u : 0u, PO = dh ? 0u : 33792u;
    f32x4 S[8];
#pragma unroll
    for (int i = 0; i < 8; ++i) S[i] = (f32x4){0.f, 0.f, 0.f, 0.f};
    const bf16* vtp = VT + (size_t)(ecol + r) * MT + b * 2048 + 8 * g;
#define SC_DMA(cc, bufo_) do { const unsigned char* src_ = rec0 + (size_t)(cc) * REC_BYTES + lane * 16; \
        _Pragma("unroll") for (int j_ = 0; j_ < 6; ++j_) { const int i_ = wave + NWAVES * j_; \
            if (i_ < SC_PIECES) __builtin_amdgcn_global_load_lds((const GAS unsigned*)(src_ + i_ * 1024), (LAS unsigned*)(lds + (bufo_) + i_ * 1024), 16, 0, 0); } } while (0)
#define SC_OSTORE(cc) do { const LAS unsigned char* ot_ = lds + SC_OT + ((cc) & 1) * 16384; \
        _Pragma("unroll") for (int j_ = 0; j_ < 2; ++j_) { const int idx_ = tid + 512 * j_, row_ = idx_ >> 4, q_ = idx_ & 15; \
            const v4u v_ = *(const LAS v4u*)(ot_ + row_ * 256 + ((q_ ^ (row_ & 15)) << 4)); \
            *(GAS v4u*)(OB + (size_t)((cc) * 64 + row_) * DM + q_ * 8) = v_; } } while (0)
    bf16x8 vc0 = *(const bf16x8*)vtp, vc1 = *(const bf16x8*)(vtp + 32), vn0 = vc0, vn1 = vc1;
    SC_DMA(0, 0u); SC_DMA(1, (unsigned)SC_BUF);
    __syncthreads();
    unsigned bo0 = 0u, bo1 = SC_BUF, bo2 = 2u * SC_BUF;
#pragma unroll 1
    for (int c = 0; c < nch; ++c) {
        bf16x8 vf[2]; vf[0] = vc0; vf[1] = vc1;
        { const bf16* vp_ = vtp + (c + 1 < 32 ? c + 1 : 31) * 64;
          asm volatile("global_load_dwordx4 %0, %2, off\n\tglobal_load_dwordx4 %1, %2, off offset:64" : "=&v"(vn0), "=&v"(vn1) : "v"(vp_) : "memory"); }
        if (c > 0) SC_OSTORE(c - 1);
        const unsigned bufo = bo0;
        const unsigned qbase = bufo + HO + H_QT + (unsigned)(r * 256 + ((r >> 2) << 6) + ((g ^ (r & 3)) << 4));
        const unsigned kbase = bufo + HO + H_KT + (unsigned)(r * 128 + ((rr >> 2) << 6) + ((g ^ (rr & 3)) << 4));
        const unsigned pbase = bufo + PO + (unsigned)(r * 128 + ((dh ^ (rr >> 2)) << 6) + ((g ^ (rr & 3)) << 4));
        const unsigned gbase = bufo + HO + H_G + (unsigned)(g * 16);
#define SC_FENCE() __builtin_amdgcn_sched_barrier(0)
#define SC_BQ(k2, tt) (*(const LAS bf16x8*)(lds + ((qbase ^ ((k2) << 6)) + (tt) * 4096)))
#define SC_KF(i, ks) (*(const LAS bf16x8*)(lds + ((kbase ^ ((ks) << 6)) + (i) * 2048)))
#define SC_AF(k2) __builtin_bit_cast(bf16x8, (v4u){cvtpk2(S[2 * (k2)][0], S[2 * (k2)][1]), cvtpk2(S[2 * (k2)][2], S[2 * (k2)][3]), cvtpk2(S[2 * (k2) + 1][0], S[2 * (k2) + 1][1]), cvtpk2(S[2 * (k2) + 1][2], S[2 * (k2) + 1][3])})
        f32x4 gm[4]; bf16x8 qa[8], qb[8];
#pragma unroll
        for (int i = 0; i < 4; ++i) gm[i] = *(const LAS f32x4*)(lds + (gbase + i * 64));
#pragma unroll
        for (int tt = 0; tt < 4; ++tt) { qa[tt] = SC_BQ(0, tt); qa[4 + tt] = SC_BQ(1, tt); }
        SC_FENCE();
#pragma unroll
        for (int i = 0; i < 4; ++i) S[i] = S[i] * gm[i];
#pragma unroll
        for (int i = 0; i < 4; ++i) gm[i] = *(const LAS f32x4*)(lds + (gbase + (4 + i) * 64));
#pragma unroll
        for (int tt = 0; tt < 4; ++tt) { qb[tt] = SC_BQ(2, tt); qb[4 + tt] = SC_BQ(3, tt); }
        bf16x8 pq[4];
#pragma unroll
        for (int tt = 0; tt < 4; ++tt) pq[tt] = *(const LAS bf16x8*)(lds + (pbase + tt * 2048));
        SC_FENCE();
        f32x4 Z[4];
#pragma unroll
        for (int tt = 0; tt < 4; ++tt) Z[tt] = (f32x4){0.f, 0.f, 0.f, 0.f};
        { const bf16x8 a0 = SC_AF(0), a1 = SC_AF(1);
#pragma unroll
          for (int tt = 0; tt < 4; ++tt) Z[tt] = MFMA16(a0, qa[tt], Z[tt]);
#pragma unroll
          for (int tt = 0; tt < 4; ++tt) Z[tt] = MFMA16(a1, qa[4 + tt], Z[tt]); }
#pragma unroll
        for (int i = 0; i < 4; ++i) S[4 + i] = S[4 + i] * gm[i];
#pragma unroll
        for (int i = 0; i < 4; ++i) { qa[2 * i] = SC_KF(i, 0); qa[2 * i + 1] = SC_KF(i, 1); }
        SC_FENCE();

        { const bf16x8 a2 = SC_AF(2), a3 = SC_AF(3);
#pragma unroll
          for (int tt = 0; tt < 4; ++tt) Z[tt] = MFMA16(a2, qb[tt], Z[tt]);
#pragma unroll
          for (int tt = 0; tt < 4; ++tt) Z[tt] = MFMA16(a3, qb[4 + tt], Z[tt]);
#pragma unroll
          for (int tt = 0; tt < 4; ++tt) Z[tt] = MFMA16(dh ? vf[1] : vf[0], pq[tt], Z[tt]); }
#pragma unroll
        for (int i = 0; i < 4; ++i) { qb[2 * i] = SC_KF(4 + i, 0); qb[2 * i + 1] = SC_KF(4 + i, 1); }
        SC_FENCE();
        asm volatile("s_waitcnt vmcnt(0)" : "+v"(vn0), "+v"(vn1) :: "memory");
        SC_DMA((c + 2 < 32 ? c + 2 : 31), bo2);
        SC_FENCE();
#pragma unroll
        for (int i = 0; i < 4; ++i) { S[i] = MFMA16(qa[2 * i], vf[0], S[i]); S[i] = MFMA16(qa[2 * i + 1], vf[1], S[i]); }
#pragma unroll
        for (int i = 0; i < 4; ++i) { S[4 + i] = MFMA16(qb[2 * i], vf[0], S[4 + i]); S[4 + i] = MFMA16(qb[2 * i + 1], vf[1], S[4 + i]); }
#undef SC_FENCE
#undef SC_BQ
#undef SC_KF
#undef SC_AF
        { LAS unsigned char* ot = lds + SC_OT + (c & 1) * 16384 + (g & 1) * 8;
#pragma unroll
          for (int tt = 0; tt < 4; ++tt) { u32x2 w; w.x = cvtpk2(Z[tt][0], Z[tt][1]); w.y = cvtpk2(Z[tt][2], Z[tt][3]);
              *(LAS u32x2*)(ot + (16 * tt + r) * 256 + (((2 * wave + (g >> 1)) ^ r) << 4)) = w; } }
        asm volatile("s_waitcnt lgkmcnt(0)" ::: "memory"); __builtin_amdgcn_s_barrier(); asm volatile("" ::: "memory");
        vc0 = vn0; vc1 = vn1;
        { const unsigned t_ = bo0; bo0 = bo1; bo1 = bo2; bo2 = t_; }
    }
    SC_OSTORE(nch - 1);
#undef SC_OSTORE
#undef SC_DMA
    asm volatile("s_waitcnt vmcnt(0)" ::: "memory"); __syncthreads();
    float* SO = P.out + OUT_GLAP + ((size_t)bh * 256 + 128 * dh + 4 * g) * 512 + eq * 128 + 16 * wave + r;
#pragma unroll
    for (int i = 0; i < 8; ++i) { float* so = SO + (size_t)i * 16 * 512; asm volatile("" : "+v"(so));
        so[0] = S[i][0]; so[512] = S[i][1]; so[1024] = S[i][2]; so[1536] = S[i][3]; }
}

__device__ __forceinline__ void gla_sample_unit(const Ptrs& P, LAS unsigned char* lds, int u, int tid, int wave, int lane) {
    const int h = u & 3, b = u >> 2;
    LAS float* GL = (LAS float*)lds;
    LAS float* QD = (LAS float*)(lds + 1024);
    LAS float* KD = (LAS float*)(lds + 1024 + 8192);
    LAS float* GD = (LAS float*)(lds + 1024 + 16384);
    LAS float* PR = (LAS float*)(lds + 18432);
    LAS float* RED = (LAS float*)(lds + 18688);
    LAS float* VL = (LAS float*)(lds + 20480);
    LAS float* OP = (LAS float*)(lds + 36864);
    const int row0 = MPR + b * 8;
    const bf16* QK = (const bf16*)(P.ws + WS_QK); const bf16* VT = (const bf16*)(P.ws + WS_VT); const float* GLOW = (const float*)(P.ws + WS_GLOW);
    const int eq = tid & 127, dq = tid >> 7;
    const size_t sbase = ((size_t)(b * 4 + h) * 256 + 64 * dq) * 512 + 4 * eq;
    const float* S0p = P.state + sbase; float* S1p = P.out + OUT_GLAS + sbase;
    if (tid < 32) ((LAS f32x4*)GL)[tid] = ((const f32x4*)(GLOW + (size_t)row0 * 16))[tid];
    { const v4u vv = *(const GAS v4u*)(VT + (size_t)(h * 512 + tid) * MT + row0);
      VL[0 * 512 + tid] = __uint_as_float(vv.x << 16); VL[1 * 512 + tid] = __uint_as_float(vv.x & 0xffff0000u); VL[2 * 512 + tid] = __uint_as_float(vv.y << 16); VL[3 * 512 + tid] = __uint_as_float(vv.y & 0xffff0000u);
      VL[4 * 512 + tid] = __uint_as_float(vv.z << 16); VL[5 * 512 + tid] = __uint_as_float(vv.z & 0xffff0000u); VL[6 * 512 + tid] = __uint_as_float(vv.w << 16); VL[7 * 512 + tid] = __uint_as_float(vv.w & 0xffff0000u); }
    __syncthreads();
    if (tid < 256) {
        const int d = tid;
        float wg[16];
#pragma unroll
        for (int r = 0; r < 16; ++r) wg[r] = P.w_gate_up[r * 1024 + h * 256 + d];
        const float bias = P.b_gate[h * 256 + d];
        float bc[8], q[8], k[8]; float run = 0.f;
#pragma unroll
        for (int t = 0; t < 8; ++t) { q[t] = bf2f(QK[(size_t)(row0 + t) * DM + h * 256 + d]); k[t] = bf2f(QK[(size_t)(row0 + t) * DM + 1024 + h * 256 + d]); }
#pragma unroll
        for (int t = 0; t < 8; ++t) { const LAS f32x4* gr = (const LAS f32x4*)(GL + t * 16); const f32x4 g0 = gr[0], g1 = gr[1], g2 = gr[2], g3 = gr[3];
            float z = bias + g0.x * wg[0] + g0.y * wg[1] + g0.z * wg[2] + g0.w * wg[3] + g1.x * wg[4] + g1.y * wg[5] + g1.z * wg[6] + g1.w * wg[7]
                           + g2.x * wg[8] + g2.y * wg[9] + g2.z * wg[10] + g2.w * wg[11] + g3.x * wg[12] + g3.y * wg[13] + g3.z * wg[14] + g3.w * wg[15];
            const float ls = fminf(z, 0.f) - __logf(1.0f + __expf(-fabsf(z)));
            run += ls * 0.0625f; bc[t] = run; }
        const float blast = bc[7];
#pragma unroll
        for (int t = 0; t < 8; ++t) { QD[d * 8 + t] = q[t] * __expf(bc[t]); KD[d * 8 + t] = k[t] * __expf(blast - bc[t]); }
        GD[d] = __expf(blast);
        int idx = 0;
#pragma unroll
        for (int t = 0; t < 8; ++t)
#pragma unroll
            for (int s = 0; s <= t; ++s) { float v = q[t] * k[s] * __expf(bc[t] - bc[s]); v = wave_sum(v); if (lane == 0) RED[wave * 36 + idx] = v; ++idx; }
    }
    __syncthreads();
    if (tid < 64) { const int t = tid >> 3, s = tid & 7; float v = 0.f; if (s <= t) { const int idx = t * (t + 1) / 2 + s; v = RED[idx] + RED[36 + idx] + RED[72 + idx] + RED[108 + idx]; } PR[t * 8 + s] = v; }
    { f32x4 sa[4], sb[4];
#pragma unroll
      for (int i = 0; i < 4; ++i) sa[i] = *(const GAS f32x4*)(S0p + (size_t)i * 512);
      f32x4 v[8], o[8];
#pragma unroll
      for (int s = 0; s < 8; ++s) v[s] = *(const LAS f32x4*)(VL + s * 512 + 4 * eq);
#pragma unroll
      for (int t = 0; t < 8; ++t) o[t] = (f32x4){0.f, 0.f, 0.f, 0.f};
#define GS_STEP(cur, nxt, d0, more) do { if (more) { _Pragma("unroll") for (int i = 0; i < 4; ++i) nxt[i] = *(const GAS f32x4*)(S0p + (size_t)((d0) + 4 + i) * 512); } \
        _Pragma("unroll") for (int i = 0; i < 4; ++i) { const int dd = 64 * dq + (d0) + i; \
          const f32x4 qa = *(const LAS f32x4*)(QD + dd * 8), qb = *(const LAS f32x4*)(QD + dd * 8 + 4), ka = *(const LAS f32x4*)(KD + dd * 8), kb = *(const LAS f32x4*)(KD + dd * 8 + 4); \
          const float gm = GD[dd]; const f32x4 x = cur[i]; \
          o[0] += x * qa.x; o[1] += x * qa.y; o[2] += x * qa.z; o[3] += x * qa.w; o[4] += x * qb.x; o[5] += x * qb.y; o[6] += x * qb.z; o[7] += x * qb.w; \
          f32x4 sn = x * gm; sn += v[0] * ka.x; sn += v[1] * ka.y; sn += v[2] * ka.z; sn += v[3] * ka.w; sn += v[4] * kb.x; sn += v[5] * kb.y; sn += v[6] * kb.z; sn += v[7] * kb.w; \
          *(GAS f32x4*)(S1p + (size_t)((d0) + i) * 512) = sn; } } while (0)
#pragma unroll 1
      for (int d0 = 0; d0 < 64; d0 += 8) { GS_STEP(sa, sb, d0, true); GS_STEP(sb, sa, d0 + 4, d0 + 8 < 64); }
#undef GS_STEP
#pragma unroll
      for (int t = 0; t < 8; ++t) *(LAS f32x4*)(OP + (dq * 8 + t) * 512 + 4 * eq) = o[t];
    }
    __syncthreads();
    { const int t = tid >> 6, el = tid & 63; bf16* A2 = (bf16*)(P.ws + WS_BUFA); const bf16* SR = (const bf16*)(P.ws + WS_SR);
      float ov[8]; float ss = 0.f;
#pragma unroll
      for (int j = 0; j < 8; ++j) { const int e = el + 64 * j; float acc = (OP[(0 * 8 + t) * 512 + e] + OP[(1 * 8 + t) * 512 + e]) + (OP[(2 * 8 + t) * 512 + e] + OP[(3 * 8 + t) * 512 + e]);
#pragma unroll
          for (int s = 0; s < 8; ++s) acc += PR[t * 8 + s] * VL[s * 512 + e];
          ov[j] = acc; ss += acc * acc; }
      const float rs = 1.0f / sqrtf(wave_sum(ss) * (1.f / 512.f) + RMS_EPS);
#pragma unroll
      for (int j = 0; j < 8; ++j) { const size_t off = (size_t)(row0 + t) * DM + h * 512 + el + 64 * j; A2[off] = (bf16)(cvtpk2(ov[j] * rs * bf2f(SR[off]), 0.f) & 0xffffu); } }
    __syncthreads();
}

__device__ __forceinline__ void gate_rows(const Ptrs& P, int lane, int m0, int step, int mend) {
    bf16* O0 = (bf16*)(P.ws + WS_BUFA); const bf16* O1 = (const bf16*)(P.ws + WS_QK); const bf16* SR = (const bf16*)(P.ws + WS_SR);
    v4u a0[4], b0[4], s0[4], a1[4], b1[4], s1[4];
#define GR_LD(a, bq, s, m) do { _Pragma("unroll") for (int j = 0; j < 4; ++j) { const size_t off_ = (size_t)(m) * DM + 512 * j + 8 * lane; a[j] = *(const GAS v4u*)(O0 + off_); bq[j] = *(const GAS v4u*)(O1 + off_); s[j] = *(const GAS v4u*)(SR + off_); } } while (0)
#define GR_DO(a, bq, s, m) do { _Pragma("unroll") for (int j = 0; j < 4; ++j) { const size_t off_ = (size_t)(m) * DM + 512 * j + 8 * lane; float o[8]; \
        o[0] = __uint_as_float(a[j].x << 16) + __uint_as_float(bq[j].x << 16); o[1] = __uint_as_float(a[j].x & 0xffff0000u) + __uint_as_float(bq[j].x & 0xffff0000u); \
        o[2] = __uint_as_float(a[j].y << 16) + __uint_as_float(bq[j].y << 16); o[3] = __uint_as_float(a[j].y & 0xffff0000u) + __uint_as_float(bq[j].y & 0xffff0000u); \
        o[4] = __uint_as_float(a[j].z << 16) + __uint_as_float(bq[j].z << 16); o[5] = __uint_as_float(a[j].z & 0xffff0000u) + __uint_as_float(bq[j].z & 0xffff0000u); \
        o[6] = __uint_as_float(a[j].w << 16) + __uint_as_float(bq[j].w << 16); o[7] = __uint_as_float(a[j].w & 0xffff0000u) + __uint_as_float(bq[j].w & 0xffff0000u); \
        const float ss_ = ((o[0] * o[0] + o[1] * o[1]) + (o[2] * o[2] + o[3] * o[3])) + ((o[4] * o[4] + o[5] * o[5]) + (o[6] * o[6] + o[7] * o[7])); \
        const float rs_ = 1.0f / sqrtf(wave_sum(ss_) * (1.f / 512.f) + RMS_EPS); v4u w; \
        w.x = cvtpk2(o[0] * rs_ * __uint_as_float(s[j].x << 16), o[1] * rs_ * __uint_as_float(s[j].x & 0xffff0000u)); w.y = cvtpk2(o[2] * rs_ * __uint_as_float(s[j].y << 16), o[3] * rs_ * __uint_as_float(s[j].y & 0xffff0000u)); \
        w.z = cvtpk2(o[4] * rs_ * __uint_as_float(s[j].z << 16), o[5] * rs_ * __uint_as_float(s[j].z & 0xffff0000u)); w.w = cvtpk2(o[6] * rs_ * __uint_as_float(s[j].w << 16), o[7] * rs_ * __uint_as_float(s[j].w & 0xffff0000u)); \
        *(GAS v4u*)(O0 + off_) = w; } } while (0)
    if (m0 < mend) GR_LD(a0, b0, s0, m0);
#pragma unroll 1
    for (int m = m0; m < mend; m += 2 * step) {
        if (m + step < mend) GR_LD(a1, b1, s1, m + step);
        GR_DO(a0, b0, s0, m);
        if (m + step < mend) { if (m + 2 * step < mend) GR_LD(a0, b0, s0, m + 2 * step); GR_DO(a1, b1, s1, m + step); }
    }
#undef GR_LD
#undef GR_DO
}
__device__ __forceinline__ void final_rows(float* base, const float* gfin, int lane, int m0, int step, int mend) {
    const GAS f32x4* gr = (const GAS f32x4*)gfin + lane;
    f32x4 va[8], vb[8];
    if (m0 < mend) { const GAS f32x4* xr = (const GAS f32x4*)(base + (size_t)m0 * DM) + lane;
#pragma unroll
        for (int j = 0; j < 8; ++j) va[j] = xr[64 * j]; }
#define FR_STEP(cur, nxt, m) do { const int mn_ = (m) + step; if (mn_ < mend) { const GAS f32x4* xn_ = (const GAS f32x4*)(base + (size_t)mn_ * DM) + lane; _Pragma("unroll") for (int j = 0; j < 8; ++j) nxt[j] = xn_[64 * j]; } \
        float s_ = 0.f; _Pragma("unroll") for (int j = 0; j < 8; ++j) s_ += (cur[j].x * cur[j].x + cur[j].y * cur[j].y) + (cur[j].z * cur[j].z + cur[j].w * cur[j].w); \
        const float rstd_ = 1.0f / sqrtf(wave_sum(s_) * (1.f / DM) + RMS_EPS); GAS f32x4* dr_ = (GAS f32x4*)(base + (size_t)(m) * DM) + lane; \
        _Pragma("unroll") for (int j = 0; j < 8; ++j) dr_[64 * j] = cur[j] * rstd_ * gr[64 * j]; } while (0)
#pragma unroll 1
    for (int m = m0; m < mend; m += 2 * step) { FR_STEP(va, vb, m); if (m + step < mend) FR_STEP(vb, va, m + step); }
#undef FR_STEP
}
__device__ __forceinline__ void final_row(float* hrow, const float* gfin, int lane, float* drow) {
    GAS f32x4* xr = (GAS f32x4*)hrow + lane; GAS f32x4* dr = (GAS f32x4*)drow + lane; const GAS f32x4* gr = (const GAS f32x4*)gfin + lane;
    f32x4 v[8]; float s = 0.f;
#pragma unroll
    for (int j = 0; j < 8; ++j) { v[j] = xr[64 * j]; s += (v[j].x * v[j].x + v[j].y * v[j].y) + (v[j].z * v[j].z + v[j].w * v[j].w); }
    const float rstd = 1.0f / sqrtf(wave_sum(s) * (1.f / DM) + RMS_EPS);
#pragma unroll
    for (int j = 0; j < 8; ++j) dr[64 * j] = v[j] * rstd * gr[64 * j];
}

__device__ __forceinline__ void attn_subblock(const LAS bf16* KI, const LAS bf16* VI, int ts, const bf16x8 q0, const bf16x8 q1, int qpos, int kpos0, float slope2, float sink2,
                                              const u32x2 (&zz)[4], bf16* orow, bool store, int lane) {
    const int r = lane & 15, g = lane >> 4;
    f32x4 sc[10]; float mx = -INFINITY;
    const int D = qpos - (kpos0 + 16 * ts + 4 * g); const unsigned U = (unsigned)(qpos < 128 ? qpos : 128);
    const float c0 = -slope2 * (float)D; const f32x4 cinit = {c0, c0, c0, c0};
    { bf16x8 ka[10], kb[10];
      const LAS bf16* kr0 = KI + (16 * ts + r) * 80 + 8 * g;
#pragma unroll
      for (int i = 0; i < 5; ++i) { ka[2 * i] = *(const LAS bf16x8*)(kr0 + i * 1280); ka[2 * i + 1] = *(const LAS bf16x8*)(kr0 + i * 1280 + 32); }
      __builtin_amdgcn_sched_barrier(0);
#pragma unroll
      for (int i = 0; i < 5; ++i) { kb[2 * i] = *(const LAS bf16x8*)(kr0 + (5 + i) * 1280); kb[2 * i + 1] = *(const LAS bf16x8*)(kr0 + (5 + i) * 1280 + 32); }
#pragma unroll
      for (int i = 0; i < 5; ++i) { f32x4 a = MFMA16(ka[2 * i], q0, cinit); sc[i] = MFMA16(ka[2 * i + 1], q1, a); }
      __builtin_amdgcn_sched_barrier(0);
#pragma unroll
      for (int i = 0; i < 5; ++i) { f32x4 a = MFMA16(kb[2 * i], q0, cinit); sc[5 + i] = MFMA16(kb[2 * i + 1], q1, a); } }
#pragma unroll
    for (int i = 0; i < 10; ++i) {
#pragma unroll
        for (int e = 0; e < 4; ++e) { const unsigned dist = (unsigned)(D - (16 * i + e));
            const float v = dist <= U ? __builtin_fmaf(slope2, (float)(16 * i + e), sc[i][e]) : -INFINITY; sc[i][e] = v; mx = fmaxf(mx, v); } }
    mx = fmaxf(mx, __shfl_xor(mx, 16)); mx = fmaxf(mx, __shfl_xor(mx, 32)); mx = fmaxf(mx, sink2);
    float l = 0.f;
#pragma unroll
    for (int i = 0; i < 10; ++i)
#pragma unroll
        for (int e = 0; e < 4; ++e) { const float p = __builtin_amdgcn_exp2f(sc[i][e] - mx); sc[i][e] = p; l += p; }
    l += __shfl_xor(l, 16); l += __shfl_xor(l, 32);
    const float inv = 1.0f / (l + __builtin_amdgcn_exp2f(sink2 - mx));
    f32x4 o[4];
#pragma unroll
    for (int dt = 0; dt < 4; ++dt) o[dt] = (f32x4){0.f, 0.f, 0.f, 0.f};
    { const LAS bf16* vr0 = VI + r * 264 + 16 * ts + 4 * g;
#define AT_VRD(dst, ks) do { _Pragma("unroll") for (int dt = 0; dt < 4; ++dt) { const LAS bf16* vr = vr0 + dt * 4224 + (ks) * 32; \
          const u32x2 lo = *(const LAS u32x2*)vr, hi = *(const LAS u32x2*)(vr + 16); dst[dt].x = lo.x; dst[dt].y = lo.y; dst[dt].z = hi.x; dst[dt].w = hi.y; } } while (0)
#define AT_PV(src, ks) do { v4u pp; pp.x = cvtpk2(sc[2 * (ks)][0], sc[2 * (ks)][1]); pp.y = cvtpk2(sc[2 * (ks)][2], sc[2 * (ks)][3]); pp.z = cvtpk2(sc[2 * (ks) + 1][0], sc[2 * (ks) + 1][1]); pp.w = cvtpk2(sc[2 * (ks) + 1][2], sc[2 * (ks) + 1][3]); \
          const bf16x8 pb = __builtin_bit_cast(bf16x8, pp); _Pragma("unroll") for (int dt = 0; dt < 4; ++dt) o[dt] = MFMA16(__builtin_bit_cast(bf16x8, src[dt]), pb, o[dt]); } while (0)
      v4u va[4], vb[4];
      AT_VRD(va, 0); AT_VRD(vb, 1);
      __builtin_amdgcn_sched_barrier(0);
      AT_PV(va, 0); AT_VRD(va, 2);
      __builtin_amdgcn_sched_barrier(0);
      AT_PV(vb, 1); AT_VRD(vb, 3);
      __builtin_amdgcn_sched_barrier(0);
      AT_PV(va, 2); AT_VRD(va, 4);
      __builtin_amdgcn_sched_barrier(0);
      AT_PV(vb, 3);
      __builtin_amdgcn_sched_barrier(0);
      AT_PV(va, 4);
#undef AT_VRD
#undef AT_PV
    }
    if (store) {
#pragma unroll
        for (int dt = 0; dt < 4; ++dt) {
            u32x2 w; w.x = cvtpk2(o[dt][0] * inv * __uint_as_float(zz[dt].x << 16), o[dt][1] * inv * __uint_as_float(zz[dt].x & 0xffff0000u));
            w.y = cvtpk2(o[dt][2] * inv * __uint_as_float(zz[dt].y << 16), o[dt][3] * inv * __uint_as_float(zz[dt].y & 0xffff0000u));
            *(GAS u32x2*)(orow + 16 * dt + 4 * g) = w; }
    }
}
__device__ __forceinline__ void attn_prompt_unit(const Ptrs& P, LAS unsigned char* lds, int u, int tid, int wave, int lane) {
    const int kvh = u & 3, qb = (u >> 2) & 15, b = u >> 6;
    LAS bf16* KI = (LAS bf16*)lds;
    LAS bf16* VI = (LAS bf16*)(lds + 40960);
    const bf16* KB = (const bf16*)(P.ws + WS_KB); const bf16* VT2 = (const bf16*)(P.ws + WS_VT2); const bf16* QZ = (const bf16*)(P.ws + WS_QZ); bf16* A3 = (bf16*)(P.ws + WS_BUFA);
    const int kpos0 = (qb - 1) * 128;
    for (int i = tid; i < 2048; i += NWAVES * 64) { const int j = i >> 3, ch = i & 7; const int kpos = kpos0 + j;
        v4u v = {0u, 0u, 0u, 0u}; if (kpos >= 0) v = *(const GAS v4u*)(KB + (size_t)(b * 2048 + kpos) * 256 + kvh * 64 + ch * 8);
        *(LAS v4u*)(KI + j * 80 + ch * 8) = v; }
    for (int i = tid; i < 2048; i += NWAVES * 64) { const int d = i >> 5, ch = i & 31; const int kpos = kpos0 + ch * 8;
        v4u v = {0u, 0u, 0u, 0u}; if (kpos >= 0) v = *(const GAS v4u*)(VT2 + (size_t)(kvh * 64 + d) * MT + b * 2048 + kpos);
        *(LAS v4u*)(VI + d * 264 + ch * 8) = v; }
    __syncthreads();
    const int hh = kvh * 8 + wave;
    const float slope2 = __builtin_amdgcn_exp2f(-0.25f * (float)(hh + 1)) * LOG2E, sink2 = P.sinks[hh] * LOG2E;
    { const int g = lane >> 4; const bf16* qz0 = QZ + ((size_t)b * 2048 + qb * 128 + (lane & 15)) * 4096 + hh * 64;
      bf16x8 qc0 = *(const bf16x8*)(qz0 + 8 * g), qc1 = *(const bf16x8*)(qz0 + 32 + 8 * g);
#pragma unroll 1
      for (int qs = 0; qs < 8; ++qs) { const int qpos = qb * 128 + 16 * qs + (lane & 15); const size_t row = (size_t)b * 2048 + qpos;
          const bf16* qzr = qz0 + (size_t)qs * 16 * 4096;
          u32x2 zz[4];
#pragma unroll
          for (int dt = 0; dt < 4; ++dt) zz[dt] = *(const GAS u32x2*)(qzr + 2048 + 16 * dt + 4 * g);
          const bf16* qzn = qzr + (qs < 7 ? 16 * 4096 : 0);
          const bf16x8 qn0 = *(const bf16x8*)(qzn + 8 * g), qn1 = *(const bf16x8*)(qzn + 32 + 8 * g);
          attn_subblock(KI, VI, qs < 6 ? qs : 6, qc0, qc1, qpos, kpos0, slope2, sink2, zz, A3 + row * DM + hh * 64, true, lane);
          qc0 = qn0; qc1 = qn1; } }
    __syncthreads();
}
__device__ __forceinline__ void attn_sample_unit(const Ptrs& P, LAS unsigned char* lds, int u, int tid, int wave, int lane) {
    const int kvh = u & 3, b = u >> 2;
    LAS bf16* KI = (LAS bf16*)lds;
    LAS bf16* VI = (LAS bf16*)(lds + 40960);
    const bf16* KB = (const bf16*)(P.ws + WS_KB); const bf16* VT2 = (const bf16*)(P.ws + WS_VT2); const bf16* QZ = (const bf16*)(P.ws + WS_QZ); bf16* A3 = (bf16*)(P.ws + WS_BUFA);
    for (int i = tid; i < 160 * 64; i += NWAVES * 64) { const int j = i >> 6, d = i & 63; float kv = 0.f, vv = 0.f;
        if (j < 128) { kv = P.ck[((size_t)(b * 128 + j) * 4 + kvh) * 64 + d]; vv = P.cv[((size_t)(b * 128 + j) * 4 + kvh) * 64 + d]; }
        else if (j < 136) { kv = bf2f(KB[(size_t)(MPR + b * 8 + j - 128) * 256 + kvh * 64 + d]); vv = bf2f(VT2[(size_t)(kvh * 64 + d) * MT + MPR + b * 8 + j - 128]); }
        KI[j * 80 + d] = (bf16)(cvtpk2(kv, 0.f) & 0xffffu); VI[d * 264 + j] = (bf16)(cvtpk2(vv, 0.f) & 0xffffu); }
    __syncthreads();
    const int hh = kvh * 8 + wave;
    const float slope2 = __builtin_amdgcn_exp2f(-0.25f * (float)(hh + 1)) * LOG2E, sink2 = P.sinks[hh] * LOG2E;
    const int n = lane & 15, qi = n < 8 ? n : 7; const size_t row = (size_t)MPR + b * 8 + qi;
    { const int g = lane >> 4; const bf16* qzr = QZ + row * 4096 + hh * 64; u32x2 zz[4];
#pragma unroll
      for (int dt = 0; dt < 4; ++dt) zz[dt] = *(const GAS u32x2*)(qzr + 2048 + 16 * dt + 4 * g);
      attn_subblock(KI, VI, 0, *(const bf16x8*)(qzr + 8 * g), *(const bf16x8*)(qzr + 32 + 8 * g), 128 + qi, 0, slope2, sink2, zz, A3 + row * DM + hh * 64, n < 8, lane); }
    __syncthreads();
}
constexpr int SG_A = 0, SG_B = 10240, SG_STAGE = 30720, SG_RS = 2 * SG_STAGE;
template <bool NAT>
__device__ __forceinline__ void sgemm_core(LAS unsigned char* lds, const bf16* A, const bf16* B, f32x4 (&acc)[2][2], int tid, int wave, int lane) {
    const int wm = wave >> 2, wn = wave & 3, r = lane & 15, g = lane >> 4, lr = tid >> 3, ch = tid & 7;
    const GAS v4u* ga = (const GAS v4u*)(A + (size_t)lr * 2048 + ch * 8); const GAS v4u* gb0 = (const GAS v4u*)(B + (size_t)lr * 2048 + ch * 8); const GAS v4u* gb1 = (const GAS v4u*)(B + (size_t)(64 + lr) * 2048 + ch * 8);
    v4u ra0, rb0, rc0, ra1, rb1, rc1, ra2, rb2, rc2, ra3, rb3, rc3;
#pragma unroll
    for (int i = 0; i < 2; ++i)
#pragma unroll
        for (int j = 0; j < 2; ++j) acc[i][j] = (f32x4){0.f, 0.f, 0.f, 0.f};
#define SG_LD(s, kt) do { ra##s = ga[(kt) * 8]; rb##s = gb0[(kt) * 8]; rc##s = gb1[(kt) * 8]; } while (0)
#define SG_ST(s, stg) do { *(LAS v4u*)(lds + (stg) * SG_STAGE + SG_A + lr * 160 + ch * 16) = ra##s; *(LAS v4u*)(lds + (stg) * SG_STAGE + SG_B + lr * 160 + ch * 16) = rb##s; \
                           *(LAS v4u*)(lds + (stg) * SG_STAGE + SG_B + (64 + lr) * 160 + ch * 16) = rc##s; } while (0)
#define SG_COMPUTE(stg) do { _Pragma("unroll") for (int kk = 0; kk < 2; ++kk) { bf16x8 af[2], bfr[2]; \
        _Pragma("unroll") for (int i = 0; i < 2; ++i) af[i] = *(const LAS bf16x8*)(lds + (stg) * SG_STAGE + SG_A + (32 * wm + 16 * i + r) * 160 + (32 * kk + 8 * g) * 2); \
        _Pragma("unroll") for (int j = 0; j < 2; ++j) bfr[j] = *(const LAS bf16x8*)(lds + (stg) * SG_STAGE + SG_B + (32 * wn + 16 * j + r) * 160 + (32 * kk + 8 * g) * 2); \
        _Pragma("unroll") for (int i = 0; i < 2; ++i) _Pragma("unroll") for (int j = 0; j < 2; ++j) acc[i][j] = NAT ? MFMA16(af[i], bfr[j], acc[i][j]) : MFMA16(bfr[j], af[i], acc[i][j]); } } while (0)
#define SG_STEP(kt, s, stg) do { SG_COMPUTE(stg); if ((kt) + 1 < 32) SG_ST(s, (stg) ^ 1); if ((kt) + 5 < 32) SG_LD(s, (kt) + 5); __syncthreads(); } while (0)
    SG_LD(0, 0); SG_LD(1, 1); SG_LD(2, 2); SG_LD(3, 3); SG_ST(0, 0); SG_LD(0, 4);
    __syncthreads();
#pragma unroll 1
    for (int kt = 0; kt < 32; kt += 4) { SG_STEP(kt, 1, 0); SG_STEP(kt + 1, 2, 1); SG_STEP(kt + 2, 3, 0); SG_STEP(kt + 3, 0, 1); }
#undef SG_STEP
#undef SG_LD
#undef SG_ST
#undef SG_COMPUTE
}
template <bool SILU>
__device__ __forceinline__ void sg_store_bf16(const f32x4 (&acc)[2][2], bf16* dst, int ld, int wave, int lane, float rs0, float rs1) {
    const int wm = wave >> 2, wn = wave & 3, r = lane & 15, g = lane >> 4;
#pragma unroll
    for (int i = 0; i < 2; ++i)
#pragma unroll
        for (int j = 0; j < 2; ++j) { f32x4 v = acc[i][j] * (i ? rs1 : rs0);
            if (SILU) { v[0] = pg8::silu_f(v[0]); v[1] = pg8::silu_f(v[1]); v[2] = pg8::silu_f(v[2]); v[3] = pg8::silu_f(v[3]); }
            u32x2 w; w.x = cvtpk2(v[0], v[1]); w.y = cvtpk2(v[2], v[3]);
            *(GAS u32x2*)(dst + (size_t)(32 * wm + 16 * i + r) * ld + 32 * wn + 16 * j + 4 * g) = w; }
}
__device__ __forceinline__ void s_in_a_block(const Ptrs& P, LAS unsigned char* lds, int rb, int nbk, int tid, int wave, int lane) {
    const bf16* A = (const bf16*)(P.ws + WS_BUFA) + (size_t)(MPR + 64 * rb) * DM; const bf16* B = (const bf16*)(P.ws + WS_WINA) + (size_t)(128 * nbk) * DM;
    f32x4 acc[2][2];
    if (nbk >= 16 && nbk < 32) {
        sgemm_core<true>(lds, A, B, acc, tid, wave, lane);
        const int wm = wave >> 2, wn = wave & 3, r = lane & 15, g = lane >> 4; bf16* VT = (bf16*)(P.ws + WS_VT);
#pragma unroll
        for (int i = 0; i < 2; ++i)
#pragma unroll
            for (int j = 0; j < 2; ++j) { u32x2 w; w.x = cvtpk2(acc[i][j][0], acc[i][j][1]); w.y = cvtpk2(acc[i][j][2], acc[i][j][3]);
                *(GAS u32x2*)(VT + (size_t)((nbk - 16) * 128 + 32 * wn + 16 * j + r) * MT + MPR + 64 * rb + 32 * wm + 16 * i + 4 * g) = w; }
    } else {
        sgemm_core<false>(lds, A, B, acc, tid, wave, lane);
        if (nbk < 16) sg_store_bf16<false>(acc, (bf16*)(P.ws + WS_QK) + (size_t)(MPR + 64 * rb) * DM + nbk * 128, DM, wave, lane, 1.f, 1.f);
        else sg_store_bf16<true>(acc, (bf16*)(P.ws + WS_SR) + (size_t)(MPR + 64 * rb) * DM + (nbk - 32) * 128, DM, wave, lane, 1.f, 1.f);
    }
}
template <bool WITH_B16>
__device__ __forceinline__ void s_out_block(const Ptrs& P, LAS unsigned char* lds, const bf16* Abase, const bf16* Wt, const float* res, int rb, int nb, int tid, int wave, int lane) {
    f32x4 acc[2][2];
    sgemm_core<false>(lds, Abase + (size_t)(64 * rb) * DM, Wt + (size_t)(128 * nb) * DM, acc, tid, wave, lane);
    const int wm = wave >> 2, wn = wave & 3, r = lane & 15, g = lane >> 4;
    float* out = P.out + OUT_Y + (size_t)MPR * DM; bf16* H1b = (bf16*)(P.ws + WS_SR) + (size_t)MPR * DM; float* SSQ2 = (float*)(P.ws + WS_SSQP);
#pragma unroll
    for (int i = 0; i < 2; ++i) { const int row = 64 * rb + 32 * wm + 16 * i + r; float ss = 0.f;
#pragma unroll
        for (int j = 0; j < 2; ++j) { const size_t off = (size_t)row * DM + 128 * nb + 32 * wn + 16 * j + 4 * g;
            const f32x4 v = *(const GAS f32x4*)(res + off) + acc[i][j]; *(GAS f32x4*)(out + off) = v;
            if (WITH_B16) { u32x2 w; w.x = cvtpk2(v[0], v[1]); w.y = cvtpk2(v[2], v[3]); *(GAS u32x2*)(H1b + off) = w; ss += (v[0] * v[0] + v[1] * v[1]) + (v[2] * v[2] + v[3] * v[3]); } }
        if (WITH_B16) { ss += __shfl_xor(ss, 16); ss += __shfl_xor(ss, 32); if (g == 0) SSQ2[(size_t)row * 64 + nb * 4 + wn] = ss; } }
}
__device__ __forceinline__ void s_in_b_block(const Ptrs& P, LAS unsigned char* lds, int rb, int nbk, int tid, int wave, int lane) {
    const bf16* A = (const bf16*)(P.ws + WS_SR) + (size_t)(MPR + 64 * rb) * DM; const bf16* B = (const bf16*)(P.ws + WS_WINB) + (size_t)(128 * nbk) * DM;
    LAS float* RS = (LAS float*)(lds + SG_RS);
    { const int row = tid >> 3, part = tid & 7; const float* sp = (const float*)(P.ws + WS_SSQP) + (size_t)(64 * rb + row) * 64 + part * 8;
      const f32x4 a = *(const GAS f32x4*)sp, b = *(const GAS f32x4*)(sp + 4); float s = (a[0] + a[1]) + (a[2] + a[3]) + (b[0] + b[1]) + (b[2] + b[3]);
      s += __shfl_xor(s, 1); s += __shfl_xor(s, 2); s += __shfl_xor(s, 4);
      if (part == 0) RS[row] = 1.0f / sqrtf(s * (1.f / DM) + RMS_EPS); }
    f32x4 acc[2][2];
    const int wm = wave >> 2, wn = wave & 3, r = lane & 15, g = lane >> 4;
    if (nbk >= 34) {
        sgemm_core<true>(lds, A, B, acc, tid, wave, lane);
        bf16* VT2 = (bf16*)(P.ws + WS_VT2); float* vws = P.out + OUT_VWS;
#pragma unroll
        for (int i = 0; i < 2; ++i) { const f32x4 rs = *(const LAS f32x4*)(RS + 32 * wm + 16 * i + 4 * g);
#pragma unroll
            for (int j = 0; j < 2; ++j) { const f32x4 v = acc[i][j] * rs; const int col = (nbk - 34) * 128 + 32 * wn + 16 * j + r; const int srow = 64 * rb + 32 * wm + 16 * i + 4 * g;
                u32x2 w; w.x = cvtpk2(v[0], v[1]); w.y = cvtpk2(v[2], v[3]);
                *(GAS u32x2*)(VT2 + (size_t)col * MT + MPR + srow) = w;
#pragma unroll
                for (int e = 0; e < 4; ++e) { const int s = srow + e; vws[((size_t)(s >> 3) * 128 + 120 + (s & 7)) * 256 + col] = v[e]; } } }
    } else {
        sgemm_core<false>(lds, A, B, acc, tid, wave, lane);
        const float rs0 = RS[32 * wm + r], rs1 = RS[32 * wm + 16 + r];
        if (nbk < 16) sg_store_bf16<false>(acc, (bf16*)(P.ws + WS_QZ) + (size_t)(MPR + 64 * rb) * 4096 + nbk * 128, 4096, wave, lane, rs0, rs1);
        else if (nbk < 32) sg_store_bf16<true>(acc, (bf16*)(P.ws + WS_QZ) + (size_t)(MPR + 64 * rb) * 4096 + nbk * 128, 4096, wave, lane, rs0, rs1);
        else { sg_store_bf16<false>(acc, (bf16*)(P.ws + WS_KB) + (size_t)(MPR + 64 * rb) * 256 + (nbk - 32) * 128, 256, wave, lane, rs0, rs1);
            float* kws = P.out + OUT_KWS;
#pragma unroll
            for (int i = 0; i < 2; ++i) { const int s = 64 * rb + 32 * wm + 16 * i + r; float* d = kws + ((size_t)(s >> 3) * 128 + 120 + (s & 7)) * 256 + (nbk - 32) * 128 + 32 * wn + 4 * g;
#pragma unroll
                for (int j = 0; j < 2; ++j) *(GAS f32x4*)(d + 16 * j) = acc[i][j] * (i ? rs1 : rs0); } }
    }
}
#ifndef MK_N_LAUNCHES
#define MK_N_LAUNCHES 1
#endif
constexpr int N_PHASES = 11;
constexpr int N_LAUNCHES = MK_N_LAUNCHES;
struct Args { Ptrs p; int ph_lo, ph_hi; };
static_assert(sizeof(Args) == 20 * 8 + 8, "Args has no padding");

__global__ void __launch_bounds__(NWAVES * 64, 2) yoco_fwd(Args args) {
    extern __shared__ __attribute__((aligned(16))) unsigned char lds_raw[];
    LAS unsigned char* lds = (LAS unsigned char*)lds_raw;
    volatile LAS unsigned* MISC = (volatile LAS unsigned*)(lds + MISC_OFF);
    const int tid = threadIdx.x, lane = tid & 63, wave = __builtin_amdgcn_readfirstlane(tid >> 6);
    const int G = gridDim.x, c = blockIdx.x;
    const int vcu = (G % 8 == 0) ? (c % 8) * (G / 8) + c / 8 : c;
    const Ptrs& P = args.p;
    gu32* ctl = (gu32*)(P.ws + WS_CTL);
    for (int u = tid; u < (LDS_BYTES - LDSCTL_OFF) / 4; u += NWAVES * 64) ((LAS unsigned*)(lds + LDSCTL_OFF))[u] = 0u;
    __syncthreads();
    XcdBarrier bar; bar.bar = (unsigned*)(ctl + CW_BAR); bar.x = 0; bar.st = nullptr;
    const int lo = args.ph_lo, hi = args.ph_hi;
    if (hi - lo > 1) bar = xcd_barrier_post((unsigned*)(ctl + CW_BAR), MISC + 8);
#define IN(k) (lo <= (k) && (k) < hi)
#define SEAM(k) do { if (IN(k) && IN((k) + 1)) xcd_barrier(bar); } while (0)
    const int gw = vcu * NWAVES + wave, NGW = G * NWAVES;

    if (IN(0)) { p0_prologue(P, lds, vcu, G, tid, wave, lane); SEAM(0); }

    if (IN(1)) {
        pg8::SchedInA S{G, c, (const char*)(P.ws + WS_BUFA), (const char*)(P.ws + WS_WINA)};
        pg8::EpiInA E{(pg8::bf16_t*)(P.ws + WS_QK), (pg8::bf16_t*)(P.ws + WS_SR), (pg8::bf16_t*)(P.ws + WS_VT), MT};
        const bool early_glow = G == 256 && (c & 8);
        if (early_glow) { const int slot = ((c >> 4) * 8 + (c & 7)) * NWAVES + wave; if (slot < MT / 16) glow_task((const bf16*)(P.ws + WS_BUFA), (const bf16*)(P.ws + WS_WINA) + (size_t)6144 * DM, (float*)(P.ws + WS_GLOW), slot, lane); __syncthreads(); }
        pg8::gemm_phase<pg8::EpiInA, pg8::SchedInA, true, true>(lds, 2048, S, E);
        if (G != 256) for (int task = c * NWAVES + wave; task < MT / 16; task += NGW)
            glow_task((const bf16*)(P.ws + WS_BUFA), (const bf16*)(P.ws + WS_WINA) + (size_t)6144 * DM, (float*)(P.ws + WS_GLOW), task, lane);
        SEAM(1);
    }

    if (IN(2)) {
        for (int blk = c; blk < 192; blk += G) s_in_a_block(P, lds, blk / 48, blk % 48, tid, wave, lane);
        if (G == 256) { for (int j = 0; j < 2; ++j) gla_prep_unit(P, lds, (2 * (c & 7) + j) * 32 + (c >> 3), tid, wave, lane); }
        else for (int u = c; u < 512; u += G) gla_prep_unit(P, lds, u, tid, wave, lane);
        SEAM(2);
    }

    if (IN(3)) {
        if (G >= 256) {
            constexpr int CV_A = 1408;
            if (c < 128) { const int xcd = c & 7, idx = c >> 3; gla_scan_unit(P, lds, xcd * 2 + (idx >> 3), (idx >> 2) & 1, idx & 3, tid, wave, lane);
                convert_weights(P, lds, 1, CV_A + c * NWAVES + wave, 128 * NWAVES, 2176, wave, lane); }
            else { gla_sample_unit(P, lds, c - 128, tid, wave, lane);
                convert_weights(P, lds, 1, (c - 128) * NWAVES + wave, 128 * NWAVES, CV_A, wave, lane); }
        } else {
            for (int u = c; u < 128; u += G) gla_scan_unit(P, lds, u >> 3, (u >> 2) & 1, u & 3, tid, wave, lane);
            for (int t = c; t < 128; t += G) gla_sample_unit(P, lds, t, tid, wave, lane);
        }
        SEAM(3);
    }

    if (IN(4)) {
        const int NS = G >= 128 ? 64 : 0;
        constexpr int GR0 = 8192;
        if (c < NS) { for (int blk = c; blk < 64; blk += NS) s_out_block<true>(P, lds, (const bf16*)(P.ws + WS_BUFA) + (size_t)MPR * DM, (const bf16*)(P.ws + WS_WOA), P.x_sample, blk >> 4, blk & 15, tid, wave, lane);
            gate_rows(P, lane, GR0 + c * NWAVES + wave, NS * NWAVES, MPR); }
        else { gate_rows(P, lane, (c - NS) * NWAVES + wave, (G - NS) * NWAVES, NS ? GR0 : MPR);
            if (NS == 0) { __syncthreads(); for (int blk = c; blk < 64; blk += G) s_out_block<true>(P, lds, (const bf16*)(P.ws + WS_BUFA) + (size_t)MPR * DM, (const bf16*)(P.ws + WS_WOA), P.x_sample, blk >> 4, blk & 15, tid, wave, lane); } }
        SEAM(4);
    }

    if (IN(5)) {
        pg8::SchedOut S{G, c, (const char*)(P.ws + WS_BUFA), (const char*)(P.ws + WS_WOA)};
        pg8::EpiOutA E{P.x_prompt, (pg8::bf16_t*)(P.ws + WS_SR), (float*)(P.ws + WS_SSQ1)};
        pg8::gemm_phase<pg8::EpiOutA, pg8::SchedOut, true, true>(lds, 2048, S, E);
        SEAM(5);
    }

    if (IN(6)) {
        pg8::SchedInB S{G, c, (const char*)(P.ws + WS_SR), (const char*)(P.ws + WS_WINB), (const float*)(P.ws + WS_SSQ1), (LAS float*)(lds + TAB_OFF)};
        pg8::EpiInB E{(pg8::bf16_t*)(P.ws + WS_QZ), (pg8::bf16_t*)(P.ws + WS_KB), (pg8::bf16_t*)(P.ws + WS_VT2), MT, P.out + OUT_KWP, P.out + OUT_VWP, P.out + OUT_KWS, P.out + OUT_VWS, (const LAS float*)(lds + TAB_OFF)};
        pg8::gemm_phase<pg8::EpiInB, pg8::SchedInB, true, true>(lds, 2048, S, E);
        for (int blk = (c + G - (64 % G)) % G; blk < 144; blk += G) s_in_b_block(P, lds, blk / 36, blk % 36, tid, wave, lane);
        SEAM(6);
    }

    if (IN(7)) {
        for (int u = c; u < 256; u += G) attn_prompt_unit(P, lds, u, tid, wave, lane);
        for (int u = c; u < 128; u += G) attn_sample_unit(P, lds, u, tid, wave, lane);
        SEAM(7);
    }

    if (IN(8)) {
        pg8::SchedOut S{G, c, (const char*)(P.ws + WS_BUFA), (const char*)(P.ws + WS_WOB)};
        pg8::EpiOutB E{(const pg8::bf16_t*)(P.ws + WS_SR), P.out + OUT_Y};
        pg8::gemm_phase<pg8::EpiOutB, pg8::SchedOut, true, true>(lds, 2048, S, E);
        SEAM(8);
    }

    if (IN(9)) {
        const int NS = G >= 128 ? 64 : 0;
        constexpr int FR0 = 8192;
        if (c < NS) { for (int blk = c; blk < 64; blk += NS) s_out_block<false>(P, lds, (const bf16*)(P.ws + WS_BUFA) + (size_t)MPR * DM, (const bf16*)(P.ws + WS_WOB), P.out + OUT_Y + (size_t)MPR * DM, blk >> 4, blk & 15, tid, wave, lane);
            final_rows(P.out + OUT_Y, P.g_final, lane, FR0 + c * NWAVES + wave, NS * NWAVES, MPR); }
        else { if (NS == 0) for (int blk = c; blk < 64; blk += G) s_out_block<false>(P, lds, (const bf16*)(P.ws + WS_BUFA) + (size_t)MPR * DM, (const bf16*)(P.ws + WS_WOB), P.out + OUT_Y + (size_t)MPR * DM, blk >> 4, blk & 15, tid, wave, lane);
            final_rows(P.out + OUT_Y, P.g_final, lane, (c - NS) * NWAVES + wave, (G - NS) * NWAVES, NS ? FR0 : MPR); }
        SEAM(9);
    }

    if (IN(10)) { for (int m = MPR + gw; m < MT; m += NGW) final_row(P.out + OUT_Y + (size_t)m * DM, P.g_final, lane, P.out + OUT_Y + (size_t)m * DM); }
#undef IN
#undef SEAM
}

extern "C" void kernel_launch(void* const* d_in, const int* in_sizes, int n_in, void* d_out, int out_size, void* d_ws, size_t ws_size, hipStream_t stream) {
    static int grid = 0;
    if (grid == 0) {
        if (n_in != 18 || (size_t)out_size != OUT_TOTAL || ws_size < WS_END) { fprintf(stderr, "kernel_launch: unexpected shapes (n_in %d, out %d, ws %zu); nothing launched\n", n_in, out_size, ws_size); grid = -1; return; }
        int dev = 0, cus = 0, per_cu = 0;
        if (hipGetDevice(&dev) != hipSuccess || hipDeviceGetAttribute(&cus, hipDeviceAttributeMultiprocessorCount, dev) != hipSuccess) { grid = -1; return; }
        if (hipFuncSetAttribute((const void*)yoco_fwd, hipFuncAttributeMaxDynamicSharedMemorySize, LDS_BYTES) != hipSuccess) { fprintf(stderr, "kernel_launch: hipFuncSetAttribute failed\n"); grid = -1; return; }
        if (hipOccupancyMaxActiveBlocksPerMultiprocessor(&per_cu, (const void*)yoco_fwd, NWAVES * 64, LDS_BYTES) != hipSuccess || per_cu < 1)
            fprintf(stderr, "kernel_launch: note: occupancy query reports %d workgroups per CU\n", per_cu);
        (void)hipGetLastError();
        grid = cus;
    }
    if (grid < 0) return;
    (void)hipMemsetAsync((char*)d_ws + WS_CTL, 0, CTL_ZERO_BYTES, stream);
    Args a{};
    const float** pp = (const float**)&a.p;
    for (int i = 0; i < 18; ++i) pp[i] = (const float*)d_in[i];
    a.p.out = (float*)d_out; a.p.ws = (unsigned char*)d_ws;
    for (int li = 0; li < N_LAUNCHES; ++li) {
        a.ph_lo = (N_LAUNCHES == 1) ? 0 : li; a.ph_hi = (N_LAUNCHES == 1) ? N_PHASES : li + 1;
        hipLaunchKernelGGL(yoco_fwd, dim3(grid), dim3(NWAVES * 64), LDS_BYTES, stream, a);
    }
}
```

```cpp
#include <hip/hip_runtime.h>
#include <cstdio>
#include <cstdint>
#include <cmath>
namespace pg8 {
#define PG8_LAS __attribute__((address_space(3)))
typedef unsigned short bf16_t;
typedef short bf16x8 __attribute__((ext_vector_type(8)));
typedef float f32x4 __attribute__((ext_vector_type(4)));
typedef unsigned u32x4 __attribute__((ext_vector_type(4)));
constexpr int BM = 256, BK = 64, HALF = 128, HTB = HALF * BK * 2  , STAGE_BYTES = 8 * HTB, NXCD = 8, WGM = 8;

__host__ __device__ __forceinline__ int lds_byte(int r, int c) { const int st = (r >> 4) * 2 + (c >> 5), rr = r & 15, cc = c & 31, ob = rr * 64 + cc * 2; return st * 1024 + (ob ^ (((ob >> 9) & 1) << 5)); }
__host__ __device__ __forceinline__ void stage_rc(int b, int& R, int& C) { const int st = b / 1024, sb = b % 1024, swz = sb ^ (((sb >> 9) & 1) << 5); R = (st >> 1) * 16 + swz / 64; C = (st & 1) * 32 + (swz % 64) / 2; }
__host__ __device__ __forceinline__ int perm32(int rho) { const int n = rho >> 4, i = rho & 15; return 8 * (i >> 2) + 4 * n + (i & 3); }

struct Unit { const char* a; const char* b; int pm, pn, kind, par; };
__device__ __forceinline__ void tile_map(int L, int nM, int nN, int& pm, int& pn) {
    const int nwg = nM * nN; int wgid = L; { const int q = nwg / NXCD, r = nwg % NXCD, xcd = wgid % NXCD, off = wgid / NXCD; wgid = (xcd < r ? xcd * (q + 1) : r * (q + 1) + (xcd - r) * q) + off; }
    const int nig = WGM * nN, gid = wgid / nig, fm = gid * WGM, gsz = (nM - fm) < WGM ? (nM - fm) : WGM;
    pm = fm + ((wgid % nig) % gsz); pn = (wgid % nig) / gsz;
}
typedef float f32x2_t __attribute__((ext_vector_type(2))); typedef __bf16 bf16x2_t __attribute__((ext_vector_type(2)));
__device__ __forceinline__ unsigned cvtpk(float lo, float hi) { f32x2_t v = {lo, hi}; bf16x2_t b = __builtin_convertvector(v, bf16x2_t); return __builtin_bit_cast(unsigned, b); }
__device__ __forceinline__ float silu_f(float v) { return v / (1.0f + __expf(-v)); }

template <bool SILU>
__device__ __forceinline__ void store_tile_bf16(const f32x4 (&acc)[2][2][4][2], bf16_t* base, int ldc, int row_t, int col_t, int wr, int wc, int fr, int fq, const PG8_LAS float* rtab = nullptr) {
    const int row0 = row_t + wr * 64 + fr, col0 = col_t + wc * 32 + 8 * fq;
#pragma unroll
    for (int ai = 0; ai < 2; ++ai)
#pragma unroll
        for (int m = 0; m < 4; ++m) { bf16_t* rowp = base + (size_t)(row0 + ai * HALF + m * 16) * ldc + col0; const float rsc = rtab ? rtab[wr * 64 + fr + ai * HALF + m * 16] : 1.0f;
#pragma unroll
            for (int bj = 0; bj < 2; ++bj) { f32x4 v0 = acc[ai][bj][m][0] * rsc, v1 = acc[ai][bj][m][1] * rsc;
                if (SILU) { v0[0] = silu_f(v0[0]); v0[1] = silu_f(v0[1]); v0[2] = silu_f(v0[2]); v0[3] = silu_f(v0[3]); v1[0] = silu_f(v1[0]); v1[1] = silu_f(v1[1]); v1[2] = silu_f(v1[2]); v1[3] = silu_f(v1[3]); }
                u32x4 w; w.x = cvtpk(v0[0], v0[1]); w.y = cvtpk(v0[2], v0[3]); w.z = cvtpk(v1[0], v1[1]); w.w = cvtpk(v1[2], v1[3]);
                *(u32x4*)(rowp + bj * HALF) = w; } }
}

struct EpiInA {
    static constexpr bool PERM = true, AFTER_DRAIN = false;
    bf16_t* QK; bf16_t* SR; bf16_t* VT; int MT;
    __device__ __forceinline__ void operator()(const f32x4 (&acc)[2][2][4][2], const Unit& u, int wr, int wc, int fr, int fq) const {
        if (u.kind == 0) store_tile_bf16<false>(acc, QK, 2048, u.pm * BM, u.pn * BM, wr, wc, fr, fq);
        else if (u.kind == 1) store_tile_bf16<true>(acc, SR, 2048, u.pm * BM, (u.pn - 8) * BM, wr, wc, fr, fq);
        else store_tile_bf16<false>(acc, VT, MT, u.pm * BM, u.pn * BM, wr, wc, fr, fq);
    }
};

struct EpiInB {
    static constexpr bool PERM = true, AFTER_DRAIN = false;
    bf16_t* QZ; bf16_t* KB; bf16_t* VT2; int MT; float* kwp; float* vwp; float* kws; float* vws; const PG8_LAS float* tab;
    __device__ __forceinline__ static float* win_row(int t, float* wp, float* wsmp) {
        if (t < 8192) { const int pos = t & 2047; if (pos < 1920) return nullptr; return wp + ((size_t)(t >> 11) * 128 + (pos - 1920)) * 256; }
        const int s = t - 8192; return wsmp + ((size_t)(s >> 3) * 128 + 120 + (s & 7)) * 256;
    }
    __device__ __forceinline__ void operator()(const f32x4 (&acc)[2][2][4][2], const Unit& u, int wr, int wc, int fr, int fq) const {
        const PG8_LAS float* T = tab + (u.par << 8);
        if (u.kind == 0) { store_tile_bf16<false>(acc, QZ, 4096, u.pm * BM, u.pn * BM, wr, wc, fr, fq, T); return; }
        if (u.kind == 1) { store_tile_bf16<true>(acc, QZ, 4096, u.pm * BM, u.pn * BM, wr, wc, fr, fq, T); return; }
        if (u.kind == 2) {
            store_tile_bf16<false>(acc, KB, 256, u.pm * BM, 0, wr, wc, fr, fq, T);
            if ((u.pm & 7) == 7) {
                const int row0 = u.pm * BM + wr * 64 + fr, col0 = wc * 32 + 8 * fq;
#pragma unroll
                for (int ai = 0; ai < 2; ++ai)
#pragma unroll
                    for (int m = 0; m < 4; ++m) { float* d = win_row(row0 + ai * HALF + m * 16, kwp, kws); const float rsc = T[wr * 64 + fr + ai * HALF + m * 16];
                        if (d) {
#pragma unroll
                            for (int bj = 0; bj < 2; ++bj) { *(f32x4*)(d + col0 + bj * HALF) = acc[ai][bj][m][0] * rsc; *(f32x4*)(d + col0 + bj * HALF + 4) = acc[ai][bj][m][1] * rsc; } } }
            }
            return;
        }
        const int row0 = wr * 64 + fr, colb = wc * 32 + 8 * fq;
        f32x4 cs[2][2];
#pragma unroll
        for (int bj = 0; bj < 2; ++bj) { cs[bj][0] = *(const PG8_LAS f32x4*)(T + colb + bj * HALF); cs[bj][1] = *(const PG8_LAS f32x4*)(T + colb + bj * HALF + 4); }
#pragma unroll
        for (int ai = 0; ai < 2; ++ai)
#pragma unroll
            for (int m = 0; m < 4; ++m) { bf16_t* rowp = VT2 + (size_t)(row0 + ai * HALF + m * 16) * MT + u.pn * BM + colb;
#pragma unroll
                for (int bj = 0; bj < 2; ++bj) { const f32x4 v0 = acc[ai][bj][m][0] * cs[bj][0], v1 = acc[ai][bj][m][1] * cs[bj][1];
                    u32x4 w; w.x = cvtpk(v0[0], v0[1]); w.y = cvtpk(v0[2], v0[3]); w.z = cvtpk(v1[0], v1[1]); w.w = cvtpk(v1[2], v1[3]);
                    *(u32x4*)(rowp + bj * HALF) = w; } }
        if ((u.pn & 7) == 7) {
            const int col0 = u.pn * BM + colb;
#pragma unroll
            for (int bj = 0; bj < 2; ++bj)
#pragma unroll
                for (int n = 0; n < 2; ++n)
#pragma unroll
                    for (int j = 0; j < 4; ++j) { float* d = win_row(col0 + bj * HALF + 4 * n + j, vwp, vws);
                        if (d) {
#pragma unroll
                            for (int ai = 0; ai < 2; ++ai)
#pragma unroll
                                for (int m = 0; m < 4; ++m) d[row0 + ai * HALF + m * 16] = acc[ai][bj][m][n][j] * cs[bj][n][j]; } }
        }
    }
};

struct EpiOutA {
    static constexpr bool PERM = false, AFTER_DRAIN = false;
    const float* x; bf16_t* H1b; float* SSQ1;
    __device__ __forceinline__ void operator()(const f32x4 (&acc)[2][2][4][2], const Unit& u, int wr, int wc, int fr, int fq) const {
        typedef unsigned u32x2_t __attribute__((ext_vector_type(2)));
        const int row0 = u.pm * BM + wr * 64 + fr, col0 = u.pn * BM + wc * 32 + 4 * fq;
        const float* xb = x + (size_t)row0 * 2048 + col0; bf16_t* hb = H1b + (size_t)row0 * 2048 + col0;
        f32x4 xr[3][4];
#define EOA_LD(slot, gi) do { const size_t o_ = (size_t)(((gi) >> 2) * HALF + ((gi) & 3) * 16) * 2048; xr[slot][0] = *(const f32x4*)(xb + o_); xr[slot][1] = *(const f32x4*)(xb + o_ + 16); xr[slot][2] = *(const f32x4*)(xb + o_ + HALF); xr[slot][3] = *(const f32x4*)(xb + o_ + HALF + 16); } while (0)
        EOA_LD(0, 0); EOA_LD(1, 1);
#pragma unroll
        for (int gi = 0; gi < 8; ++gi) { const int ai = gi >> 2, m = gi & 3;
            if (gi + 2 < 8) EOA_LD((gi + 2) % 3, gi + 2);
            const size_t o = (size_t)(ai * HALF + m * 16) * 2048; float ss = 0.f;
#pragma unroll
            for (int bj = 0; bj < 2; ++bj)
#pragma unroll
                for (int n = 0; n < 2; ++n) { const f32x4 v = xr[gi % 3][bj * 2 + n] + acc[ai][bj][m][n];
                    u32x2_t w; w.x = cvtpk(v[0], v[1]); w.y = cvtpk(v[2], v[3]);
                    *(u32x2_t*)(hb + o + bj * HALF + n * 16) = w; ss += (v[0] * v[0] + v[1] * v[1]) + (v[2] * v[2] + v[3] * v[3]); }
            ss += __shfl_xor(ss, 16); ss += __shfl_xor(ss, 32);
            if (fq == 0) SSQ1[(size_t)(row0 + ai * HALF + m * 16) * 32 + u.pn * 4 + wc] = ss; }
#undef EOA_LD
    }
};
struct EpiOutB {
    static constexpr bool PERM = false, AFTER_DRAIN = false;
    const bf16_t* H1b; float* out;
    __device__ __forceinline__ void operator()(const f32x4 (&acc)[2][2][4][2], const Unit& u, int wr, int wc, int fr, int fq) const {
        typedef unsigned u32x2_t __attribute__((ext_vector_type(2)));
        const int row0 = u.pm * BM + wr * 64 + fr, col0 = u.pn * BM + wc * 32 + 4 * fq;
        const bf16_t* hb = H1b + (size_t)row0 * 2048 + col0; float* ob = out + (size_t)row0 * 2048 + col0;
        u32x2_t hr[3][4];
#define EOB_LD(slot, gi) do { const size_t o_ = (size_t)(((gi) >> 2) * HALF + ((gi) & 3) * 16) * 2048; hr[slot][0] = *(const u32x2_t*)(hb + o_); hr[slot][1] = *(const u32x2_t*)(hb + o_ + 16); hr[slot][2] = *(const u32x2_t*)(hb + o_ + HALF); hr[slot][3] = *(const u32x2_t*)(hb + o_ + HALF + 16); } while (0)
        EOB_LD(0, 0); EOB_LD(1, 1);
#pragma unroll
        for (int gi = 0; gi < 8; ++gi) { const int ai = gi >> 2, m = gi & 3;
            if (gi + 2 < 8) EOB_LD((gi + 2) % 3, gi + 2);
            const size_t o = (size_t)(ai * HALF + m * 16) * 2048;
#pragma unroll
            for (int bj = 0; bj < 2; ++bj)
#pragma unroll
                for (int n = 0; n < 2; ++n) { const u32x2_t h = hr[gi % 3][bj * 2 + n];
                    f32x4 r; r[0] = __uint_as_float(h.x << 16); r[1] = __uint_as_float(h.x & 0xffff0000u); r[2] = __uint_as_float(h.y << 16); r[3] = __uint_as_float(h.y & 0xffff0000u);
                    *(f32x4*)(ob + o + bj * HALF + n * 16) = r + acc[ai][bj][m][n]; } }
#undef EOB_LD
    }
};

struct SchedInA {
    int G, c; const char* XN; const char* W;
    __device__ __forceinline__ bool next(int i, Unit& u) const {
        const int L = i * G + c; const size_t P = (size_t)BM * 2048 * 2;
        if (L < 512) { u.par = 0; tile_map(L, 32, 16, u.pm, u.pn); u.kind = u.pn < 8 ? 0 : 1; u.a = XN + u.pm * P; u.b = W + (u.pn < 8 ? u.pn : u.pn + 8) * P; return true; }
        if (L < 768) { u.par = 0; tile_map(L - 512, 8, 32, u.pm, u.pn); u.kind = 2; u.a = W + (8 + u.pm) * P; u.b = XN + u.pn * P; return true; }
        return false;
    }
    __device__ __forceinline__ void a_ready(const Unit&) const {}
    __device__ __forceinline__ void done(const Unit&) const {}
};
struct SchedInB {
    int G, c; const char* XN; const char* W; const float* SSQ1; PG8_LAS float* tab;
    __device__ __forceinline__ bool next(int i, Unit& u) const {
        const int L = i * G + c; const size_t P = (size_t)BM * 2048 * 2; u.par = i & 1;
        if (L < 544) { tile_map(L, 32, 17, u.pm, u.pn); u.kind = u.pn < 8 ? 0 : (u.pn < 16 ? 1 : 2); u.a = XN + u.pm * P; u.b = W + u.pn * P; return true; }
        if (L < 576) { u.pm = 0; u.pn = L - 544; u.kind = 3; u.a = W + 17 * P; u.b = XN + u.pn * P; return true; }
        return false;
    }
    __device__ __forceinline__ void a_ready(const Unit& u) const {
        int t = threadIdx.x; asm volatile("" : "+v"(t));
        const int row = t >> 1, hf = t & 1, panel = u.kind == 3 ? u.pn : u.pm;
        const float* p = SSQ1 + ((size_t)panel * BM + row) * 32 + hf * 16;
        const f32x4 a0 = *(const f32x4*)p, a1 = *(const f32x4*)(p + 4), a2 = *(const f32x4*)(p + 8), a3 = *(const f32x4*)(p + 12);
        float s = ((a0[0] + a0[1]) + (a0[2] + a0[3])) + ((a1[0] + a1[1]) + (a1[2] + a1[3])) + ((a2[0] + a2[1]) + (a2[2] + a2[3])) + ((a3[0] + a3[1]) + (a3[2] + a3[3]));
        s += __shfl_xor(s, 1);
        if (hf == 0) tab[(u.par << 8) + row] = 1.0f / sqrtf(s * (1.0f / 2048.0f) + 1e-6f);
    }
    __device__ __forceinline__ void done(const Unit&) const {}
};
struct SchedOut {
    int G, c; const char* A; const char* W;
    __device__ __forceinline__ bool next(int i, Unit& u) const {
        const int L = i * G + c; const size_t P = (size_t)BM * 2048 * 2;
        if (L >= 256) return false;
        tile_map(L, 32, 8, u.pm, u.pn); u.kind = 0; u.par = 0; u.a = A + u.pm * P; u.b = W + u.pn * P; return true;
    }
    __device__ __forceinline__ void a_ready(const Unit&) const {}
    __device__ __forceinline__ void done(const Unit&) const {}
};
template <class Epi, class Sched, bool ALIGN_EPI = false, bool SP2 = false>
__device__ __forceinline__ void gemm_phase(PG8_LAS unsigned char* lds, const int K_, const Sched& S, const Epi& E) {
    const int tid = threadIdx.x, wid = __builtin_amdgcn_readfirstlane(tid >> 6), lane = tid & 63, wr = wid >> 2, wc = wid & 3, fr = lane & 15, fq = lane >> 4;
    const int K = K_, nt = K / BK;
    unsigned voffA[2], voffB[2];
#pragma unroll
    for (int i = 0; i < 2; ++i) { int R, C; stage_rc(tid * 16 + i * 8192, R, C); const int Rb = Epi::PERM ? ((R & ~31) + perm32(R & 31)) : R;
        voffA[i] = (unsigned)(R * K + C) * 2u; voffB[i] = (unsigned)(Rb * K + C) * 2u; }
    const size_t kstep = (size_t)(BK * 2);
    const size_t hstep = (size_t)HALF * K * 2;
    const unsigned ldsw = (unsigned)wid * 1024u;
    const int aoff = lds_byte(wr * 64 + fr, fq * 8), boff = lds_byte(wc * 32 + fr, fq * 8);
#define PG8_SA(b, h) (((b) * 2 + (h)) * HTB)
#define PG8_SB(b, h) ((4 + (b) * 2 + (h)) * HTB)
#define PG8_STAGE(bufoff, gbase, voff) do { _Pragma("unroll") for (int _i = 0; _i < 2; ++_i) \
        __builtin_amdgcn_global_load_lds((const unsigned*)((const char*)(gbase) + (voff)[_i]), (PG8_LAS unsigned*)(lds + (bufoff) + ldsw + _i * 8192), 16, 0, 0); } while (0)
#define PG8_LDA(dst, b, h) do { _Pragma("unroll") for (int m = 0; m < 4; ++m) _Pragma("unroll") for (int k = 0; k < 2; ++k) dst[m][k] = *(const PG8_LAS bf16x8*)(lds + PG8_SA(b, h) + aoff + m * 2048 + k * 1024); } while (0)
#define PG8_LDB(dst, b, h) do { _Pragma("unroll") for (int n = 0; n < 2; ++n) _Pragma("unroll") for (int k = 0; k < 2; ++k) dst[n][k] = *(const PG8_LAS bf16x8*)(lds + PG8_SB(b, h) + boff + n * 2048 + k * 1024); } while (0)
#define PG8_MMA(ai, bj, At, Bt) do { __builtin_amdgcn_s_setprio(1); _Pragma("unroll") for (int m = 0; m < 4; ++m) _Pragma("unroll") for (int n = 0; n < 2; ++n) _Pragma("unroll") for (int k = 0; k < 2; ++k) \
        acc[ai][bj][m][n] = __builtin_amdgcn_mfma_f32_16x16x32_bf16(Bt[n][k], At[m][k], acc[ai][bj][m][n], 0, 0, 0); __builtin_amdgcn_s_setprio(0); } while (0)
#define PG8_WAIT_V(n) asm volatile("s_waitcnt vmcnt(" #n ")" ::: "memory")
#define PG8_WAIT_L(n) asm volatile("s_waitcnt lgkmcnt(" #n ")" ::: "memory")
#define PG8_BAR __builtin_amdgcn_s_barrier()
#define PG8_SCHED __builtin_amdgcn_sched_barrier(0)
    Unit cur, nxt; int ui = 0;
    if (!S.next(0, cur)) return;
    f32x4 acc[2][2][4][2];
#pragma unroll
    for (int a = 0; a < 2; ++a)
#pragma unroll
        for (int b = 0; b < 2; ++b)
#pragma unroll
            for (int m = 0; m < 4; ++m)
#pragma unroll
                for (int n = 0; n < 2; ++n) acc[a][b][m][n] = (f32x4){0.f, 0.f, 0.f, 0.f};
    bf16x8 At[4][2], B0[2][2], B1[2][2];
    const char* cA = cur.a; const char* cB = cur.b;
    S.a_ready(cur);
    if constexpr (SP2) {
        PG8_STAGE(PG8_SB(0, 0), cB, voffB); PG8_STAGE(PG8_SB(0, 1), cB + hstep, voffB); PG8_STAGE(PG8_SA(0, 0), cA, voffA); PG8_STAGE(PG8_SA(0, 1), cA + hstep, voffA);
        if (wr == 1) PG8_BAR;
        PG8_WAIT_V(2); PG8_BAR;
        PG8_STAGE(PG8_SB(1, 0), cB + kstep, voffB); PG8_STAGE(PG8_SA(1, 0), cA + kstep, voffA); PG8_STAGE(PG8_SB(1, 1), cB + hstep + kstep, voffB);
        PG8_WAIT_V(6); PG8_BAR;
    } else {
        PG8_STAGE(PG8_SB(0, 0), cB, voffB); PG8_STAGE(PG8_SA(0, 0), cA, voffA); PG8_STAGE(PG8_SB(0, 1), cB + hstep, voffB); PG8_STAGE(PG8_SA(0, 1), cA + hstep, voffA);
        if (wr == 1) PG8_BAR;
        PG8_WAIT_V(4); PG8_BAR;
        PG8_STAGE(PG8_SB(1, 0), cB + kstep, voffB); PG8_STAGE(PG8_SA(1, 0), cA + kstep, voffA); PG8_STAGE(PG8_SB(1, 1), cB + hstep + kstep, voffB);
        PG8_WAIT_V(6); PG8_BAR;
    }
    for (;;) {
        const bool has_next = S.next(ui + 1, nxt);
        const char* nA = has_next ? nxt.a : cA; const char* nB = has_next ? nxt.b : cB;
        for (int t = 0; t < nt; t += 2) {
            const bool last = (t == nt - 2);
            const char* a1 = cA + (size_t)(t + 1) * kstep;
            const char* a2 = last ? nA : cA + (size_t)(t + 2) * kstep; const char* b2 = last ? nB : cB + (size_t)(t + 2) * kstep;
            const char* a3 = a2 + kstep; const char* b3 = b2 + kstep;
            if (last && has_next) S.a_ready(nxt);
            if constexpr (SP2) {
            PG8_LDB(B0, 0, 0); PG8_LDB(B1, 0, 1); PG8_SCHED; PG8_LDA(At, 0, 0); PG8_STAGE(PG8_SA(1, 1), a1 + hstep, voffA);
            PG8_WAIT_V(8); PG8_WAIT_L(0); PG8_BAR; PG8_MMA(0, 0, At, B0); PG8_MMA(0, 1, At, B1); PG8_BAR; PG8_SCHED;
            PG8_LDA(At, 0, 1); PG8_STAGE(PG8_SB(0, 0), b2, voffB); PG8_STAGE(PG8_SB(0, 1), b2 + hstep, voffB); PG8_STAGE(PG8_SA(0, 0), a2, voffA);
            PG8_WAIT_V(8); PG8_WAIT_L(0); PG8_BAR; PG8_MMA(1, 0, At, B0); PG8_MMA(1, 1, At, B1); PG8_BAR; PG8_SCHED;
            PG8_LDB(B0, 1, 0); PG8_LDB(B1, 1, 1); PG8_SCHED; PG8_LDA(At, 1, 0); PG8_STAGE(PG8_SA(0, 1), a2 + hstep, voffA);
            PG8_WAIT_V(8); PG8_WAIT_L(0); PG8_BAR; PG8_MMA(0, 0, At, B0); PG8_MMA(0, 1, At, B1); PG8_BAR; PG8_SCHED;
            PG8_LDA(At, 1, 1); PG8_STAGE(PG8_SB(1, 0), b3, voffB); PG8_STAGE(PG8_SB(1, 1), b3 + hstep, voffB); PG8_STAGE(PG8_SA(1, 0), a3, voffA);
            PG8_WAIT_V(8); PG8_WAIT_L(0); PG8_BAR; PG8_MMA(1, 0, At, B0); PG8_MMA(1, 1, At, B1); PG8_BAR; PG8_SCHED;
            } else {
            PG8_LDB(B0, 0, 0); PG8_SCHED; PG8_LDA(At, 0, 0); PG8_STAGE(PG8_SA(1, 1), a1 + hstep, voffA);
            PG8_WAIT_L(8); PG8_BAR; PG8_WAIT_L(0); PG8_MMA(0, 0, At, B0); PG8_BAR; PG8_SCHED;
            PG8_LDB(B1, 0, 1); PG8_STAGE(PG8_SB(0, 0), b2, voffB);
            PG8_BAR; PG8_WAIT_L(0); PG8_MMA(0, 1, At, B1); PG8_BAR;
            PG8_LDA(At, 0, 1); PG8_STAGE(PG8_SA(0, 0), a2, voffA);
            PG8_BAR; PG8_WAIT_L(0); PG8_MMA(1, 0, At, B0); PG8_BAR; PG8_SCHED;
            PG8_STAGE(PG8_SB(0, 1), b2 + hstep, voffB);
            PG8_WAIT_V(6); PG8_BAR; PG8_MMA(1, 1, At, B1); PG8_BAR;
            PG8_LDB(B0, 1, 0); PG8_SCHED; PG8_LDA(At, 1, 0); PG8_STAGE(PG8_SA(0, 1), a2 + hstep, voffA);
            PG8_WAIT_L(8); PG8_BAR; PG8_WAIT_L(0); PG8_MMA(0, 0, At, B0); PG8_BAR; PG8_SCHED;
            PG8_LDB(B1, 1, 1); PG8_STAGE(PG8_SB(1, 0), b3, voffB);
            PG8_BAR; PG8_WAIT_L(0); PG8_MMA(0, 1, At, B1); PG8_BAR;
            PG8_LDA(At, 1, 1); PG8_STAGE(PG8_SA(1, 0), a3, voffA);
            PG8_BAR; PG8_WAIT_L(0); PG8_MMA(1, 0, At, B0); PG8_BAR; PG8_SCHED;
            PG8_STAGE(PG8_SB(1, 1), b3 + hstep, voffB);
            PG8_WAIT_V(6); PG8_BAR; PG8_MMA(1, 1, At, B1); PG8_BAR;
            }
        }
        if constexpr (ALIGN_EPI) { if (wr == 0) PG8_BAR; }
        if constexpr (!Epi::AFTER_DRAIN) { E(acc, cur, wr, wc, fr, fq); S.done(cur); }
        if (!has_next) break;
#pragma unroll
        for (int a = 0; a < 2; ++a)
#pragma unroll
            for (int b = 0; b < 2; ++b)
#pragma unroll
                for (int m = 0; m < 4; ++m)
#pragma unroll
                    for (int n = 0; n < 2; ++n) acc[a][b][m][n] = (f32x4){0.f, 0.f, 0.f, 0.f};
        cur = nxt; cA = nA; cB = nB; ++ui;
        if constexpr (ALIGN_EPI) { if (wr == 1) PG8_BAR; }
    }
    PG8_WAIT_V(0);
    if constexpr (!ALIGN_EPI) { if (wr == 0) PG8_BAR; }
    PG8_BAR;
    if constexpr (Epi::AFTER_DRAIN) { E.fused(acc, cur, wr, wc, fr, fq, lds, wid, lane); S.done(cur); }
#undef PG8_SA
#undef PG8_SB
#undef PG8_STAGE
#undef PG8_LDA
#undef PG8_LDB
#undef PG8_MMA
#undef PG8_WAIT_V
#undef PG8_WAIT_L
#undef PG8_BAR
#undef PG8_SCHED
}
}
#define GAS __attribute__((address_space(1)))
#define LAS __attribute__((address_space(3)))
typedef unsigned short bf16;
typedef unsigned v4u __attribute__((ext_vector_type(4)));
typedef float f32x4 __attribute__((ext_vector_type(4)));
typedef short bf16x8 __attribute__((ext_vector_type(8)));
typedef GAS unsigned gu32;
typedef GAS unsigned long long gu64;
#define RLX_AGENT __ATOMIC_RELAXED, __HIP_MEMORY_SCOPE_AGENT
#define LDS_WAIT() asm volatile("s_waitcnt lgkmcnt(0)" ::: "memory")
#define VM_WAIT() asm volatile("s_waitcnt vmcnt(0)" ::: "memory")
__device__ __forceinline__ unsigned long long rt() { return __builtin_amdgcn_s_memrealtime(); }
__device__ __forceinline__ unsigned f2bf(float f) { unsigned u = __builtin_bit_cast(unsigned, f); return (u + 0x7fffu + ((u >> 16) & 1u)) >> 16; }
__device__ __forceinline__ unsigned pk2(float lo, float hi) { return f2bf(lo) | (f2bf(hi) << 16); }

#define XB_TMO      128
#define XB_XCNT(j)  (256  + 64 * (j))
#define XB_XSUB(j)  (1280 + 64 * (j))
#define XB_XGEN(j)  (2304 + 64 * (j))
#define XB_TOP      3328
#define XB_TOPGEN   3392
#define XCD_BAR_WORDS 3456
#define XB_SPIN_CAP (1u << 18)

__device__ __forceinline__ unsigned xb_ld(unsigned* p)              { return __hip_atomic_load(p, __ATOMIC_RELAXED, __HIP_MEMORY_SCOPE_AGENT); }
__device__ __forceinline__ unsigned xb_add(unsigned* p, unsigned v) { return __hip_atomic_fetch_add(p, v, __ATOMIC_RELAXED, __HIP_MEMORY_SCOPE_AGENT); }
__device__ __forceinline__ unsigned xb_xcc_id() { return (unsigned)__builtin_amdgcn_s_getreg((3 << 11) | 20) & 0xFu; }
#define XB_SPIN(cond, bar) do { unsigned _sp = 0; while (cond) { __builtin_amdgcn_s_sleep(1); \
    if ((++_sp & 255u) == 0u) { if (xb_ld(&(bar)[XB_TMO])) break; if (_sp > XB_SPIN_CAP) { atomicAdd(&(bar)[XB_TMO], 1u); break; } } } } while (0)

struct XcdBarrier {
    unsigned* bar; unsigned x;
    volatile LAS unsigned* st;
};

__device__ __forceinline__ XcdBarrier xcd_barrier_post(unsigned* bar, volatile LAS unsigned* st) {
    XcdBarrier b; b.bar = bar; b.x = xb_xcc_id(); b.st = st;
    if (threadIdx.x == 0) (void)xb_add(&bar[XB_XCNT(b.x)], 1u);
    return b;
}
__device__ __forceinline__ void xcd_barrier_complete(unsigned* bar, unsigned x, unsigned& nloc, unsigned& nx) {
    const unsigned G = gridDim.x * gridDim.y * gridDim.z;
    unsigned sum, cnt, mine, sp = 0u;
    for (;;) {
        sum = 0u; cnt = 0u; mine = 0u;
#pragma unroll
        for (unsigned j = 0; j < 16; ++j) { const unsigned c = xb_ld(&bar[XB_XCNT(j)]); sum += c; cnt += (c > 0u) ? 1u : 0u; mine = (j == x) ? c : mine; }
        if (sum == G) break;
        __builtin_amdgcn_s_sleep(1);
        if ((++sp & 255u) == 0u) { if (xb_ld(&bar[XB_TMO])) break; if (sp > XB_SPIN_CAP) { atomicAdd(&bar[XB_TMO], 1u); break; } }
    }
    nloc = mine > 0u ? mine : 1u; nx = cnt > 0u ? cnt : 1u;
}

__device__ __forceinline__ void xcd_barrier(const XcdBarrier& b) {
    asm volatile("s_waitcnt vmcnt(0)" ::: "memory");
    __syncthreads();
    if (threadIdx.x == 0) {
        unsigned* bar = b.bar;
        __builtin_amdgcn_s_waitcnt(0);
        unsigned nloc = b.st[0], nx = b.st[1];
        if (nloc == 0u) { xcd_barrier_complete(bar, b.x, nloc, nx); b.st[0] = nloc; b.st[1] = nx; }
        const unsigned old = xb_add(&bar[XB_XSUB(b.x)], 1u);
        const unsigned gen = old / nloc;
        if (old + 1u == (gen + 1u) * nloc) {
            __builtin_amdgcn_fence(__ATOMIC_RELEASE, "agent");
            asm volatile("s_waitcnt vmcnt(0)" ::: "memory");
            const unsigned og = xb_add(&bar[XB_TOP], 1u);
            const unsigned tg = og / nx;
            if (og + 1u == (tg + 1u) * nx) xb_add(&bar[XB_TOPGEN], 1u);
            else XB_SPIN(xb_ld(&bar[XB_TOPGEN]) == tg, bar);
            __builtin_amdgcn_fence(__ATOMIC_ACQUIRE, "agent");
            xb_add(&bar[XB_XGEN(b.x)], 1u);
            asm volatile("s_waitcnt vmcnt(0)" ::: "memory");
        } else {
            XB_SPIN(xb_ld(&bar[XB_XGEN(b.x)]) == gen, bar);
            __builtin_amdgcn_fence(__ATOMIC_ACQUIRE, "agent");
            asm volatile("s_waitcnt vmcnt(0)" ::: "memory");
        }
    }
    __syncthreads();
}
constexpr int NWAVES = 8;
constexpr int MPR = 8192, MSM = 256, MT = MPR + MSM;
constexpr int DM = 2048;
constexpr float RMS_EPS = 1e-6f;
constexpr float LOG2E = 1.4426950408889634f;
constexpr size_t MiB = 1u << 20;
constexpr size_t WS_CTL = 0, CTL_ZERO_BYTES = 64 * 1024;
constexpr size_t WS_WINA = 1 * MiB;
constexpr size_t WS_WOA = 26 * MiB;
constexpr size_t WS_WINB = 34 * MiB;
constexpr size_t WS_WOB = 52 * MiB;
constexpr size_t WS_BUFA = 60 * MiB;
constexpr size_t WS_QK = 93 * MiB;
constexpr size_t WS_VT = 126 * MiB;
constexpr size_t WS_QZ = 93 * MiB;
constexpr size_t WS_SR = 159 * MiB;
constexpr size_t WS_REC = 192 * MiB;
constexpr size_t WS_KB = 192 * MiB;
constexpr size_t WS_VT2 = 198 * MiB;
constexpr size_t WS_GLOW = 234 * MiB;
constexpr size_t WS_SSQP = 235 * MiB;
constexpr size_t WS_SSQ1 = 236 * MiB;
constexpr int TAB_OFF = 131072;
constexpr size_t WS_END = 240 * MiB;
constexpr int CW_BAR = 1024;
constexpr int HREC = 33792, REC_PO = 33792, REC_H1 = 41984, REC_BYTES = 75776, REC_DMA = 41984, H_QT = 0, H_KT = 16384, H_G = 32768;
static_assert(512 * (size_t)REC_BYTES <= 42 * MiB && REC_DMA % 1024 == 0, "record");
__device__ __forceinline__ int qt_off(int t, int dl) {
    const int d5 = dl & 31; const int p = d5 < 16 ? ((d5 >> 2) << 3) + (d5 & 3) : (((d5 - 16) >> 2) << 3) + 4 + (d5 & 3);
    const int chunk = ((dl >> 5) << 2) + (p >> 3); return t * 256 + ((chunk ^ (t & 15)) << 4) + ((p & 7) << 1); }
__device__ __forceinline__ int qt_chunk(int t, int c) { return t * 256 + ((c ^ (t & 15)) << 4); }
__device__ __forceinline__ int kt_chunk(int d, int c) { return d * 128 + ((c ^ ((d >> 1) & 7)) << 4); }
constexpr size_t OUT_Y = 0, OUT_GLAP = 17301504, OUT_GLAS = 19398656, OUT_KWP = 36175872, OUT_VWP = 36306944, OUT_KWS = 36438016, OUT_VWS = 37486592, OUT_TOTAL = 38535168;
constexpr int RING_BYTES = 131072, LDS_BYTES = 163840, LDSCTL_OFF = LDS_BYTES - 1024, MISC_OFF = LDSCTL_OFF + 320;

__device__ __forceinline__ float bf2f(unsigned short u) { return __uint_as_float(((unsigned)u) << 16); }
__device__ __forceinline__ unsigned cvtpk2(float lo, float hi) { return pg8::cvtpk(lo, hi); }
__device__ __forceinline__ float wave_sum(float v) {
#pragma unroll
    for (int o = 1; o < 64; o <<= 1) v += __shfl_xor(v, o);
    return v;
}
#define MFMA16(a, b, c) __builtin_amdgcn_mfma_f32_16x16x32_bf16((a), (b), (c), 0, 0, 0)
typedef unsigned u32x2 __attribute__((ext_vector_type(2)));

struct Ptrs {
    const float *x_prompt, *x_sample, *state, *ck, *cv, *g_norm_a, *w_in_a, *w_gate_up, *b_gate, *g_onorm, *w_out_a, *g_norm_kv, *w_kv, *g_norm_b, *w_in_b, *sinks, *w_out_b, *g_final;
    float* out; unsigned char* ws;
};

__device__ __forceinline__ void p0_transpose_item(const float* W, int ldw, int ncol0, int nvalid, const float* gain, int scale_cols, float scale, bf16* WT, int row_off, LAS float* scr, int kb, int nb, int lane) {
    const int k0 = 64 * kb, n0 = 32 * nb, nl = lane & 31; const bool ok = (n0 + nl) < nvalid; const float cs = (n0 + nl) < scale_cols ? scale : 1.0f;
#pragma unroll 8
    for (int i = 0; i < 32; ++i) { const int kk = 2 * i + (lane >> 5); float v = ok ? W[(size_t)(k0 + kk) * ldw + ncol0 + n0 + nl] : 0.f; if (gain) v *= gain[k0 + kk]; scr[kk * 33 + nl] = v * cs; }
    LDS_WAIT(); asm volatile("" ::: "memory");
    const int c = lane & 7;
#pragma unroll
    for (int j = 0; j < 4; ++j) { const int n = (lane >> 3) + 8 * j; const LAS float* s = scr + (8 * c) * 33 + n;
        v4u o; o.x = cvtpk2(s[0 * 33], s[1 * 33]); o.y = cvtpk2(s[2 * 33], s[3 * 33]); o.z = cvtpk2(s[4 * 33], s[5 * 33]); o.w = cvtpk2(s[6 * 33], s[7 * 33]);
        if (n0 + n < nvalid) *(GAS v4u*)(WT + (size_t)(row_off + n0 + n) * 2048 + k0 + 8 * c) = o; }
    LDS_WAIT(); asm volatile("" ::: "memory");
}
__device__ __forceinline__ void rms_row_to_bf16(const float* xrow, bf16* orow, int lane) {
    const GAS f32x4* xr = (const GAS f32x4*)xrow + lane;
    f32x4 v[8]; float s = 0.f;
#pragma unroll
    for (int j = 0; j < 8; ++j) { v[j] = xr[64 * j]; s += (v[j].x * v[j].x + v[j].y * v[j].y) + (v[j].z * v[j].z + v[j].w * v[j].w); }
    const float rstd = 1.0f / sqrtf(wave_sum(s) * (1.f / DM) + RMS_EPS);
    GAS u32x2* o8 = (GAS u32x2*)orow + lane;
#pragma unroll
    for (int j = 0; j < 8; ++j) { u32x2 w; w.x = cvtpk2(v[j].x * rstd, v[j].y * rstd); w.y = cvtpk2(v[j].z * rstd, v[j].w * rstd); o8[64 * j] = w; }
}
__device__ __forceinline__ void p0_transpose_big(const float* W, int ldw, const float* gain, float cs, bf16* WT, int row_off, LAS unsigned char* scr, int kb, int nb, int lane) {
    const int k0 = 64 * kb, n0 = 128 * nb, hl = lane >> 5, nl = lane & 31;
    const GAS f32x4* src = (const GAS f32x4*)(W + (size_t)(k0 + 32 * hl) * ldw + n0 + 4 * nl);
    f32x4 v[32];
#pragma unroll
    for (int i = 0; i < 32; ++i) v[i] = src[(size_t)i * (ldw / 4)];
    f32x4 gk[8];
#pragma unroll
    for (int i = 0; i < 8; ++i) gk[i] = gain ? *(const GAS f32x4*)(gain + k0 + 32 * hl + 4 * i) * cs : (f32x4){cs, cs, cs, cs};
#pragma unroll
    for (int j = 0; j < 4; ++j) { const int n = 4 * nl + j;
#pragma unroll
        for (int q = 0; q < 4; ++q) { v4u o;
            o.x = cvtpk2(v[8 * q + 0][j] * gk[2 * q][0], v[8 * q + 1][j] * gk[2 * q][1]); o.y = cvtpk2(v[8 * q + 2][j] * gk[2 * q][2], v[8 * q + 3][j] * gk[2 * q][3]);
            o.z = cvtpk2(v[8 * q + 4][j] * gk[2 * q + 1][0], v[8 * q + 5][j] * gk[2 * q + 1][1]); o.w = cvtpk2(v[8 * q + 6][j] * gk[2 * q + 1][2], v[8 * q + 7][j] * gk[2 * q + 1][3]);
            *(LAS v4u*)(scr + n * 128 + (((4 * hl + q) ^ (n & 7)) << 4)) = o; } }
    LDS_WAIT(); asm volatile("" ::: "memory");
#pragma unroll
    for (int it = 0; it < 16; ++it) { const int idx = it * 64 + lane, n = idx >> 3, ch = idx & 7;
        const v4u o = *(const LAS v4u*)(scr + n * 128 + ((ch ^ (n & 7)) << 4));
        *(GAS v4u*)(WT + (size_t)(row_off + n0 + n) * 2048 + k0 + 8 * ch) = o; }
    LDS_WAIT(); asm volatile("" ::: "memory");
}
__device__ __forceinline__ void convert_weights(const Ptrs& P, LAS unsigned char* lds, int group, int gwi, int ngw, int iend, int wave, int lane) {
    LAS unsigned char* scr = lds + wave * 16384;
    bf16* WinaT = (bf16*)(P.ws + WS_WINA); bf16* WoaT = (bf16*)(P.ws + WS_WOA); bf16* WinbT = (bf16*)(P.ws + WS_WINB); bf16* WobT = (bf16*)(P.ws + WS_WOB);
    constexpr int I0 = 32 * 48, I1 = 32, I2 = 32 * 16, I3 = 32 * 32, I4 = 32 * 4, I5 = 32 * 16;
    if (group == 0) {
        for (int r = gwi; r < I0; r += ngw) { const int nb = r % 48; p0_transpose_big(P.w_in_a, 6160, P.g_norm_a, nb < 8 ? 0.0625f : 1.f, WinaT, 0, scr, r / 48, nb, lane); }
        for (int it = ngw - 1 - gwi; it < I1; it += ngw) p0_transpose_item(P.w_in_a, 6160, 6144, 16, P.g_norm_a, 0, 1.f, WinaT, 6144, (LAS float*)scr, it, 0, lane);
    } else {
        for (int it = gwi; it < iend; it += ngw) {
            int r = it;
            if (r < I2) { p0_transpose_big(P.w_out_a, 2048, P.g_onorm, 1.f, WoaT, 0, scr, r / 16, r % 16, lane); continue; } r -= I2;
            if (r < I3) { const int nb = r % 32; p0_transpose_big(P.w_in_b, 4096, P.g_norm_b, nb < 16 ? 0.125f * LOG2E : 1.f, WinbT, 0, scr, r / 32, nb, lane); continue; } r -= I3;
            if (r < I4) { p0_transpose_big(P.w_kv, 512, P.g_norm_kv, 1.f, WinbT, 4096, scr, r / 4, r % 4, lane); continue; } r -= I4;
            p0_transpose_big(P.w_out_b, 2048, nullptr, 1.f, WobT, 0, scr, r / 16, r % 16, lane);
        }
    }
}
__device__ __forceinline__ void p0_prologue(const Ptrs& P, LAS unsigned char* lds, int vcu, int G, int tid, int wave, int lane) {
    const int gw = vcu * NWAVES + wave, NGW = G * NWAVES;
    convert_weights(P, lds, 0, gw, NGW, 0, wave, lane);
    if (G < 256) convert_weights(P, lds, 1, gw, NGW, 2176, wave, lane);
    bf16* XN = (bf16*)(P.ws + WS_BUFA);
    for (int m = gw; m < MT; m += NGW) rms_row_to_bf16(m < MPR ? P.x_prompt + (size_t)m * DM : P.x_sample + (size_t)(m - MPR) * DM, XN + (size_t)m * DM, lane);
    const int gt = vcu * (NWAVES * 64) + tid, NGT = G * NWAVES * 64;
    for (int i = gt; i < 32 * 120 * 64; i += NGT) { const int b = i / (120 * 64), rem = i % (120 * 64);
        ((f32x4*)(P.out + OUT_KWS))[(size_t)b * 128 * 64 + rem] = ((const f32x4*)P.ck)[(size_t)b * 128 * 64 + 8 * 64 + rem];
        ((f32x4*)(P.out + OUT_VWS))[(size_t)b * 128 * 64 + rem] = ((const f32x4*)P.cv)[(size_t)b * 128 * 64 + 8 * 64 + rem]; }
}

__device__ __forceinline__ void glow_task(const bf16* XN, const bf16* WgT, float* GLOW, int task, int lane) {
    const int r = lane & 15, g = lane >> 4, row0 = task * 16;
    const bf16* ap = XN + (size_t)(row0 + r) * DM + g * 8; const bf16* bp = WgT + (size_t)r * DM + g * 8;
    f32x4 acc = {0.f, 0.f, 0.f, 0.f};
#pragma unroll 8
    for (int kk = 0; kk < 64; ++kk) { const bf16x8 a = *(const bf16x8*)(ap + kk * 32); const bf16x8 b = *(const bf16x8*)(bp + kk * 32); acc = MFMA16(a, b, acc); }
#pragma unroll
    for (int i = 0; i < 4; ++i) GLOW[(size_t)(row0 + 4 * g + i) * 16 + r] = acc[i];
}

__device__ __forceinline__ void gla_prep_unit(const Ptrs& P, LAS unsigned char* lds, int u, int tid, int wave, int lane) {
    const int c = u & 31, h = (u >> 5) & 3, b = u >> 7;
    const int d = tid & 255, th = tid >> 8, hh = d >> 7, dl = d & 127;
    LAS unsigned char* QI = lds;
    LAS unsigned char* KI = lds + 32768;
    LAS float* GL = (LAS float*)(lds + 65536);
    LAS float* TOT = (LAS float*)(lds + 65536 + 4096);
    const int row0 = b * 2048 + c * 64;
    const float* GLOW = (const float*)(P.ws + WS_GLOW);
    const bf16* QK = (const bf16*)(P.ws + WS_QK);
    unsigned char* rec = P.ws + WS_REC + (size_t)u * REC_BYTES;
    unsigned char* rech = rec + (hh ? REC_H1 : 0);
#pragma unroll
    for (int i = 0; i < 4; ++i) { const int idx = tid + 512 * i, t = idx >> 5, ch = idx & 31;
        const v4u q = *(const GAS v4u*)(QK + (size_t)(row0 + t) * DM + h * 256 + ch * 8), k = *(const GAS v4u*)(QK + (size_t)(row0 + t) * DM + 1024 + h * 256 + ch * 8);
        *(LAS v4u*)(QI + t * 512 + ch * 16) = q; *(LAS v4u*)(KI + t * 512 + ch * 16) = k; }
    if (tid < 256) ((LAS f32x4*)GL)[tid] = ((const f32x4*)(GLOW + (size_t)row0 * 16))[tid];
    float wg[16];
#pragma unroll
    for (int r = 0; r < 16; ++r) wg[r] = P.w_gate_up[r * 1024 + h * 256 + d];
    const float bias = P.b_gate[h * 256 + d];
    __syncthreads();
    float bl[32]; float run = 0.f;
#pragma unroll
    for (int tt = 0; tt < 32; ++tt) { const int t = th * 32 + tt; const LAS f32x4* gr = (const LAS f32x4*)(GL + t * 16);
        const f32x4 g0 = gr[0], g1 = gr[1], g2 = gr[2], g3 = gr[3];
        float z = bias + g0.x * wg[0] + g0.y * wg[1] + g0.z * wg[2] + g0.w * wg[3] + g1.x * wg[4] + g1.y * wg[5] + g1.z * wg[6] + g1.w * wg[7]
                       + g2.x * wg[8] + g2.y * wg[9] + g2.z * wg[10] + g2.w * wg[11] + g3.x * wg[12] + g3.y * wg[13] + g3.z * wg[14] + g3.w * wg[15];
        const float ls = fminf(z, 0.f) - __logf(1.0f + __expf(-fabsf(z)));
        run += ls * 0.0625f; bl[tt] = run; }
    TOT[th * 256 + d] = run;
    unsigned short qr[32], kr[32];
#pragma unroll
    for (int tt = 0; tt < 32; ++tt) { qr[tt] = *(const LAS unsigned short*)(QI + (th * 32 + tt) * 512 + d * 2); kr[tt] = *(const LAS unsigned short*)(KI + (th * 32 + tt) * 512 + d * 2); }
    __syncthreads();
    const float tot0 = TOT[d], tot1 = TOT[256 + d], blast = tot0 + tot1, base = th ? tot0 : 0.f;
    unsigned kt[16];
#pragma unroll
    for (int tt = 0; tt < 32; tt += 2) {
        float kv2[2];
#pragma unroll
        for (int k2 = 0; k2 < 2; ++k2) { const int t = th * 32 + tt + k2; const float bt = base + bl[tt + k2];
            const float e1 = __expf(bt - blast), e2 = __builtin_amdgcn_rcpf(e1);
            const float qv = bf2f(qr[tt + k2]) * e1, kv = bf2f(kr[tt + k2]) * e2; kv2[k2] = kv;
            const int off = hh * 16384 + qt_off(t, dl);
            *(LAS unsigned short*)(QI + off) = (unsigned short)(cvtpk2(qv, 0.f) & 0xffffu); *(LAS unsigned short*)(KI + off) = (unsigned short)(cvtpk2(kv, 0.f) & 0xffffu); }
        kt[tt >> 1] = cvtpk2(kv2[0], kv2[1]); }
#pragma unroll
    for (int i = 0; i < 4; ++i) { v4u o; o.x = kt[4 * i]; o.y = kt[4 * i + 1]; o.z = kt[4 * i + 2]; o.w = kt[4 * i + 3]; *(GAS v4u*)(rech + H_KT + kt_chunk(dl, 4 * th + i)) = o; }
    if (th == 0) ((GAS float*)(rech + H_G))[dl] = __expf(blast);
    __syncthreads();
    { const int r = lane & 15, g = lane >> 4, mt = wave >> 1, st0 = 2 * (wave & 1);
      f32x4 a0 = {0.f, 0.f, 0.f, 0.f}, a1 = {0.f, 0.f, 0.f, 0.f};
      bf16x8 bq[8], k0[8], k1[8];
#pragma unroll
      for (int kk = 0; kk < 8; ++kk) { const int ho = (kk >> 2) * 16384, cc = 4 * (kk & 3) + g;
          bq[kk] = *(const LAS bf16x8*)(QI + ho + qt_chunk(16 * mt + r, cc)); k0[kk] = *(const LAS bf16x8*)(KI + ho + qt_chunk(16 * st0 + r, cc)); k1[kk] = *(const LAS bf16x8*)(KI + ho + qt_chunk(16 * st0 + 16 + r, cc)); }
#pragma unroll
      for (int kk = 0; kk < 8; ++kk) { a0 = MFMA16(k0[kk], bq[kk], a0); a1 = MFMA16(k1[kk], bq[kk], a1); }
      const int t = 16 * mt + r;
#pragma unroll
      for (int j = 0; j < 2; ++j) { const f32x4 a = j ? a1 : a0; const int s0 = 16 * (st0 + j) + 4 * g;
          u32x2 w; w.x = cvtpk2(s0 + 0 <= t ? a[0] : 0.f, s0 + 1 <= t ? a[1] : 0.f); w.y = cvtpk2(s0 + 2 <= t ? a[2] : 0.f, s0 + 3 <= t ? a[3] : 0.f);
          *(GAS u32x2*)(rec + REC_PO + kt_chunk(t, s0 >> 3) + (s0 & 7) * 2) = w; } }
#pragma unroll
    for (int i = 0; i < 4; ++i) { const int idx = tid + 512 * i; ((GAS v4u*)(rec + ((idx >> 10) ? REC_H1 : 0) + H_QT))[idx & 1023] = ((const LAS v4u*)QI)[idx]; }
    __syncthreads();
}

constexpr int SC_BUF = REC_DMA, SC_PIECES = REC_DMA / 1024, SC_OT = 3 * REC_DMA;
static_assert(SC_OT + 2 * 16384 <= LDSCTL_OFF, "scan LDS map");
__device__ __forceinline__ void gla_scan_unit(const Ptrs& P, LAS unsigned char* lds, int bh, int dh, int eq, int tid, int wave, int lane, int nch = 32) {
    const int b = bh >> 2, h = bh & 3, r = lane & 15, g = lane >> 4, rr = (r >> 1) & 7;
    const int ecol = h * 512 + eq * 128 + 16 * wave;
    const bf16* VT = (const bf16*)(P.ws + WS_VT);
    bf16* OB = (bf16*)(P.ws + (dh ? WS_QK : WS_BUFA)) + (size_t)(b * 2048) * DM + h * 512 + eq * 128;
    const unsigned char* rec0 = P.ws + WS_REC + (size_t)(bh * 32) * REC_BYTES + (dh ? REC_PO : 0);
    const unsigned HO = dh ? 8192u : 0u, PO = dh ? 0u : 33792u;
    f32x4 S[8];
#pragma unroll
    for (int i = 0; i < 8; ++i) S[i] = (f32x4){0.f, 0.f, 0.f, 0.f};
    const bf16* vtp = VT + (size_t)(ecol + r) * MT + b * 2048 + 8 * g;
#define SC_DMA(cc, bufo_) do { const unsigned char* src_ = rec0 + (size_t)(cc) * REC_BYTES + lane * 16; \
        _Pragma("unroll") for (int j_ = 0; j_ < 6; ++j_) { const int i_ = wave + NWAVES * j_; \
            if (i_ < SC_PIECES) __builtin_amdgcn_global_load_lds((const GAS unsigned*)(src_ + i_ * 1024), (LAS unsigned*)(lds + (bufo_) + i_ * 1024), 16, 0, 0); } } while (0)
#define SC_OSTORE(cc) do { const LAS unsigned char* ot_ = lds + SC_OT + ((cc) & 1) * 16384; \
        _Pragma("unroll") for (int j_ = 0; j_ < 2; ++j_) { const int idx_ = tid + 512 * j_, row_ = idx_ >> 4, q_ = idx_ & 15; \
            const v4u v_ = *(const LAS v4u*)(ot_ + row_ * 256 + ((q_ ^ (row_ & 15)) << 4)); \
            *(GAS v4u*)(OB + (size_t)((cc) * 64 + row_) * DM + q_ * 8) = v_; } } while (0)
    bf16x8 vc0 = *(const bf16x8*)vtp, vc1 = *(const bf16x8*)(vtp + 32), vn0 = vc0, vn1 = vc1;
    SC_DMA(0, 0u); SC_DMA(1, (unsigned)SC_BUF);
    __syncthreads();
    unsigned bo0 = 0u, bo1 = SC_BUF, bo2 = 2u * SC_BUF;
#pragma unroll 1
    for (int c = 0; c < nch; ++c) {
        bf16x8 vf[2]; vf[0] = vc0; vf[1] = vc1;
        { const bf16* vp_ = vtp + (c + 1 < 32 ? c + 1 : 31) * 64;
          asm volatile("global_load_dwordx4 %0, %2, off\n\tglobal_load_dwordx4 %1, %2, off offset:64" : "=&v"(vn0), "=&v"(vn1) : "v"(vp_) : "memory"); }
        if (c > 0) SC_OSTORE(c - 1);
        const unsigned bufo = bo0;
        const unsigned qbase = bufo + HO + H_QT + (unsigned)(r * 256 + ((r >> 2) << 6) + ((g ^ (r & 3)) << 4));
        const unsigned kbase = bufo + HO + H_KT + (unsigned)(r * 128 + ((rr >> 2) << 6) + ((g ^ (rr & 3)) << 4));
        const unsigned pbase = bufo + PO + (unsigned)(r * 128 + ((dh ^ (rr >> 2)) << 6) + ((g ^ (rr & 3)) << 4));
        const unsigned gbase = bufo + HO + H_G + (unsigned)(g * 16);
#define SC_FENCE() __builtin_amdgcn_sched_barrier(0)
#define SC_BQ(k2, tt) (*(const LAS bf16x8*)(lds + ((qbase ^ ((k2) << 6)) + (tt) * 4096)))
#define SC_KF(i, ks) (*(const LAS bf16x8*)(lds + ((kbase ^ ((ks) << 6)) + (i) * 2048)))
#define SC_AF(k2) __builtin_bit_cast(bf16x8, (v4u){cvtpk2(S[2 * (k2)][0], S[2 * (k2)][1]), cvtpk2(S[2 * (k2)][2], S[2 * (k2)][3]), cvtpk2(S[2 * (k2) + 1][0], S[2 * (k2) + 1][1]), cvtpk2(S[2 * (k2) + 1][2], S[2 * (k2) + 1][3])})
        f32x4 gm[4]; bf16x8 qa[8], qb[8];
#pragma unroll
        for (int i = 0; i < 4; ++i) gm[i] = *(const LAS f32x4*)(lds + (gbase + i * 64));
#pragma unroll
        for (int tt = 0; tt < 4; ++tt) { qa[tt] = SC_BQ(0, tt); qa[4 + tt] = SC_BQ(1, tt); }
        SC_FENCE();
#pragma unroll
        for (int i = 0; i < 4; ++i) S[i] = S[i] * gm[i];
#pragma unroll
        for (int i = 0; i < 4; ++i) gm[i] = *(const LAS f32x4*)(lds + (gbase + (4 + i) * 64));
#pragma unroll
        for (int tt = 0; tt < 4; ++tt) { qb[tt] = SC_BQ(2, tt); qb[4 + tt] = SC_BQ(3, tt); }
        bf16x8 pq[4];
#pragma unroll
        for (int tt = 0; tt < 4; ++tt) pq[tt] = *(const LAS bf16x8*)(lds + (pbase + tt * 2048));
        SC_FENCE();
        f32x4 Z[4];
#pragma unroll
        for (int tt = 0; tt < 4; ++tt) Z[tt] = (f32x4){0.f, 0.f, 0.f, 0.f};
        { const bf16x8 a0 = SC_AF(0), a1 = SC_AF(1);
#pragma unroll
          for (int tt = 0; tt < 4; ++tt) Z[tt] = MFMA16(a0, qa[tt], Z[tt]);
#pragma unroll
          for (int tt = 0; tt < 4; ++tt) Z[tt] = MFMA16(a1, qa[4 + tt], Z[tt]); }
#pragma unroll
        for (int i = 0; i < 4; ++i) S[4 + i] = S[4 + i] * gm[i];
#pragma unroll
        for (int i = 0; i < 4; ++i) { qa[2 * i] = SC_KF(i, 0); qa[2 * i + 1] = SC_KF(i, 1); }
        SC_FENCE();

        { const bf16x8 a2 = SC_AF(2), a3 = SC_AF(3);
#pragma unroll
          for (int tt = 0; tt < 4; ++tt) Z[tt] = MFMA16(a2, qb[tt], Z[tt]);
#pragma unroll
          for (int tt = 0; tt < 4; ++tt) Z[tt] = MFMA16(a3, qb[4 + tt], Z[tt]);
#pragma unroll
          for (int tt = 0; tt < 4; ++tt) Z[tt] = MFMA16(dh ? vf[1] : vf[0], pq[tt], Z[tt]); }
#pragma unroll
        for (int i = 0; i < 4; ++i) { qb[2 * i] = SC_KF(4 + i, 0); qb[2 * i + 1] = SC_KF(4 + i, 1); }
        SC_FENCE();
        asm volatile("s_waitcnt vmcnt(0)" : "+v"(vn0), "+v"(vn1) :: "memory");
        SC_DMA((c + 2 < 32 ? c + 2 : 31), bo2);
        SC_FENCE();
#pragma unroll
        for (int i = 0; i < 4; ++i) { S[i] = MFMA16(qa[2 * i], vf[0], S[i]); S[i] = MFMA16(qa[2 * i + 1], vf[1], S[i]); }
#pragma unroll
        for (int i = 0; i < 4; ++i) { S[4 + i] = MFMA16(qb[2 * i], vf[0], S[4 + i]); S[4 + i] = MFMA16(qb[2 * i + 1], vf[1], S[4 + i]); }
#undef SC_FENCE
#undef SC_BQ
#undef SC_KF
#undef SC_AF
        { LAS unsigned char* ot = lds + SC_OT + (c & 1) * 16384 + (g & 1) * 8;
#pragma unroll
          for (int tt = 0; tt < 4; ++tt) { u32x2 w; w.x = cvtpk2(Z[tt][0], Z[tt][1]); w.y = cvtpk2(Z[tt][2], Z[tt][3]);
              *(LAS u32x2*)(ot + (16 * tt + r) * 256 + (((2 * wave + (g >> 1)) ^ r) << 4)) = w; } }
        asm volatile("s_waitcnt lgkmcnt(0)" ::: "memory"); __builtin_amdgcn_s_barrier(); asm volatile("" ::: "memory");
        vc0 = vn0; vc1 = vn1;
        { const unsigned t_ = bo0; bo0 = bo1; bo1 = bo2; bo2 = t_; }
    }
    SC_OSTORE(nch - 1);
#undef SC_OSTORE
#undef SC_DMA
    asm volatile("s_waitcnt vmcnt(0)" ::: "memory"); __syncthreads();
    float* SO = P.out + OUT_GLAP + ((size_t)bh * 256 + 128 * dh + 4 * g) * 512 + eq * 128 + 16 * wave + r;
#pragma unroll
    for (int i = 0; i < 8; ++i) { float* so = SO + (size_t)i * 16 * 512; asm volatile("" : "+v"(so));
        so[0] = S[i][0]; so[512] = S[i][1]; so[1024] = S[i][2]; so[1536] = S[i][3]; }
}

__device__ __forceinline__ void gla_sample_unit(const Ptrs& P, LAS unsigned char* lds, int u, int tid, int wave, int lane) {
    const int h = u & 3, b = u >> 2;
    LAS float* GL = (LAS float*)lds;
    LAS float* QD = (LAS float*)(lds + 1024);
    LAS float* KD = (LAS float*)(lds + 1024 + 8192);
    LAS float* GD = (LAS float*)(lds + 1024 + 16384);
    LAS float* PR = (LAS float*)(lds + 18432);
    LAS float* RED = (LAS float*)(lds + 18688);
    LAS float* VL = (LAS float*)(lds + 20480);
    LAS float* OP = (LAS float*)(lds + 36864);
    const int row0 = MPR + b * 8;
    const bf16* QK = (const bf16*)(P.ws + WS_QK); const bf16* VT = (const bf16*)(P.ws + WS_VT); const float* GLOW = (const float*)(P.ws + WS_GLOW);
    const int eq = tid & 127, dq = tid >> 7;
    const size_t sbase = ((size_t)(b * 4 + h) * 256 + 64 * dq) * 512 + 4 * eq;
    const float* S0p = P.state + sbase; float* S1p = P.out + OUT_GLAS + sbase;
    if (tid < 32) ((LAS f32x4*)GL)[tid] = ((const f32x4*)(GLOW + (size_t)row0 * 16))[tid];
    { const v4u vv = *(const GAS v4u*)(VT + (size_t)(h * 512 + tid) * MT + row0);
      VL[0 * 512 + tid] = __uint_as_float(vv.x << 16); VL[1 * 512 + tid] = __uint_as_float(vv.x & 0xffff0000u); VL[2 * 512 + tid] = __uint_as_float(vv.y << 16); VL[3 * 512 + tid] = __uint_as_float(vv.y & 0xffff0000u);
      VL[4 * 512 + tid] = __uint_as_float(vv.z << 16); VL[5 * 512 + tid] = __uint_as_float(vv.z & 0xffff0000u); VL[6 * 512 + tid] = __uint_as_float(vv.w << 16); VL[7 * 512 + tid] = __uint_as_float(vv.w & 0xffff0000u); }
    __syncthreads();
    if (tid < 256) {
        const int d = tid;
        float wg[16];
#pragma unroll
        for (int r = 0; r < 16; ++r) wg[r] = P.w_gate_up[r * 1024 + h * 256 + d];
        const float bias = P.b_gate[h * 256 + d];
        float bc[8], q[8], k[8]; float run = 0.f;
#pragma unroll
        for (int t = 0; t < 8; ++t) { q[t] = bf2f(QK[(size_t)(row0 + t) * DM + h * 256 + d]); k[t] = bf2f(QK[(size_t)(row0 + t) * DM + 1024 + h * 256 + d]); }
#pragma unroll
        for (int t = 0; t < 8; ++t) { const LAS f32x4* gr = (const LAS f32x4*)(GL + t * 16); const f32x4 g0 = gr[0], g1 = gr[1], g2 = gr[2], g3 = gr[3];
            float z = bias + g0.x * wg[0] + g0.y * wg[1] + g0.z * wg[2] + g0.w * wg[3] + g1.x * wg[4] + g1.y * wg[5] + g1.z * wg[6] + g1.w * wg[7]
                           + g2.x * wg[8] + g2.y * wg[9] + g2.z * wg[10] + g2.w * wg[11] + g3.x * wg[12] + g3.y * wg[13] + g3.z * wg[14] + g3.w * wg[15];
            const float ls = fminf(z, 0.f) - __logf(1.0f + __expf(-fabsf(z)));
            run += ls * 0.0625f; bc[t] = run; }
        const float blast = bc[7];
#pragma unroll
        for (int t = 0; t < 8; ++t) { QD[d * 8 + t] = q[t] * __expf(bc[t]); KD[d * 8 + t] = k[t] * __expf(blast - bc[t]); }
        GD[d] = __expf(blast);
        int idx = 0;
#pragma unroll
        for (int t = 0; t < 8; ++t)
#pragma unroll
            for (int s = 0; s <= t; ++s) { float v = q[t] * k[s] * __expf(bc[t] - bc[s]); v = wave_sum(v); if (lane == 0) RED[wave * 36 + idx] = v; ++idx; }
    }
    __syncthreads();
    if (tid < 64) { const int t = tid >> 3, s = tid & 7; float v = 0.f; if (s <= t) { const int idx = t * (t + 1) / 2 + s; v = RED[idx] + RED[36 + idx] + RED[72 + idx] + RED[108 + idx]; } PR[t * 8 + s] = v; }
    { f32x4 sa[4], sb[4];
#pragma unroll
      for (int i = 0; i < 4; ++i) sa[i] = *(const GAS f32x4*)(S0p + (size_t)i * 512);
      f32x4 v[8], o[8];
#pragma unroll
      for (int s = 0; s < 8; ++s) v[s] = *(const LAS f32x4*)(VL + s * 512 + 4 * eq);
#pragma unroll
      for (int t = 0; t < 8; ++t) o[t] = (f32x4){0.f, 0.f, 0.f, 0.f};
#define GS_STEP(cur, nxt, d0, more) do { if (more) { _Pragma("unroll") for (int i = 0; i < 4; ++i) nxt[i] = *(const GAS f32x4*)(S0p + (size_t)((d0) + 4 + i) * 512); } \
        _Pragma("unroll") for (int i = 0; i < 4; ++i) { const int dd = 64 * dq + (d0) + i; \
          const f32x4 qa = *(const LAS f32x4*)(QD + dd * 8), qb = *(const LAS f32x4*)(QD + dd * 8 + 4), ka = *(const LAS f32x4*)(KD + dd * 8), kb = *(const LAS f32x4*)(KD + dd * 8 + 4); \
          const float gm = GD[dd]; const f32x4 x = cur[i]; \
          o[0] += x * qa.x; o[1] += x * qa.y; o[2] += x * qa.z; o[3] += x * qa.w; o[4] += x * qb.x; o[5] += x * qb.y; o[6] += x * qb.z; o[7] += x * qb.w; \
          f32x4 sn = x * gm; sn += v[0] * ka.x; sn += v[1] * ka.y; sn += v[2] * ka.z; sn += v[3] * ka.w; sn += v[4] * kb.x; sn += v[5] * kb.y; sn += v[6] * kb.z; sn += v[7] * kb.w; \
          *(GAS f32x4*)(S1p + (size_t)((d0) + i) * 512) = sn; } } while (0)
#pragma unroll 1
      for (int d0 = 0; d0 < 64; d0 += 8) { GS_STEP(sa, sb, d0, true); GS_STEP(sb, sa, d0 + 4, d0 + 8 < 64); }
#undef GS_STEP
#pragma unroll
      for (int t = 0; t < 8; ++t) *(LAS f32x4*)(OP + (dq * 8 + t) * 512 + 4 * eq) = o[t];
    }
    __syncthreads();
    { const int t = tid >> 6, el = tid & 63; bf16* A2 = (bf16*)(P.ws + WS_BUFA); const bf16* SR = (const bf16*)(P.ws + WS_SR);
      float ov[8]; float ss = 0.f;
#pragma unroll
      for (int j = 0; j < 8; ++j) { const int e = el + 64 * j; float acc = (OP[(0 * 8 + t) * 512 + e] + OP[(1 * 8 + t) * 512 + e]) + (OP[(2 * 8 + t) * 512 + e] + OP[(3 * 8 + t) * 512 + e]);
#pragma unroll
          for (int s = 0; s < 8; ++s) acc += PR[t * 8 + s] * VL[s * 512 + e];
          ov[j] = acc; ss += acc * acc; }
      const float rs = 1.0f / sqrtf(wave_sum(ss) * (1.f / 512.f) + RMS_EPS);
#pragma unroll
      for (int j = 0; j < 8; ++j) { const size_t off = (size_t)(row0 + t) * DM + h * 512 + el + 64 * j; A2[off] = (bf16)(cvtpk2(ov[j] * rs * bf2f(SR[off]), 0.f) & 0xffffu); } }
    __syncthreads();
}

__device__ __forceinline__ void gate_rows(const Ptrs& P, int lane, int m0, int step, int mend) {
    bf16* O0 = (bf16*)(P.ws + WS_BUFA); const bf16* O1 = (const bf16*)(P.ws + WS_QK); const bf16* SR = (const bf16*)(P.ws + WS_SR);
    v4u a0[4], b0[4], s0[4], a1[4], b1[4], s1[4];
#define GR_LD(a, bq, s, m) do { _Pragma("unroll") for (int j = 0; j < 4; ++j) { const size_t off_ = (size_t)(m) * DM + 512 * j + 8 * lane; a[j] = *(const GAS v4u*)(O0 + off_); bq[j] = *(const GAS v4u*)(O1 + off_); s[j] = *(const GAS v4u*)(SR + off_); } } while (0)
#define GR_DO(a, bq, s, m) do { _Pragma("unroll") for (int j = 0; j < 4; ++j) { const size_t off_ = (size_t)(m) * DM + 512 * j + 8 * lane; float o[8]; \
        o[0] = __uint_as_float(a[j].x << 16) + __uint_as_float(bq[j].x << 16); o[1] = __uint_as_float(a[j].x & 0xffff0000u) + __uint_as_float(bq[j].x & 0xffff0000u); \
        o[2] = __uint_as_float(a[j].y << 16) + __uint_as_float(bq[j].y << 16); o[3] = __uint_as_float(a[j].y & 0xffff0000u) + __uint_as_float(bq[j].y & 0xffff0000u); \
        o[4] = __uint_as_float(a[j].z << 16) + __uint_as_float(bq[j].z << 16); o[5] = __uint_as_float(a[j].z & 0xffff0000u) + __uint_as_float(bq[j].z & 0xffff0000u); \
        o[6] = __uint_as_float(a[j].w << 16) + __uint_as_float(bq[j].w << 16); o[7] = __uint_as_float(a[j].w & 0xffff0000u) + __uint_as_float(bq[j].w & 0xffff0000u); \
        const float ss_ = ((o[0] * o[0] + o[1] * o[1]) + (o[2] * o[2] + o[3] * o[3])) + ((o[4] * o[4] + o[5] * o[5]) + (o[6] * o[6] + o[7] * o[7])); \
        const float rs_ = 1.0f / sqrtf(wave_sum(ss_) * (1.f / 512.f) + RMS_EPS); v4u w; \
        w.x = cvtpk2(o[0] * rs_ * __uint_as_float(s[j].x << 16), o[1] * rs_ * __uint_as_float(s[j].x & 0xffff0000u)); w.y = cvtpk2(o[2] * rs_ * __uint_as_float(s[j].y << 16), o[3] * rs_ * __uint_as_float(s[j].y & 0xffff0000u)); \
        w.z = cvtpk2(o[4] * rs_ * __uint_as_float(s[j].z << 16), o[5] * rs_ * __uint_as_float(s[j].z & 0xffff0000u)); w.w = cvtpk2(o[6] * rs_ * __uint_as_float(s[j].w << 16), o[7] * rs_ * __uint_as_float(s[j].w & 0xffff0000u)); \
        *(GAS v4u*)(O0 + off_) = w; } } while (0)
    if (m0 < mend) GR_LD(a0, b0, s0, m0);
#pragma unroll 1
    for (int m = m0; m < mend; m += 2 * step) {
        if (m + step < mend) GR_LD(a1, b1, s1, m + step);
        GR_DO(a0, b0, s0, m);
        if (m + step < mend) { if (m + 2 * step < mend) GR_LD(a0, b0, s0, m + 2 * step); GR_DO(a1, b1, s1, m + step); }
    }
#undef GR_LD
#undef GR_DO
}
__device__ __forceinline__ void final_rows(float* base, const float* gfin, int lane, int m0, int step, int mend) {
    const GAS f32x4* gr = (const GAS f32x4*)gfin + lane;
    f32x4 va[8], vb[8];
    if (m0 < mend) { const GAS f32x4* xr = (const GAS f32x4*)(base + (size_t)m0 * DM) + lane;
#pragma unroll
        for (int j = 0; j < 8; ++j) va[j] = xr[64 * j]; }
#define FR_STEP(cur, nxt, m) do { const int mn_ = (m) + step; if (mn_ < mend) { const GAS f32x4* xn_ = (const GAS f32x4*)(base + (size_t)mn_ * DM) + lane; _Pragma("unroll") for (int j = 0; j < 8; ++j) nxt[j] = xn_[64 * j]; } \
        float s_ = 0.f; _Pragma("unroll") for (int j = 0; j < 8; ++j) s_ += (cur[j].x * cur[j].x + cur[j].y * cur[j].y) + (cur[j].z * cur[j].z + cur[j].w * cur[j].w); \
        const float rstd_ = 1.0f / sqrtf(wave_sum(s_) * (1.f / DM) + RMS_EPS); GAS f32x4* dr_ = (GAS f32x4*)(base + (size_t)(m) * DM) + lane; \
        _Pragma("unroll") for (int j = 0; j < 8; ++j) dr_[64 * j] = cur[j] * rstd_ * gr[64 * j]; } while (0)
#pragma unroll 1
    for (int m = m0; m < mend; m += 2 * step) { FR_STEP(va, vb, m); if (m + step < mend) FR_STEP(vb, va, m + step); }
#undef FR_STEP
}
__device__ __forceinline__ void final_row(float* hrow, const float* gfin, int lane, float* drow) {
    GAS f32x4* xr = (GAS f32x4*)hrow + lane; GAS f32x4* dr = (GAS f32x4*)drow + lane; const GAS f32x4* gr = (const GAS f32x4*)gfin + lane;
    f32x4 v[8]; float s = 0.f;
#pragma unroll
    for (int j = 0; j < 8; ++j) { v[j] = xr[64 * j]; s += (v[j].x * v[j].x + v[j].y * v[j].y) + (v[j].z * v[j].z + v[j].w * v[j].w); }
    const float rstd = 1.0f / sqrtf(wave_sum(s) * (1.f / DM) + RMS_EPS);
#pragma unroll
    for (int j = 0; j < 8; ++j) dr[64 * j] = v[j] * rstd * gr[64 * j];
}

__device__ __forceinline__ void attn_subblock(const LAS bf16* KI, const LAS bf16* VI, int ts, const bf16x8 q0, const bf16x8 q1, int qpos, int kpos0, float slope2, float sink2,
                                              const u32x2 (&zz)[4], bf16* orow, bool store, int lane) {
    const int r = lane & 15, g = lane >> 4;
    f32x4 sc[10]; float mx = -INFINITY;
    const int D = qpos - (kpos0 + 16 * ts + 4 * g); const unsigned U = (unsigned)(qpos < 128 ? qpos : 128);
    const float c0 = -slope2 * (float)D; const f32x4 cinit = {c0, c0, c0, c0};
    { bf16x8 ka[10], kb[10];
      const LAS bf16* kr0 = KI + (16 * ts + r) * 80 + 8 * g;
#pragma unroll
      for (int i = 0; i < 5; ++i) { ka[2 * i] = *(const LAS bf16x8*)(kr0 + i * 1280); ka[2 * i + 1] = *(const LAS bf16x8*)(kr0 + i * 1280 + 32); }
      __builtin_amdgcn_sched_barrier(0);
#pragma unroll
      for (int i = 0; i < 5; ++i) { kb[2 * i] = *(const LAS bf16x8*)(kr0 + (5 + i) * 1280); kb[2 * i + 1] = *(const LAS bf16x8*)(kr0 + (5 + i) * 1280 + 32); }
#pragma unroll
      for (int i = 0; i < 5; ++i) { f32x4 a = MFMA16(ka[2 * i], q0, cinit); sc[i] = MFMA16(ka[2 * i + 1], q1, a); }
      __builtin_amdgcn_sched_barrier(0);
#pragma unroll
      for (int i = 0; i < 5; ++i) { f32x4 a = MFMA16(kb[2 * i], q0, cinit); sc[5 + i] = MFMA16(kb[2 * i + 1], q1, a); } }
#pragma unroll
    for (int i = 0; i < 10; ++i) {
#pragma unroll
        for (int e = 0; e < 4; ++e) { const unsigned dist = (unsigned)(D - (16 * i + e));
            const float v = dist <= U ? __builtin_fmaf(slope2, (float)(16 * i + e), sc[i][e]) : -INFINITY; sc[i][e] = v; mx = fmaxf(mx, v); } }
    mx = fmaxf(mx, __shfl_xor(mx, 16)); mx = fmaxf(mx, __shfl_xor(mx, 32)); mx = fmaxf(mx, sink2);
    float l = 0.f;
#pragma unroll
    for (int i = 0; i < 10; ++i)
#pragma unroll
        for (int e = 0; e < 4; ++e) { const float p = __builtin_amdgcn_exp2f(sc[i][e] - mx); sc[i][e] = p; l += p; }
    l += __shfl_xor(l, 16); l += __shfl_xor(l, 32);
    const float inv = 1.0f / (l + __builtin_amdgcn_exp2f(sink2 - mx));
    f32x4 o[4];
#pragma unroll
    for (int dt = 0; dt < 4; ++dt) o[dt] = (f32x4){0.f, 0.f, 0.f, 0.f};
    { const LAS bf16* vr0 = VI + r * 264 + 16 * ts + 4 * g;
#define AT_VRD(dst, ks) do { _Pragma("unroll") for (int dt = 0; dt < 4; ++dt) { const LAS bf16* vr = vr0 + dt * 4224 + (ks) * 32; \
          const u32x2 lo = *(const LAS u32x2*)vr, hi = *(const LAS u32x2*)(vr + 16); dst[dt].x = lo.x; dst[dt].y = lo.y; dst[dt].z = hi.x; dst[dt].w = hi.y; } } while (0)
#define AT_PV(src, ks) do { v4u pp; pp.x = cvtpk2(sc[2 * (ks)][0], sc[2 * (ks)][1]); pp.y = cvtpk2(sc[2 * (ks)][2], sc[2 * (ks)][3]); pp.z = cvtpk2(sc[2 * (ks) + 1][0], sc[2 * (ks) + 1][1]); pp.w = cvtpk2(sc[2 * (ks) + 1][2], sc[2 * (ks) + 1][3]); \
          const bf16x8 pb = __builtin_bit_cast(bf16x8, pp); _Pragma("unroll") for (int dt = 0; dt < 4; ++dt) o[dt] = MFMA16(__builtin_bit_cast(bf16x8, src[dt]), pb, o[dt]); } while (0)
      v4u va[4], vb[4];
      AT_VRD(va, 0); AT_VRD(vb, 1);
      __builtin_amdgcn_sched_barrier(0);
      AT_PV(va, 0); AT_VRD(va, 2);
      __builtin_amdgcn_sched_barrier(0);
      AT_PV(vb, 1); AT_VRD(vb, 3);
      __builtin_amdgcn_sched_barrier(0);
      AT_PV(va, 2); AT_VRD(va, 4);
      __builtin_amdgcn_sched_barrier(0);
      AT_PV(vb, 3);
      __builtin_amdgcn_sched_barrier(0);
      AT_PV(va, 4);
#undef AT_VRD
#undef AT_PV
    }
    if (store) {
#pragma unroll
        for (int dt = 0; dt < 4; ++dt) {
            u32x2 w; w.x = cvtpk2(o[dt][0] * inv * __uint_as_float(zz[dt].x << 16), o[dt][1] * inv * __uint_as_float(zz[dt].x & 0xffff0000u));
            w.y = cvtpk2(o[dt][2] * inv * __uint_as_float(zz[dt].y << 16), o[dt][3] * inv * __uint_as_float(zz[dt].y & 0xffff0000u));
            *(GAS u32x2*)(orow + 16 * dt + 4 * g) = w; }
    }
}
__device__ __forceinline__ void attn_prompt_unit(const Ptrs& P, LAS unsigned char* lds, int u, int tid, int wave, int lane) {
    const int kvh = u & 3, qb = (u >> 2) & 15, b = u >> 6;
    LAS bf16* KI = (LAS bf16*)lds;
    LAS bf16* VI = (LAS bf16*)(lds + 40960);
    const bf16* KB = (const bf16*)(P.ws + WS_KB); const bf16* VT2 = (const bf16*)(P.ws + WS_VT2); const bf16* QZ = (const bf16*)(P.ws + WS_QZ); bf16* A3 = (bf16*)(P.ws + WS_BUFA);
    const int kpos0 = (qb - 1) * 128;
    for (int i = tid; i < 2048; i += NWAVES * 64) { const int j = i >> 3, ch = i & 7; const int kpos = kpos0 + j;
        v4u v = {0u, 0u, 0u, 0u}; if (kpos >= 0) v = *(const GAS v4u*)(KB + (size_t)(b * 2048 + kpos) * 256 + kvh * 64 + ch * 8);
        *(LAS v4u*)(KI + j * 80 + ch * 8) = v; }
    for (int i = tid; i < 2048; i += NWAVES * 64) { const int d = i >> 5, ch = i & 31; const int kpos = kpos0 + ch * 8;
        v4u v = {0u, 0u, 0u, 0u}; if (kpos >= 0) v = *(const GAS v4u*)(VT2 + (size_t)(kvh * 64 + d) * MT + b * 2048 + kpos);
        *(LAS v4u*)(VI + d * 264 + ch * 8) = v; }
    __syncthreads();
    const int hh = kvh * 8 + wave;
    const float slope2 = __builtin_amdgcn_exp2f(-0.25f * (float)(hh + 1)) * LOG2E, sink2 = P.sinks[hh] * LOG2E;
    { const int g = lane >> 4; const bf16* qz0 = QZ + ((size_t)b * 2048 + qb * 128 + (lane & 15)) * 4096 + hh * 64;
      bf16x8 qc0 = *(const bf16x8*)(qz0 + 8 * g), qc1 = *(const bf16x8*)(qz0 + 32 + 8 * g);
#pragma unroll 1
      for (int qs = 0; qs < 8; ++qs) { const int qpos = qb * 128 + 16 * qs + (lane & 15); const size_t row = (size_t)b * 2048 + qpos;
          const bf16* qzr = qz0 + (size_t)qs * 16 * 4096;
          u32x2 zz[4];
#pragma unroll
          for (int dt = 0; dt < 4; ++dt) zz[dt] = *(const GAS u32x2*)(qzr + 2048 + 16 * dt + 4 * g);
          const bf16* qzn = qzr + (qs < 7 ? 16 * 4096 : 0);
          const bf16x8 qn0 = *(const bf16x8*)(qzn + 8 * g), qn1 = *(const bf16x8*)(qzn + 32 + 8 * g);
          attn_subblock(KI, VI, qs < 6 ? qs : 6, qc0, qc1, qpos, kpos0, slope2, sink2, zz, A3 + row * DM + hh * 64, true, lane);
          qc0 = qn0; qc1 = qn1; } }
    __syncthreads();
}
__device__ __forceinline__ void attn_sample_unit(const Ptrs& P, LAS unsigned char* lds, int u, int tid, int wave, int lane) {
    const int kvh = u & 3, b = u >> 2;
    LAS bf16* KI = (LAS bf16*)lds;
    LAS bf16* VI = (LAS bf16*)(lds + 40960);
    const bf16* KB = (const bf16*)(P.ws + WS_KB); const bf16* VT2 = (const bf16*)(P.ws + WS_VT2); const bf16* QZ = (const bf16*)(P.ws + WS_QZ); bf16* A3 = (bf16*)(P.ws + WS_BUFA);
    for (int i = tid; i < 160 * 64; i += NWAVES * 64) { const int j = i >> 6, d = i & 63; float kv = 0.f, vv = 0.f;
        if (j < 128) { kv = P.ck[((size_t)(b * 128 + j) * 4 + kvh) * 64 + d]; vv = P.cv[((size_t)(b * 128 + j) * 4 + kvh) * 64 + d]; }
        else if (j < 136) { kv = bf2f(KB[(size_t)(MPR + b * 8 + j - 128) * 256 + kvh * 64 + d]); vv = bf2f(VT2[(size_t)(kvh * 64 + d) * MT + MPR + b * 8 + j - 128]); }
        KI[j * 80 + d] = (bf16)(cvtpk2(kv, 0.f) & 0xffffu); VI[d * 264 + j] = (bf16)(cvtpk2(vv, 0.f) & 0xffffu); }
    __syncthreads();
    const int hh = kvh * 8 + wave;
    const float slope2 = __builtin_amdgcn_exp2f(-0.25f * (float)(hh + 1)) * LOG2E, sink2 = P.sinks[hh] * LOG2E;
    const int n = lane & 15, qi = n < 8 ? n : 7; const size_t row = (size_t)MPR + b * 8 + qi;
    { const int g = lane >> 4; const bf16* qzr = QZ + row * 4096 + hh * 64; u32x2 zz[4];
#pragma unroll
      for (int dt = 0; dt < 4; ++dt) zz[dt] = *(const GAS u32x2*)(qzr + 2048 + 16 * dt + 4 * g);
      attn_subblock(KI, VI, 0, *(const bf16x8*)(qzr + 8 * g), *(const bf16x8*)(qzr + 32 + 8 * g), 128 + qi, 0, slope2, sink2, zz, A3 + row * DM + hh * 64, n < 8, lane); }
    __syncthreads();
}
constexpr int SG_A = 0, SG_B = 10240, SG_STAGE = 30720, SG_RS = 2 * SG_STAGE;
template <bool NAT>
__device__ __forceinline__ void sgemm_core(LAS unsigned char* lds, const bf16* A, const bf16* B, f32x4 (&acc)[2][2], int tid, int wave, int lane) {
    const int wm = wave >> 2, wn = wave & 3, r = lane & 15, g = lane >> 4, lr = tid >> 3, ch = tid & 7;
    const GAS v4u* ga = (const GAS v4u*)(A + (size_t)lr * 2048 + ch * 8); const GAS v4u* gb0 = (const GAS v4u*)(B + (size_t)lr * 2048 + ch * 8); const GAS v4u* gb1 = (const GAS v4u*)(B + (size_t)(64 + lr) * 2048 + ch * 8);
    v4u ra0, rb0, rc0, ra1, rb1, rc1, ra2, rb2, rc2, ra3, rb3, rc3;
#pragma unroll
    for (int i = 0; i < 2; ++i)
#pragma unroll
        for (int j = 0; j < 2; ++j) acc[i][j] = (f32x4){0.f, 0.f, 0.f, 0.f};
#define SG_LD(s, kt) do { ra##s = ga[(kt) * 8]; rb##s = gb0[(kt) * 8]; rc##s = gb1[(kt) * 8]; } while (0)
#define SG_ST(s, stg) do { *(LAS v4u*)(lds + (stg) * SG_STAGE + SG_A + lr * 160 + ch * 16) = ra##s; *(LAS v4u*)(lds + (stg) * SG_STAGE + SG_B + lr * 160 + ch * 16) = rb##s; \
                           *(LAS v4u*)(lds + (stg) * SG_STAGE + SG_B + (64 + lr) * 160 + ch * 16) = rc##s; } while (0)
#define SG_COMPUTE(stg) do { _Pragma("unroll") for (int kk = 0; kk < 2; ++kk) { bf16x8 af[2], bfr[2]; \
        _Pragma("unroll") for (int i = 0; i < 2; ++i) af[i] = *(const LAS bf16x8*)(lds + (stg) * SG_STAGE + SG_A + (32 * wm + 16 * i + r) * 160 + (32 * kk + 8 * g) * 2); \
        _Pragma("unroll") for (int j = 0; j < 2; ++j) bfr[j] = *(const LAS bf16x8*)(lds + (stg) * SG_STAGE + SG_B + (32 * wn + 16 * j + r) * 160 + (32 * kk + 8 * g) * 2); \
        _Pragma("unroll") for (int i = 0; i < 2; ++i) _Pragma("unroll") for (int j = 0; j < 2; ++j) acc[i][j] = NAT ? MFMA16(af[i], bfr[j], acc[i][j]) : MFMA16(bfr[j], af[i], acc[i][j]); } } while (0)
#define SG_STEP(kt, s, stg) do { SG_COMPUTE(stg); if ((kt) + 1 < 32) SG_ST(s, (stg) ^ 1); if ((kt) + 5 < 32) SG_LD(s, (kt) + 5); __syncthreads(); } while (0)
    SG_LD(0, 0); SG_LD(1, 1); SG_LD(2, 2); SG_LD(3, 3); SG_ST(0, 0); SG_LD(0, 4);
    __syncthreads();
#pragma unroll 1
    for (int kt = 0; kt < 32; kt += 4) { SG_STEP(kt, 1, 0); SG_STEP(kt + 1, 2, 1); SG_STEP(kt + 2, 3, 0); SG_STEP(kt + 3, 0, 1); }
#undef SG_STEP
#undef SG_LD
#undef SG_ST
#undef SG_COMPUTE
}
template <bool SILU>
__device__ __forceinline__ void sg_store_bf16(const f32x4 (&acc)[2][2], bf16* dst, int ld, int wave, int lane, float rs0, float rs1) {
    const int wm = wave >> 2, wn = wave & 3, r = lane & 15, g = lane >> 4;
#pragma unroll
    for (int i = 0; i < 2; ++i)
#pragma unroll
        for (int j = 0; j < 2; ++j) { f32x4 v = acc[i][j] * (i ? rs1 : rs0);
            if (SILU) { v[0] = pg8::silu_f(v[0]); v[1] = pg8::silu_f(v[1]); v[2] = pg8::silu_f(v[2]); v[3] = pg8::silu_f(v[3]); }
            u32x2 w; w.x = cvtpk2(v[0], v[1]); w.y = cvtpk2(v[2], v[3]);
            *(GAS u32x2*)(dst + (size_t)(32 * wm + 16 * i + r) * ld + 32 * wn + 16 * j + 4 * g) = w; }
}
__device__ __forceinline__ void s_in_a_block(const Ptrs& P, LAS unsigned char* lds, int rb, int nbk, int tid, int wave, int lane) {
    const bf16* A = (const bf16*)(P.ws + WS_BUFA) + (size_t)(MPR + 64 * rb) * DM; const bf16* B = (const bf16*)(P.ws + WS_WINA) + (size_t)(128 * nbk) * DM;
    f32x4 acc[2][2];
    if (nbk >= 16 && nbk < 32) {
        sgemm_core<true>(lds, A, B, acc, tid, wave, lane);
        const int wm = wave >> 2, wn = wave & 3, r = lane & 15, g = lane >> 4; bf16* VT = (bf16*)(P.ws + WS_VT);
#pragma unroll
        for (int i = 0; i < 2; ++i)
#pragma unroll
            for (int j = 0; j < 2; ++j) { u32x2 w; w.x = cvtpk2(acc[i][j][0], acc[i][j][1]); w.y = cvtpk2(acc[i][j][2], acc[i][j][3]);
                *(GAS u32x2*)(VT + (size_t)((nbk - 16) * 128 + 32 * wn + 16 * j + r) * MT + MPR + 64 * rb + 32 * wm + 16 * i + 4 * g) = w; }
    } else {
        sgemm_core<false>(lds, A, B, acc, tid, wave, lane);
        if (nbk < 16) sg_store_bf16<false>(acc, (bf16*)(P.ws + WS_QK) + (size_t)(MPR + 64 * rb) * DM + nbk * 128, DM, wave, lane, 1.f, 1.f);
        else sg_store_bf16<true>(acc, (bf16*)(P.ws + WS_SR) + (size_t)(MPR + 64 * rb) * DM + (nbk - 32) * 128, DM, wave, lane, 1.f, 1.f);
    }
}
template <bool WITH_B16>
__device__ __forceinline__ void s_out_block(const Ptrs& P, LAS unsigned char* lds, const bf16* Abase, const bf16* Wt, const float* res, int rb, int nb, int tid, int wave, int lane) {
    f32x4 acc[2][2];
    sgemm_core<false>(lds, Abase + (size_t)(64 * rb) * DM, Wt + (size_t)(128 * nb) * DM, acc, tid, wave, lane);
    const int wm = wave >> 2, wn = wave & 3, r = lane & 15, g = lane >> 4;
    float* out = P.out + OUT_Y + (size_t)MPR * DM; bf16* H1b = (bf16*)(P.ws + WS_SR) + (size_t)MPR * DM; float* SSQ2 = (float*)(P.ws + WS_SSQP);
#pragma unroll
    for (int i = 0; i < 2; ++i) { const int row = 64 * rb + 32 * wm + 16 * i + r; float ss = 0.f;
#pragma unroll
        for (int j = 0; j < 2; ++j) { const size_t off = (size_t)row * DM + 128 * nb + 32 * wn + 16 * j + 4 * g;
            const f32x4 v = *(const GAS f32x4*)(res + off) + acc[i][j]; *(GAS f32x4*)(out + off) = v;
            if (WITH_B16) { u32x2 w; w.x = cvtpk2(v[0], v[1]); w.y = cvtpk2(v[2], v[3]); *(GAS u32x2*)(H1b + off) = w; ss += (v[0] * v[0] + v[1] * v[1]) + (v[2] * v[2] + v[3] * v[3]); } }
        if (WITH_B16) { ss += __shfl_xor(ss, 16); ss += __shfl_xor(ss, 32); if (g == 0) SSQ2[(size_t)row * 64 + nb * 4 + wn] = ss; } }
}
__device__ __forceinline__ void s_in_b_block(const Ptrs& P, LAS unsigned char* lds, int rb, int nbk, int tid, int wave, int lane) {
    const bf16* A = (const bf16*)(P.ws + WS_SR) + (size_t)(MPR + 64 * rb) * DM; const bf16* B = (const bf16*)(P.ws + WS_WINB) + (size_t)(128 * nbk) * DM;
    LAS float* RS = (LAS float*)(lds + SG_RS);
    { const int row = tid >> 3, part = tid & 7; const float* sp = (const float*)(P.ws + WS_SSQP) + (size_t)(64 * rb + row) * 64 + part * 8;
      const f32x4 a = *(const GAS f32x4*)sp, b = *(const GAS f32x4*)(sp + 4); float s = (a[0] + a[1]) + (a[2] + a[3]) + (b[0] + b[1]) + (b[2] + b[3]);
      s += __shfl_xor(s, 1); s += __shfl_xor(s, 2); s += __shfl_xor(s, 4);
      if (part == 0) RS[row] = 1.0f / sqrtf(s * (1.f / DM) + RMS_EPS); }
    f32x4 acc[2][2];
    const int wm = wave >> 2, wn = wave & 3, r = lane & 15, g = lane >> 4;
    if (nbk >= 34) {
        sgemm_core<true>(lds, A, B, acc, tid, wave, lane);
        bf16* VT2 = (bf16*)(P.ws + WS_VT2); float* vws = P.out + OUT_VWS;
#pragma unroll
        for (int i = 0; i < 2; ++i) { const f32x4 rs = *(const LAS f32x4*)(RS + 32 * wm + 16 * i + 4 * g);
#pragma unroll
            for (int j = 0; j < 2; ++j) { const f32x4 v = acc[i][j] * rs; const int col = (nbk - 34) * 128 + 32 * wn + 16 * j + r; const int srow = 64 * rb + 32 * wm + 16 * i + 4 * g;
                u32x2 w; w.x = cvtpk2(v[0], v[1]); w.y = cvtpk2(v[2], v[3]);
                *(GAS u32x2*)(VT2 + (size_t)col * MT + MPR + srow) = w;
#pragma unroll
                for (int e = 0; e < 4; ++e) { const int s = srow + e; vws[((size_t)(s >> 3) * 128 + 120 + (s & 7)) * 256 + col] = v[e]; } } }
    } else {
        sgemm_core<false>(lds, A, B, acc, tid, wave, lane);
        const float rs0 = RS[32 * wm + r], rs1 = RS[32 * wm + 16 + r];
        if (nbk < 16) sg_store_bf16<false>(acc, (bf16*)(P.ws + WS_QZ) + (size_t)(MPR + 64 * rb) * 4096 + nbk * 128, 4096, wave, lane, rs0, rs1);
        else if (nbk < 32) sg_store_bf16<true>(acc, (bf16*)(P.ws + WS_QZ) + (size_t)(MPR + 64 * rb) * 4096 + nbk * 128, 4096, wave, lane, rs0, rs1);
        else { sg_store_bf16<false>(acc, (bf16*)(P.ws + WS_KB) + (size_t)(MPR + 64 * rb) * 256 + (nbk - 32) * 128, 256, wave, lane, rs0, rs1);
            float* kws = P.out + OUT_KWS;
#pragma unroll
            for (int i = 0; i < 2; ++i) { const int s = 64 * rb + 32 * wm + 16 * i + r; float* d = kws + ((size_t)(s >> 3) * 128 + 120 + (s & 7)) * 256 + (nbk - 32) * 128 + 32 * wn + 4 * g;
#pragma unroll
                for (int j = 0; j < 2; ++j) *(GAS f32x4*)(d + 16 * j) = acc[i][j] * (i ? rs1 : rs0); } }
    }
}
#ifndef MK_N_LAUNCHES
#define MK_N_LAUNCHES 1
#endif
constexpr int N_PHASES = 11;
constexpr int N_LAUNCHES = MK_N_LAUNCHES;
struct Args { Ptrs p; int ph_lo, ph_hi; };
static_assert(sizeof(Args) == 20 * 8 + 8, "Args has no padding");

__global__ void __launch_bounds__(NWAVES * 64, 2) yoco_fwd(Args args) {
    extern __shared__ __attribute__((aligned(16))) unsigned char lds_raw[];
    LAS unsigned char* lds = (LAS unsigned char*)lds_raw;
    volatile LAS unsigned* MISC = (volatile LAS unsigned*)(lds + MISC_OFF);
    const int tid = threadIdx.x, lane = tid & 63, wave = __builtin_amdgcn_readfirstlane(tid >> 6);
    const int G = gridDim.x, c = blockIdx.x;
    const int vcu = (G % 8 == 0) ? (c % 8) * (G / 8) + c / 8 : c;
    const Ptrs& P = args.p;
    gu32* ctl = (gu32*)(P.ws + WS_CTL);
    for (int u = tid; u < (LDS_BYTES - LDSCTL_OFF) / 4; u += NWAVES * 64) ((LAS unsigned*)(lds + LDSCTL_OFF))[u] = 0u;
    __syncthreads();
    XcdBarrier bar; bar.bar = (unsigned*)(ctl + CW_BAR); bar.x = 0; bar.st = nullptr;
    const int lo = args.ph_lo, hi = args.ph_hi;
    if (hi - lo > 1) bar = xcd_barrier_post((unsigned*)(ctl + CW_BAR), MISC + 8);
#define IN(k) (lo <= (k) && (k) < hi)
#define SEAM(k) do { if (IN(k) && IN((k) + 1)) xcd_barrier(bar); } while (0)
    const int gw = vcu * NWAVES + wave, NGW = G * NWAVES;

    if (IN(0)) { p0_prologue(P, lds, vcu, G, tid, wave, lane); SEAM(0); }

    if (IN(1)) {
        pg8::SchedInA S{G, c, (const char*)(P.ws + WS_BUFA), (const char*)(P.ws + WS_WINA)};
        pg8::EpiInA E{(pg8::bf16_t*)(P.ws + WS_QK), (pg8::bf16_t*)(P.ws + WS_SR), (pg8::bf16_t*)(P.ws + WS_VT), MT};
        const bool early_glow = G == 256 && (c & 8);
        if (early_glow) { const int slot = wave * 128 + ((c >> 4) * 8 + (c & 7)); if (slot < MT / 16) glow_task((const bf16*)(P.ws + WS_BUFA), (const bf16*)(P.ws + WS_WINA) + (size_t)6144 * DM, (float*)(P.ws + WS_GLOW), slot, lane); __syncthreads(); }
        pg8::gemm_phase<pg8::EpiInA, pg8::SchedInA, true, true>(lds, 2048, S, E);
        if (G != 256) for (int task = c * NWAVES + wave; task < MT / 16; task += NGW)
            glow_task((const bf16*)(P.ws + WS_BUFA), (const bf16*)(P.ws + WS_WINA) + (size_t)6144 * DM, (float*)(P.ws + WS_GLOW), task, lane);
        SEAM(1);
    }

    if (IN(2)) {
        for (int blk = c; blk < 192; blk += G) s_in_a_block(P, lds, blk / 48, blk % 48, tid, wave, lane);
        if (G == 256) { for (int j = 0; j < 2; ++j) gla_prep_unit(P, lds, (2 * (c & 7) + j) * 32 + (c >> 3), tid, wave, lane); }
        else for (int u = c; u < 512; u += G) gla_prep_unit(P, lds, u, tid, wave, lane);
        SEAM(2);
    }

    if (IN(3)) {
        if (G >= 256) {
            constexpr int CV_A = 1408;
            if (c < 128) { const int xcd = c & 7, idx = c >> 3; gla_scan_unit(P, lds, xcd * 2 + (idx >> 3), (idx >> 2) & 1, idx & 3, tid, wave, lane);
                convert_weights(P, lds, 1, CV_A + c * NWAVES + wave, 128 * NWAVES, 2176, wave, lane); }
            else { gla_sample_unit(P, lds, c - 128, tid, wave, lane);
                convert_weights(P, lds, 1, (c - 128) * NWAVES + wave, 128 * NWAVES, CV_A, wave, lane); }
        } else {
            for (int u = c; u < 128; u += G) gla_scan_unit(P, lds, u >> 3, (u >> 2) & 1, u & 3, tid, wave, lane);
            for (int t = c; t < 128; t += G) gla_sample_unit(P, lds, t, tid, wave, lane);
        }
        SEAM(3);
    }

    if (IN(4)) {
        const int NS = G >= 128 ? 64 : 0;
        constexpr int GR0 = 8192;
        if (c < NS) { for (int blk = c; blk < 64; blk += NS) s_out_block<true>(P, lds, (const bf16*)(P.ws + WS_BUFA) + (size_t)MPR * DM, (const bf16*)(P.ws + WS_WOA), P.x_sample, blk >> 4, blk & 15, tid, wave, lane);
            gate_rows(P, lane, GR0 + c * NWAVES + wave, NS * NWAVES, MPR); }
        else { gate_rows(P, lane, (c - NS) * NWAVES + wave, (G - NS) * NWAVES, NS ? GR0 : MPR);
            if (NS == 0) { __syncthreads(); for (int blk = c; blk < 64; blk += G) s_out_block<true>(P, lds, (const bf16*)(P.ws + WS_BUFA) + (size_t)MPR * DM, (const bf16*)(P.ws + WS_WOA), P.x_sample, blk >> 4, blk & 15, tid, wave, lane); } }
        SEAM(4);
    }

    if (IN(5)) {
        pg8::SchedOut S{G, c, (const char*)(P.ws + WS_BUFA), (const char*)(P.ws + WS_WOA)};
        pg8::EpiOutA E{P.x_prompt, (pg8::bf16_t*)(P.ws + WS_SR), (float*)(P.ws + WS_SSQ1)};
        pg8::gemm_phase<pg8::EpiOutA, pg8::SchedOut, true, true>(lds, 2048, S, E);
        SEAM(5);
    }

    if (IN(6)) {
        pg8::SchedInB S{G, c, (const char*)(P.ws + WS_SR), (const char*)(P.ws + WS_WINB), (const float*)(P.ws + WS_SSQ1), (LAS float*)(lds + TAB_OFF)};
        pg8::EpiInB E{(pg8::bf16_t*)(P.ws + WS_QZ), (pg8::bf16_t*)(P.ws + WS_KB), (pg8::bf16_t*)(P.ws + WS_VT2), MT, P.out + OUT_KWP, P.out + OUT_VWP, P.out + OUT_KWS, P.out + OUT_VWS, (const LAS float*)(lds + TAB_OFF)};
        pg8::gemm_phase<pg8::EpiInB, pg8::SchedInB, true, true>(lds, 2048, S, E);
        for (int blk = (c + G - (64 % G)) % G; blk < 144; blk += G) s_in_b_block(P, lds, blk / 36, blk % 36, tid, wave, lane);
        SEAM(6);
    }

    if (IN(7)) {
        for (int u = c; u < 256; u += G) attn_prompt_unit(P, lds, u, tid, wave, lane);
        for (int u = c; u < 128; u += G) attn_sample_unit(P, lds, u, tid, wave, lane);
        SEAM(7);
    }

    if (IN(8)) {
        pg8::SchedOut S{G, c, (const char*)(P.ws + WS_BUFA), (const char*)(P.ws + WS_WOB)};
        pg8::EpiOutB E{(const pg8::bf16_t*)(P.ws + WS_SR), P.out + OUT_Y};
        pg8::gemm_phase<pg8::EpiOutB, pg8::SchedOut, true, true>(lds, 2048, S, E);
        SEAM(8);
    }

    if (IN(9)) {
        const int NS = G >= 128 ? 64 : 0;
        constexpr int FR0 = 8192;
        if (c < NS) { for (int blk = c; blk < 64; blk += NS) s_out_block<false>(P, lds, (const bf16*)(P.ws + WS_BUFA) + (size_t)MPR * DM, (const bf16*)(P.ws + WS_WOB), P.out + OUT_Y + (size_t)MPR * DM, blk >> 4, blk & 15, tid, wave, lane);
            final_rows(P.out + OUT_Y, P.g_final, lane, FR0 + c * NWAVES + wave, NS * NWAVES, MPR); }
        else { if (NS == 0) for (int blk = c; blk < 64; blk += G) s_out_block<false>(P, lds, (const bf16*)(P.ws + WS_BUFA) + (size_t)MPR * DM, (const bf16*)(P.ws + WS_WOB), P.out + OUT_Y + (size_t)MPR * DM, blk >> 4, blk & 15, tid, wave, lane);
            final_rows(P.out + OUT_Y, P.g_final, lane, (c - NS) * NWAVES + wave, (G - NS) * NWAVES, NS ? FR0 : MPR); }
        SEAM(9);
    }

    if (IN(10)) { for (int m = MPR + gw; m < MT; m += NGW) final_row(P.out + OUT_Y + (size_t)m * DM, P.g_final, lane, P.out + OUT_Y + (size_t)m * DM); }
#undef IN
#undef SEAM
}

extern "C" void kernel_launch(void* const* d_in, const int* in_sizes, int n_in, void* d_out, int out_size, void* d_ws, size_t ws_size, hipStream_t stream) {
    static int grid = 0;
    if (grid == 0) {
        if (n_in != 18 || (size_t)out_size != OUT_TOTAL || ws_size < WS_END) { fprintf(stderr, "kernel_launch: unexpected shapes (n_in %d, out %d, ws %zu); nothing launched\n", n_in, out_size, ws_size); grid = -1; return; }
        int dev = 0, cus = 0, per_cu = 0;
        if (hipGetDevice(&dev) != hipSuccess || hipDeviceGetAttribute(&cus, hipDeviceAttributeMultiprocessorCount, dev) != hipSuccess) { grid = -1; return; }
        if (hipFuncSetAttribute((const void*)yoco_fwd, hipFuncAttributeMaxDynamicSharedMemorySize, LDS_BYTES) != hipSuccess) { fprintf(stderr, "kernel_launch: hipFuncSetAttribute failed\n"); grid = -1; return; }
        if (hipOccupancyMaxActiveBlocksPerMultiprocessor(&per_cu, (const void*)yoco_fwd, NWAVES * 64, LDS_BYTES) != hipSuccess || per_cu < 1)
            fprintf(stderr, "kernel_launch: note: occupancy query reports %d workgroups per CU\n", per_cu);
        (void)hipGetLastError();
        grid = cus;
    }
    if (grid < 0) return;
    (void)hipMemsetAsync((char*)d_ws + WS_CTL, 0, CTL_ZERO_BYTES, stream);
    Args a{};
    const float** pp = (const float**)&a.p;
    for (int i = 0; i < 18; ++i) pp[i] = (const float*)d_in[i];
    a.p.out = (float*)d_out; a.p.ws = (unsigned char*)d_ws;
    for (int li = 0; li < N_LAUNCHES; ++li) {
        a.ph_lo = (N_LAUNCHES == 1) ? 0 : li; a.ph_hi = (N_LAUNCHES == 1) ? N_PHASES : li + 1;
        hipLaunchKernelGGL(yoco_fwd, dim3(grid), dim3(NWAVES * 64), LDS_BYTES, stream, a);
    }
}
```

```cpp
#include <hip/hip_runtime.h>
#include <cstdio>
#include <cstdint>
#include <cmath>
namespace pg8 {
#define PG8_LAS __attribute__((address_space(3)))
typedef unsigned short bf16_t;
typedef short bf16x8 __attribute__((ext_vector_type(8)));
typedef float f32x4 __attribute__((ext_vector_type(4)));
typedef unsigned u32x4 __attribute__((ext_vector_type(4)));
constexpr int BM = 256, BK = 64, HALF = 128, HTB = HALF * BK * 2  , STAGE_BYTES = 8 * HTB, NXCD = 8, WGM = 8;

__host__ __device__ __forceinline__ int lds_byte(int r, int c) { const int st = (r >> 4) * 2 + (c >> 5), rr = r & 15, cc = c & 31, ob = rr * 64 + cc * 2; return st * 1024 + (ob ^ (((ob >> 9) & 1) << 5)); }
__host__ __device__ __forceinline__ void stage_rc(int b, int& R, int& C) { const int st = b / 1024, sb = b % 1024, swz = sb ^ (((sb >> 9) & 1) << 5); R = (st >> 1) * 16 + swz / 64; C = (st & 1) * 32 + (swz % 64) / 2; }
__host__ __device__ __forceinline__ int perm32(int rho) { const int n = rho >> 4, i = rho & 15; return 8 * (i >> 2) + 4 * n + (i & 3); }

struct Unit { const char* a; const char* b; int pm, pn, kind, par; };
__device__ __forceinline__ void tile_map(int L, int nM, int nN, int& pm, int& pn) {
    const int nwg = nM * nN; int wgid = L; { const int q = nwg / NXCD, r = nwg % NXCD, xcd = wgid % NXCD, off = wgid / NXCD; wgid = (xcd < r ? xcd * (q + 1) : r * (q + 1) + (xcd - r) * q) + off; }
    const int nig = WGM * nN, gid = wgid / nig, fm = gid * WGM, gsz = (nM - fm) < WGM ? (nM - fm) : WGM;
    pm = fm + ((wgid % nig) % gsz); pn = (wgid % nig) / gsz;
}
typedef float f32x2_t __attribute__((ext_vector_type(2))); typedef __bf16 bf16x2_t __attribute__((ext_vector_type(2)));
__device__ __forceinline__ unsigned cvtpk(float lo, float hi) { f32x2_t v = {lo, hi}; bf16x2_t b = __builtin_convertvector(v, bf16x2_t); return __builtin_bit_cast(unsigned, b); }
__device__ __forceinline__ float silu_f(float v) { return v / (1.0f + __expf(-v)); }

template <bool SILU>
__device__ __forceinline__ void store_tile_bf16(const f32x4 (&acc)[2][2][4][2], bf16_t* base, int ldc, int row_t, int col_t, int wr, int wc, int fr, int fq, const PG8_LAS float* rtab = nullptr) {
    const int row0 = row_t + wr * 64 + fr, col0 = col_t + wc * 32 + 8 * fq;
#pragma unroll
    for (int ai = 0; ai < 2; ++ai)
#pragma unroll
        for (int m = 0; m < 4; ++m) { bf16_t* rowp = base + (size_t)(row0 + ai * HALF + m * 16) * ldc + col0; const float rsc = rtab ? rtab[wr * 64 + fr + ai * HALF + m * 16] : 1.0f;
#pragma unroll
            for (int bj = 0; bj < 2; ++bj) { f32x4 v0 = acc[ai][bj][m][0] * rsc, v1 = acc[ai][bj][m][1] * rsc;
                if (SILU) { v0[0] = silu_f(v0[0]); v0[1] = silu_f(v0[1]); v0[2] = silu_f(v0[2]); v0[3] = silu_f(v0[3]); v1[0] = silu_f(v1[0]); v1[1] = silu_f(v1[1]); v1[2] = silu_f(v1[2]); v1[3] = silu_f(v1[3]); }
                u32x4 w; w.x = cvtpk(v0[0], v0[1]); w.y = cvtpk(v0[2], v0[3]); w.z = cvtpk(v1[0], v1[1]); w.w = cvtpk(v1[2], v1[3]);
                *(u32x4*)(rowp + bj * HALF) = w; } }
}

struct EpiInA {
    static constexpr bool PERM = true, AFTER_DRAIN = false;
    bf16_t* QK; bf16_t* SR; bf16_t* VT; int MT;
    __device__ __forceinline__ void operator()(const f32x4 (&acc)[2][2][4][2], const Unit& u, int wr, int wc, int fr, int fq) const {
        if (u.kind == 0) store_tile_bf16<false>(acc, QK, 2048, u.pm * BM, u.pn * BM, wr, wc, fr, fq);
        else if (u.kind == 1) store_tile_bf16<true>(acc, SR, 2048, u.pm * BM, (u.pn - 8) * BM, wr, wc, fr, fq);
        else store_tile_bf16<false>(acc, VT, MT, u.pm * BM, u.pn * BM, wr, wc, fr, fq);
    }
};

struct EpiInB {
    static constexpr bool PERM = true, AFTER_DRAIN = false;
    bf16_t* QZ; bf16_t* KB; bf16_t* VT2; int MT; float* kwp; float* vwp; float* kws; float* vws; const PG8_LAS float* tab;
    __device__ __forceinline__ static float* win_row(int t, float* wp, float* wsmp) {
        if (t < 8192) { const int pos = t & 2047; if (pos < 1920) return nullptr; return wp + ((size_t)(t >> 11) * 128 + (pos - 1920)) * 256; }
        const int s = t - 8192; return wsmp + ((size_t)(s >> 3) * 128 + 120 + (s & 7)) * 256;
    }
    __device__ __forceinline__ void operator()(const f32x4 (&acc)[2][2][4][2], const Unit& u, int wr, int wc, int fr, int fq) const {
        const PG8_LAS float* T = tab + (u.par << 8);
        if (u.kind == 0) { store_tile_bf16<false>(acc, QZ, 4096, u.pm * BM, u.pn * BM, wr, wc, fr, fq, T); return; }
        if (u.kind == 1) { store_tile_bf16<true>(acc, QZ, 4096, u.pm * BM, u.pn * BM, wr, wc, fr, fq, T); return; }
        if (u.kind == 2) {
            store_tile_bf16<false>(acc, KB, 256, u.pm * BM, 0, wr, wc, fr, fq, T);
            if ((u.pm & 7) == 7) {
                const int row0 = u.pm * BM + wr * 64 + fr, col0 = wc * 32 + 8 * fq;
#pragma unroll
                for (int ai = 0; ai < 2; ++ai)
#pragma unroll
                    for (int m = 0; m < 4; ++m) { float* d = win_row(row0 + ai * HALF + m * 16, kwp, kws); const float rsc = T[wr * 64 + fr + ai * HALF + m * 16];
                        if (d) {
#pragma unroll
                            for (int bj = 0; bj < 2; ++bj) { *(f32x4*)(d + col0 + bj * HALF) = acc[ai][bj][m][0] * rsc; *(f32x4*)(d + col0 + bj * HALF + 4) = acc[ai][bj][m][1] * rsc; } } }
            }
            return;
        }
        const int row0 = wr * 64 + fr, colb = wc * 32 + 8 * fq;
        f32x4 cs[2][2];
#pragma unroll
        for (int bj = 0; bj < 2; ++bj) { cs[bj][0] = *(const PG8_LAS f32x4*)(T + colb + bj * HALF); cs[bj][1] = *(const PG8_LAS f32x4*)(T + colb + bj * HALF + 4); }
#pragma unroll
        for (int ai = 0; ai < 2; ++ai)
#pragma unroll
            for (int m = 0; m < 4; ++m) { bf16_t* rowp = VT2 + (size_t)(row0 + ai * HALF + m * 16) * MT + u.pn * BM + colb;
#pragma unroll
                for (int bj = 0; bj < 2; ++bj) { const f32x4 v0 = acc[ai][bj][m][0] * cs[bj][0], v1 = acc[ai][bj][m][1] * cs[bj][1];
                    u32x4 w; w.x = cvtpk(v0[0], v0[1]); w.y = cvtpk(v0[2], v0[3]); w.z = cvtpk(v1[0], v1[1]); w.w = cvtpk(v1[2], v1[3]);
                    *(u32x4*)(rowp + bj * HALF) = w; } }
        if ((u.pn & 7) == 7) {
            const int col0 = u.pn * BM + colb;
#pragma unroll
            for (int bj = 0; bj < 2; ++bj)
#pragma unroll
                for (int n = 0; n < 2; ++n)
#pragma unroll
                    for (int j = 0; j < 4; ++j) { float* d = win_row(col0 + bj * HALF + 4 * n + j, vwp, vws);
                        if (d) {
#pragma unroll
                            for (int ai = 0; ai < 2; ++ai)
#pragma unroll
                                for (int m = 0; m < 4; ++m) d[row0 + ai * HALF + m * 16] = acc[ai][bj][m][n][j] * cs[bj][n][j]; } }
        }
    }
};

struct EpiOutA {
    static constexpr bool PERM = false, AFTER_DRAIN = false;
    const float* x; bf16_t* H1b; float* SSQ1;
    __device__ __forceinline__ void operator()(const f32x4 (&acc)[2][2][4][2], const Unit& u, int wr, int wc, int fr, int fq) const {
        typedef unsigned u32x2_t __attribute__((ext_vector_type(2)));
        const int row0 = u.pm * BM + wr * 64 + fr, col0 = u.pn * BM + wc * 32 + 4 * fq;
        const float* xb = x + (size_t)row0 * 2048 + col0; bf16_t* hb = H1b + (size_t)row0 * 2048 + col0;
        f32x4 xr[3][4];
#define EOA_LD(slot, gi) do { const size_t o_ = (size_t)(((gi) >> 2) * HALF + ((gi) & 3) * 16) * 2048; xr[slot][0] = *(const f32x4*)(xb + o_); xr[slot][1] = *(const f32x4*)(xb + o_ + 16); xr[slot][2] = *(const f32x4*)(xb + o_ + HALF); xr[slot][3] = *(const f32x4*)(xb + o_ + HALF + 16); } while (0)
        EOA_LD(0, 0); EOA_LD(1, 1);
#pragma unroll
        for (int gi = 0; gi < 8; ++gi) { const int ai = gi >> 2, m = gi & 3;
            if (gi + 2 < 8) EOA_LD((gi + 2) % 3, gi + 2);
            const size_t o = (size_t)(ai * HALF + m * 16) * 2048; float ss = 0.f;
#pragma unroll
            for (int bj = 0; bj < 2; ++bj)
#pragma unroll
                for (int n = 0; n < 2; ++n) { const f32x4 v = xr[gi % 3][bj * 2 + n] + acc[ai][bj][m][n];
                    u32x2_t w; w.x = cvtpk(v[0], v[1]); w.y = cvtpk(v[2], v[3]);
                    *(u32x2_t*)(hb + o + bj * HALF + n * 16) = w; ss += (v[0] * v[0] + v[1] * v[1]) + (v[2] * v[2] + v[3] * v[3]); }
            ss += __shfl_xor(ss, 16); ss += __shfl_xor(ss, 32);
            if (fq == 0) SSQ1[(size_t)(row0 + ai * HALF + m * 16) * 32 + u.pn * 4 + wc] = ss; }
#undef EOA_LD
    }
};
struct EpiOutB {
    static constexpr bool PERM = false, AFTER_DRAIN = false;
    const bf16_t* H1b; bf16_t* H2b;
    __device__ __forceinline__ void operator()(const f32x4 (&acc)[2][2][4][2], const Unit& u, int wr, int wc, int fr, int fq) const {
        typedef unsigned u32x2_t __attribute__((ext_vector_type(2)));
        const int row0 = u.pm * BM + wr * 64 + fr, col0 = u.pn * BM + wc * 32 + 4 * fq;
        const bf16_t* hb = H1b + (size_t)row0 * 2048 + col0; bf16_t* ob = H2b + (size_t)row0 * 2048 + col0;
        u32x2_t hr[3][4];
#define EOB_LD(slot, gi) do { const size_t o_ = (size_t)(((gi) >> 2) * HALF + ((gi) & 3) * 16) * 2048; hr[slot][0] = *(const u32x2_t*)(hb + o_); hr[slot][1] = *(const u32x2_t*)(hb + o_ + 16); hr[slot][2] = *(const u32x2_t*)(hb + o_ + HALF); hr[slot][3] = *(const u32x2_t*)(hb + o_ + HALF + 16); } while (0)
        EOB_LD(0, 0); EOB_LD(1, 1);
#pragma unroll
        for (int gi = 0; gi < 8; ++gi) { const int ai = gi >> 2, m = gi & 3;
            if (gi + 2 < 8) EOB_LD((gi + 2) % 3, gi + 2);
            const size_t o = (size_t)(ai * HALF + m * 16) * 2048;
#pragma unroll
            for (int bj = 0; bj < 2; ++bj)
#pragma unroll
                for (int n = 0; n < 2; ++n) { const u32x2_t h = hr[gi % 3][bj * 2 + n];
                    f32x4 r; r[0] = __uint_as_float(h.x << 16); r[1] = __uint_as_float(h.x & 0xffff0000u); r[2] = __uint_as_float(h.y << 16); r[3] = __uint_as_float(h.y & 0xffff0000u);
                    r = r + acc[ai][bj][m][n]; u32x2_t w; w.x = cvtpk(r[0], r[1]); w.y = cvtpk(r[2], r[3]);
                    *(u32x2_t*)(ob + o + bj * HALF + n * 16) = w; } }
#undef EOB_LD
    }
};

struct SchedInA {
    int G, c; const char* XN; const char* W;
    __device__ __forceinline__ bool next(int i, Unit& u) const {
        const int L = i * G + c; const size_t P = (size_t)BM * 2048 * 2;
        if (L < 512) { u.par = 0; tile_map(L, 32, 16, u.pm, u.pn); u.kind = u.pn < 8 ? 0 : 1; u.a = XN + u.pm * P; u.b = W + (u.pn < 8 ? u.pn : u.pn + 8) * P; return true; }
        if (L < 768) { u.par = 0; tile_map(L - 512, 8, 32, u.pm, u.pn); u.kind = 2; u.a = W + (8 + u.pm) * P; u.b = XN + u.pn * P; return true; }
        return false;
    }
    __device__ __forceinline__ void a_ready(const Unit&) const {}
    __device__ __forceinline__ void done(const Unit&) const {}
};
struct SchedInB {
    int G, c; const char* XN; const char* W; const float* SSQ1; PG8_LAS float* tab;
    __device__ __forceinline__ bool next(int i, Unit& u) const {
        const int L = i * G + c; const size_t P = (size_t)BM * 2048 * 2; u.par = i & 1;
        if (L < 544) { tile_map(L, 32, 17, u.pm, u.pn); u.kind = u.pn < 8 ? 0 : (u.pn < 16 ? 1 : 2); u.a = XN + u.pm * P; u.b = W + u.pn * P; return true; }
        if (L < 576) { u.pm = 0; u.pn = L - 544; u.kind = 3; u.a = W + 17 * P; u.b = XN + u.pn * P; return true; }
        return false;
    }
    __device__ __forceinline__ void a_ready(const Unit& u) const {
        int t = threadIdx.x; asm volatile("" : "+v"(t));
        const int row = t >> 1, hf = t & 1, panel = u.kind == 3 ? u.pn : u.pm;
        const float* p = SSQ1 + ((size_t)panel * BM + row) * 32 + hf * 16;
        const f32x4 a0 = *(const f32x4*)p, a1 = *(const f32x4*)(p + 4), a2 = *(const f32x4*)(p + 8), a3 = *(const f32x4*)(p + 12);
        float s = ((a0[0] + a0[1]) + (a0[2] + a0[3])) + ((a1[0] + a1[1]) + (a1[2] + a1[3])) + ((a2[0] + a2[1]) + (a2[2] + a2[3])) + ((a3[0] + a3[1]) + (a3[2] + a3[3]));
        s += __shfl_xor(s, 1);
        if (hf == 0) tab[(u.par << 8) + row] = 1.0f / sqrtf(s * (1.0f / 2048.0f) + 1e-6f);
    }
    __device__ __forceinline__ void done(const Unit&) const {}
};
struct SchedOut {
    int G, c; const char* A; const char* W;
    __device__ __forceinline__ bool next(int i, Unit& u) const {
        const int L = i * G + c; const size_t P = (size_t)BM * 2048 * 2;
        if (L >= 256) return false;
        tile_map(L, 32, 8, u.pm, u.pn); u.kind = 0; u.par = 0; u.a = A + u.pm * P; u.b = W + u.pn * P; return true;
    }
    __device__ __forceinline__ void a_ready(const Unit&) const {}
    __device__ __forceinline__ void done(const Unit&) const {}
};
template <class Epi, class Sched, bool ALIGN_EPI = false, bool SP2 = false>
__device__ __forceinline__ void gemm_phase(PG8_LAS unsigned char* lds, const int K_, const Sched& S, const Epi& E) {
    const int tid = threadIdx.x, wid = __builtin_amdgcn_readfirstlane(tid >> 6), lane = tid & 63, wr = wid >> 2, wc = wid & 3, fr = lane & 15, fq = lane >> 4;
    const int K = K_, nt = K / BK;
    unsigned voffA[2], voffB[2];
#pragma unroll
    for (int i = 0; i < 2; ++i) { int R, C; stage_rc(tid * 16 + i * 8192, R, C); const int Rb = Epi::PERM ? ((R & ~31) + perm32(R & 31)) : R;
        voffA[i] = (unsigned)(R * K + C) * 2u; voffB[i] = (unsigned)(Rb * K + C) * 2u; }
    const size_t kstep = (size_t)(BK * 2);
    const size_t hstep = (size_t)HALF * K * 2;
    const unsigned ldsw = (unsigned)wid * 1024u;
    const int aoff = lds_byte(wr * 64 + fr, fq * 8), boff = lds_byte(wc * 32 + fr, fq * 8);
#define PG8_SA(b, h) (((b) * 2 + (h)) * HTB)
#define PG8_SB(b, h) ((4 + (b) * 2 + (h)) * HTB)
#define PG8_STAGE(bufoff, gbase, voff) do { _Pragma("unroll") for (int _i = 0; _i < 2; ++_i) \
        __builtin_amdgcn_global_load_lds((const unsigned*)((const char*)(gbase) + (voff)[_i]), (PG8_LAS unsigned*)(lds + (bufoff) + ldsw + _i * 8192), 16, 0, 0); } while (0)
#define PG8_LDA(dst, b, h) do { _Pragma("unroll") for (int m = 0; m < 4; ++m) _Pragma("unroll") for (int k = 0; k < 2; ++k) dst[m][k] = *(const PG8_LAS bf16x8*)(lds + PG8_SA(b, h) + aoff + m * 2048 + k * 1024); } while (0)
#define PG8_LDB(dst, b, h) do { _Pragma("unroll") for (int n = 0; n < 2; ++n) _Pragma("unroll") for (int k = 0; k < 2; ++k) dst[n][k] = *(const PG8_LAS bf16x8*)(lds + PG8_SB(b, h) + boff + n * 2048 + k * 1024); } while (0)
#define PG8_MMA(ai, bj, At, Bt) do { __builtin_amdgcn_s_setprio(1); _Pragma("unroll") for (int m = 0; m < 4; ++m) _Pragma("unroll") for (int n = 0; n < 2; ++n) _Pragma("unroll") for (int k = 0; k < 2; ++k) \
        acc[ai][bj][m][n] = __builtin_amdgcn_mfma_f32_16x16x32_bf16(Bt[n][k], At[m][k], acc[ai][bj][m][n], 0, 0, 0); __builtin_amdgcn_s_setprio(0); } while (0)
#define PG8_WAIT_V(n) asm volatile("s_waitcnt vmcnt(" #n ")" ::: "memory")
#define PG8_WAIT_L(n) asm volatile("s_waitcnt lgkmcnt(" #n ")" ::: "memory")
#define PG8_BAR __builtin_amdgcn_s_barrier()
#define PG8_SCHED __builtin_amdgcn_sched_barrier(0)
    Unit cur, nxt; int ui = 0;
    if (!S.next(0, cur)) return;
    f32x4 acc[2][2][4][2];
#pragma unroll
    for (int a = 0; a < 2; ++a)
#pragma unroll
        for (int b = 0; b < 2; ++b)
#pragma unroll
            for (int m = 0; m < 4; ++m)
#pragma unroll
                for (int n = 0; n < 2; ++n) acc[a][b][m][n] = (f32x4){0.f, 0.f, 0.f, 0.f};
    bf16x8 At[4][2], B0[2][2], B1[2][2];
    const char* cA = cur.a; const char* cB = cur.b;
    S.a_ready(cur);
    if constexpr (SP2) {
        PG8_STAGE(PG8_SB(0, 0), cB, voffB); PG8_STAGE(PG8_SB(0, 1), cB + hstep, voffB); PG8_STAGE(PG8_SA(0, 0), cA, voffA); PG8_STAGE(PG8_SA(0, 1), cA + hstep, voffA);
        if (wr == 1) PG8_BAR;
        PG8_WAIT_V(2); PG8_BAR;
        PG8_STAGE(PG8_SB(1, 0), cB + kstep, voffB); PG8_STAGE(PG8_SA(1, 0), cA + kstep, voffA); PG8_STAGE(PG8_SB(1, 1), cB + hstep + kstep, voffB);
        PG8_WAIT_V(6); PG8_BAR;
    } else {
        PG8_STAGE(PG8_SB(0, 0), cB, voffB); PG8_STAGE(PG8_SA(0, 0), cA, voffA); PG8_STAGE(PG8_SB(0, 1), cB + hstep, voffB); PG8_STAGE(PG8_SA(0, 1), cA + hstep, voffA);
        if (wr == 1) PG8_BAR;
        PG8_WAIT_V(4); PG8_BAR;
        PG8_STAGE(PG8_SB(1, 0), cB + kstep, voffB); PG8_STAGE(PG8_SA(1, 0), cA + kstep, voffA); PG8_STAGE(PG8_SB(1, 1), cB + hstep + kstep, voffB);
        PG8_WAIT_V(6); PG8_BAR;
    }
    for (;;) {
        const bool has_next = S.next(ui + 1, nxt);
        const char* nA = has_next ? nxt.a : cA; const char* nB = has_next ? nxt.b : cB;
        for (int t = 0; t < nt; t += 2) {
            const bool last = (t == nt - 2);
            const char* a1 = cA + (size_t)(t + 1) * kstep;
            const char* a2 = last ? nA : cA + (size_t)(t + 2) * kstep; const char* b2 = last ? nB : cB + (size_t)(t + 2) * kstep;
            const char* a3 = a2 + kstep; const char* b3 = b2 + kstep;
            if (last && has_next) S.a_ready(nxt);
            if constexpr (SP2) {
            PG8_LDB(B0, 0, 0); PG8_LDB(B1, 0, 1); PG8_SCHED; PG8_LDA(At, 0, 0); PG8_STAGE(PG8_SA(1, 1), a1 + hstep, voffA);
            PG8_WAIT_V(8); PG8_WAIT_L(0); PG8_BAR; PG8_MMA(0, 0, At, B0); PG8_MMA(0, 1, At, B1); PG8_BAR; PG8_SCHED;
            PG8_LDA(At, 0, 1); PG8_STAGE(PG8_SB(0, 0), b2, voffB); PG8_STAGE(PG8_SB(0, 1), b2 + hstep, voffB); PG8_STAGE(PG8_SA(0, 0), a2, voffA);
            PG8_WAIT_V(8); PG8_WAIT_L(0); PG8_BAR; PG8_MMA(1, 0, At, B0); PG8_MMA(1, 1, At, B1); PG8_BAR; PG8_SCHED;
            PG8_LDB(B0, 1, 0); PG8_LDB(B1, 1, 1); PG8_SCHED; PG8_LDA(At, 1, 0); PG8_STAGE(PG8_SA(0, 1), a2 + hstep, voffA);
            PG8_WAIT_V(8); PG8_WAIT_L(0); PG8_BAR; PG8_MMA(0, 0, At, B0); PG8_MMA(0, 1, At, B1); PG8_BAR; PG8_SCHED;
            PG8_LDA(At, 1, 1); PG8_STAGE(PG8_SB(1, 0), b3, voffB); PG8_STAGE(PG8_SB(1, 1), b3 + hstep, voffB); PG8_STAGE(PG8_SA(1, 0), a3, voffA);
            PG8_WAIT_V(8); PG8_WAIT_L(0); PG8_BAR; PG8_MMA(1, 0, At, B0); PG8_MMA(1, 1, At, B1); PG8_BAR; PG8_SCHED;
            } else {
            PG8_LDB(B0, 0, 0); PG8_SCHED; PG8_LDA(At, 0, 0); PG8_STAGE(PG8_SA(1, 1), a1 + hstep, voffA);
            PG8_WAIT_L(8); PG8_BAR; PG8_WAIT_L(0); PG8_MMA(0, 0, At, B0); PG8_BAR; PG8_SCHED;
            PG8_LDB(B1, 0, 1); PG8_STAGE(PG8_SB(0, 0), b2, voffB);
            PG8_BAR; PG8_WAIT_L(0); PG8_MMA(0, 1, At, B1); PG8_BAR;
            PG8_LDA(At, 0, 1); PG8_STAGE(PG8_SA(0, 0), a2, voffA);
            PG8_BAR; PG8_WAIT_L(0); PG8_MMA(1, 0, At, B0); PG8_BAR; PG8_SCHED;
            PG8_STAGE(PG8_SB(0, 1), b2 + hstep, voffB);
            PG8_WAIT_V(6); PG8_BAR; PG8_MMA(1, 1, At, B1); PG8_BAR;
            PG8_LDB(B0, 1, 0); PG8_SCHED; PG8_LDA(At, 1, 0); PG8_STAGE(PG8_SA(0, 1), a2 + hstep, voffA);
            PG8_WAIT_L(8); PG8_BAR; PG8_WAIT_L(0); PG8_MMA(0, 0, At, B0); PG8_BAR; PG8_SCHED;
            PG8_LDB(B1, 1, 1); PG8_STAGE(PG8_SB(1, 0), b3, voffB);
            PG8_BAR; PG8_WAIT_L(0); PG8_MMA(0, 1, At, B1); PG8_BAR;
            PG8_LDA(At, 1, 1); PG8_STAGE(PG8_SA(1, 0), a3, voffA);
            PG8_BAR; PG8_WAIT_L(0); PG8_MMA(1, 0, At, B0); PG8_BAR; PG8_SCHED;
            PG8_STAGE(PG8_SB(1, 1), b3 + hstep, voffB);
            PG8_WAIT_V(6); PG8_BAR; PG8_MMA(1, 1, At, B1); PG8_BAR;
            }
        }
        if constexpr (ALIGN_EPI) { if (wr == 0) PG8_BAR; }
        if constexpr (!Epi::AFTER_DRAIN) { E(acc, cur, wr, wc, fr, fq); S.done(cur); }
        if (!has_next) break;
#pragma unroll
        for (int a = 0; a < 2; ++a)
#pragma unroll
            for (int b = 0; b < 2; ++b)
#pragma unroll
                for (int m = 0; m < 4; ++m)
#pragma unroll
                    for (int n = 0; n < 2; ++n) acc[a][b][m][n] = (f32x4){0.f, 0.f, 0.f, 0.f};
        cur = nxt; cA = nA; cB = nB; ++ui;
        if constexpr (ALIGN_EPI) { if (wr == 1) PG8_BAR; }
    }
    PG8_WAIT_V(0);
    if constexpr (!ALIGN_EPI) { if (wr == 0) PG8_BAR; }
    PG8_BAR;
    if constexpr (Epi::AFTER_DRAIN) { E.fused(acc, cur, wr, wc, fr, fq, lds, wid, lane); S.done(cur); }
#undef PG8_SA
#undef PG8_SB
#undef PG8_STAGE
#undef PG8_LDA
#undef PG8_LDB
#undef PG8_MMA
#undef PG8_WAIT_V
#undef PG8_WAIT_L
#undef PG8_BAR
#undef PG8_SCHED
}
}
#define GAS __attribute__((address_space(1)))
#define LAS __attribute__((address_space(3)))
typedef unsigned short bf16;
typedef unsigned v4u __attribute__((ext_vector_type(4)));
typedef float f32x4 __attribute__((ext_vector_type(4)));
typedef short bf16x8 __attribute__((ext_vector_type(8)));
typedef GAS unsigned gu32;
typedef GAS unsigned long long gu64;
#define RLX_AGENT __ATOMIC_RELAXED, __HIP_MEMORY_SCOPE_AGENT
#define LDS_WAIT() asm volatile("s_waitcnt lgkmcnt(0)" ::: "memory")
#define VM_WAIT() asm volatile("s_waitcnt vmcnt(0)" ::: "memory")
__device__ __forceinline__ unsigned long long rt() { return __builtin_amdgcn_s_memrealtime(); }
__device__ __forceinline__ unsigned f2bf(float f) { unsigned u = __builtin_bit_cast(unsigned, f); return (u + 0x7fffu + ((u >> 16) & 1u)) >> 16; }
__device__ __forceinline__ unsigned pk2(float lo, float hi) { return f2bf(lo) | (f2bf(hi) << 16); }

#define XB_TMO      128
#define XB_XCNT(j)  (256  + 64 * (j))
#define XB_XSUB(j)  (1280 + 64 * (j))
#define XB_XGEN(j)  (2304 + 64 * (j))
#define XB_TOP      3328
#define XB_TOPGEN   3392
#define XCD_BAR_WORDS 3456
#define XB_SPIN_CAP (1u << 18)

__device__ __forceinline__ unsigned xb_ld(unsigned* p)              { return __hip_atomic_load(p, __ATOMIC_RELAXED, __HIP_MEMORY_SCOPE_AGENT); }
__device__ __forceinline__ unsigned xb_add(unsigned* p, unsigned v) { return __hip_atomic_fetch_add(p, v, __ATOMIC_RELAXED, __HIP_MEMORY_SCOPE_AGENT); }
__device__ __forceinline__ unsigned xb_xcc_id() { return (unsigned)__builtin_amdgcn_s_getreg((3 << 11) | 20) & 0xFu; }
#define XB_SPIN(cond, bar) do { unsigned _sp = 0; while (cond) { __builtin_amdgcn_s_sleep(1); \
    if ((++_sp & 255u) == 0u) { if (xb_ld(&(bar)[XB_TMO])) break; if (_sp > XB_SPIN_CAP) { atomicAdd(&(bar)[XB_TMO], 1u); break; } } } } while (0)

struct XcdBarrier {
    unsigned* bar; unsigned x;
    volatile LAS unsigned* st;
};

__device__ __forceinline__ XcdBarrier xcd_barrier_post(unsigned* bar, volatile LAS unsigned* st) {
    XcdBarrier b; b.bar = bar; b.x = xb_xcc_id(); b.st = st;
    if (threadIdx.x == 0) (void)xb_add(&bar[XB_XCNT(b.x)], 1u);
    return b;
}
__device__ __forceinline__ void xcd_barrier_complete(unsigned* bar, unsigned x, unsigned& nloc, unsigned& nx) {
    const unsigned G = gridDim.x * gridDim.y * gridDim.z;
    unsigned sum, cnt, mine, sp = 0u;
    for (;;) {
        sum = 0u; cnt = 0u; mine = 0u;
#pragma unroll
        for (unsigned j = 0; j < 16; ++j) { const unsigned c = xb_ld(&bar[XB_XCNT(j)]); sum += c; cnt += (c > 0u) ? 1u : 0u; mine = (j == x) ? c : mine; }
        if (sum == G) break;
        __builtin_amdgcn_s_sleep(1);
        if ((++sp & 255u) == 0u) { if (xb_ld(&bar[XB_TMO])) break; if (sp > XB_SPIN_CAP) { atomicAdd(&bar[XB_TMO], 1u); break; } }
    }
    nloc = mine > 0u ? mine : 1u; nx = cnt > 0u ? cnt : 1u;
}

__device__ __forceinline__ void xcd_barrier(const XcdBarrier& b) {
    asm volatile("s_waitcnt vmcnt(0)" ::: "memory");
    __syncthreads();
    if (threadIdx.x == 0) {
        unsigned* bar = b.bar;
        __builtin_amdgcn_s_waitcnt(0);
        unsigned nloc = b.st[0], nx = b.st[1];
        if (nloc == 0u) { xcd_barrier_complete(bar, b.x, nloc, nx); b.st[0] = nloc; b.st[1] = nx; }
        const unsigned old = xb_add(&bar[XB_XSUB(b.x)], 1u);
        const unsigned gen = old / nloc;
        if (old + 1u == (gen + 1u) * nloc) {
            __builtin_amdgcn_fence(__ATOMIC_RELEASE, "agent");
            asm volatile("s_waitcnt vmcnt(0)" ::: "memory");
            const unsigned og = xb_add(&bar[XB_TOP], 1u);
            const unsigned tg = og / nx;
            if (og + 1u == (tg + 1u) * nx) xb_add(&bar[XB_TOPGEN], 1u);
            else XB_SPIN(xb_ld(&bar[XB_TOPGEN]) == tg, bar);
            __builtin_amdgcn_fence(__ATOMIC_ACQUIRE, "agent");
            xb_add(&bar[XB_XGEN(b.x)], 1u);
            asm volatile("s_waitcnt vmcnt(0)" ::: "memory");
        } else {
            XB_SPIN(xb_ld(&bar[XB_XGEN(b.x)]) == gen, bar);
            __builtin_amdgcn_fence(__ATOMIC_ACQUIRE, "agent");
            asm volatile("s_waitcnt vmcnt(0)" ::: "memory");
        }
    }
    __syncthreads();
}
constexpr int NWAVES = 8;
constexpr int MPR = 8192, MSM = 256, MT = MPR + MSM;
constexpr int DM = 2048;
constexpr float RMS_EPS = 1e-6f;
constexpr float LOG2E = 1.4426950408889634f;
constexpr size_t MiB = 1u << 20;
constexpr size_t WS_CTL = 0, CTL_ZERO_BYTES = 64 * 1024;
constexpr size_t WS_WINA = 1 * MiB;
constexpr size_t WS_WOA = 26 * MiB;
constexpr size_t WS_WINB = 34 * MiB;
constexpr size_t WS_WOB = 52 * MiB;
constexpr size_t WS_BUFA = 60 * MiB;
constexpr size_t WS_QK = 93 * MiB;
constexpr size_t WS_VT = 126 * MiB;
constexpr size_t WS_QZ = 93 * MiB;
constexpr size_t WS_SR = 159 * MiB;
constexpr size_t WS_REC = 192 * MiB;
constexpr size_t WS_KB = 192 * MiB;
constexpr size_t WS_VT2 = 198 * MiB;
constexpr size_t WS_GLOW = 234 * MiB;
constexpr size_t WS_SSQP = 235 * MiB;
constexpr size_t WS_SSQ1 = 236 * MiB;
constexpr int TAB_OFF = 131072;
constexpr size_t WS_END = 240 * MiB;
constexpr int CW_BAR = 1024;
constexpr int HREC = 33792, REC_PO = 33792, REC_H1 = 41984, REC_BYTES = 75776, REC_DMA = 41984, H_QT = 0, H_KT = 16384, H_G = 32768;
static_assert(512 * (size_t)REC_BYTES <= 42 * MiB && REC_DMA % 1024 == 0, "record");
__device__ __forceinline__ int qt_off(int t, int dl) {
    const int d5 = dl & 31; const int p = d5 < 16 ? ((d5 >> 2) << 3) + (d5 & 3) : (((d5 - 16) >> 2) << 3) + 4 + (d5 & 3);
    const int chunk = ((dl >> 5) << 2) + (p >> 3); return t * 256 + ((chunk ^ (t & 15)) << 4) + ((p & 7) << 1); }
__device__ __forceinline__ int qt_chunk(int t, int c) { return t * 256 + ((c ^ (t & 15)) << 4); }
__device__ __forceinline__ int kt_chunk(int d, int c) { return d * 128 + ((c ^ ((d >> 1) & 7)) << 4); }
constexpr size_t OUT_Y = 0, OUT_GLAP = 17301504, OUT_GLAS = 19398656, OUT_KWP = 36175872, OUT_VWP = 36306944, OUT_KWS = 36438016, OUT_VWS = 37486592, OUT_TOTAL = 38535168;
constexpr int RING_BYTES = 131072, LDS_BYTES = 163840, LDSCTL_OFF = LDS_BYTES - 1024, MISC_OFF = LDSCTL_OFF + 320;

__device__ __forceinline__ float bf2f(unsigned short u) { return __uint_as_float(((unsigned)u) << 16); }
__device__ __forceinline__ unsigned cvtpk2(float lo, float hi) { return pg8::cvtpk(lo, hi); }
__device__ __forceinline__ float wave_sum(float v) {
#pragma unroll
    for (int o = 1; o < 64; o <<= 1) v += __shfl_xor(v, o);
    return v;
}
#define MFMA16(a, b, c) __builtin_amdgcn_mfma_f32_16x16x32_bf16((a), (b), (c), 0, 0, 0)
typedef unsigned u32x2 __attribute__((ext_vector_type(2)));

struct Ptrs {
    const float *x_prompt, *x_sample, *state, *ck, *cv, *g_norm_a, *w_in_a, *w_gate_up, *b_gate, *g_onorm, *w_out_a, *g_norm_kv, *w_kv, *g_norm_b, *w_in_b, *sinks, *w_out_b, *g_final;
    float* out; unsigned char* ws;
};

__device__ __forceinline__ void p0_transpose_item(const float* W, int ldw, int ncol0, int nvalid, const float* gain, int scale_cols, float scale, bf16* WT, int row_off, LAS float* scr, int kb, int nb, int lane) {
    const int k0 = 64 * kb, n0 = 32 * nb, nl = lane & 31; const bool ok = (n0 + nl) < nvalid; const float cs = (n0 + nl) < scale_cols ? scale : 1.0f;
#pragma unroll 8
    for (int i = 0; i < 32; ++i) { const int kk = 2 * i + (lane >> 5); float v = ok ? W[(size_t)(k0 + kk) * ldw + ncol0 + n0 + nl] : 0.f; if (gain) v *= gain[k0 + kk]; scr[kk * 33 + nl] = v * cs; }
    LDS_WAIT(); asm volatile("" ::: "memory");
    const int c = lane & 7;
#pragma unroll
    for (int j = 0; j < 4; ++j) { const int n = (lane >> 3) + 8 * j; const LAS float* s = scr + (8 * c) * 33 + n;
        v4u o; o.x = cvtpk2(s[0 * 33], s[1 * 33]); o.y = cvtpk2(s[2 * 33], s[3 * 33]); o.z = cvtpk2(s[4 * 33], s[5 * 33]); o.w = cvtpk2(s[6 * 33], s[7 * 33]);
        if (n0 + n < nvalid) *(GAS v4u*)(WT + (size_t)(row_off + n0 + n) * 2048 + k0 + 8 * c) = o; }
    LDS_WAIT(); asm volatile("" ::: "memory");
}
__device__ __forceinline__ void rms_row_to_bf16(const float* xrow, bf16* orow, int lane) {
    const GAS f32x4* xr = (const GAS f32x4*)xrow + lane;
    f32x4 v[8]; float s = 0.f;
#pragma unroll
    for (int j = 0; j < 8; ++j) { v[j] = xr[64 * j]; s += (v[j].x * v[j].x + v[j].y * v[j].y) + (v[j].z * v[j].z + v[j].w * v[j].w); }
    const float rstd = 1.0f / sqrtf(wave_sum(s) * (1.f / DM) + RMS_EPS);
    GAS u32x2* o8 = (GAS u32x2*)orow + lane;
#pragma unroll
    for (int j = 0; j < 8; ++j) { u32x2 w; w.x = cvtpk2(v[j].x * rstd, v[j].y * rstd); w.y = cvtpk2(v[j].z * rstd, v[j].w * rstd); o8[64 * j] = w; }
}
__device__ __forceinline__ void p0_transpose_big(const float* W, int ldw, const float* gain, float cs, bf16* WT, int row_off, LAS unsigned char* scr, int kb, int nb, int lane) {
    const int k0 = 64 * kb, n0 = 128 * nb, hl = lane >> 5, nl = lane & 31;
    const GAS f32x4* src = (const GAS f32x4*)(W + (size_t)(k0 + 32 * hl) * ldw + n0 + 4 * nl);
    f32x4 v[32];
#pragma unroll
    for (int i = 0; i < 32; ++i) v[i] = src[(size_t)i * (ldw / 4)];
    f32x4 gk[8];
#pragma unroll
    for (int i = 0; i < 8; ++i) gk[i] = gain ? *(const GAS f32x4*)(gain + k0 + 32 * hl + 4 * i) * cs : (f32x4){cs, cs, cs, cs};
#pragma unroll
    for (int j = 0; j < 4; ++j) { const int n = 4 * nl + j;
#pragma unroll
        for (int q = 0; q < 4; ++q) { v4u o;
            o.x = cvtpk2(v[8 * q + 0][j] * gk[2 * q][0], v[8 * q + 1][j] * gk[2 * q][1]); o.y = cvtpk2(v[8 * q + 2][j] * gk[2 * q][2], v[8 * q + 3][j] * gk[2 * q][3]);
            o.z = cvtpk2(v[8 * q + 4][j] * gk[2 * q + 1][0], v[8 * q + 5][j] * gk[2 * q + 1][1]); o.w = cvtpk2(v[8 * q + 6][j] * gk[2 * q + 1][2], v[8 * q + 7][j] * gk[2 * q + 1][3]);
            *(LAS v4u*)(scr + n * 128 + (((4 * hl + q) ^ (n & 7)) << 4)) = o; } }
    LDS_WAIT(); asm volatile("" ::: "memory");
#pragma unroll
    for (int it = 0; it < 16; ++it) { const int idx = it * 64 + lane, n = idx >> 3, ch = idx & 7;
        const v4u o = *(const LAS v4u*)(scr + n * 128 + ((ch ^ (n & 7)) << 4));
        *(GAS v4u*)(WT + (size_t)(row_off + n0 + n) * 2048 + k0 + 8 * ch) = o; }
    LDS_WAIT(); asm volatile("" ::: "memory");
}
__device__ __forceinline__ void convert_weights(const Ptrs& P, LAS unsigned char* lds, int group, int gwi, int ngw, int iend, int wave, int lane) {
    LAS unsigned char* scr = lds + wave * 16384;
    bf16* WinaT = (bf16*)(P.ws + WS_WINA); bf16* WoaT = (bf16*)(P.ws + WS_WOA); bf16* WinbT = (bf16*)(P.ws + WS_WINB); bf16* WobT = (bf16*)(P.ws + WS_WOB);
    constexpr int I0 = 32 * 48, I1 = 32, I2 = 32 * 16, I3 = 32 * 32, I4 = 32 * 4, I5 = 32 * 16;
    if (group == 0) {
        for (int r = gwi; r < I0; r += ngw) { const int nb = r % 48; p0_transpose_big(P.w_in_a, 6160, P.g_norm_a, nb < 8 ? 0.0625f : 1.f, WinaT, 0, scr, r / 48, nb, lane); }
        for (int it = ngw - 1 - gwi; it < I1; it += ngw) p0_transpose_item(P.w_in_a, 6160, 6144, 16, P.g_norm_a, 0, 1.f, WinaT, 6144, (LAS float*)scr, it, 0, lane);
    } else {
        for (int it = gwi; it < iend; it += ngw) {
            int r = it;
            if (r < I2) { p0_transpose_big(P.w_out_a, 2048, P.g_onorm, 1.f, WoaT, 0, scr, r / 16, r % 16, lane); continue; } r -= I2;
            if (r < I3) { const int nb = r % 32; p0_transpose_big(P.w_in_b, 4096, P.g_norm_b, nb < 16 ? 0.125f * LOG2E : 1.f, WinbT, 0, scr, r / 32, nb, lane); continue; } r -= I3;
            if (r < I4) { p0_transpose_big(P.w_kv, 512, P.g_norm_kv, 1.f, WinbT, 4096, scr, r / 4, r % 4, lane); continue; } r -= I4;
            p0_transpose_big(P.w_out_b, 2048, nullptr, 1.f, WobT, 0, scr, r / 16, r % 16, lane);
        }
    }
}
__device__ __forceinline__ void p0_prologue(const Ptrs& P, LAS unsigned char* lds, int vcu, int G, int tid, int wave, int lane) {
    const int gw = vcu * NWAVES + wave, NGW = G * NWAVES;
    convert_weights(P, lds, 0, gw, NGW, 0, wave, lane);
    if (G < 256) convert_weights(P, lds, 1, gw, NGW, 2176, wave, lane);
    bf16* XN = (bf16*)(P.ws + WS_BUFA);
    for (int m = gw; m < MT; m += NGW) rms_row_to_bf16(m < MPR ? P.x_prompt + (size_t)m * DM : P.x_sample + (size_t)(m - MPR) * DM, XN + (size_t)m * DM, lane);
    const int gt = vcu * (NWAVES * 64) + tid, NGT = G * NWAVES * 64;
    for (int i = gt; i < 32 * 120 * 64; i += NGT) { const int b = i / (120 * 64), rem = i % (120 * 64);
        ((f32x4*)(P.out + OUT_KWS))[(size_t)b * 128 * 64 + rem] = ((const f32x4*)P.ck)[(size_t)b * 128 * 64 + 8 * 64 + rem];
        ((f32x4*)(P.out + OUT_VWS))[(size_t)b * 128 * 64 + rem] = ((const f32x4*)P.cv)[(size_t)b * 128 * 64 + 8 * 64 + rem]; }
}

__device__ __forceinline__ void glow_task(const bf16* XN, const bf16* WgT, float* GLOW, int task, int lane) {
    const int r = lane & 15, g = lane >> 4, row0 = task * 16;
    const bf16* ap = XN + (size_t)(row0 + r) * DM + g * 8; const bf16* bp = WgT + (size_t)r * DM + g * 8;
    f32x4 acc = {0.f, 0.f, 0.f, 0.f};
#pragma unroll 8
    for (int kk = 0; kk < 64; ++kk) { const bf16x8 a = *(const bf16x8*)(ap + kk * 32); const bf16x8 b = *(const bf16x8*)(bp + kk * 32); acc = MFMA16(a, b, acc); }
#pragma unroll
    for (int i = 0; i < 4; ++i) GLOW[(size_t)(row0 + 4 * g + i) * 16 + r] = acc[i];
}

__device__ __forceinline__ void gla_prep_unit(const Ptrs& P, LAS unsigned char* lds, int u, int tid, int wave, int lane) {
    const int c = u & 31, h = (u >> 5) & 3, b = u >> 7;
    const int d = tid & 255, th = tid >> 8, hh = d >> 7, dl = d & 127;
    LAS unsigned char* QI = lds;
    LAS unsigned char* KI = lds + 32768;
    LAS float* GL = (LAS float*)(lds + 65536);
    LAS float* TOT = (LAS float*)(lds + 65536 + 4096);
    const int row0 = b * 2048 + c * 64;
    const float* GLOW = (const float*)(P.ws + WS_GLOW);
    const bf16* QK = (const bf16*)(P.ws + WS_QK);
    unsigned char* rec = P.ws + WS_REC + (size_t)u * REC_BYTES;
    unsigned char* rech = rec + (hh ? REC_H1 : 0);
#pragma unroll
    for (int i = 0; i < 4; ++i) { const int idx = tid + 512 * i, t = idx >> 5, ch = idx & 31;
        const v4u q = *(const GAS v4u*)(QK + (size_t)(row0 + t) * DM + h * 256 + ch * 8), k = *(const GAS v4u*)(QK + (size_t)(row0 + t) * DM + 1024 + h * 256 + ch * 8);
        *(LAS v4u*)(QI + t * 512 + ch * 16) = q; *(LAS v4u*)(KI + t * 512 + ch * 16) = k; }
    if (tid < 256) ((LAS f32x4*)GL)[tid] = ((const f32x4*)(GLOW + (size_t)row0 * 16))[tid];
    float wg[16];
#pragma unroll
    for (int r = 0; r < 16; ++r) wg[r] = P.w_gate_up[r * 1024 + h * 256 + d];
    const float bias = P.b_gate[h * 256 + d];
    __syncthreads();
    float bl[32]; float run = 0.f;
#pragma unroll
    for (int tt = 0; tt < 32; ++tt) { const int t = th * 32 + tt; const LAS f32x4* gr = (const LAS f32x4*)(GL + t * 16);
        const f32x4 g0 = gr[0], g1 = gr[1], g2 = gr[2], g3 = gr[3];
        float z = bias + g0.x * wg[0] + g0.y * wg[1] + g0.z * wg[2] + g0.w * wg[3] + g1.x * wg[4] + g1.y * wg[5] + g1.z * wg[6] + g1.w * wg[7]
                       + g2.x * wg[8] + g2.y * wg[9] + g2.z * wg[10] + g2.w * wg[11] + g3.x * wg[12] + g3.y * wg[13] + g3.z * wg[14] + g3.w * wg[15];
        const float ls = fminf(z, 0.f) - __logf(1.0f + __expf(-fabsf(z)));
        run += ls * 0.0625f; bl[tt] = run; }
    TOT[th * 256 + d] = run;
    unsigned short qr[32], kr[32];
#pragma unroll
    for (int tt = 0; tt < 32; ++tt) { qr[tt] = *(const LAS unsigned short*)(QI + (th * 32 + tt) * 512 + d * 2); kr[tt] = *(const LAS unsigned short*)(KI + (th * 32 + tt) * 512 + d * 2); }
    __syncthreads();
    const float tot0 = TOT[d], tot1 = TOT[256 + d], blast = tot0 + tot1, base = th ? tot0 : 0.f;
    unsigned kt[16];
#pragma unroll
    for (int tt = 0; tt < 32; tt += 2) {
        float kv2[2];
#pragma unroll
        for (int k2 = 0; k2 < 2; ++k2) { const int t = th * 32 + tt + k2; const float bt = base + bl[tt + k2];
            const float e1 = __expf(bt - blast), e2 = __builtin_amdgcn_rcpf(e1);
            const float qv = bf2f(qr[tt + k2]) * e1, kv = bf2f(kr[tt + k2]) * e2; kv2[k2] = kv;
            const int off = hh * 16384 + qt_off(t, dl);
            *(LAS unsigned short*)(QI + off) = (unsigned short)(cvtpk2(qv, 0.f) & 0xffffu); *(LAS unsigned short*)(KI + off) = (unsigned short)(cvtpk2(kv, 0.f) & 0xffffu); }
        kt[tt >> 1] = cvtpk2(kv2[0], kv2[1]); }
#pragma unroll
    for (int i = 0; i < 4; ++i) { v4u o; o.x = kt[4 * i]; o.y = kt[4 * i + 1]; o.z = kt[4 * i + 2]; o.w = kt[4 * i + 3]; *(GAS v4u*)(rech + H_KT + kt_chunk(dl, 4 * th + i)) = o; }
    if (th == 0) ((GAS float*)(rech + H_G))[dl] = __expf(blast);
    __syncthreads();
    { const int r = lane & 15, g = lane >> 4, mt = wave >> 1, st0 = 2 * (wave & 1);
      f32x4 a0 = {0.f, 0.f, 0.f, 0.f}, a1 = {0.f, 0.f, 0.f, 0.f};
      bf16x8 bq[8], k0[8], k1[8];
#pragma unroll
      for (int kk = 0; kk < 8; ++kk) { const int ho = (kk >> 2) * 16384, cc = 4 * (kk & 3) + g;
          bq[kk] = *(const LAS bf16x8*)(QI + ho + qt_chunk(16 * mt + r, cc)); k0[kk] = *(const LAS bf16x8*)(KI + ho + qt_chunk(16 * st0 + r, cc)); k1[kk] = *(const LAS bf16x8*)(KI + ho + qt_chunk(16 * st0 + 16 + r, cc)); }
#pragma unroll
      for (int kk = 0; kk < 8; ++kk) { a0 = MFMA16(k0[kk], bq[kk], a0); a1 = MFMA16(k1[kk], bq[kk], a1); }
      const int t = 16 * mt + r;
#pragma unroll
      for (int j = 0; j < 2; ++j) { const f32x4 a = j ? a1 : a0; const int s0 = 16 * (st0 + j) + 4 * g;
          u32x2 w; w.x = cvtpk2(s0 + 0 <= t ? a[0] : 0.f, s0 + 1 <= t ? a[1] : 0.f); w.y = cvtpk2(s0 + 2 <= t ? a[2] : 0.f, s0 + 3 <= t ? a[3] : 0.f);
          *(GAS u32x2*)(rec + REC_PO + kt_chunk(t, s0 >> 3) + (s0 & 7) * 2) = w; } }
#pragma unroll
    for (int i = 0; i < 4; ++i) { const int idx = tid + 512 * i; ((GAS v4u*)(rec + ((idx >> 10) ? REC_H1 : 0) + H_QT))[idx & 1023] = ((const LAS v4u*)QI)[idx]; }
    __syncthreads();
}

constexpr int SC_BUF = REC_DMA, SC_PIECES = REC_DMA / 1024, SC_OT = 3 * REC_DMA;
static_assert(SC_OT + 2 * 16384 <= LDSCTL_OFF, "scan LDS map");
__device__ __forceinline__ void gla_scan_unit(const Ptrs& P, LAS unsigned char* lds, int bh, int dh, int eq, int tid, int wave, int lane, int nch = 32) {
    const int b = bh >> 2, h = bh & 3, r = lane & 15, g = lane >> 4, rr = (r >> 1) & 7;
    const int ecol = h * 512 + eq * 128 + 16 * wave;
    const bf16* VT = (const bf16*)(P.ws + WS_VT);
    bf16* OB = (bf16*)(P.ws + (dh ? WS_QK : WS_BUFA)) + (size_t)(b * 2048) * DM + h * 512 + eq * 128;
    const unsigned char* rec0 = P.ws + WS_REC + (size_t)(bh * 32) * REC_BYTES + (dh ? REC_PO : 0);
    const unsigned HO = dh ? 8192u : 0u, PO = dh ? 0u : 33792u;
    f32x4 S[8];
#pragma unroll
    for (int i = 0; i < 8; ++i) S[i] = (f32x4){0.f, 0.f, 0.f, 0.f};
    const bf16* vtp = VT + (size_t)(ecol + r) * MT + b * 2048 + 8 * g;
#define SC_DMA(cc, bufo_) do { const unsigned char* src_ = rec0 + (size_t)(cc) * REC_BYTES + lane * 16; \
        _Pragma("unroll") for (int j_ = 0; j_ < 6; ++j_) { const int i_ = wave + NWAVES * j_; \
            if (i_ < SC_PIECES) __builtin_amdgcn_global_load_lds((const GAS unsigned*)(src_ + i_ * 1024), (LAS unsigned*)(lds + (bufo_) + i_ * 1024), 16, 0, 0); } } while (0)
#define SC_OSTORE(cc) do { const LAS unsigned char* ot_ = lds + SC_OT + ((cc) & 1) * 16384; \
        _Pragma("unroll") for (int j_ = 0; j_ < 2; ++j_) { const int idx_ = tid + 512 * j_, row_ = idx_ >> 4, q_ = idx_ & 15; \
            const v4u v_ = *(const LAS v4u*)(ot_ + row_ * 256 + ((q_ ^ (row_ & 15)) << 4)); \
            *(GAS v4u*)(OB + (size_t)((cc) * 64 + row_) * DM + q_ * 8) = v_; } } while (0)
    bf16x8 vc0 = *(const bf16x8*)vtp, vc1 = *(const bf16x8*)(vtp + 32), vn0 = vc0, vn1 = vc1;
    SC_DMA(0, 0u); SC_DMA(1, (unsigned)SC_BUF);
    __syncthreads();
    unsigned bo0 = 0u, bo1 = SC_BUF, bo2 = 2u * SC_BUF;
#pragma unroll 1
    for (int c = 0; c < nch; ++c) {
        bf16x8 vf[2]; vf[0] = vc0; vf[1] = vc1;
        { const bf16* vp_ = vtp + (c + 1 < 32 ? c + 1 : 31) * 64;
          asm volatile("global_load_dwordx4 %0, %2, off\n\tglobal_load_dwordx4 %1, %2, off offset:64" : "=&v"(vn0), "=&v"(vn1) : "v"(vp_) : "memory"); }
        if (c > 0) SC_OSTORE(c - 1);
        const unsigned bufo = bo0;
        const unsigned qbase = bufo + HO + H_QT + (unsigned)(r * 256 + ((r >> 2) << 6) + ((g ^ (r & 3)) << 4));
        const unsigned kbase = bufo + HO + H_KT + (unsigned)(r * 128 + ((rr >> 2) << 6) + ((g ^ (rr & 3)) << 4));
        const unsigned pbase = bufo + PO + (unsigned)(r * 128 + ((dh ^ (rr >> 2)) << 6) + ((g ^ (rr & 3)) << 4));
        const unsigned gbase = bufo + HO + H_G + (unsigned)(g * 16);
#define SC_FENCE() __builtin_amdgcn_sched_barrier(0)
#define SC_BQ(k2, tt) (*(const LAS bf16x8*)(lds + ((qbase ^ ((k2) << 6)) + (tt) * 4096)))
#define SC_KF(i, ks) (*(const LAS bf16x8*)(lds + ((kbase ^ ((ks) << 6)) + (i) * 2048)))
#define SC_AF(k2) __builtin_bit_cast(bf16x8, (v4u){cvtpk2(S[2 * (k2)][0], S[2 * (k2)][1]), cvtpk2(S[2 * (k2)][2], S[2 * (k2)][3]), cvtpk2(S[2 * (k2) + 1][0], S[2 * (k2) + 1][1]), cvtpk2(S[2 * (k2) + 1][2], S[2 * (k2) + 1][3])})
        f32x4 gm[4]; bf16x8 qa[8], qb[8];
#pragma unroll
        for (int i = 0; i < 4; ++i) gm[i] = *(const LAS f32x4*)(lds + (gbase + i * 64));
#pragma unroll
        for (int tt = 0; tt < 4; ++tt) { qa[tt] = SC_BQ(0, tt); qa[4 + tt] = SC_BQ(1, tt); }
        SC_FENCE();
#pragma unroll
        for (int i = 0; i < 4; ++i) S[i] = S[i] * gm[i];
#pragma unroll
        for (int i = 0; i < 4; ++i) gm[i] = *(const LAS f32x4*)(lds + (gbase + (4 + i) * 64));
#pragma unroll
        for (int tt = 0; tt < 4; ++tt) { qb[tt] = SC_BQ(2, tt); qb[4 + tt] = SC_BQ(3, tt); }
        bf16x8 pq[4];
#pragma unroll
        for (int tt = 0; tt < 4; ++tt) pq[tt] = *(const LAS bf16x8*)(lds + (pbase + tt * 2048));
        SC_FENCE();
        f32x4 Z[4];
#pragma unroll
        for (int tt = 0; tt < 4; ++tt) Z[tt] = (f32x4){0.f, 0.f, 0.f, 0.f};
        { const bf16x8 a0 = SC_AF(0), a1 = SC_AF(1);
#pragma unroll
          for (int tt = 0; tt < 4; ++tt) Z[tt] = MFMA16(a0, qa[tt], Z[tt]);
#pragma unroll
          for (int tt = 0; tt < 4; ++tt) Z[tt] = MFMA16(a1, qa[4 + tt], Z[tt]); }
#pragma unroll
        for (int i = 0; i < 4; ++i) S[4 + i] = S[4 + i] * gm[i];
#pragma unroll
        for (int i = 0; i < 4; ++i) { qa[2 * i] = SC_KF(i, 0); qa[2 * i + 1] = SC_KF(i, 1); }
        SC_FENCE();

        { const bf16x8 a2 = SC_AF(2), a3 = SC_AF(3);
#pragma unroll
          for (int tt = 0; tt < 4; ++tt) Z[tt] = MFMA16(a2, qb[tt], Z[tt]);
#pragma unroll
          for (int tt = 0; tt < 4; ++tt) Z[tt] = MFMA16(a3, qb[4 + tt], Z[tt]);
#pragma unroll
          for (int tt = 0; tt < 4; ++tt) Z[tt] = MFMA16(dh ? vf[1] : vf[0], pq[tt], Z[tt]); }
#pragma unroll
        for (int i = 0; i < 4; ++i) { qb[2 * i] = SC_KF(4 + i, 0); qb[2 * i + 1] = SC_KF(4 + i, 1); }
        SC_FENCE();
        asm volatile("s_waitcnt vmcnt(0)" : "+v"(vn0), "+v"(vn1) :: "memory");
        SC_DMA((c + 2 < 32 ? c + 2 : 31), bo2);
        SC_FENCE();
#pragma unroll
        for (int i = 0; i < 4; ++i) { S[i] = MFMA16(qa[2 * i], vf[0], S[i]); S[i] = MFMA16(qa[2 * i + 1], vf[1], S[i]); }
#pragma unroll
        for (int i = 0; i < 4; ++i) { S[4 + i] = MFMA16(qb[2 * i], vf[0], S[4 + i]); S[4 + i] = MFMA16(qb[2 * i + 1], vf[1], S[4 + i]); }
#undef SC_FENCE
#undef SC_BQ
#undef SC_KF
#undef SC_AF
        { LAS unsigned char* ot = lds + SC_OT + (c & 1) * 16384 + (g & 1) * 8;
#pragma unroll
          for (int tt = 0; tt < 4; ++tt) { u32x2 w; w.x = cvtpk2(Z[tt][0], Z[tt][1]); w.y = cvtpk2(Z[tt][2], Z[tt][3]);
              *(LAS u32x2*)(ot + (16 * tt + r) * 256 + (((2 * wave + (g >> 1)) ^ r) << 4)) = w; } }
        asm volatile("s_waitcnt lgkmcnt(0)" ::: "memory"); __builtin_amdgcn_s_barrier(); asm volatile("" ::: "memory");
        vc0 = vn0; vc1 = vn1;
        { const unsigned t_ = bo0; bo0 = bo1; bo1 = bo2; bo2 = t_; }
    }
    SC_OSTORE(nch - 1);
#undef SC_OSTORE
#undef SC_DMA
    asm volatile("s_waitcnt vmcnt(0)" ::: "memory"); __syncthreads();
    float* SO = P.out + OUT_GLAP + ((size_t)bh * 256 + 128 * dh + 4 * g) * 512 + eq * 128 + 16 * wave + r;
#pragma unroll
    for (int i = 0; i < 8; ++i) { float* so = SO + (size_t)i * 16 * 512; asm volatile("" : "+v"(so));
        so[0] = S[i][0]; so[512] = S[i][1]; so[1024] = S[i][2]; so[1536] = S[i][3]; }
}

__device__ __forceinline__ void gla_sample_unit(const Ptrs& P, LAS unsigned char* lds, int u, int tid, int wave, int lane) {
    const int h = u & 3, b = u >> 2;
    LAS float* GL = (LAS float*)lds;
    LAS float* QD = (LAS float*)(lds + 1024);
    LAS float* KD = (LAS float*)(lds + 1024 + 8192);
    LAS float* GD = (LAS float*)(lds + 1024 + 16384);
    LAS float* PR = (LAS float*)(lds + 18432);
    LAS float* RED = (LAS float*)(lds + 18688);
    LAS float* VL = (LAS float*)(lds + 20480);
    LAS float* OP = (LAS float*)(lds + 36864);
    const int row0 = MPR + b * 8;
    const bf16* QK = (const bf16*)(P.ws + WS_QK); const bf16* VT = (const bf16*)(P.ws + WS_VT); const float* GLOW = (const float*)(P.ws + WS_GLOW);
    const int eq = tid & 127, dq = tid >> 7;
    const size_t sbase = ((size_t)(b * 4 + h) * 256 + 64 * dq) * 512 + 4 * eq;
    const float* S0p = P.state + sbase; float* S1p = P.out + OUT_GLAS + sbase;
    if (tid < 32) ((LAS f32x4*)GL)[tid] = ((const f32x4*)(GLOW + (size_t)row0 * 16))[tid];
    { const v4u vv = *(const GAS v4u*)(VT + (size_t)(h * 512 + tid) * MT + row0);
      VL[0 * 512 + tid] = __uint_as_float(vv.x << 16); VL[1 * 512 + tid] = __uint_as_float(vv.x & 0xffff0000u); VL[2 * 512 + tid] = __uint_as_float(vv.y << 16); VL[3 * 512 + tid] = __uint_as_float(vv.y & 0xffff0000u);
      VL[4 * 512 + tid] = __uint_as_float(vv.z << 16); VL[5 * 512 + tid] = __uint_as_float(vv.z & 0xffff0000u); VL[6 * 512 + tid] = __uint_as_float(vv.w << 16); VL[7 * 512 + tid] = __uint_as_float(vv.w & 0xffff0000u); }
    __syncthreads();
    if (tid < 256) {
        const int d = tid;
        float wg[16];
#pragma unroll
        for (int r = 0; r < 16; ++r) wg[r] = P.w_gate_up[r * 1024 + h * 256 + d];
        const float bias = P.b_gate[h * 256 + d];
        float bc[8], q[8], k[8]; float run = 0.f;
#pragma unroll
        for (int t = 0; t < 8; ++t) { q[t] = bf2f(QK[(size_t)(row0 + t) * DM + h * 256 + d]); k[t] = bf2f(QK[(size_t)(row0 + t) * DM + 1024 + h * 256 + d]); }
#pragma unroll
        for (int t = 0; t < 8; ++t) { const LAS f32x4* gr = (const LAS f32x4*)(GL + t * 16); const f32x4 g0 = gr[0], g1 = gr[1], g2 = gr[2], g3 = gr[3];
            float z = bias + g0.x * wg[0] + g0.y * wg[1] + g0.z * wg[2] + g0.w * wg[3] + g1.x * wg[4] + g1.y * wg[5] + g1.z * wg[6] + g1.w * wg[7]
                           + g2.x * wg[8] + g2.y * wg[9] + g2.z * wg[10] + g2.w * wg[11] + g3.x * wg[12] + g3.y * wg[13] + g3.z * wg[14] + g3.w * wg[15];
            const float ls = fminf(z, 0.f) - __logf(1.0f + __expf(-fabsf(z)));
            run += ls * 0.0625f; bc[t] = run; }
        const float blast = bc[7];
#pragma unroll
        for (int t = 0; t < 8; ++t) { QD[d * 8 + t] = q[t] * __expf(bc[t]); KD[d * 8 + t] = k[t] * __expf(blast - bc[t]); }
        GD[d] = __expf(blast);
        int idx = 0;
#pragma unroll
        for (int t = 0; t < 8; ++t)
#pragma unroll
            for (int s = 0; s <= t; ++s) { float v = q[t] * k[s] * __expf(bc[t] - bc[s]); v = wave_sum(v); if (lane == 0) RED[wave * 36 + idx] = v; ++idx; }
    }
    __syncthreads();
    if (tid < 64) { const int t = tid >> 3, s = tid & 7; float v = 0.f; if (s <= t) { const int idx = t * (t + 1) / 2 + s; v = RED[idx] + RED[36 + idx] + RED[72 + idx] + RED[108 + idx]; } PR[t * 8 + s] = v; }
    { f32x4 sa[4], sb[4];
#pragma unroll
      for (int i = 0; i < 4; ++i) sa[i] = *(const GAS f32x4*)(S0p + (size_t)i * 512);
      f32x4 v[8], o[8];
#pragma unroll
      for (int s = 0; s < 8; ++s) v[s] = *(const LAS f32x4*)(VL + s * 512 + 4 * eq);
#pragma unroll
      for (int t = 0; t < 8; ++t) o[t] = (f32x4){0.f, 0.f, 0.f, 0.f};
#define GS_STEP(cur, nxt, d0, more) do { if (more) { _Pragma("unroll") for (int i = 0; i < 4; ++i) nxt[i] = *(const GAS f32x4*)(S0p + (size_t)((d0) + 4 + i) * 512); } \
        _Pragma("unroll") for (int i = 0; i < 4; ++i) { const int dd = 64 * dq + (d0) + i; \
          const f32x4 qa = *(const LAS f32x4*)(QD + dd * 8), qb = *(const LAS f32x4*)(QD + dd * 8 + 4), ka = *(const LAS f32x4*)(KD + dd * 8), kb = *(const LAS f32x4*)(KD + dd * 8 + 4); \
          const float gm = GD[dd]; const f32x4 x = cur[i]; \
          o[0] += x * qa.x; o[1] += x * qa.y; o[2] += x * qa.z; o[3] += x * qa.w; o[4] += x * qb.x; o[5] += x * qb.y; o[6] += x * qb.z; o[7] += x * qb.w; \
          f32x4 sn = x * gm; sn += v[0] * ka.x; sn += v[1] * ka.y; sn += v[2] * ka.z; sn += v[3] * ka.w; sn += v[4] * kb.x; sn += v[5] * kb.y; sn += v[6] * kb.z; sn += v[7] * kb.w; \
          *(GAS f32x4*)(S1p + (size_t)((d0) + i) * 512) = sn; } } while (0)
#pragma unroll 1
      for (int d0 = 0; d0 < 64; d0 += 8) { GS_STEP(sa, sb, d0, true); GS_STEP(sb, sa, d0 + 4, d0 + 8 < 64); }
#undef GS_STEP
#pragma unroll
      for (int t = 0; t < 8; ++t) *(LAS f32x4*)(OP + (dq * 8 + t) * 512 + 4 * eq) = o[t];
    }
    __syncthreads();
    { const int t = tid >> 6, el = tid & 63; bf16* A2 = (bf16*)(P.ws + WS_BUFA); const bf16* SR = (const bf16*)(P.ws + WS_SR);
      float ov[8]; float ss = 0.f;
#pragma unroll
      for (int j = 0; j < 8; ++j) { const int e = el + 64 * j; float acc = (OP[(0 * 8 + t) * 512 + e] + OP[(1 * 8 + t) * 512 + e]) + (OP[(2 * 8 + t) * 512 + e] + OP[(3 * 8 + t) * 512 + e]);
#pragma unroll
          for (int s = 0; s < 8; ++s) acc += PR[t * 8 + s] * VL[s * 512 + e];
          ov[j] = acc; ss += acc * acc; }
      const float rs = 1.0f / sqrtf(wave_sum(ss) * (1.f / 512.f) + RMS_EPS);
#pragma unroll
      for (int j = 0; j < 8; ++j) { const size_t off = (size_t)(row0 + t) * DM + h * 512 + el + 64 * j; A2[off] = (bf16)(cvtpk2(ov[j] * rs * bf2f(SR[off]), 0.f) & 0xffffu); } }
    __syncthreads();
}

__device__ __forceinline__ void gate_rows(const Ptrs& P, int lane, int m0, int step, int mend) {
    bf16* O0 = (bf16*)(P.ws + WS_BUFA); const bf16* O1 = (const bf16*)(P.ws + WS_QK); const bf16* SR = (const bf16*)(P.ws + WS_SR);
    v4u a0[4], b0[4], s0[4], a1[4], b1[4], s1[4];
#define GR_LD(a, bq, s, m) do { _Pragma("unroll") for (int j = 0; j < 4; ++j) { const size_t off_ = (size_t)(m) * DM + 512 * j + 8 * lane; a[j] = *(const GAS v4u*)(O0 + off_); bq[j] = *(const GAS v4u*)(O1 + off_); s[j] = *(const GAS v4u*)(SR + off_); } } while (0)
#define GR_DO(a, bq, s, m) do { _Pragma("unroll") for (int j = 0; j < 4; ++j) { const size_t off_ = (size_t)(m) * DM + 512 * j + 8 * lane; float o[8]; \
        o[0] = __uint_as_float(a[j].x << 16) + __uint_as_float(bq[j].x << 16); o[1] = __uint_as_float(a[j].x & 0xffff0000u) + __uint_as_float(bq[j].x & 0xffff0000u); \
        o[2] = __uint_as_float(a[j].y << 16) + __uint_as_float(bq[j].y << 16); o[3] = __uint_as_float(a[j].y & 0xffff0000u) + __uint_as_float(bq[j].y & 0xffff0000u); \
        o[4] = __uint_as_float(a[j].z << 16) + __uint_as_float(bq[j].z << 16); o[5] = __uint_as_float(a[j].z & 0xffff0000u) + __uint_as_float(bq[j].z & 0xffff0000u); \
        o[6] = __uint_as_float(a[j].w << 16) + __uint_as_float(bq[j].w << 16); o[7] = __uint_as_float(a[j].w & 0xffff0000u) + __uint_as_float(bq[j].w & 0xffff0000u); \
        const float ss_ = ((o[0] * o[0] + o[1] * o[1]) + (o[2] * o[2] + o[3] * o[3])) + ((o[4] * o[4] + o[5] * o[5]) + (o[6] * o[6] + o[7] * o[7])); \
        const float rs_ = 1.0f / sqrtf(wave_sum(ss_) * (1.f / 512.f) + RMS_EPS); v4u w; \
        w.x = cvtpk2(o[0] * rs_ * __uint_as_float(s[j].x << 16), o[1] * rs_ * __uint_as_float(s[j].x & 0xffff0000u)); w.y = cvtpk2(o[2] * rs_ * __uint_as_float(s[j].y << 16), o[3] * rs_ * __uint_as_float(s[j].y & 0xffff0000u)); \
        w.z = cvtpk2(o[4] * rs_ * __uint_as_float(s[j].z << 16), o[5] * rs_ * __uint_as_float(s[j].z & 0xffff0000u)); w.w = cvtpk2(o[6] * rs_ * __uint_as_float(s[j].w << 16), o[7] * rs_ * __uint_as_float(s[j].w & 0xffff0000u)); \
        *(GAS v4u*)(O0 + off_) = w; } } while (0)
    if (m0 < mend) GR_LD(a0, b0, s0, m0);
#pragma unroll 1
    for (int m = m0; m < mend; m += 2 * step) {
        if (m + step < mend) GR_LD(a1, b1, s1, m + step);
        GR_DO(a0, b0, s0, m);
        if (m + step < mend) { if (m + 2 * step < mend) GR_LD(a0, b0, s0, m + 2 * step); GR_DO(a1, b1, s1, m + step); }
    }
#undef GR_LD
#undef GR_DO
}
__device__ __forceinline__ void final_rows(float* base, const float* gfin, int lane, int m0, int step, int mend) {
    const GAS f32x4* gr = (const GAS f32x4*)gfin + lane;
    f32x4 va[8], vb[8];
    if (m0 < mend) { const GAS f32x4* xr = (const GAS f32x4*)(base + (size_t)m0 * DM) + lane;
#pragma unroll
        for (int j = 0; j < 8; ++j) va[j] = xr[64 * j]; }
#define FR_STEP(cur, nxt, m) do { const int mn_ = (m) + step; if (mn_ < mend) { const GAS f32x4* xn_ = (const GAS f32x4*)(base + (size_t)mn_ * DM) + lane; _Pragma("unroll") for (int j = 0; j < 8; ++j) nxt[j] = xn_[64 * j]; } \
        float s_ = 0.f; _Pragma("unroll") for (int j = 0; j < 8; ++j) s_ += (cur[j].x * cur[j].x + cur[j].y * cur[j].y) + (cur[j].z * cur[j].z + cur[j].w * cur[j].w); \
        const float rstd_ = 1.0f / sqrtf(wave_sum(s_) * (1.f / DM) + RMS_EPS); GAS f32x4* dr_ = (GAS f32x4*)(base + (size_t)(m) * DM) + lane; \
        _Pragma("unroll") for (int j = 0; j < 8; ++j) dr_[64 * j] = cur[j] * rstd_ * gr[64 * j]; } while (0)
#pragma unroll 1
    for (int m = m0; m < mend; m += 2 * step) { FR_STEP(va, vb, m); if (m + step < mend) FR_STEP(vb, va, m + step); }
#undef FR_STEP
}
__device__ __forceinline__ void final_rows_b16(const bf16* H2b, float* ybase, const float* gfin, int lane, int m0, int step, int mend) {
    const GAS f32x4* gr = (const GAS f32x4*)gfin + 2 * lane;
    v4u va[4], vb[4];
    if (m0 < mend) { const GAS v4u* xr = (const GAS v4u*)(H2b + (size_t)m0 * DM) + lane;
#pragma unroll
        for (int j = 0; j < 4; ++j) va[j] = xr[64 * j]; }
#define FB_STEP(cur, nxt, m) do { const int mn_ = (m) + step; if (mn_ < mend) { const GAS v4u* xn_ = (const GAS v4u*)(H2b + (size_t)mn_ * DM) + lane; _Pragma("unroll") for (int j = 0; j < 4; ++j) nxt[j] = xn_[64 * j]; } \
        float f_[4][8]; float s_ = 0.f; _Pragma("unroll") for (int j = 0; j < 4; ++j) { \
            f_[j][0] = __uint_as_float(cur[j].x << 16); f_[j][1] = __uint_as_float(cur[j].x & 0xffff0000u); f_[j][2] = __uint_as_float(cur[j].y << 16); f_[j][3] = __uint_as_float(cur[j].y & 0xffff0000u); \
            f_[j][4] = __uint_as_float(cur[j].z << 16); f_[j][5] = __uint_as_float(cur[j].z & 0xffff0000u); f_[j][6] = __uint_as_float(cur[j].w << 16); f_[j][7] = __uint_as_float(cur[j].w & 0xffff0000u); \
            _Pragma("unroll") for (int e_ = 0; e_ < 8; ++e_) s_ += f_[j][e_] * f_[j][e_]; } \
        const float rstd_ = 1.0f / sqrtf(wave_sum(s_) * (1.f / DM) + RMS_EPS); GAS f32x4* dr_ = (GAS f32x4*)(ybase + (size_t)(m) * DM) + 2 * lane; \
        _Pragma("unroll") for (int j = 0; j < 4; ++j) { const f32x4 g0_ = gr[128 * j], g1_ = gr[128 * j + 1]; \
            dr_[128 * j] = (f32x4){f_[j][0] * rstd_ * g0_[0], f_[j][1] * rstd_ * g0_[1], f_[j][2] * rstd_ * g0_[2], f_[j][3] * rstd_ * g0_[3]}; \
            dr_[128 * j + 1] = (f32x4){f_[j][4] * rstd_ * g1_[0], f_[j][5] * rstd_ * g1_[1], f_[j][6] * rstd_ * g1_[2], f_[j][7] * rstd_ * g1_[3]}; } } while (0)
#pragma unroll 1
    for (int m = m0; m < mend; m += 2 * step) { FB_STEP(va, vb, m); if (m + step < mend) FB_STEP(vb, va, m + step); }
#undef FB_STEP
}
__device__ __forceinline__ void final_row(float* hrow, const float* gfin, int lane, float* drow) {
    GAS f32x4* xr = (GAS f32x4*)hrow + lane; GAS f32x4* dr = (GAS f32x4*)drow + lane; const GAS f32x4* gr = (const GAS f32x4*)gfin + lane;
    f32x4 v[8]; float s = 0.f;
#pragma unroll
    for (int j = 0; j < 8; ++j) { v[j] = xr[64 * j]; s += (v[j].x * v[j].x + v[j].y * v[j].y) + (v[j].z * v[j].z + v[j].w * v[j].w); }
    const float rstd = 1.0f / sqrtf(wave_sum(s) * (1.f / DM) + RMS_EPS);
#pragma unroll
    for (int j = 0; j < 8; ++j) dr[64 * j] = v[j] * rstd * gr[64 * j];
}

__device__ __forceinline__ void attn_subblock(const LAS bf16* KI, const LAS bf16* VI, int ts, const bf16x8 q0, const bf16x8 q1, int qpos, int kpos0, float slope2, float sink2,
                                              const u32x2 (&zz)[4], bf16* orow, bool store, int lane) {
    const int r = lane & 15, g = lane >> 4;
    f32x4 sc[10]; float mx = -INFINITY;
    const int D = qpos - (kpos0 + 16 * ts + 4 * g); const unsigned U = (unsigned)(qpos < 128 ? qpos : 128);
    const float c0 = -slope2 * (float)D; const f32x4 cinit = {c0, c0, c0, c0};
    { bf16x8 ka[10], kb[10];
      const LAS bf16* kr0 = KI + (16 * ts + r) * 80 + 8 * g;
#pragma unroll
      for (int i = 0; i < 5; ++i) { ka[2 * i] = *(const LAS bf16x8*)(kr0 + i * 1280); ka[2 * i + 1] = *(const LAS bf16x8*)(kr0 + i * 1280 + 32); }
      __builtin_amdgcn_sched_barrier(0);
#pragma unroll
      for (int i = 0; i < 5; ++i) { kb[2 * i] = *(const LAS bf16x8*)(kr0 + (5 + i) * 1280); kb[2 * i + 1] = *(const LAS bf16x8*)(kr0 + (5 + i) * 1280 + 32); }
#pragma unroll
      for (int i = 0; i < 5; ++i) { f32x4 a = MFMA16(ka[2 * i], q0, cinit); sc[i] = MFMA16(ka[2 * i + 1], q1, a); }
      __builtin_amdgcn_sched_barrier(0);
#pragma unroll
      for (int i = 0; i < 5; ++i) { f32x4 a = MFMA16(kb[2 * i], q0, cinit); sc[5 + i] = MFMA16(kb[2 * i + 1], q1, a); } }
#pragma unroll
    for (int i = 0; i < 10; ++i) {
#pragma unroll
        for (int e = 0; e < 4; ++e) { const unsigned dist = (unsigned)(D - (16 * i + e));
            const float v = dist <= U ? __builtin_fmaf(slope2, (float)(16 * i + e), sc[i][e]) : -INFINITY; sc[i][e] = v; mx = fmaxf(mx, v); } }
    mx = fmaxf(mx, __shfl_xor(mx, 16)); mx = fmaxf(mx, __shfl_xor(mx, 32)); mx = fmaxf(mx, sink2);
    float l = 0.f;
#pragma unroll
    for (int i = 0; i < 10; ++i)
#pragma unroll
        for (int e = 0; e < 4; ++e) { const float p = __builtin_amdgcn_exp2f(sc[i][e] - mx); sc[i][e] = p; l += p; }
    l += __shfl_xor(l, 16); l += __shfl_xor(l, 32);
    const float inv = 1.0f / (l + __builtin_amdgcn_exp2f(sink2 - mx));
    f32x4 o[4];
#pragma unroll
    for (int dt = 0; dt < 4; ++dt) o[dt] = (f32x4){0.f, 0.f, 0.f, 0.f};
    { const LAS bf16* vr0 = VI + r * 264 + 16 * ts + 4 * g;
#define AT_VRD(dst, ks) do { _Pragma("unroll") for (int dt = 0; dt < 4; ++dt) { const LAS bf16* vr = vr0 + dt * 4224 + (ks) * 32; \
          const u32x2 lo = *(const LAS u32x2*)vr, hi = *(const LAS u32x2*)(vr + 16); dst[dt].x = lo.x; dst[dt].y = lo.y; dst[dt].z = hi.x; dst[dt].w = hi.y; } } while (0)
#define AT_PV(src, ks) do { v4u pp; pp.x = cvtpk2(sc[2 * (ks)][0], sc[2 * (ks)][1]); pp.y = cvtpk2(sc[2 * (ks)][2], sc[2 * (ks)][3]); pp.z = cvtpk2(sc[2 * (ks) + 1][0], sc[2 * (ks) + 1][1]); pp.w = cvtpk2(sc[2 * (ks) + 1][2], sc[2 * (ks) + 1][3]); \
          const bf16x8 pb = __builtin_bit_cast(bf16x8, pp); _Pragma("unroll") for (int dt = 0; dt < 4; ++dt) o[dt] = MFMA16(__builtin_bit_cast(bf16x8, src[dt]), pb, o[dt]); } while (0)
      v4u va[4], vb[4];
      AT_VRD(va, 0); AT_VRD(vb, 1);
      __builtin_amdgcn_sched_barrier(0);
      AT_PV(va, 0); AT_VRD(va, 2);
      __builtin_amdgcn_sched_barrier(0);
      AT_PV(vb, 1); AT_VRD(vb, 3);
      __builtin_amdgcn_sched_barrier(0);
      AT_PV(va, 2); AT_VRD(va, 4);
      __builtin_amdgcn_sched_barrier(0);
      AT_PV(vb, 3);
      __builtin_amdgcn_sched_barrier(0);
      AT_PV(va, 4);
#undef AT_VRD
#undef AT_PV
    }
    if (store) {
#pragma unroll
        for (int dt = 0; dt < 4; ++dt) {
            u32x2 w; w.x = cvtpk2(o[dt][0] * inv * __uint_as_float(zz[dt].x << 16), o[dt][1] * inv * __uint_as_float(zz[dt].x & 0xffff0000u));
            w.y = cvtpk2(o[dt][2] * inv * __uint_as_float(zz[dt].y << 16), o[dt][3] * inv * __uint_as_float(zz[dt].y & 0xffff0000u));
            *(GAS u32x2*)(orow + 16 * dt + 4 * g) = w; }
    }
}
__device__ __forceinline__ void attn_prompt_unit(const Ptrs& P, LAS unsigned char* lds, int u, int tid, int wave, int lane) {
    const int kvh = u & 3, qb = (u >> 2) & 15, b = u >> 6;
    LAS bf16* KI = (LAS bf16*)lds;
    LAS bf16* VI = (LAS bf16*)(lds + 40960);
    const bf16* KB = (const bf16*)(P.ws + WS_KB); const bf16* VT2 = (const bf16*)(P.ws + WS_VT2); const bf16* QZ = (const bf16*)(P.ws + WS_QZ); bf16* A3 = (bf16*)(P.ws + WS_BUFA);
    const int kpos0 = (qb - 1) * 128;
    for (int i = tid; i < 2048; i += NWAVES * 64) { const int j = i >> 3, ch = i & 7; const int kpos = kpos0 + j;
        v4u v = {0u, 0u, 0u, 0u}; if (kpos >= 0) v = *(const GAS v4u*)(KB + (size_t)(b * 2048 + kpos) * 256 + kvh * 64 + ch * 8);
        *(LAS v4u*)(KI + j * 80 + ch * 8) = v; }
    for (int i = tid; i < 2048; i += NWAVES * 64) { const int d = i >> 5, ch = i & 31; const int kpos = kpos0 + ch * 8;
        v4u v = {0u, 0u, 0u, 0u}; if (kpos >= 0) v = *(const GAS v4u*)(VT2 + (size_t)(kvh * 64 + d) * MT + b * 2048 + kpos);
        *(LAS v4u*)(VI + d * 264 + ch * 8) = v; }
    __syncthreads();
    const int hh = kvh * 8 + wave;
    const float slope2 = __builtin_amdgcn_exp2f(-0.25f * (float)(hh + 1)) * LOG2E, sink2 = P.sinks[hh] * LOG2E;
    { const int g = lane >> 4; const bf16* qz0 = QZ + ((size_t)b * 2048 + qb * 128 + (lane & 15)) * 4096 + hh * 64;
      bf16x8 qc0 = *(const bf16x8*)(qz0 + 8 * g), qc1 = *(const bf16x8*)(qz0 + 32 + 8 * g);
#pragma unroll 1
      for (int qs = 0; qs < 8; ++qs) { const int qpos = qb * 128 + 16 * qs + (lane & 15); const size_t row = (size_t)b * 2048 + qpos;
          const bf16* qzr = qz0 + (size_t)qs * 16 * 4096;
          u32x2 zz[4];
#pragma unroll
          for (int dt = 0; dt < 4; ++dt) zz[dt] = *(const GAS u32x2*)(qzr + 2048 + 16 * dt + 4 * g);
          const bf16* qzn = qzr + (qs < 7 ? 16 * 4096 : 0);
          const bf16x8 qn0 = *(const bf16x8*)(qzn + 8 * g), qn1 = *(const bf16x8*)(qzn + 32 + 8 * g);
          attn_subblock(KI, VI, qs < 6 ? qs : 6, qc0, qc1, qpos, kpos0, slope2, sink2, zz, A3 + row * DM + hh * 64, true, lane);
          qc0 = qn0; qc1 = qn1; } }
    __syncthreads();
}
__device__ __forceinline__ void attn_sample_unit(const Ptrs& P, LAS unsigned char* lds, int u, int tid, int wave, int lane) {
    const int kvh = u & 3, b = u >> 2;
    LAS bf16* KI = (LAS bf16*)lds;
    LAS bf16* VI = (LAS bf16*)(lds + 40960);
    const bf16* KB = (const bf16*)(P.ws + WS_KB); const bf16* VT2 = (const bf16*)(P.ws + WS_VT2); const bf16* QZ = (const bf16*)(P.ws + WS_QZ); bf16* A3 = (bf16*)(P.ws + WS_BUFA);
    for (int i = tid; i < 160 * 64; i += NWAVES * 64) { const int j = i >> 6, d = i & 63; float kv = 0.f, vv = 0.f;
        if (j < 128) { kv = P.ck[((size_t)(b * 128 + j) * 4 + kvh) * 64 + d]; vv = P.cv[((size_t)(b * 128 + j) * 4 + kvh) * 64 + d]; }
        else if (j < 136) { kv = bf2f(KB[(size_t)(MPR + b * 8 + j - 128) * 256 + kvh * 64 + d]); vv = bf2f(VT2[(size_t)(kvh * 64 + d) * MT + MPR + b * 8 + j - 128]); }
        KI[j * 80 + d] = (bf16)(cvtpk2(kv, 0.f) & 0xffffu); VI[d * 264 + j] = (bf16)(cvtpk2(vv, 0.f) & 0xffffu); }
    __syncthreads();
    const int hh = kvh * 8 + wave;
    const float slope2 = __builtin_amdgcn_exp2f(-0.25f * (float)(hh + 1)) * LOG2E, sink2 = P.sinks[hh] * LOG2E;
    const int n = lane & 15, qi = n < 8 ? n : 7; const size_t row = (size_t)MPR + b * 8 + qi;
    { const int g = lane >> 4; const bf16* qzr = QZ + row * 4096 + hh * 64; u32x2 zz[4];
#pragma unroll
      for (int dt = 0; dt < 4; ++dt) zz[dt] = *(const GAS u32x2*)(qzr + 2048 + 16 * dt + 4 * g);
      attn_subblock(KI, VI, 0, *(const bf16x8*)(qzr + 8 * g), *(const bf16x8*)(qzr + 32 + 8 * g), 128 + qi, 0, slope2, sink2, zz, A3 + row * DM + hh * 64, n < 8, lane); }
    __syncthreads();
}
constexpr int SG_A = 0, SG_B = 10240, SG_STAGE = 30720, SG_RS = 2 * SG_STAGE;
template <bool NAT>
__device__ __forceinline__ void sgemm_core(LAS unsigned char* lds, const bf16* A, const bf16* B, f32x4 (&acc)[2][2], int tid, int wave, int lane) {
    const int wm = wave >> 2, wn = wave & 3, r = lane & 15, g = lane >> 4, lr = tid >> 3, ch = tid & 7;
    const GAS v4u* ga = (const GAS v4u*)(A + (size_t)lr * 2048 + ch * 8); const GAS v4u* gb0 = (const GAS v4u*)(B + (size_t)lr * 2048 + ch * 8); const GAS v4u* gb1 = (const GAS v4u*)(B + (size_t)(64 + lr) * 2048 + ch * 8);
    v4u ra0, rb0, rc0, ra1, rb1, rc1, ra2, rb2, rc2, ra3, rb3, rc3;
#pragma unroll
    for (int i = 0; i < 2; ++i)
#pragma unroll
        for (int j = 0; j < 2; ++j) acc[i][j] = (f32x4){0.f, 0.f, 0.f, 0.f};
#define SG_LD(s, kt) do { ra##s = ga[(kt) * 8]; rb##s = gb0[(kt) * 8]; rc##s = gb1[(kt) * 8]; } while (0)
#define SG_ST(s, stg) do { *(LAS v4u*)(lds + (stg) * SG_STAGE + SG_A + lr * 160 + ch * 16) = ra##s; *(LAS v4u*)(lds + (stg) * SG_STAGE + SG_B + lr * 160 + ch * 16) = rb##s; \
                           *(LAS v4u*)(lds + (stg) * SG_STAGE + SG_B + (64 + lr) * 160 + ch * 16) = rc##s; } while (0)
#define SG_COMPUTE(stg) do { _Pragma("unroll") for (int kk = 0; kk < 2; ++kk) { bf16x8 af[2], bfr[2]; \
        _Pragma("unroll") for (int i = 0; i < 2; ++i) af[i] = *(const LAS bf16x8*)(lds + (stg) * SG_STAGE + SG_A + (32 * wm + 16 * i + r) * 160 + (32 * kk + 8 * g) * 2); \
        _Pragma("unroll") for (int j = 0; j < 2; ++j) bfr[j] = *(const LAS bf16x8*)(lds + (stg) * SG_STAGE + SG_B + (32 * wn + 16 * j + r) * 160 + (32 * kk + 8 * g) * 2); \
        _Pragma("unroll") for (int i = 0; i < 2; ++i) _Pragma("unroll") for (int j = 0; j < 2; ++j) acc[i][j] = NAT ? MFMA16(af[i], bfr[j], acc[i][j]) : MFMA16(bfr[j], af[i], acc[i][j]); } } while (0)
#define SG_STEP(kt, s, stg) do { SG_COMPUTE(stg); if ((kt) + 1 < 32) SG_ST(s, (stg) ^ 1); if ((kt) + 5 < 32) SG_LD(s, (kt) + 5); __syncthreads(); } while (0)
    SG_LD(0, 0); SG_LD(1, 1); SG_LD(2, 2); SG_LD(3, 3); SG_ST(0, 0); SG_LD(0, 4);
    __syncthreads();
#pragma unroll 1
    for (int kt = 0; kt < 32; kt += 4) { SG_STEP(kt, 1, 0); SG_STEP(kt + 1, 2, 1); SG_STEP(kt + 2, 3, 0); SG_STEP(kt + 3, 0, 1); }
#undef SG_STEP
#undef SG_LD
#undef SG_ST
#undef SG_COMPUTE
}
template <bool SILU>
__device__ __forceinline__ void sg_store_bf16(const f32x4 (&acc)[2][2], bf16* dst, int ld, int wave, int lane, float rs0, float rs1) {
    const int wm = wave >> 2, wn = wave & 3, r = lane & 15, g = lane >> 4;
#pragma unroll
    for (int i = 0; i < 2; ++i)
#pragma unroll
        for (int j = 0; j < 2; ++j) { f32x4 v = acc[i][j] * (i ? rs1 : rs0);
            if (SILU) { v[0] = pg8::silu_f(v[0]); v[1] = pg8::silu_f(v[1]); v[2] = pg8::silu_f(v[2]); v[3] = pg8::silu_f(v[3]); }
            u32x2 w; w.x = cvtpk2(v[0], v[1]); w.y = cvtpk2(v[2], v[3]);
            *(GAS u32x2*)(dst + (size_t)(32 * wm + 16 * i + r) * ld + 32 * wn + 16 * j + 4 * g) = w; }
}
__device__ __forceinline__ void s_in_a_block(const Ptrs& P, LAS unsigned char* lds, int rb, int nbk, int tid, int wave, int lane) {
    const bf16* A = (const bf16*)(P.ws + WS_BUFA) + (size_t)(MPR + 64 * rb) * DM; const bf16* B = (const bf16*)(P.ws + WS_WINA) + (size_t)(128 * nbk) * DM;
    f32x4 acc[2][2];
    if (nbk >= 16 && nbk < 32) {
        sgemm_core<true>(lds, A, B, acc, tid, wave, lane);
        const int wm = wave >> 2, wn = wave & 3, r = lane & 15, g = lane >> 4; bf16* VT = (bf16*)(P.ws + WS_VT);
#pragma unroll
        for (int i = 0; i < 2; ++i)
#pragma unroll
            for (int j = 0; j < 2; ++j) { u32x2 w; w.x = cvtpk2(acc[i][j][0], acc[i][j][1]); w.y = cvtpk2(acc[i][j][2], acc[i][j][3]);
                *(GAS u32x2*)(VT + (size_t)((nbk - 16) * 128 + 32 * wn + 16 * j + r) * MT + MPR + 64 * rb + 32 * wm + 16 * i + 4 * g) = w; }
    } else {
        sgemm_core<false>(lds, A, B, acc, tid, wave, lane);
        if (nbk < 16) sg_store_bf16<false>(acc, (bf16*)(P.ws + WS_QK) + (size_t)(MPR + 64 * rb) * DM + nbk * 128, DM, wave, lane, 1.f, 1.f);
        else sg_store_bf16<true>(acc, (bf16*)(P.ws + WS_SR) + (size_t)(MPR + 64 * rb) * DM + (nbk - 32) * 128, DM, wave, lane, 1.f, 1.f);
    }
}
template <bool WITH_B16>
__device__ __forceinline__ void s_out_block(const Ptrs& P, LAS unsigned char* lds, const bf16* Abase, const bf16* Wt, const float* res, int rb, int nb, int tid, int wave, int lane) {
    f32x4 acc[2][2];
    sgemm_core<false>(lds, Abase + (size_t)(64 * rb) * DM, Wt + (size_t)(128 * nb) * DM, acc, tid, wave, lane);
    const int wm = wave >> 2, wn = wave & 3, r = lane & 15, g = lane >> 4;
    float* out = P.out + OUT_Y + (size_t)MPR * DM; bf16* H1b = (bf16*)(P.ws + WS_SR) + (size_t)MPR * DM; float* SSQ2 = (float*)(P.ws + WS_SSQP);
#pragma unroll
    for (int i = 0; i < 2; ++i) { const int row = 64 * rb + 32 * wm + 16 * i + r; float ss = 0.f;
#pragma unroll
        for (int j = 0; j < 2; ++j) { const size_t off = (size_t)row * DM + 128 * nb + 32 * wn + 16 * j + 4 * g;
            const f32x4 v = *(const GAS f32x4*)(res + off) + acc[i][j]; *(GAS f32x4*)(out + off) = v;
            if (WITH_B16) { u32x2 w; w.x = cvtpk2(v[0], v[1]); w.y = cvtpk2(v[2], v[3]); *(GAS u32x2*)(H1b + off) = w; ss += (v[0] * v[0] + v[1] * v[1]) + (v[2] * v[2] + v[3] * v[3]); } }
        if (WITH_B16) { ss += __shfl_xor(ss, 16); ss += __shfl_xor(ss, 32); if (g == 0) SSQ2[(size_t)row * 64 + nb * 4 + wn] = ss; } }
}
__device__ __forceinline__ void s_in_b_block(const Ptrs& P, LAS unsigned char* lds, int rb, int nbk, int tid, int wave, int lane) {
    const bf16* A = (const bf16*)(P.ws + WS_SR) + (size_t)(MPR + 64 * rb) * DM; const bf16* B = (const bf16*)(P.ws + WS_WINB) + (size_t)(128 * nbk) * DM;
    LAS float* RS = (LAS float*)(lds + SG_RS);
    { const int row = tid >> 3, part = tid & 7; const float* sp = (const float*)(P.ws + WS_SSQP) + (size_t)(64 * rb + row) * 64 + part * 8;
      const f32x4 a = *(const GAS f32x4*)sp, b = *(const GAS f32x4*)(sp + 4); float s = (a[0] + a[1]) + (a[2] + a[3]) + (b[0] + b[1]) + (b[2] + b[3]);
      s += __shfl_xor(s, 1); s += __shfl_xor(s, 2); s += __shfl_xor(s, 4);
      if (part == 0) RS[row] = 1.0f / sqrtf(s * (1.f / DM) + RMS_EPS); }
    f32x4 acc[2][2];
    const int wm = wave >> 2, wn = wave & 3, r = lane & 15, g = lane >> 4;
    if (nbk >= 34) {
        sgemm_core<true>(lds, A, B, acc, tid, wave, lane);
        bf16* VT2 = (bf16*)(P.ws + WS_VT2); float* vws = P.out + OUT_VWS;
#pragma unroll
        for (int i = 0; i < 2; ++i) { const f32x4 rs = *(const LAS f32x4*)(RS + 32 * wm + 16 * i + 4 * g);
#pragma unroll
            for (int j = 0; j < 2; ++j) { const f32x4 v = acc[i][j] * rs; const int col = (nbk - 34) * 128 + 32 * wn + 16 * j + r; const int srow = 64 * rb + 32 * wm + 16 * i + 4 * g;
                u32x2 w; w.x = cvtpk2(v[0], v[1]); w.y = cvtpk2(v[2], v[3]);
                *(GAS u32x2*)(VT2 + (size_t)col * MT + MPR + srow) = w;
#pragma unroll
                for (int e = 0; e < 4; ++e) { const int s = srow + e; vws[((size_t)(s >> 3) * 128 + 120 + (s & 7)) * 256 + col] = v[e]; } } }
    } else {
        sgemm_core<false>(lds, A, B, acc, tid, wave, lane);
        const float rs0 = RS[32 * wm + r], rs1 = RS[32 * wm + 16 + r];
        if (nbk < 16) sg_store_bf16<false>(acc, (bf16*)(P.ws + WS_QZ) + (size_t)(MPR + 64 * rb) * 4096 + nbk * 128, 4096, wave, lane, rs0, rs1);
        else if (nbk < 32) sg_store_bf16<true>(acc, (bf16*)(P.ws + WS_QZ) + (size_t)(MPR + 64 * rb) * 4096 + nbk * 128, 4096, wave, lane, rs0, rs1);
        else { sg_store_bf16<false>(acc, (bf16*)(P.ws + WS_KB) + (size_t)(MPR + 64 * rb) * 256 + (nbk - 32) * 128, 256, wave, lane, rs0, rs1);
            float* kws = P.out + OUT_KWS;
#pragma unroll
            for (int i = 0; i < 2; ++i) { const int s = 64 * rb + 32 * wm + 16 * i + r; float* d = kws + ((size_t)(s >> 3) * 128 + 120 + (s & 7)) * 256 + (nbk - 32) * 128 + 32 * wn + 4 * g;
#pragma unroll
                for (int j = 0; j < 2; ++j) *(GAS f32x4*)(d + 16 * j) = acc[i][j] * (i ? rs1 : rs0); } }
    }
}
#ifndef MK_N_LAUNCHES
#define MK_N_LAUNCHES 1
#endif
constexpr int N_PHASES = 11;
constexpr int N_LAUNCHES = MK_N_LAUNCHES;
struct Args { Ptrs p; int ph_lo, ph_hi; };
static_assert(sizeof(Args) == 20 * 8 + 8, "Args has no padding");

__global__ void __launch_bounds__(NWAVES * 64, 2) yoco_fwd(Args args) {
    extern __shared__ __attribute__((aligned(16))) unsigned char lds_raw[];
    LAS unsigned char* lds = (LAS unsigned char*)lds_raw;
    volatile LAS unsigned* MISC = (volatile LAS unsigned*)(lds + MISC_OFF);
    const int tid = threadIdx.x, lane = tid & 63, wave = __builtin_amdgcn_readfirstlane(tid >> 6);
    const int G = gridDim.x, c = blockIdx.x;
    const int vcu = (G % 8 == 0) ? (c % 8) * (G / 8) + c / 8 : c;
    const Ptrs& P = args.p;
    gu32* ctl = (gu32*)(P.ws + WS_CTL);
    for (int u = tid; u < (LDS_BYTES - LDSCTL_OFF) / 4; u += NWAVES * 64) ((LAS unsigned*)(lds + LDSCTL_OFF))[u] = 0u;
    __syncthreads();
    XcdBarrier bar; bar.bar = (unsigned*)(ctl + CW_BAR); bar.x = 0; bar.st = nullptr;
    const int lo = args.ph_lo, hi = args.ph_hi;
    if (hi - lo > 1) bar = xcd_barrier_post((unsigned*)(ctl + CW_BAR), MISC + 8);
#define IN(k) (lo <= (k) && (k) < hi)
#define SEAM(k) do { if (IN(k) && IN((k) + 1)) xcd_barrier(bar); } while (0)
    const int gw = vcu * NWAVES + wave, NGW = G * NWAVES;

    if (IN(0)) { p0_prologue(P, lds, vcu, G, tid, wave, lane); SEAM(0); }

    if (IN(1)) {
        pg8::SchedInA S{G, c, (const char*)(P.ws + WS_BUFA), (const char*)(P.ws + WS_WINA)};
        pg8::EpiInA E{(pg8::bf16_t*)(P.ws + WS_QK), (pg8::bf16_t*)(P.ws + WS_SR), (pg8::bf16_t*)(P.ws + WS_VT), MT};
        const bool early_glow = G == 256 && (c & 8);
        if (early_glow) { const int slot = wave * 128 + ((c >> 4) * 8 + (c & 7)); if (slot < MT / 16) glow_task((const bf16*)(P.ws + WS_BUFA), (const bf16*)(P.ws + WS_WINA) + (size_t)6144 * DM, (float*)(P.ws + WS_GLOW), slot, lane); __syncthreads(); }
        pg8::gemm_phase<pg8::EpiInA, pg8::SchedInA, true, true>(lds, 2048, S, E);
        if (G != 256) for (int task = c * NWAVES + wave; task < MT / 16; task += NGW)
            glow_task((const bf16*)(P.ws + WS_BUFA), (const bf16*)(P.ws + WS_WINA) + (size_t)6144 * DM, (float*)(P.ws + WS_GLOW), task, lane);
        SEAM(1);
    }

    if (IN(2)) {
        for (int blk = c; blk < 192; blk += G) s_in_a_block(P, lds, blk / 48, blk % 48, tid, wave, lane);
        if (G == 256) { for (int j = 0; j < 2; ++j) gla_prep_unit(P, lds, (2 * (c & 7) + j) * 32 + (c >> 3), tid, wave, lane); }
        else for (int u = c; u < 512; u += G) gla_prep_unit(P, lds, u, tid, wave, lane);
        SEAM(2);
    }

    if (IN(3)) {
        if (G >= 256) {
            constexpr int CV_A = 1408;
            if (c < 128) { const int xcd = c & 7, idx = c >> 3; gla_scan_unit(P, lds, xcd * 2 + (idx >> 3), (idx >> 2) & 1, idx & 3, tid, wave, lane);
                convert_weights(P, lds, 1, CV_A + c * NWAVES + wave, 128 * NWAVES, 2176, wave, lane); }
            else { gla_sample_unit(P, lds, c - 128, tid, wave, lane);
                convert_weights(P, lds, 1, (c - 128) * NWAVES + wave, 128 * NWAVES, CV_A, wave, lane); }
        } else {
            for (int u = c; u < 128; u += G) gla_scan_unit(P, lds, u >> 3, (u >> 2) & 1, u & 3, tid, wave, lane);
            for (int t = c; t < 128; t += G) gla_sample_unit(P, lds, t, tid, wave, lane);
        }
        SEAM(3);
    }

    if (IN(4)) {
        const int NS = G >= 128 ? 64 : 0;
        constexpr int GR0 = 8192;
        if (c < NS) { for (int blk = c; blk < 64; blk += NS) s_out_block<true>(P, lds, (const bf16*)(P.ws + WS_BUFA) + (size_t)MPR * DM, (const bf16*)(P.ws + WS_WOA), P.x_sample, blk >> 4, blk & 15, tid, wave, lane);
            gate_rows(P, lane, GR0 + c * NWAVES + wave, NS * NWAVES, MPR); }
        else { gate_rows(P, lane, (c - NS) * NWAVES + wave, (G - NS) * NWAVES, NS ? GR0 : MPR);
            if (NS == 0) { __syncthreads(); for (int blk = c; blk < 64; blk += G) s_out_block<true>(P, lds, (const bf16*)(P.ws + WS_BUFA) + (size_t)MPR * DM, (const bf16*)(P.ws + WS_WOA), P.x_sample, blk >> 4, blk & 15, tid, wave, lane); } }
        SEAM(4);
    }

    if (IN(5)) {
        pg8::SchedOut S{G, c, (const char*)(P.ws + WS_BUFA), (const char*)(P.ws + WS_WOA)};
        pg8::EpiOutA E{P.x_prompt, (pg8::bf16_t*)(P.ws + WS_SR), (float*)(P.ws + WS_SSQ1)};
        pg8::gemm_phase<pg8::EpiOutA, pg8::SchedOut, true, true>(lds, 2048, S, E);
        SEAM(5);
    }

    if (IN(6)) {
        pg8::SchedInB S{G, c, (const char*)(P.ws + WS_SR), (const char*)(P.ws + WS_WINB), (const float*)(P.ws + WS_SSQ1), (LAS float*)(lds + TAB_OFF)};
        pg8::EpiInB E{(pg8::bf16_t*)(P.ws + WS_QZ), (pg8::bf16_t*)(P.ws + WS_KB), (pg8::bf16_t*)(P.ws + WS_VT2), MT, P.out + OUT_KWP, P.out + OUT_VWP, P.out + OUT_KWS, P.out + OUT_VWS, (const LAS float*)(lds + TAB_OFF)};
        pg8::gemm_phase<pg8::EpiInB, pg8::SchedInB, true, true>(lds, 2048, S, E);
        for (int blk = (c + G - (64 % G)) % G; blk < 144; blk += G) s_in_b_block(P, lds, blk / 36, blk % 36, tid, wave, lane);
        SEAM(6);
    }

    if (IN(7)) {
        for (int u = c; u < 256; u += G) attn_prompt_unit(P, lds, u, tid, wave, lane);
        for (int u = c; u < 128; u += G) attn_sample_unit(P, lds, u, tid, wave, lane);
        SEAM(7);
    }

    if (IN(8)) {
        pg8::SchedOut S{G, c, (const char*)(P.ws + WS_BUFA), (const char*)(P.ws + WS_WOB)};
        pg8::EpiOutB E{(const pg8::bf16_t*)(P.ws + WS_SR), (pg8::bf16_t*)(P.ws + WS_QZ)};
        pg8::gemm_phase<pg8::EpiOutB, pg8::SchedOut, true, true>(lds, 2048, S, E);
        SEAM(8);
    }

    if (IN(9)) {
        const int NS = G >= 128 ? 64 : 0;
        constexpr int FR0 = 8192;
        if (c < NS) { for (int blk = c; blk < 64; blk += NS) s_out_block<false>(P, lds, (const bf16*)(P.ws + WS_BUFA) + (size_t)MPR * DM, (const bf16*)(P.ws + WS_WOB), P.out + OUT_Y + (size_t)MPR * DM, blk >> 4, blk & 15, tid, wave, lane);
            final_rows_b16((const bf16*)(P.ws + WS_QZ), P.out + OUT_Y, P.g_final, lane, FR0 + c * NWAVES + wave, NS * NWAVES, MPR); }
        else { if (NS == 0) for (int blk = c; blk < 64; blk += G) s_out_block<false>(P, lds, (const bf16*)(P.ws + WS_BUFA) + (size_t)MPR * DM, (const bf16*)(P.ws + WS_WOB), P.out + OUT_Y + (size_t)MPR * DM, blk >> 4, blk & 15, tid, wave, lane);
            final_rows_b16((const bf16*)(P.ws + WS_QZ), P.out + OUT_Y, P.g_final, lane, (c - NS) * NWAVES + wave, (G - NS) * NWAVES, NS ? FR0 : MPR); }
        SEAM(9);
    }

    if (IN(10)) { for (int m = MPR + gw; m < MT; m += NGW) final_row(P.out + OUT_Y + (size_t)m * DM, P.g_final, lane, P.out + OUT_Y + (size_t)m * DM); }
#undef IN
#undef SEAM
}

extern "C" void kernel_launch(void* const* d_in, const int* in_sizes, int n_in, void* d_out, int out_size, void* d_ws, size_t ws_size, hipStream_t stream) {
    static int grid = 0;
    if (grid == 0) {
        if (n_in != 18 || (size_t)out_size != OUT_TOTAL || ws_size < WS_END) { fprintf(stderr, "kernel_launch: unexpected shapes (n_in %d, out %d, ws %zu); nothing launched\n", n_in, out_size, ws_size); grid = -1; return; }
        int dev = 0, cus = 0, per_cu = 0;
        if (hipGetDevice(&dev) != hipSuccess || hipDeviceGetAttribute(&cus, hipDeviceAttributeMultiprocessorCount, dev) != hipSuccess) { grid = -1; return; }
        if (hipFuncSetAttribute((const void*)yoco_fwd, hipFuncAttributeMaxDynamicSharedMemorySize, LDS_BYTES) != hipSuccess) { fprintf(stderr, "kernel_launch: hipFuncSetAttribute failed\n"); grid = -1; return; }
        if (hipOccupancyMaxActiveBlocksPerMultiprocessor(&per_cu, (const void*)yoco_fwd, NWAVES * 64, LDS_BYTES) != hipSuccess || per_cu < 1)
            fprintf(stderr, "kernel_launch: note: occupancy query reports %d workgroups per CU\n", per_cu);
        (void)hipGetLastError();
        grid = cus;
    }
    if (grid < 0) return;
    (void)hipMemsetAsync((char*)d_ws + WS_CTL, 0, CTL_ZERO_BYTES, stream);
    Args a{};
    const float** pp = (const float**)&a.p;
    for (int i = 0; i < 18; ++i) pp[i] = (const float*)d_in[i];
    a.p.out = (float*)d_out; a.p.ws = (unsigned char*)d_ws;
    for (int li = 0; li < N_LAUNCHES; ++li) {
        a.ph_lo = (N_LAUNCHES == 1) ? 0 : li; a.ph_hi = (N_LAUNCHES == 1) ? N_PHASES : li + 1;
        hipLaunchKernelGGL(yoco_fwd, dim3(grid), dim3(NWAVES * 64), LDS_BYTES, stream, a);
    }
}
```

```cpp
#include <hip/hip_runtime.h>
#include <cstdio>
#include <cstdint>
#include <cmath>
namespace pg8 {
#define PG8_LAS __attribute__((address_space(3)))
typedef unsigned short bf16_t;
typedef short bf16x8 __attribute__((ext_vector_type(8)));
typedef float f32x4 __attribute__((ext_vector_type(4)));
typedef unsigned u32x4 __attribute__((ext_vector_type(4)));
constexpr int BM = 256, BK = 64, HALF = 128, HTB = HALF * BK * 2  , STAGE_BYTES = 8 * HTB, NXCD = 8, WGM = 8;

__host__ __device__ __forceinline__ int lds_byte(int r, int c) { const int st = (r >> 4) * 2 + (c >> 5), rr = r & 15, cc = c & 31, ob = rr * 64 + cc * 2; return st * 1024 + (ob ^ (((ob >> 9) & 1) << 5)); }
__host__ __device__ __forceinline__ void stage_rc(int b, int& R, int& C) { const int st = b / 1024, sb = b % 1024, swz = sb ^ (((sb >> 9) & 1) << 5); R = (st >> 1) * 16 + swz / 64; C = (st & 1) * 32 + (swz % 64) / 2; }
__host__ __device__ __forceinline__ int perm32(int rho) { const int n = rho >> 4, i = rho & 15; return 8 * (i >> 2) + 4 * n + (i & 3); }

struct Unit { const char* a; const char* b; int pm, pn, kind, par; };
__device__ __forceinline__ void tile_map(int L, int nM, int nN, int& pm, int& pn) {
    const int nwg = nM * nN; int wgid = L; { const int q = nwg / NXCD, r = nwg % NXCD, xcd = wgid % NXCD, off = wgid / NXCD; wgid = (xcd < r ? xcd * (q + 1) : r * (q + 1) + (xcd - r) * q) + off; }
    const int nig = WGM * nN, gid = wgid / nig, fm = gid * WGM, gsz = (nM - fm) < WGM ? (nM - fm) : WGM;
    pm = fm + ((wgid % nig) % gsz); pn = (wgid % nig) / gsz;
}
typedef float f32x2_t __attribute__((ext_vector_type(2))); typedef __bf16 bf16x2_t __attribute__((ext_vector_type(2)));
__device__ __forceinline__ unsigned cvtpk(float lo, float hi) { f32x2_t v = {lo, hi}; bf16x2_t b = __builtin_convertvector(v, bf16x2_t); return __builtin_bit_cast(unsigned, b); }
__device__ __forceinline__ float silu_f(float v) { return v / (1.0f + __expf(-v)); }

__device__ __forceinline__ void st16_wt(void* p, const u32x4& w) { asm volatile("global_store_dwordx4 %0, %1, off sc1\n\ts_nop 2" :: "v"(p), "v"(w) : "memory"); }
template <bool SILU, bool WT = false>
__device__ __forceinline__ void store_tile_bf16(const f32x4 (&acc)[2][2][4][2], bf16_t* base, int ldc, int row_t, int col_t, int wr, int wc, int fr, int fq, const PG8_LAS float* rtab = nullptr) {
    const int row0 = row_t + wr * 64 + fr, col0 = col_t + wc * 32 + 8 * fq;
#pragma unroll
    for (int ai = 0; ai < 2; ++ai)
#pragma unroll
        for (int m = 0; m < 4; ++m) { bf16_t* rowp = base + (size_t)(row0 + ai * HALF + m * 16) * ldc + col0; const float rsc = rtab ? rtab[wr * 64 + fr + ai * HALF + m * 16] : 1.0f;
#pragma unroll
            for (int bj = 0; bj < 2; ++bj) { f32x4 v0 = acc[ai][bj][m][0] * rsc, v1 = acc[ai][bj][m][1] * rsc;
                if (SILU) { v0[0] = silu_f(v0[0]); v0[1] = silu_f(v0[1]); v0[2] = silu_f(v0[2]); v0[3] = silu_f(v0[3]); v1[0] = silu_f(v1[0]); v1[1] = silu_f(v1[1]); v1[2] = silu_f(v1[2]); v1[3] = silu_f(v1[3]); }
                u32x4 w; w.x = cvtpk(v0[0], v0[1]); w.y = cvtpk(v0[2], v0[3]); w.z = cvtpk(v1[0], v1[1]); w.w = cvtpk(v1[2], v1[3]);
                if (WT) st16_wt(rowp + bj * HALF, w); else *(u32x4*)(rowp + bj * HALF) = w; } }
}

struct EpiInA {
    static constexpr bool PERM = true, AFTER_DRAIN = false;
    bf16_t* QK; bf16_t* SR; bf16_t* VT; int MT;
    __device__ __forceinline__ void operator()(const f32x4 (&acc)[2][2][4][2], const Unit& u, int wr, int wc, int fr, int fq) const {
        if (u.kind == 0) store_tile_bf16<false>(acc, QK, 2048, u.pm * BM, u.pn * BM, wr, wc, fr, fq);
        else if (u.kind == 1) store_tile_bf16<true>(acc, SR, 2048, u.pm * BM, (u.pn - 8) * BM, wr, wc, fr, fq);
        else store_tile_bf16<false>(acc, VT, MT, u.pm * BM, u.pn * BM, wr, wc, fr, fq);
    }
};

struct EpiInB {
    static constexpr bool PERM = true, AFTER_DRAIN = false;
    bf16_t* QZ; bf16_t* KB; bf16_t* VT2; int MT; float* kwp; float* vwp; float* kws; float* vws; const PG8_LAS float* tab;
    __device__ __forceinline__ static float* win_row(int t, float* wp, float* wsmp) {
        if (t < 8192) { const int pos = t & 2047; if (pos < 1920) return nullptr; return wp + ((size_t)(t >> 11) * 128 + (pos - 1920)) * 256; }
        const int s = t - 8192; return wsmp + ((size_t)(s >> 3) * 128 + 120 + (s & 7)) * 256;
    }
    __device__ __forceinline__ void operator()(const f32x4 (&acc)[2][2][4][2], const Unit& u, int wr, int wc, int fr, int fq) const {
        asm volatile("" : "+v"(fr), "+v"(fq));
        const PG8_LAS float* T = tab + (u.par << 8);
        if (u.kind == 0) { store_tile_bf16<false, true>(acc, QZ, 4096, u.pm * BM, u.pn * BM, wr, wc, fr, fq, T); return; }
        if (u.kind == 1) { store_tile_bf16<true, true>(acc, QZ, 4096, u.pm * BM, u.pn * BM, wr, wc, fr, fq, T); return; }
        if (u.kind == 2) {
            store_tile_bf16<false, true>(acc, KB, 256, u.pm * BM, 0, wr, wc, fr, fq, T);
            if ((u.pm & 7) == 7) {
                const int row0 = u.pm * BM + wr * 64 + fr, col0 = wc * 32 + 8 * fq;
#pragma unroll
                for (int ai = 0; ai < 2; ++ai)
#pragma unroll
                    for (int m = 0; m < 4; ++m) { float* d = win_row(row0 + ai * HALF + m * 16, kwp, kws); const float rsc = T[wr * 64 + fr + ai * HALF + m * 16];
                        if (d) {
#pragma unroll
                            for (int bj = 0; bj < 2; ++bj) { *(f32x4*)(d + col0 + bj * HALF) = acc[ai][bj][m][0] * rsc; *(f32x4*)(d + col0 + bj * HALF + 4) = acc[ai][bj][m][1] * rsc; } } }
            }
            return;
        }
        const int row0 = wr * 64 + fr, colb = wc * 32 + 8 * fq;
        f32x4 cs[2][2];
#pragma unroll
        for (int bj = 0; bj < 2; ++bj) { cs[bj][0] = *(const PG8_LAS f32x4*)(T + colb + bj * HALF); cs[bj][1] = *(const PG8_LAS f32x4*)(T + colb + bj * HALF + 4); }
#pragma unroll
        for (int ai = 0; ai < 2; ++ai)
#pragma unroll
            for (int m = 0; m < 4; ++m) { bf16_t* rowp = VT2 + (size_t)(row0 + ai * HALF + m * 16) * MT + u.pn * BM + colb;
#pragma unroll
                for (int bj = 0; bj < 2; ++bj) { const f32x4 v0 = acc[ai][bj][m][0] * cs[bj][0], v1 = acc[ai][bj][m][1] * cs[bj][1];
                    u32x4 w; w.x = cvtpk(v0[0], v0[1]); w.y = cvtpk(v0[2], v0[3]); w.z = cvtpk(v1[0], v1[1]); w.w = cvtpk(v1[2], v1[3]);
                    st16_wt(rowp + bj * HALF, w); } }
        if ((u.pn & 7) == 7) {
            const int col0 = u.pn * BM + colb;
#pragma unroll
            for (int bj = 0; bj < 2; ++bj)
#pragma unroll
                for (int n = 0; n < 2; ++n)
#pragma unroll
                    for (int j = 0; j < 4; ++j) { float* d = win_row(col0 + bj * HALF + 4 * n + j, vwp, vws);
                        if (d) {
#pragma unroll
                            for (int ai = 0; ai < 2; ++ai)
#pragma unroll
                                for (int m = 0; m < 4; ++m) d[row0 + ai * HALF + m * 16] = acc[ai][bj][m][n][j] * cs[bj][n][j]; } }
        }
    }
};

struct EpiOutA {
    static constexpr bool PERM = true, AFTER_DRAIN = false;
    const float* x; bf16_t* H1b; float* SSQ1;
    __device__ __forceinline__ void operator()(const f32x4 (&acc)[2][2][4][2], const Unit& u, int wr, int wc, int fr, int fq) const {
        const int row0 = u.pm * BM + wr * 64 + fr, col0 = u.pn * BM + wc * 32 + 8 * fq;
        const float* xb = x + (size_t)row0 * 2048 + col0; bf16_t* hb = H1b + (size_t)row0 * 2048 + col0;
        f32x4 xr[3][4];
#define EOA_LD(slot, gi) do { const size_t o_ = (size_t)(((gi) >> 2) * HALF + ((gi) & 3) * 16) * 2048; xr[slot][0] = *(const f32x4*)(xb + o_); xr[slot][1] = *(const f32x4*)(xb + o_ + 4); xr[slot][2] = *(const f32x4*)(xb + o_ + HALF); xr[slot][3] = *(const f32x4*)(xb + o_ + HALF + 4); } while (0)
        EOA_LD(0, 0); EOA_LD(1, 1);
#pragma unroll
        for (int gi = 0; gi < 8; ++gi) { const int ai = gi >> 2, m = gi & 3;
            if (gi + 2 < 8) EOA_LD((gi + 2) % 3, gi + 2);
            const size_t o = (size_t)(ai * HALF + m * 16) * 2048; float ss = 0.f;
#pragma unroll
            for (int bj = 0; bj < 2; ++bj) { const f32x4 v0 = xr[gi % 3][bj * 2] + acc[ai][bj][m][0], v1 = xr[gi % 3][bj * 2 + 1] + acc[ai][bj][m][1];
                u32x4 w; w.x = cvtpk(v0[0], v0[1]); w.y = cvtpk(v0[2], v0[3]); w.z = cvtpk(v1[0], v1[1]); w.w = cvtpk(v1[2], v1[3]);
                *(u32x4*)(hb + o + bj * HALF) = w;
                ss += ((v0[0] * v0[0] + v0[1] * v0[1]) + (v0[2] * v0[2] + v0[3] * v0[3])) + ((v1[0] * v1[0] + v1[1] * v1[1]) + (v1[2] * v1[2] + v1[3] * v1[3])); }
            ss += __shfl_xor(ss, 16); ss += __shfl_xor(ss, 32);
            if (fq == 0) SSQ1[(size_t)(row0 + ai * HALF + m * 16) * 32 + u.pn * 4 + wc] = ss; }
#undef EOA_LD
    }
};
struct EpiOutB {
    static constexpr bool PERM = false, AFTER_DRAIN = false;
    const bf16_t* H1b; bf16_t* H2b;
    __device__ __forceinline__ void operator()(const f32x4 (&acc)[2][2][4][2], const Unit& u, int wr, int wc, int fr, int fq) const {
        typedef unsigned u32x2_t __attribute__((ext_vector_type(2)));
        const int row0 = u.pm * BM + wr * 64 + fr, col0 = u.pn * BM + wc * 32 + 4 * fq;
        const bf16_t* hb = H1b + (size_t)row0 * 2048 + col0; bf16_t* ob = H2b + (size_t)row0 * 2048 + col0;
        u32x2_t hr[3][4];
#define EOB_LD(slot, gi) do { const size_t o_ = (size_t)(((gi) >> 2) * HALF + ((gi) & 3) * 16) * 2048; hr[slot][0] = *(const u32x2_t*)(hb + o_); hr[slot][1] = *(const u32x2_t*)(hb + o_ + 16); hr[slot][2] = *(const u32x2_t*)(hb + o_ + HALF); hr[slot][3] = *(const u32x2_t*)(hb + o_ + HALF + 16); } while (0)
        EOB_LD(0, 0); EOB_LD(1, 1);
#pragma unroll
        for (int gi = 0; gi < 8; ++gi) { const int ai = gi >> 2, m = gi & 3;
            if (gi + 2 < 8) EOB_LD((gi + 2) % 3, gi + 2);
            const size_t o = (size_t)(ai * HALF + m * 16) * 2048;
#pragma unroll
            for (int bj = 0; bj < 2; ++bj)
#pragma unroll
                for (int n = 0; n < 2; ++n) { const u32x2_t h = hr[gi % 3][bj * 2 + n];
                    f32x4 r; r[0] = __uint_as_float(h.x << 16); r[1] = __uint_as_float(h.x & 0xffff0000u); r[2] = __uint_as_float(h.y << 16); r[3] = __uint_as_float(h.y & 0xffff0000u);
                    r = r + acc[ai][bj][m][n]; u32x2_t w; w.x = cvtpk(r[0], r[1]); w.y = cvtpk(r[2], r[3]);
                    *(u32x2_t*)(ob + o + bj * HALF + n * 16) = w; } }
#undef EOB_LD
    }
};


template <class Mid>
struct EpiOutF {
    static constexpr bool PERM = true, AFTER_DRAIN = false;
    const bf16_t* H1b; float* Y; const float* gfin; float* SSQ; unsigned* cnt; PG8_LAS float* tab; const Mid& mid;
    __device__ __forceinline__ void operator()(const f32x4 (&acc_)[2][2][4][2], const Unit& u, int wr, int wc, int fr, int fq) const {
        f32x4 (&acc)[2][2][4][2] = const_cast<f32x4 (&)[2][2][4][2]>(acc_);
        const int row0 = u.pm * BM + wr * 64 + fr, col0 = u.pn * BM + wc * 32 + 8 * fq;
        const bf16_t* hb = H1b + (size_t)row0 * 2048 + col0;
        u32x4 hr[3][2];
#define EOF_LD(slot, gi) do { const size_t o_ = (size_t)(((gi) >> 2) * HALF + ((gi) & 3) * 16) * 2048; hr[slot][0] = *(const u32x4*)(hb + o_); hr[slot][1] = *(const u32x4*)(hb + o_ + HALF); } while (0)
        EOF_LD(0, 0); EOF_LD(1, 1);
#pragma unroll
        for (int gi = 0; gi < 8; ++gi) { const int ai = gi >> 2, m = gi & 3;
            if (gi + 2 < 8) EOF_LD((gi + 2) % 3, gi + 2);
            float ss = 0.f;
#pragma unroll
            for (int bj = 0; bj < 2; ++bj) { const u32x4 h = hr[gi % 3][bj];
                f32x4 r0, r1; r0[0] = __uint_as_float(h.x << 16); r0[1] = __uint_as_float(h.x & 0xffff0000u); r0[2] = __uint_as_float(h.y << 16); r0[3] = __uint_as_float(h.y & 0xffff0000u);
                r1[0] = __uint_as_float(h.z << 16); r1[1] = __uint_as_float(h.z & 0xffff0000u); r1[2] = __uint_as_float(h.w << 16); r1[3] = __uint_as_float(h.w & 0xffff0000u);
                r0 = r0 + acc[ai][bj][m][0]; r1 = r1 + acc[ai][bj][m][1]; acc[ai][bj][m][0] = r0; acc[ai][bj][m][1] = r1;
                ss += ((r0[0] * r0[0] + r0[1] * r0[1]) + (r0[2] * r0[2] + r0[3] * r0[3])) + ((r1[0] * r1[0] + r1[1] * r1[1]) + (r1[2] * r1[2] + r1[3] * r1[3])); }
            ss += __shfl_xor(ss, 16); ss += __shfl_xor(ss, 32);
            if (fq == 0) __hip_atomic_store(SSQ + (size_t)(row0 + ai * HALF + m * 16) * 32 + u.pn * 4 + wc, ss, __ATOMIC_RELAXED, __HIP_MEMORY_SCOPE_AGENT); }
#undef EOF_LD
        asm volatile("s_waitcnt vmcnt(0)" ::: "memory");
        unsigned* cw = cnt + u.pm * 16;
        if ((threadIdx.x & 63) == 0) (void)__hip_atomic_fetch_add(cw, 1u, __ATOMIC_RELAXED, __HIP_MEMORY_SCOPE_AGENT);
        mid();
        if (threadIdx.x < 64) {
            unsigned sp = 0; while (__hip_atomic_load(cw, __ATOMIC_RELAXED, __HIP_MEMORY_SCOPE_AGENT) < 64u) { __builtin_amdgcn_s_sleep(8); if (++sp > (1u << 20)) break; }
            __builtin_amdgcn_fence(__ATOMIC_ACQUIRE, "agent");
            asm volatile("s_waitcnt vmcnt(0)" ::: "memory");
        }
        __builtin_amdgcn_s_barrier();
        { int t = threadIdx.x; asm volatile("" : "+v"(t));
          const int row = t >> 1, hf = t & 1; const float* p = SSQ + ((size_t)u.pm * BM + row) * 32 + hf * 16;
          const f32x4 a0 = *(const f32x4*)p, a1 = *(const f32x4*)(p + 4), a2 = *(const f32x4*)(p + 8), a3 = *(const f32x4*)(p + 12);
          float s = ((a0[0] + a0[1]) + (a0[2] + a0[3])) + ((a1[0] + a1[1]) + (a1[2] + a1[3])) + ((a2[0] + a2[1]) + (a2[2] + a2[3])) + ((a3[0] + a3[1]) + (a3[2] + a3[3]));
          s += __shfl_xor(s, 1);
          if (hf == 0) tab[row] = 1.0f / sqrtf(s * (1.0f / 2048.0f) + 1e-6f); }
        asm volatile("s_waitcnt lgkmcnt(0)" ::: "memory");
        __builtin_amdgcn_s_barrier();
        f32x4 gq[2][2];
#pragma unroll
        for (int bj = 0; bj < 2; ++bj)
#pragma unroll
            for (int n = 0; n < 2; ++n) gq[bj][n] = *(const f32x4*)(gfin + col0 + bj * HALF + n * 4);
        float* yb = Y + (size_t)row0 * 2048 + col0;
#pragma unroll
        for (int gi = 0; gi < 8; ++gi) { const int ai = gi >> 2, m = gi & 3; const float rs = tab[wr * 64 + fr + ai * HALF + m * 16];
            const size_t o = (size_t)(ai * HALF + m * 16) * 2048;
#pragma unroll
            for (int bj = 0; bj < 2; ++bj)
#pragma unroll
                for (int n = 0; n < 2; ++n) *(f32x4*)(yb + o + bj * HALF + n * 4) = acc[ai][bj][m][n] * rs * gq[bj][n]; }
    }
};
struct SchedInA {
    int G, c; const char* XN; const char* W;
    __device__ __forceinline__ bool next(int i, Unit& u) const {
        const int L = i * G + c; const size_t P = (size_t)BM * 2048 * 2;
        if (L < 512) { u.par = 0; tile_map(L, 32, 16, u.pm, u.pn); u.kind = u.pn < 8 ? 0 : 1; u.a = XN + u.pm * P; u.b = W + (u.pn < 8 ? u.pn : u.pn + 8) * P; return true; }
        if (L < 768) { u.par = 0; tile_map(L - 512, 8, 32, u.pm, u.pn); u.kind = 2; u.a = W + (8 + u.pm) * P; u.b = XN + u.pn * P; return true; }
        return false;
    }
    __device__ __forceinline__ void a_ready(const Unit&) const {}
    __device__ __forceinline__ void done(const Unit&) const {}
};
struct SchedInB {
    int G, c; const char* XN; const char* W; const float* SSQ1; PG8_LAS float* tab; unsigned* flags;
    __device__ __forceinline__ bool next(int i, Unit& u) const {
        const int L = i * G + c; const size_t P = (size_t)BM * 2048 * 2; u.par = i & 1;
        if (L >= 576) return false;
        const int x = L & 7, off = L >> 3, b = x >> 1, hx = x & 1;
        if (off < 8) {
            if (hx) { u.pm = 0; u.pn = 8 * b + off; u.kind = 3; u.a = W + 17 * P; u.b = XN + u.pn * P; return true; }
            u.pm = 8 * b + off; u.pn = 16; u.kind = 2;
        } else {
            int pml, pnl; if (off < 64) { const int t = off - 8; pnl = t / 7; pml = t - 7 * pnl; } else { pml = 7; pnl = off - 64; }
            u.pm = 8 * b + pml; u.pn = hx ? 8 + pnl : pnl; u.kind = hx;
        }
        u.a = XN + u.pm * P; u.b = W + u.pn * P; return true;
    }
    __device__ __forceinline__ void a_ready(const Unit& u) const {
        int t = threadIdx.x; asm volatile("" : "+v"(t));
        const int row = t >> 1, hf = t & 1, panel = u.kind == 3 ? u.pn : u.pm;
        const float* p = SSQ1 + ((size_t)panel * BM + row) * 32 + hf * 16;
        const f32x4 a0 = *(const f32x4*)p, a1 = *(const f32x4*)(p + 4), a2 = *(const f32x4*)(p + 8), a3 = *(const f32x4*)(p + 12);
        float s = ((a0[0] + a0[1]) + (a0[2] + a0[3])) + ((a1[0] + a1[1]) + (a1[2] + a1[3])) + ((a2[0] + a2[1]) + (a2[2] + a2[3])) + ((a3[0] + a3[1]) + (a3[2] + a3[3]));
        s += __shfl_xor(s, 1);
        if (hf == 0) tab[(u.par << 8) + row] = 1.0f / sqrtf(s * (1.0f / 2048.0f) + 1e-6f);
    }
    __device__ __forceinline__ void done(const Unit& u) const {
        asm volatile("s_waitcnt vmcnt(0)" ::: "memory");
        if ((threadIdx.x & 63) == 0) { const int fi = u.kind == 3 ? 544 + u.pn : u.pm * 17 + u.pn; (void)__hip_atomic_fetch_add(flags + fi * 16, 1u, __ATOMIC_RELAXED, __HIP_MEMORY_SCOPE_AGENT); }
    }
};
struct SchedOut {
    int G, c; const char* A; const char* W;
    __device__ __forceinline__ bool next(int i, Unit& u) const {
        const int L = i * G + c; const size_t P = (size_t)BM * 2048 * 2;
        if (L >= 256) return false;
        tile_map(L, 32, 8, u.pm, u.pn); u.kind = 0; u.par = 0; u.a = A + u.pm * P; u.b = W + u.pn * P; return true;
    }
    __device__ __forceinline__ void a_ready(const Unit&) const {}
    __device__ __forceinline__ void done(const Unit&) const {}
};
template <class Epi, class Sched, bool ALIGN_EPI = false, bool SP2 = false>
__device__ __forceinline__ void gemm_phase(PG8_LAS unsigned char* lds, const int K_, const Sched& S, const Epi& E) {
    const int tid = threadIdx.x, wid = __builtin_amdgcn_readfirstlane(tid >> 6), lane = tid & 63, wr = wid >> 2, wc = wid & 3, fr = lane & 15, fq = lane >> 4;
    const int K = K_, nt = K / BK;
    unsigned voffA[2], voffB[2];
#pragma unroll
    for (int i = 0; i < 2; ++i) { int R, C; stage_rc(tid * 16 + i * 8192, R, C); const int Rb = Epi::PERM ? ((R & ~31) + perm32(R & 31)) : R;
        voffA[i] = (unsigned)(R * K + C) * 2u; voffB[i] = (unsigned)(Rb * K + C) * 2u; }
    const size_t kstep = (size_t)(BK * 2);
    const size_t hstep = (size_t)HALF * K * 2;
    const unsigned ldsw = (unsigned)wid * 1024u;
    const int aoff = lds_byte(wr * 64 + fr, fq * 8), boff = lds_byte(wc * 32 + fr, fq * 8);
#define PG8_SA(b, h) (((b) * 2 + (h)) * HTB)
#define PG8_SB(b, h) ((4 + (b) * 2 + (h)) * HTB)
#define PG8_STAGE(bufoff, gbase, voff) do { _Pragma("unroll") for (int _i = 0; _i < 2; ++_i) \
        __builtin_amdgcn_global_load_lds((const unsigned*)((const char*)(gbase) + (voff)[_i]), (PG8_LAS unsigned*)(lds + (bufoff) + ldsw + _i * 8192), 16, 0, 0); } while (0)
#define PG8_LDA(dst, b, h) do { _Pragma("unroll") for (int m = 0; m < 4; ++m) _Pragma("unroll") for (int k = 0; k < 2; ++k) dst[m][k] = *(const PG8_LAS bf16x8*)(lds + PG8_SA(b, h) + aoff + m * 2048 + k * 1024); } while (0)
#define PG8_LDB(dst, b, h) do { _Pragma("unroll") for (int n = 0; n < 2; ++n) _Pragma("unroll") for (int k = 0; k < 2; ++k) dst[n][k] = *(const PG8_LAS bf16x8*)(lds + PG8_SB(b, h) + boff + n * 2048 + k * 1024); } while (0)
#define PG8_MMA(ai, bj, At, Bt) do { __builtin_amdgcn_s_setprio(1); _Pragma("unroll") for (int m = 0; m < 4; ++m) _Pragma("unroll") for (int n = 0; n < 2; ++n) _Pragma("unroll") for (int k = 0; k < 2; ++k) \
        acc[ai][bj][m][n] = __builtin_amdgcn_mfma_f32_16x16x32_bf16(Bt[n][k], At[m][k], acc[ai][bj][m][n], 0, 0, 0); __builtin_amdgcn_s_setprio(0); } while (0)
#define PG8_WAIT_V(n) asm volatile("s_waitcnt vmcnt(" #n ")" ::: "memory")
#define PG8_WAIT_L(n) asm volatile("s_waitcnt lgkmcnt(" #n ")" ::: "memory")
#define PG8_BAR __builtin_amdgcn_s_barrier()
#define PG8_SCHED __builtin_amdgcn_sched_barrier(0)
    Unit cur, nxt; int ui = 0;
    if (!S.next(0, cur)) return;
    f32x4 acc[2][2][4][2];
#pragma unroll
    for (int a = 0; a < 2; ++a)
#pragma unroll
        for (int b = 0; b < 2; ++b)
#pragma unroll
            for (int m = 0; m < 4; ++m)
#pragma unroll
                for (int n = 0; n < 2; ++n) acc[a][b][m][n] = (f32x4){0.f, 0.f, 0.f, 0.f};
    bf16x8 At[4][2], B0[2][2], B1[2][2];
    const char* cA = cur.a; const char* cB = cur.b;
    S.a_ready(cur);
    if constexpr (SP2) {
        PG8_STAGE(PG8_SB(0, 0), cB, voffB); PG8_STAGE(PG8_SB(0, 1), cB + hstep, voffB); PG8_STAGE(PG8_SA(0, 0), cA, voffA); PG8_STAGE(PG8_SA(0, 1), cA + hstep, voffA);
        if (wr == 1) PG8_BAR;
        PG8_WAIT_V(2); PG8_BAR;
        PG8_STAGE(PG8_SB(1, 0), cB + kstep, voffB); PG8_STAGE(PG8_SA(1, 0), cA + kstep, voffA); PG8_STAGE(PG8_SB(1, 1), cB + hstep + kstep, voffB);
        PG8_WAIT_V(6); PG8_BAR;
    } else {
        PG8_STAGE(PG8_SB(0, 0), cB, voffB); PG8_STAGE(PG8_SA(0, 0), cA, voffA); PG8_STAGE(PG8_SB(0, 1), cB + hstep, voffB); PG8_STAGE(PG8_SA(0, 1), cA + hstep, voffA);
        if (wr == 1) PG8_BAR;
        PG8_WAIT_V(4); PG8_BAR;
        PG8_STAGE(PG8_SB(1, 0), cB + kstep, voffB); PG8_STAGE(PG8_SA(1, 0), cA + kstep, voffA); PG8_STAGE(PG8_SB(1, 1), cB + hstep + kstep, voffB);
        PG8_WAIT_V(6); PG8_BAR;
    }
    for (;;) {
        const bool has_next = S.next(ui + 1, nxt);
        const char* nA = has_next ? nxt.a : cA; const char* nB = has_next ? nxt.b : cB;
        for (int t = 0; t < nt; t += 2) {
            const bool last = (t == nt - 2);
            const char* a1 = cA + (size_t)(t + 1) * kstep;
            const char* a2 = last ? nA : cA + (size_t)(t + 2) * kstep; const char* b2 = last ? nB : cB + (size_t)(t + 2) * kstep;
            const char* a3 = a2 + kstep; const char* b3 = b2 + kstep;
            if (last && has_next) S.a_ready(nxt);
            if constexpr (SP2) {
            PG8_LDB(B0, 0, 0); PG8_LDB(B1, 0, 1); PG8_SCHED; PG8_LDA(At, 0, 0); PG8_STAGE(PG8_SA(1, 1), a1 + hstep, voffA);
            PG8_WAIT_V(8); PG8_WAIT_L(0); PG8_BAR; PG8_MMA(0, 0, At, B0); PG8_MMA(0, 1, At, B1); PG8_BAR; PG8_SCHED;
            PG8_LDA(At, 0, 1); PG8_STAGE(PG8_SB(0, 0), b2, voffB); PG8_STAGE(PG8_SB(0, 1), b2 + hstep, voffB); PG8_STAGE(PG8_SA(0, 0), a2, voffA);
            PG8_WAIT_V(8); PG8_WAIT_L(0); PG8_BAR; PG8_MMA(1, 0, At, B0); PG8_MMA(1, 1, At, B1); PG8_BAR; PG8_SCHED;
            PG8_LDB(B0, 1, 0); PG8_LDB(B1, 1, 1); PG8_SCHED; PG8_LDA(At, 1, 0); PG8_STAGE(PG8_SA(0, 1), a2 + hstep, voffA);
            PG8_WAIT_V(8); PG8_WAIT_L(0); PG8_BAR; PG8_MMA(0, 0, At, B0); PG8_MMA(0, 1, At, B1); PG8_BAR; PG8_SCHED;
            PG8_LDA(At, 1, 1); PG8_STAGE(PG8_SB(1, 0), b3, voffB); PG8_STAGE(PG8_SB(1, 1), b3 + hstep, voffB); PG8_STAGE(PG8_SA(1, 0), a3, voffA);
            PG8_WAIT_V(8); PG8_WAIT_L(0); PG8_BAR; PG8_MMA(1, 0, At, B0); PG8_MMA(1, 1, At, B1); PG8_BAR; PG8_SCHED;
            } else {
            PG8_LDB(B0, 0, 0); PG8_SCHED; PG8_LDA(At, 0, 0); PG8_STAGE(PG8_SA(1, 1), a1 + hstep, voffA);
            PG8_WAIT_L(8); PG8_BAR; PG8_WAIT_L(0); PG8_MMA(0, 0, At, B0); PG8_BAR; PG8_SCHED;
            PG8_LDB(B1, 0, 1); PG8_STAGE(PG8_SB(0, 0), b2, voffB);
            PG8_BAR; PG8_WAIT_L(0); PG8_MMA(0, 1, At, B1); PG8_BAR;
            PG8_LDA(At, 0, 1); PG8_STAGE(PG8_SA(0, 0), a2, voffA);
            PG8_BAR; PG8_WAIT_L(0); PG8_MMA(1, 0, At, B0); PG8_BAR; PG8_SCHED;
            PG8_STAGE(PG8_SB(0, 1), b2 + hstep, voffB);
            PG8_WAIT_V(6); PG8_BAR; PG8_MMA(1, 1, At, B1); PG8_BAR;
            PG8_LDB(B0, 1, 0); PG8_SCHED; PG8_LDA(At, 1, 0); PG8_STAGE(PG8_SA(0, 1), a2 + hstep, voffA);
            PG8_WAIT_L(8); PG8_BAR; PG8_WAIT_L(0); PG8_MMA(0, 0, At, B0); PG8_BAR; PG8_SCHED;
            PG8_LDB(B1, 1, 1); PG8_STAGE(PG8_SB(1, 0), b3, voffB);
            PG8_BAR; PG8_WAIT_L(0); PG8_MMA(0, 1, At, B1); PG8_BAR;
            PG8_LDA(At, 1, 1); PG8_STAGE(PG8_SA(1, 0), a3, voffA);
            PG8_BAR; PG8_WAIT_L(0); PG8_MMA(1, 0, At, B0); PG8_BAR; PG8_SCHED;
            PG8_STAGE(PG8_SB(1, 1), b3 + hstep, voffB);
            PG8_WAIT_V(6); PG8_BAR; PG8_MMA(1, 1, At, B1); PG8_BAR;
            }
        }
        if constexpr (ALIGN_EPI) { if (wr == 0) PG8_BAR; }
        if constexpr (!Epi::AFTER_DRAIN) { E(acc, cur, wr, wc, fr, fq); S.done(cur); }
        if (!has_next) break;
#pragma unroll
        for (int a = 0; a < 2; ++a)
#pragma unroll
            for (int b = 0; b < 2; ++b)
#pragma unroll
                for (int m = 0; m < 4; ++m)
#pragma unroll
                    for (int n = 0; n < 2; ++n) acc[a][b][m][n] = (f32x4){0.f, 0.f, 0.f, 0.f};
        cur = nxt; cA = nA; cB = nB; ++ui;
        if constexpr (ALIGN_EPI) { if (wr == 1) PG8_BAR; }
    }
    PG8_WAIT_V(0);
    if constexpr (!ALIGN_EPI) { if (wr == 0) PG8_BAR; }
    PG8_BAR;
    if constexpr (Epi::AFTER_DRAIN) { E.fused(acc, cur, wr, wc, fr, fq, lds, wid, lane); S.done(cur); }
#undef PG8_SA
#undef PG8_SB
#undef PG8_STAGE
#undef PG8_LDA
#undef PG8_LDB
#undef PG8_MMA
#undef PG8_WAIT_V
#undef PG8_WAIT_L
#undef PG8_BAR
#undef PG8_SCHED
}
}
#define GAS __attribute__((address_space(1)))
#define LAS __attribute__((address_space(3)))
typedef unsigned short bf16;
typedef unsigned v4u __attribute__((ext_vector_type(4)));
typedef float f32x4 __attribute__((ext_vector_type(4)));
typedef short bf16x8 __attribute__((ext_vector_type(8)));
typedef GAS unsigned gu32;
typedef GAS unsigned long long gu64;
#define RLX_AGENT __ATOMIC_RELAXED, __HIP_MEMORY_SCOPE_AGENT
#define LDS_WAIT() asm volatile("s_waitcnt lgkmcnt(0)" ::: "memory")
#define VM_WAIT() asm volatile("s_waitcnt vmcnt(0)" ::: "memory")
__device__ __forceinline__ unsigned long long rt() { return __builtin_amdgcn_s_memrealtime(); }
__device__ __forceinline__ unsigned f2bf(float f) { unsigned u = __builtin_bit_cast(unsigned, f); return (u + 0x7fffu + ((u >> 16) & 1u)) >> 16; }
__device__ __forceinline__ unsigned pk2(float lo, float hi) { return f2bf(lo) | (f2bf(hi) << 16); }

#define XB_TMO      128
#define XB_XCNT(j)  (256  + 64 * (j))
#define XB_XSUB(j)  (1280 + 64 * (j))
#define XB_XGEN(j)  (2304 + 64 * (j))
#define XB_TOP      3328
#define XB_TOPGEN   3392
#define XCD_BAR_WORDS 3456
#define XB_SPIN_CAP (1u << 18)

__device__ __forceinline__ unsigned xb_ld(unsigned* p)              { return __hip_atomic_load(p, __ATOMIC_RELAXED, __HIP_MEMORY_SCOPE_AGENT); }
__device__ __forceinline__ unsigned xb_add(unsigned* p, unsigned v) { return __hip_atomic_fetch_add(p, v, __ATOMIC_RELAXED, __HIP_MEMORY_SCOPE_AGENT); }
__device__ __forceinline__ unsigned xb_xcc_id() { return (unsigned)__builtin_amdgcn_s_getreg((3 << 11) | 20) & 0xFu; }
#define XB_SPIN(cond, bar) do { unsigned _sp = 0; while (cond) { __builtin_amdgcn_s_sleep(1); \
    if ((++_sp & 255u) == 0u) { if (xb_ld(&(bar)[XB_TMO])) break; if (_sp > XB_SPIN_CAP) { atomicAdd(&(bar)[XB_TMO], 1u); break; } } } } while (0)

struct XcdBarrier {
    unsigned* bar; unsigned x;
    volatile LAS unsigned* st;
};

__device__ __forceinline__ XcdBarrier xcd_barrier_post(unsigned* bar, volatile LAS unsigned* st) {
    XcdBarrier b; b.bar = bar; b.x = xb_xcc_id(); b.st = st;
    if (threadIdx.x == 0) (void)xb_add(&bar[XB_XCNT(b.x)], 1u);
    return b;
}
__device__ __forceinline__ void xcd_barrier_complete(unsigned* bar, unsigned x, unsigned& nloc, unsigned& nx) {
    const unsigned G = gridDim.x * gridDim.y * gridDim.z;
    unsigned sum, cnt, mine, sp = 0u;
    for (;;) {
        sum = 0u; cnt = 0u; mine = 0u;
#pragma unroll
        for (unsigned j = 0; j < 16; ++j) { const unsigned c = xb_ld(&bar[XB_XCNT(j)]); sum += c; cnt += (c > 0u) ? 1u : 0u; mine = (j == x) ? c : mine; }
        if (sum == G) break;
        __builtin_amdgcn_s_sleep(1);
        if ((++sp & 255u) == 0u) { if (xb_ld(&bar[XB_TMO])) break; if (sp > XB_SPIN_CAP) { atomicAdd(&bar[XB_TMO], 1u); break; } }
    }
    nloc = mine > 0u ? mine : 1u; nx = cnt > 0u ? cnt : 1u;
}

__device__ __forceinline__ void xcd_barrier(const XcdBarrier& b) {
    asm volatile("s_waitcnt vmcnt(0)" ::: "memory");
    __syncthreads();
    if (threadIdx.x == 0) {
        unsigned* bar = b.bar;
        __builtin_amdgcn_s_waitcnt(0);
        unsigned nloc = b.st[0], nx = b.st[1];
        if (nloc == 0u) { xcd_barrier_complete(bar, b.x, nloc, nx); b.st[0] = nloc; b.st[1] = nx; }
        const unsigned old = xb_add(&bar[XB_XSUB(b.x)], 1u);
        const unsigned gen = old / nloc;
        if (old + 1u == (gen + 1u) * nloc) {
            __builtin_amdgcn_fence(__ATOMIC_RELEASE, "agent");
            asm volatile("s_waitcnt vmcnt(0)" ::: "memory");
            const unsigned og = xb_add(&bar[XB_TOP], 1u);
            const unsigned tg = og / nx;
            if (og + 1u == (tg + 1u) * nx) xb_add(&bar[XB_TOPGEN], 1u);
            else XB_SPIN(xb_ld(&bar[XB_TOPGEN]) == tg, bar);
            __builtin_amdgcn_fence(__ATOMIC_ACQUIRE, "agent");
            xb_add(&bar[XB_XGEN(b.x)], 1u);
            asm volatile("s_waitcnt vmcnt(0)" ::: "memory");
        } else {
            XB_SPIN(xb_ld(&bar[XB_XGEN(b.x)]) == gen, bar);
            __builtin_amdgcn_fence(__ATOMIC_ACQUIRE, "agent");
            asm volatile("s_waitcnt vmcnt(0)" ::: "memory");
        }
    }
    __syncthreads();
}
constexpr int NWAVES = 8;
constexpr int MPR = 8192, MSM = 256, MT = MPR + MSM;
constexpr int DM = 2048;
constexpr float RMS_EPS = 1e-6f;
constexpr float LOG2E = 1.4426950408889634f;
constexpr size_t MiB = 1u << 20;
constexpr size_t WS_CTL = 0, CTL_ZERO_BYTES = 64 * 1024;
constexpr size_t WS_WINA = 1 * MiB;
constexpr size_t WS_WOA = 26 * MiB;
constexpr size_t WS_WINB = 34 * MiB;
constexpr size_t WS_WOB = 52 * MiB;
constexpr size_t WS_BUFA = 60 * MiB;
constexpr size_t WS_QK = 93 * MiB;
constexpr size_t WS_VT = 126 * MiB;
constexpr size_t WS_QZ = 93 * MiB;
constexpr size_t WS_SR = 159 * MiB;
constexpr size_t WS_SPART = 130 * MiB;
constexpr size_t WS_REC = 192 * MiB;
constexpr size_t WS_KB = 192 * MiB;
constexpr size_t WS_VT2 = 198 * MiB;
constexpr size_t WS_GLOW = 234 * MiB;
constexpr size_t WS_SSQP = 235 * MiB;
constexpr size_t WS_SSQ1 = 236 * MiB;
constexpr int TAB_OFF = 131072;
constexpr size_t WS_END = 240 * MiB;
constexpr int CW_TILE = 4608;
constexpr int CW_P8 = 14400;
constexpr int CW_SOBP = 15000;
constexpr int CW_SOBR = 14928;
constexpr int CW_SIN = 14336;
constexpr int CW_BAR = 1024;
constexpr int HREC = 33792, REC_PO = 33792, REC_H1 = 41984, REC_BYTES = 75776, REC_DMA = 41984, H_QT = 0, H_KT = 16384, H_G = 32768;
static_assert(512 * (size_t)REC_BYTES <= 42 * MiB && REC_DMA % 1024 == 0, "record");
__device__ __forceinline__ int qt_off(int t, int dl) {
    const int d5 = dl & 31; const int p = d5 < 16 ? ((d5 >> 2) << 3) + (d5 & 3) : (((d5 - 16) >> 2) << 3) + 4 + (d5 & 3);
    const int chunk = ((dl >> 5) << 2) + (p >> 3); return t * 256 + ((chunk ^ (t & 15)) << 4) + ((p & 7) << 1); }
__device__ __forceinline__ int qt_chunk(int t, int c) { return t * 256 + ((c ^ (t & 15)) << 4); }
__device__ __forceinline__ int kt_chunk(int d, int c) { return d * 128 + ((c ^ ((d >> 1) & 7)) << 4); }
constexpr size_t OUT_Y = 0, OUT_GLAP = 17301504, OUT_GLAS = 19398656, OUT_KWP = 36175872, OUT_VWP = 36306944, OUT_KWS = 36438016, OUT_VWS = 37486592, OUT_TOTAL = 38535168;
constexpr int RING_BYTES = 131072, LDS_BYTES = 163840, LDSCTL_OFF = LDS_BYTES - 1024, MISC_OFF = LDSCTL_OFF + 320;

__device__ __forceinline__ float bf2f(unsigned short u) { return __uint_as_float(((unsigned)u) << 16); }
__device__ __forceinline__ unsigned cvtpk2(float lo, float hi) { return pg8::cvtpk(lo, hi); }
__device__ __forceinline__ float wave_sum(float v) {
#pragma unroll
    for (int o = 1; o < 64; o <<= 1) v += __shfl_xor(v, o);
    return v;
}
#define MFMA16(a, b, c) __builtin_amdgcn_mfma_f32_16x16x32_bf16((a), (b), (c), 0, 0, 0)
typedef unsigned u32x2 __attribute__((ext_vector_type(2)));

struct Ptrs {
    const float *x_prompt, *x_sample, *state, *ck, *cv, *g_norm_a, *w_in_a, *w_gate_up, *b_gate, *g_onorm, *w_out_a, *g_norm_kv, *w_kv, *g_norm_b, *w_in_b, *sinks, *w_out_b, *g_final;
    float* out; unsigned char* ws;
};

__device__ __forceinline__ void p0_transpose_item(const float* W, int ldw, int ncol0, int nvalid, const float* gain, int scale_cols, float scale, bf16* WT, int row_off, LAS float* scr, int kb, int nb, int lane) {
    const int k0 = 64 * kb, n0 = 32 * nb, nl = lane & 31; const bool ok = (n0 + nl) < nvalid; const float cs = (n0 + nl) < scale_cols ? scale : 1.0f;
#pragma unroll 8
    for (int i = 0; i < 32; ++i) { const int kk = 2 * i + (lane >> 5); float v = ok ? W[(size_t)(k0 + kk) * ldw + ncol0 + n0 + nl] : 0.f; if (gain) v *= gain[k0 + kk]; scr[kk * 33 + nl] = v * cs; }
    LDS_WAIT(); asm volatile("" ::: "memory");
    const int c = lane & 7;
#pragma unroll
    for (int j = 0; j < 4; ++j) { const int n = (lane >> 3) + 8 * j; const LAS float* s = scr + (8 * c) * 33 + n;
        v4u o; o.x = cvtpk2(s[0 * 33], s[1 * 33]); o.y = cvtpk2(s[2 * 33], s[3 * 33]); o.z = cvtpk2(s[4 * 33], s[5 * 33]); o.w = cvtpk2(s[6 * 33], s[7 * 33]);
        if (n0 + n < nvalid) *(GAS v4u*)(WT + (size_t)(row_off + n0 + n) * 2048 + k0 + 8 * c) = o; }
    LDS_WAIT(); asm volatile("" ::: "memory");
}
__device__ __forceinline__ void rms_row_to_bf16(const float* xrow, bf16* orow, int lane) {
    const GAS f32x4* xr = (const GAS f32x4*)xrow + lane;
    f32x4 v[8]; float s = 0.f;
#pragma unroll
    for (int j = 0; j < 8; ++j) { v[j] = xr[64 * j]; s += (v[j].x * v[j].x + v[j].y * v[j].y) + (v[j].z * v[j].z + v[j].w * v[j].w); }
    const float rstd = 1.0f / sqrtf(wave_sum(s) * (1.f / DM) + RMS_EPS);
    GAS u32x2* o8 = (GAS u32x2*)orow + lane;
#pragma unroll
    for (int j = 0; j < 8; ++j) { u32x2 w; w.x = cvtpk2(v[j].x * rstd, v[j].y * rstd); w.y = cvtpk2(v[j].z * rstd, v[j].w * rstd); o8[64 * j] = w; }
}
__device__ __forceinline__ void p0_transpose_big(const float* W, int ldw, const float* gain, float cs, bf16* WT, int row_off, LAS unsigned char* scr, int kb, int nb, int lane) {
    const int k0 = 64 * kb, n0 = 128 * nb, hl = lane >> 5, nl = lane & 31;
    const GAS f32x4* src = (const GAS f32x4*)(W + (size_t)(k0 + 32 * hl) * ldw + n0 + 4 * nl);
    f32x4 v[32];
#pragma unroll
    for (int i = 0; i < 32; ++i) v[i] = __builtin_nontemporal_load(src + (size_t)i * (ldw / 4));
    f32x4 gk[8];
#pragma unroll
    for (int i = 0; i < 8; ++i) gk[i] = gain ? *(const GAS f32x4*)(gain + k0 + 32 * hl + 4 * i) * cs : (f32x4){cs, cs, cs, cs};
#pragma unroll
    for (int j = 0; j < 4; ++j) { const int n = 4 * nl + j;
#pragma unroll
        for (int q = 0; q < 4; ++q) { v4u o;
            o.x = cvtpk2(v[8 * q + 0][j] * gk[2 * q][0], v[8 * q + 1][j] * gk[2 * q][1]); o.y = cvtpk2(v[8 * q + 2][j] * gk[2 * q][2], v[8 * q + 3][j] * gk[2 * q][3]);
            o.z = cvtpk2(v[8 * q + 4][j] * gk[2 * q + 1][0], v[8 * q + 5][j] * gk[2 * q + 1][1]); o.w = cvtpk2(v[8 * q + 6][j] * gk[2 * q + 1][2], v[8 * q + 7][j] * gk[2 * q + 1][3]);
            *(LAS v4u*)(scr + n * 128 + (((4 * hl + q) ^ (n & 7)) << 4)) = o; } }
    LDS_WAIT(); asm volatile("" ::: "memory");
#pragma unroll
    for (int it = 0; it < 16; ++it) { const int idx = it * 64 + lane, n = idx >> 3, ch = idx & 7;
        const v4u o = *(const LAS v4u*)(scr + n * 128 + ((ch ^ (n & 7)) << 4));
        *(GAS v4u*)(WT + (size_t)(row_off + n0 + n) * 2048 + k0 + 8 * ch) = o; }
    LDS_WAIT(); asm volatile("" ::: "memory");
}
__device__ __forceinline__ void convert_weights(const Ptrs& P, LAS unsigned char* lds, int group, int gwi, int ngw, int iend, int wave, int lane) {
    LAS unsigned char* scr = lds + wave * 16384;
    bf16* WinaT = (bf16*)(P.ws + WS_WINA); bf16* WoaT = (bf16*)(P.ws + WS_WOA); bf16* WinbT = (bf16*)(P.ws + WS_WINB); bf16* WobT = (bf16*)(P.ws + WS_WOB);
    constexpr int I0 = 32 * 48, I1 = 32, I2 = 32 * 16, I3 = 32 * 32, I4 = 32 * 4, I5 = 32 * 16;
    if (group == 0) {
        for (int r = gwi; r < I0; r += ngw) { const int nb = r % 48; p0_transpose_big(P.w_in_a, 6160, P.g_norm_a, nb < 8 ? 0.0625f : 1.f, WinaT, 0, scr, r / 48, nb, lane); }
        for (int it = ngw - 1 - gwi; it < I1; it += ngw) p0_transpose_item(P.w_in_a, 6160, 6144, 16, P.g_norm_a, 0, 1.f, WinaT, 6144, (LAS float*)scr, it, 0, lane);
    } else {
        for (int it = gwi; it < iend; it += ngw) {
            int r = it;
            if (r < I2) { p0_transpose_big(P.w_out_a, 2048, P.g_onorm, 1.f, WoaT, 0, scr, r / 16, r % 16, lane); continue; } r -= I2;
            if (r < I3) { const int nb = r % 32; p0_transpose_big(P.w_in_b, 4096, P.g_norm_b, nb < 16 ? 0.125f * LOG2E : 1.f, WinbT, 0, scr, r / 32, nb, lane); continue; } r -= I3;
            if (r < I4) { p0_transpose_big(P.w_kv, 512, P.g_norm_kv, 1.f, WinbT, 4096, scr, r / 4, r % 4, lane); continue; } r -= I4;
            p0_transpose_big(P.w_out_b, 2048, nullptr, 1.f, WobT, 0, scr, r / 16, r % 16, lane);
        }
    }
}
__device__ __forceinline__ void p0_prologue(const Ptrs& P, LAS unsigned char* lds, int vcu, int G, int tid, int wave, int lane) {
    const int gw = vcu * NWAVES + wave, NGW = G * NWAVES;
    convert_weights(P, lds, 0, gw, NGW, 0, wave, lane);
    if (G < 256) convert_weights(P, lds, 1, gw, NGW, 2176, wave, lane);
    bf16* XN = (bf16*)(P.ws + WS_BUFA);
    for (int m = gw; m < MT; m += NGW) rms_row_to_bf16(m < MPR ? P.x_prompt + (size_t)m * DM : P.x_sample + (size_t)(m - MPR) * DM, XN + (size_t)m * DM, lane);
    const int gt = vcu * (NWAVES * 64) + tid, NGT = G * NWAVES * 64;
    for (int i = gt; i < 32 * 120 * 64; i += NGT) { const int b = i / (120 * 64), rem = i % (120 * 64);
        ((f32x4*)(P.out + OUT_KWS))[(size_t)b * 128 * 64 + rem] = ((const f32x4*)P.ck)[(size_t)b * 128 * 64 + 8 * 64 + rem];
        ((f32x4*)(P.out + OUT_VWS))[(size_t)b * 128 * 64 + rem] = ((const f32x4*)P.cv)[(size_t)b * 128 * 64 + 8 * 64 + rem]; }
}

__device__ __forceinline__ void glow_task(const bf16* XN, const bf16* WgT, float* GLOW, int task, int lane) {
    const int r = lane & 15, g = lane >> 4, row0 = task * 16;
    const bf16* ap = XN + (size_t)(row0 + r) * DM + g * 8; const bf16* bp = WgT + (size_t)r * DM + g * 8;
    f32x4 acc = {0.f, 0.f, 0.f, 0.f};
#pragma unroll 8
    for (int kk = 0; kk < 64; ++kk) { const bf16x8 a = *(const bf16x8*)(ap + kk * 32); const bf16x8 b = *(const bf16x8*)(bp + kk * 32); acc = MFMA16(a, b, acc); }
#pragma unroll
    for (int i = 0; i < 4; ++i) GLOW[(size_t)(row0 + 4 * g + i) * 16 + r] = acc[i];
}

__device__ __forceinline__ void gla_prep_unit(const Ptrs& P, LAS unsigned char* lds, int u, int tid, int wave, int lane) {
    const int c = u & 31, h = (u >> 5) & 3, b = u >> 7;
    const int d = tid & 255, th = tid >> 8, hh = d >> 7, dl = d & 127;
    LAS unsigned char* QI = lds;
    LAS unsigned char* KI = lds + 32768;
    LAS float* GL = (LAS float*)(lds + 65536);
    LAS float* TOT = (LAS float*)(lds + 65536 + 4096);
    const int row0 = b * 2048 + c * 64;
    const float* GLOW = (const float*)(P.ws + WS_GLOW);
    const bf16* QK = (const bf16*)(P.ws + WS_QK);
    unsigned char* rec = P.ws + WS_REC + (size_t)u * REC_BYTES;
    unsigned char* rech = rec + (hh ? REC_H1 : 0);
#pragma unroll
    for (int i = 0; i < 4; ++i) { const int idx = tid + 512 * i, t = idx >> 5, ch = idx & 31;
        const v4u q = *(const GAS v4u*)(QK + (size_t)(row0 + t) * DM + h * 256 + ch * 8), k = *(const GAS v4u*)(QK + (size_t)(row0 + t) * DM + 1024 + h * 256 + ch * 8);
        *(LAS v4u*)(QI + t * 512 + ch * 16) = q; *(LAS v4u*)(KI + t * 512 + ch * 16) = k; }
    if (tid < 256) ((LAS f32x4*)GL)[tid] = ((const f32x4*)(GLOW + (size_t)row0 * 16))[tid];
    float wg[16];
#pragma unroll
    for (int r = 0; r < 16; ++r) wg[r] = P.w_gate_up[r * 1024 + h * 256 + d];
    const float bias = P.b_gate[h * 256 + d];
    __syncthreads();
    float bl[32]; float run = 0.f;
#pragma unroll
    for (int tt = 0; tt < 32; ++tt) { const int t = th * 32 + tt; const LAS f32x4* gr = (const LAS f32x4*)(GL + t * 16);
        const f32x4 g0 = gr[0], g1 = gr[1], g2 = gr[2], g3 = gr[3];
        float z = bias + g0.x * wg[0] + g0.y * wg[1] + g0.z * wg[2] + g0.w * wg[3] + g1.x * wg[4] + g1.y * wg[5] + g1.z * wg[6] + g1.w * wg[7]
                       + g2.x * wg[8] + g2.y * wg[9] + g2.z * wg[10] + g2.w * wg[11] + g3.x * wg[12] + g3.y * wg[13] + g3.z * wg[14] + g3.w * wg[15];
        const float ls = fminf(z, 0.f) - __logf(1.0f + __expf(-fabsf(z)));
        run += ls * 0.0625f; bl[tt] = run; }
    TOT[th * 256 + d] = run;
    unsigned short qr[32], kr[32];
#pragma unroll
    for (int tt = 0; tt < 32; ++tt) { qr[tt] = *(const LAS unsigned short*)(QI + (th * 32 + tt) * 512 + d * 2); kr[tt] = *(const LAS unsigned short*)(KI + (th * 32 + tt) * 512 + d * 2); }
    __syncthreads();
    const float tot0 = TOT[d], tot1 = TOT[256 + d], blast = tot0 + tot1, base = th ? tot0 : 0.f;
    unsigned kt[16];
#pragma unroll
    for (int tt = 0; tt < 32; tt += 2) {
        float kv2[2];
#pragma unroll
        for (int k2 = 0; k2 < 2; ++k2) { const int t = th * 32 + tt + k2; const float bt = base + bl[tt + k2];
            const float e1 = __expf(bt - blast), e2 = __builtin_amdgcn_rcpf(e1);
            const float qv = bf2f(qr[tt + k2]) * e1, kv = bf2f(kr[tt + k2]) * e2; kv2[k2] = kv;
            const int off = hh * 16384 + qt_off(t, dl);
            *(LAS unsigned short*)(QI + off) = (unsigned short)(cvtpk2(qv, 0.f) & 0xffffu); *(LAS unsigned short*)(KI + off) = (unsigned short)(cvtpk2(kv, 0.f) & 0xffffu); }
        kt[tt >> 1] = cvtpk2(kv2[0], kv2[1]); }
#pragma unroll
    for (int i = 0; i < 4; ++i) { v4u o; o.x = kt[4 * i]; o.y = kt[4 * i + 1]; o.z = kt[4 * i + 2]; o.w = kt[4 * i + 3]; *(GAS v4u*)(rech + H_KT + kt_chunk(dl, 4 * th + i)) = o; }
    if (th == 0) ((GAS float*)(rech + H_G))[dl] = __expf(blast);
    __syncthreads();
    { const int r = lane & 15, g = lane >> 4, mt = wave >> 1, st0 = 2 * (wave & 1);
      f32x4 a0 = {0.f, 0.f, 0.f, 0.f}, a1 = {0.f, 0.f, 0.f, 0.f};
      bf16x8 bq[8], k0[8], k1[8];
#pragma unroll
      for (int kk = 0; kk < 8; ++kk) { const int ho = (kk >> 2) * 16384, cc = 4 * (kk & 3) + g;
          bq[kk] = *(const LAS bf16x8*)(QI + ho + qt_chunk(16 * mt + r, cc)); k0[kk] = *(const LAS bf16x8*)(KI + ho + qt_chunk(16 * st0 + r, cc)); k1[kk] = *(const LAS bf16x8*)(KI + ho + qt_chunk(16 * st0 + 16 + r, cc)); }
#pragma unroll
      for (int kk = 0; kk < 8; ++kk) { a0 = MFMA16(k0[kk], bq[kk], a0); a1 = MFMA16(k1[kk], bq[kk], a1); }
      const int t = 16 * mt + r;
#pragma unroll
      for (int j = 0; j < 2; ++j) { const f32x4 a = j ? a1 : a0; const int s0 = 16 * (st0 + j) + 4 * g;
          u32x2 w; w.x = cvtpk2(s0 + 0 <= t ? a[0] : 0.f, s0 + 1 <= t ? a[1] : 0.f); w.y = cvtpk2(s0 + 2 <= t ? a[2] : 0.f, s0 + 3 <= t ? a[3] : 0.f);
          *(GAS u32x2*)(rec + REC_PO + kt_chunk(t, s0 >> 3) + (s0 & 7) * 2) = w; } }
#pragma unroll
    for (int i = 0; i < 4; ++i) { const int idx = tid + 512 * i; ((GAS v4u*)(rec + ((idx >> 10) ? REC_H1 : 0) + H_QT))[idx & 1023] = ((const LAS v4u*)QI)[idx]; }
    __syncthreads();
}

constexpr int SC_BUF = REC_DMA, SC_PIECES = REC_DMA / 1024, SC_OT = 3 * REC_DMA;
static_assert(SC_OT + 2 * 16384 <= LDSCTL_OFF, "scan LDS map");
__device__ __forceinline__ void gla_scan_unit(const Ptrs& P, LAS unsigned char* lds, int bh, int dh, int eq, int tid, int wave, int lane, int nch = 32) {
    const int b = bh >> 2, h = bh & 3, r = lane & 15, g = lane >> 4, rr = (r >> 1) & 7;
    const int ecol = h * 512 + eq * 128 + 16 * wave;
    const bf16* VT = (const bf16*)(P.ws + WS_VT);
    bf16* OB = (bf16*)(P.ws + (dh ? WS_QK : WS_BUFA)) + (size_t)(b * 2048) * DM + h * 512 + eq * 128;
    const unsigned char* rec0 = P.ws + WS_REC + (size_t)(bh * 32) * REC_BYTES + (dh ? REC_PO : 0);
    const unsigned HO = dh ? 8192u : 0u, PO = dh ? 0u : 33792u;
    f32x4 S[8];
#pragma unroll
    for (int i = 0; i < 8; ++i) S[i] = (f32x4){0.f, 0.f, 0.f, 0.f};
    const bf16* vtp = VT + (size_t)(ecol + r) * MT + b * 2048 + 8 * g;
#define SC_DMA(cc, bufo_) do { const unsigned char* src_ = rec0 + (size_t)(cc) * REC_BYTES + lane * 16; \
        _Pragma("unroll") for (int j_ = 0; j_ < 6; ++j_) { const int i_ = wave + NWAVES * j_; \
            if (i_ < SC_PIECES) __builtin_amdgcn_global_load_lds((const GAS unsigned*)(src_ + i_ * 1024), (LAS unsigned*)(lds + (bufo_) + i_ * 1024), 16, 0, 0); } } while (0)
#define SC_OSTORE(cc) do { const LAS unsigned char* ot_ = lds + SC_OT + ((cc) & 1) * 16384; \
        _Pragma("unroll") for (int j_ = 0; j_ < 2; ++j_) { const int idx_ = tid + 512 * j_, row_ = idx_ >> 4, q_ = idx_ & 15; \
            const v4u v_ = *(const LAS v4u*)(ot_ + row_ * 256 + ((q_ ^ (row_ & 15)) << 4)); \
            *(GAS v4u*)(OB + (size_t)((cc) * 64 + row_) * DM + q_ * 8) = v_; } } while (0)
    bf16x8 vc0 = *(const bf16x8*)vtp, vc1 = *(const bf16x8*)(vtp + 32), vn0 = vc0, vn1 = vc1;
    SC_DMA(0, 0u); SC_DMA(1, (unsigned)SC_BUF);
    __syncthreads();
    unsigned bo0 = 0u, bo1 = SC_BUF, bo2 = 2u * SC_BUF;
#pragma unroll 1
    for (int c = 0; c < nch; ++c) {
        bf16x8 vf[2]; vf[0] = vc0; vf[1] = vc1;
        { const bf16* vp_ = vtp + (c + 1 < 32 ? c + 1 : 31) * 64;
          asm volatile("global_load_dwordx4 %0, %2, off\n\tglobal_load_dwordx4 %1, %2, off offset:64" : "=&v"(vn0), "=&v"(vn1) : "v"(vp_) : "memory"); }
        if (c > 0) SC_OSTORE(c - 1);
        const unsigned bufo = bo0;
        const unsigned qbase = bufo + HO + H_QT + (unsigned)(r * 256 + ((r >> 2) << 6) + ((g ^ (r & 3)) << 4));
        const unsigned kbase = bufo + HO + H_KT + (unsigned)(r * 128 + ((rr >> 2) << 6) + ((g ^ (rr & 3)) << 4));
        const unsigned pbase = bufo + PO + (unsigned)(r * 128 + ((dh ^ (rr >> 2)) << 6) + ((g ^ (rr & 3)) << 4));
        const unsigned gbase = bufo + HO + H_G + (unsigned)(g * 16);
#define SC_FENCE() __builtin_amdgcn_sched_barrier(0)
#define SC_BQ(k2, tt) (*(const LAS bf16x8*)(lds + ((qbase ^ ((k2) << 6)) + (tt) * 4096)))
#define SC_KF(i, ks) (*(const LAS bf16x8*)(lds + ((kbase ^ ((ks) << 6)) + (i) * 2048)))
#define SC_AF(k2) __builtin_bit_cast(bf16x8, (v4u){cvtpk2(S[2 * (k2)][0], S[2 * (k2)][1]), cvtpk2(S[2 * (k2)][2], S[2 * (k2)][3]), cvtpk2(S[2 * (k2) + 1][0], S[2 * (k2) + 1][1]), cvtpk2(S[2 * (k2) + 1][2], S[2 * (k2) + 1][3])})
        f32x4 gm[4]; bf16x8 qa[8], qb[8];
#pragma unroll
        for (int i = 0; i < 4; ++i) gm[i] = *(const LAS f32x4*)(lds + (gbase + i * 64));
#pragma unroll
        for (int tt = 0; tt < 4; ++tt) { qa[tt] = SC_BQ(0, tt); qa[4 + tt] = SC_BQ(1, tt); }
        SC_FENCE();
#pragma unroll
        for (int i = 0; i < 4; ++i) S[i] = S[i] * gm[i];
#pragma unroll
        for (int i = 0; i < 4; ++i) gm[i] = *(const LAS f32x4*)(lds + (gbase + (4 + i) * 64));
#pragma unroll
        for (int tt = 0; tt < 4; ++tt) { qb[tt] = SC_BQ(2, tt); qb[4 + tt] = SC_BQ(3, tt); }
        bf16x8 pq[4];
#pragma unroll
        for (int tt = 0; tt < 4; ++tt) pq[tt] = *(const LAS bf16x8*)(lds + (pbase + tt * 2048));
        SC_FENCE();
        f32x4 Z[4];
#pragma unroll
        for (int tt = 0; tt < 4; ++tt) Z[tt] = (f32x4){0.f, 0.f, 0.f, 0.f};
        { const bf16x8 a0 = SC_AF(0), a1 = SC_AF(1);
#pragma unroll
          for (int tt = 0; tt < 4; ++tt) Z[tt] = MFMA16(a0, qa[tt], Z[tt]);
#pragma unroll
          for (int tt = 0; tt < 4; ++tt) Z[tt] = MFMA16(a1, qa[4 + tt], Z[tt]); }
#pragma unroll
        for (int i = 0; i < 4; ++i) S[4 + i] = S[4 + i] * gm[i];
#pragma unroll
        for (int i = 0; i < 4; ++i) { qa[2 * i] = SC_KF(i, 0); qa[2 * i + 1] = SC_KF(i, 1); }
        SC_FENCE();

        { const bf16x8 a2 = SC_AF(2), a3 = SC_AF(3);
#pragma unroll
          for (int tt = 0; tt < 4; ++tt) Z[tt] = MFMA16(a2, qb[tt], Z[tt]);
#pragma unroll
          for (int tt = 0; tt < 4; ++tt) Z[tt] = MFMA16(a3, qb[4 + tt], Z[tt]);
#pragma unroll
          for (int tt = 0; tt < 4; ++tt) Z[tt] = MFMA16(dh ? vf[1] : vf[0], pq[tt], Z[tt]); }
#pragma unroll
        for (int i = 0; i < 4; ++i) { qb[2 * i] = SC_KF(4 + i, 0); qb[2 * i + 1] = SC_KF(4 + i, 1); }
        SC_FENCE();
        asm volatile("s_waitcnt vmcnt(0)" : "+v"(vn0), "+v"(vn1) :: "memory");
        SC_DMA((c + 2 < 32 ? c + 2 : 31), bo2);
        SC_FENCE();
#pragma unroll
        for (int i = 0; i < 4; ++i) { S[i] = MFMA16(qa[2 * i], vf[0], S[i]); S[i] = MFMA16(qa[2 * i + 1], vf[1], S[i]); }
#pragma unroll
        for (int i = 0; i < 4; ++i) { S[4 + i] = MFMA16(qb[2 * i], vf[0], S[4 + i]); S[4 + i] = MFMA16(qb[2 * i + 1], vf[1], S[4 + i]); }
#undef SC_FENCE
#undef SC_BQ
#undef SC_KF
#undef SC_AF
        { LAS unsigned char* ot = lds + SC_OT + (c & 1) * 16384 + (g & 1) * 8;
#pragma unroll
          for (int tt = 0; tt < 4; ++tt) { u32x2 w; w.x = cvtpk2(Z[tt][0], Z[tt][1]); w.y = cvtpk2(Z[tt][2], Z[tt][3]);
              *(LAS u32x2*)(ot + (16 * tt + r) * 256 + (((2 * wave + (g >> 1)) ^ r) << 4)) = w; } }
        asm volatile("s_waitcnt lgkmcnt(0)" ::: "memory"); __builtin_amdgcn_s_barrier(); asm volatile("" ::: "memory");
        vc0 = vn0; vc1 = vn1;
        { const unsigned t_ = bo0; bo0 = bo1; bo1 = bo2; bo2 = t_; }
    }
    SC_OSTORE(nch - 1);
#undef SC_OSTORE
#undef SC_DMA
    asm volatile("s_waitcnt vmcnt(0)" ::: "memory"); __syncthreads();
    float* SO = P.out + OUT_GLAP + ((size_t)bh * 256 + 128 * dh + 4 * g) * 512 + eq * 128 + 16 * wave + r;
#pragma unroll
    for (int i = 0; i < 8; ++i) { float* so = SO + (size_t)i * 16 * 512; asm volatile("" : "+v"(so));
        so[0] = S[i][0]; so[512] = S[i][1]; so[1024] = S[i][2]; so[1536] = S[i][3]; }
}

__device__ __forceinline__ void gla_sample_unit(const Ptrs& P, LAS unsigned char* lds, int u, int tid, int wave, int lane) {
    const int h = u & 3, b = u >> 2;
    LAS float* GL = (LAS float*)lds;
    LAS float* QD = (LAS float*)(lds + 1024);
    LAS float* KD = (LAS float*)(lds + 1024 + 8192);
    LAS float* GD = (LAS float*)(lds + 1024 + 16384);
    LAS float* PR = (LAS float*)(lds + 18432);
    LAS float* RED = (LAS float*)(lds + 18688);
    LAS float* VL = (LAS float*)(lds + 20480);
    LAS float* OP = (LAS float*)(lds + 36864);
    const int row0 = MPR + b * 8;
    const bf16* QK = (const bf16*)(P.ws + WS_QK); const bf16* VT = (const bf16*)(P.ws + WS_VT); const float* GLOW = (const float*)(P.ws + WS_GLOW);
    const int eq = tid & 127, dq = tid >> 7;
    const size_t sbase = ((size_t)(b * 4 + h) * 256 + 64 * dq) * 512 + 4 * eq;
    const float* S0p = P.state + sbase; float* S1p = P.out + OUT_GLAS + sbase;
    if (tid < 32) ((LAS f32x4*)GL)[tid] = ((const f32x4*)(GLOW + (size_t)row0 * 16))[tid];
    { const v4u vv = *(const GAS v4u*)(VT + (size_t)(h * 512 + tid) * MT + row0);
      VL[0 * 512 + tid] = __uint_as_float(vv.x << 16); VL[1 * 512 + tid] = __uint_as_float(vv.x & 0xffff0000u); VL[2 * 512 + tid] = __uint_as_float(vv.y << 16); VL[3 * 512 + tid] = __uint_as_float(vv.y & 0xffff0000u);
      VL[4 * 512 + tid] = __uint_as_float(vv.z << 16); VL[5 * 512 + tid] = __uint_as_float(vv.z & 0xffff0000u); VL[6 * 512 + tid] = __uint_as_float(vv.w << 16); VL[7 * 512 + tid] = __uint_as_float(vv.w & 0xffff0000u); }
    __syncthreads();
    if (tid < 256) {
        const int d = tid;
        float wg[16];
#pragma unroll
        for (int r = 0; r < 16; ++r) wg[r] = P.w_gate_up[r * 1024 + h * 256 + d];
        const float bias = P.b_gate[h * 256 + d];
        float bc[8], q[8], k[8]; float run = 0.f;
#pragma unroll
        for (int t = 0; t < 8; ++t) { q[t] = bf2f(QK[(size_t)(row0 + t) * DM + h * 256 + d]); k[t] = bf2f(QK[(size_t)(row0 + t) * DM + 1024 + h * 256 + d]); }
#pragma unroll
        for (int t = 0; t < 8; ++t) { const LAS f32x4* gr = (const LAS f32x4*)(GL + t * 16); const f32x4 g0 = gr[0], g1 = gr[1], g2 = gr[2], g3 = gr[3];
            float z = bias + g0.x * wg[0] + g0.y * wg[1] + g0.z * wg[2] + g0.w * wg[3] + g1.x * wg[4] + g1.y * wg[5] + g1.z * wg[6] + g1.w * wg[7]
                           + g2.x * wg[8] + g2.y * wg[9] + g2.z * wg[10] + g2.w * wg[11] + g3.x * wg[12] + g3.y * wg[13] + g3.z * wg[14] + g3.w * wg[15];
            const float ls = fminf(z, 0.f) - __logf(1.0f + __expf(-fabsf(z)));
            run += ls * 0.0625f; bc[t] = run; }
        const float blast = bc[7];
#pragma unroll
        for (int t = 0; t < 8; ++t) { QD[d * 8 + t] = q[t] * __expf(bc[t]); KD[d * 8 + t] = k[t] * __expf(blast - bc[t]); }
        GD[d] = __expf(blast);
        int idx = 0;
#pragma unroll
        for (int t = 0; t < 8; ++t)
#pragma unroll
            for (int s = 0; s <= t; ++s) { float v = q[t] * k[s] * __expf(bc[t] - bc[s]); v = wave_sum(v); if (lane == 0) RED[wave * 36 + idx] = v; ++idx; }
    }
    __syncthreads();
    if (tid < 64) { const int t = tid >> 3, s = tid & 7; float v = 0.f; if (s <= t) { const int idx = t * (t + 1) / 2 + s; v = RED[idx] + RED[36 + idx] + RED[72 + idx] + RED[108 + idx]; } PR[t * 8 + s] = v; }
    { f32x4 sa[4], sb[4];
#pragma unroll
      for (int i = 0; i < 4; ++i) sa[i] = __builtin_nontemporal_load((const GAS f32x4*)(S0p + (size_t)i * 512));
      f32x4 v[8], o[8];
#pragma unroll
      for (int s = 0; s < 8; ++s) v[s] = *(const LAS f32x4*)(VL + s * 512 + 4 * eq);
#pragma unroll
      for (int t = 0; t < 8; ++t) o[t] = (f32x4){0.f, 0.f, 0.f, 0.f};
#define GS_STEP(cur, nxt, d0, more) do { if (more) { _Pragma("unroll") for (int i = 0; i < 4; ++i) nxt[i] = __builtin_nontemporal_load((const GAS f32x4*)(S0p + (size_t)((d0) + 4 + i) * 512)); } \
        _Pragma("unroll") for (int i = 0; i < 4; ++i) { const int dd = 64 * dq + (d0) + i; \
          const f32x4 qa = *(const LAS f32x4*)(QD + dd * 8), qb = *(const LAS f32x4*)(QD + dd * 8 + 4), ka = *(const LAS f32x4*)(KD + dd * 8), kb = *(const LAS f32x4*)(KD + dd * 8 + 4); \
          const float gm = GD[dd]; const f32x4 x = cur[i]; \
          o[0] += x * qa.x; o[1] += x * qa.y; o[2] += x * qa.z; o[3] += x * qa.w; o[4] += x * qb.x; o[5] += x * qb.y; o[6] += x * qb.z; o[7] += x * qb.w; \
          f32x4 sn = x * gm; sn += v[0] * ka.x; sn += v[1] * ka.y; sn += v[2] * ka.z; sn += v[3] * ka.w; sn += v[4] * kb.x; sn += v[5] * kb.y; sn += v[6] * kb.z; sn += v[7] * kb.w; \
          __builtin_nontemporal_store(sn, (GAS f32x4*)(S1p + (size_t)((d0) + i) * 512)); } } while (0)
#pragma unroll 1
      for (int d0 = 0; d0 < 64; d0 += 8) { GS_STEP(sa, sb, d0, true); GS_STEP(sb, sa, d0 + 4, d0 + 8 < 64); }
#undef GS_STEP
#pragma unroll
      for (int t = 0; t < 8; ++t) *(LAS f32x4*)(OP + (dq * 8 + t) * 512 + 4 * eq) = o[t];
    }
    __syncthreads();
    { const int t = tid >> 6, el = tid & 63; bf16* A2 = (bf16*)(P.ws + WS_BUFA); const bf16* SR = (const bf16*)(P.ws + WS_SR);
      float ov[8]; float ss = 0.f;
#pragma unroll
      for (int j = 0; j < 8; ++j) { const int e = el + 64 * j; float acc = (OP[(0 * 8 + t) * 512 + e] + OP[(1 * 8 + t) * 512 + e]) + (OP[(2 * 8 + t) * 512 + e] + OP[(3 * 8 + t) * 512 + e]);
#pragma unroll
          for (int s = 0; s < 8; ++s) acc += PR[t * 8 + s] * VL[s * 512 + e];
          ov[j] = acc; ss += acc * acc; }
      const float rs = 1.0f / sqrtf(wave_sum(ss) * (1.f / 512.f) + RMS_EPS);
#pragma unroll
      for (int j = 0; j < 8; ++j) { const size_t off = (size_t)(row0 + t) * DM + h * 512 + el + 64 * j; A2[off] = (bf16)(cvtpk2(ov[j] * rs * bf2f(SR[off]), 0.f) & 0xffffu); } }
    __syncthreads();
}

__device__ __forceinline__ void gate_rows(const Ptrs& P, int lane, int m0, int step, int mend) {
    bf16* O0 = (bf16*)(P.ws + WS_BUFA); const bf16* O1 = (const bf16*)(P.ws + WS_QK); const bf16* SR = (const bf16*)(P.ws + WS_SR);
    v4u a0[4], b0[4], s0[4], a1[4], b1[4], s1[4], a2[4], b2[4], s2[4];
#define GR_LD(a, bq, s, m) do { _Pragma("unroll") for (int j = 0; j < 4; ++j) { const size_t off_ = (size_t)(m) * DM + 512 * j + 8 * lane; a[j] = __builtin_nontemporal_load((const GAS v4u*)(O0 + off_)); bq[j] = __builtin_nontemporal_load((const GAS v4u*)(O1 + off_)); s[j] = __builtin_nontemporal_load((const GAS v4u*)(SR + off_)); } } while (0)
#define GR_DO(a, bq, s, m) do { _Pragma("unroll") for (int j = 0; j < 4; ++j) { const size_t off_ = (size_t)(m) * DM + 512 * j + 8 * lane; float o[8]; \
        o[0] = __uint_as_float(a[j].x << 16) + __uint_as_float(bq[j].x << 16); o[1] = __uint_as_float(a[j].x & 0xffff0000u) + __uint_as_float(bq[j].x & 0xffff0000u); \
        o[2] = __uint_as_float(a[j].y << 16) + __uint_as_float(bq[j].y << 16); o[3] = __uint_as_float(a[j].y & 0xffff0000u) + __uint_as_float(bq[j].y & 0xffff0000u); \
        o[4] = __uint_as_float(a[j].z << 16) + __uint_as_float(bq[j].z << 16); o[5] = __uint_as_float(a[j].z & 0xffff0000u) + __uint_as_float(bq[j].z & 0xffff0000u); \
        o[6] = __uint_as_float(a[j].w << 16) + __uint_as_float(bq[j].w << 16); o[7] = __uint_as_float(a[j].w & 0xffff0000u) + __uint_as_float(bq[j].w & 0xffff0000u); \
        const float ss_ = ((o[0] * o[0] + o[1] * o[1]) + (o[2] * o[2] + o[3] * o[3])) + ((o[4] * o[4] + o[5] * o[5]) + (o[6] * o[6] + o[7] * o[7])); \
        const float rs_ = 1.0f / sqrtf(wave_sum(ss_) * (1.f / 512.f) + RMS_EPS); v4u w; \
        w.x = cvtpk2(o[0] * rs_ * __uint_as_float(s[j].x << 16), o[1] * rs_ * __uint_as_float(s[j].x & 0xffff0000u)); w.y = cvtpk2(o[2] * rs_ * __uint_as_float(s[j].y << 16), o[3] * rs_ * __uint_as_float(s[j].y & 0xffff0000u)); \
        w.z = cvtpk2(o[4] * rs_ * __uint_as_float(s[j].z << 16), o[5] * rs_ * __uint_as_float(s[j].z & 0xffff0000u)); w.w = cvtpk2(o[6] * rs_ * __uint_as_float(s[j].w << 16), o[7] * rs_ * __uint_as_float(s[j].w & 0xffff0000u)); \
        *(GAS v4u*)(O0 + off_) = w; } } while (0)
    if (m0 < mend) GR_LD(a0, b0, s0, m0);
    if (m0 + step < mend) GR_LD(a1, b1, s1, m0 + step);
#pragma unroll 1
    for (int m = m0; m < mend; m += 3 * step) {
        if (m + 2 * step < mend) GR_LD(a2, b2, s2, m + 2 * step);
        GR_DO(a0, b0, s0, m);
        if (m + step < mend) { if (m + 3 * step < mend) GR_LD(a0, b0, s0, m + 3 * step); GR_DO(a1, b1, s1, m + step); }
        if (m + 2 * step < mend) { if (m + 4 * step < mend) GR_LD(a1, b1, s1, m + 4 * step); GR_DO(a2, b2, s2, m + 2 * step); }
    }
#undef GR_LD
#undef GR_DO
}
__device__ __forceinline__ void final_rows(float* base, const float* gfin, int lane, int m0, int step, int mend) {
    const GAS f32x4* gr = (const GAS f32x4*)gfin + lane;
    f32x4 va[8], vb[8];
    if (m0 < mend) { const GAS f32x4* xr = (const GAS f32x4*)(base + (size_t)m0 * DM) + lane;
#pragma unroll
        for (int j = 0; j < 8; ++j) va[j] = xr[64 * j]; }
#define FR_STEP(cur, nxt, m) do { const int mn_ = (m) + step; if (mn_ < mend) { const GAS f32x4* xn_ = (const GAS f32x4*)(base + (size_t)mn_ * DM) + lane; _Pragma("unroll") for (int j = 0; j < 8; ++j) nxt[j] = xn_[64 * j]; } \
        float s_ = 0.f; _Pragma("unroll") for (int j = 0; j < 8; ++j) s_ += (cur[j].x * cur[j].x + cur[j].y * cur[j].y) + (cur[j].z * cur[j].z + cur[j].w * cur[j].w); \
        const float rstd_ = 1.0f / sqrtf(wave_sum(s_) * (1.f / DM) + RMS_EPS); GAS f32x4* dr_ = (GAS f32x4*)(base + (size_t)(m) * DM) + lane; \
        _Pragma("unroll") for (int j = 0; j < 8; ++j) dr_[64 * j] = cur[j] * rstd_ * gr[64 * j]; } while (0)
#pragma unroll 1
    for (int m = m0; m < mend; m += 2 * step) { FR_STEP(va, vb, m); if (m + step < mend) FR_STEP(vb, va, m + step); }
#undef FR_STEP
}
__device__ __forceinline__ void final_rows_b16(const bf16* H2b, float* ybase, const float* gfin, int lane, int m0, int step, int mend) {
    const GAS f32x4* gr = (const GAS f32x4*)gfin + 2 * lane;
    v4u va[4], vb[4], vc[4];
    if (m0 < mend) { const GAS v4u* xr = (const GAS v4u*)(H2b + (size_t)m0 * DM) + lane;
#pragma unroll
        for (int j = 0; j < 4; ++j) va[j] = xr[64 * j]; }
    if (m0 + step < mend) { const GAS v4u* xr = (const GAS v4u*)(H2b + (size_t)(m0 + step) * DM) + lane;
#pragma unroll
        for (int j = 0; j < 4; ++j) vb[j] = xr[64 * j]; }
#define FB_STEP(cur, nxt, m) do { const int mn_ = (m) + 2 * step; if (mn_ < mend) { const GAS v4u* xn_ = (const GAS v4u*)(H2b + (size_t)mn_ * DM) + lane; _Pragma("unroll") for (int j = 0; j < 4; ++j) nxt[j] = xn_[64 * j]; } \
        float f_[4][8]; float s_ = 0.f; _Pragma("unroll") for (int j = 0; j < 4; ++j) { \
            f_[j][0] = __uint_as_float(cur[j].x << 16); f_[j][1] = __uint_as_float(cur[j].x & 0xffff0000u); f_[j][2] = __uint_as_float(cur[j].y << 16); f_[j][3] = __uint_as_float(cur[j].y & 0xffff0000u); \
            f_[j][4] = __uint_as_float(cur[j].z << 16); f_[j][5] = __uint_as_float(cur[j].z & 0xffff0000u); f_[j][6] = __uint_as_float(cur[j].w << 16); f_[j][7] = __uint_as_float(cur[j].w & 0xffff0000u); \
            _Pragma("unroll") for (int e_ = 0; e_ < 8; ++e_) s_ += f_[j][e_] * f_[j][e_]; } \
        const float rstd_ = 1.0f / sqrtf(wave_sum(s_) * (1.f / DM) + RMS_EPS); GAS f32x4* dr_ = (GAS f32x4*)(ybase + (size_t)(m) * DM) + 2 * lane; \
        _Pragma("unroll") for (int j = 0; j < 4; ++j) { const f32x4 g0_ = gr[128 * j], g1_ = gr[128 * j + 1]; \
            dr_[128 * j] = (f32x4){f_[j][0] * rstd_ * g0_[0], f_[j][1] * rstd_ * g0_[1], f_[j][2] * rstd_ * g0_[2], f_[j][3] * rstd_ * g0_[3]}; \
            dr_[128 * j + 1] = (f32x4){f_[j][4] * rstd_ * g1_[0], f_[j][5] * rstd_ * g1_[1], f_[j][6] * rstd_ * g1_[2], f_[j][7] * rstd_ * g1_[3]}; } } while (0)
#pragma unroll 1
    for (int m = m0; m < mend; m += 3 * step) { FB_STEP(va, vc, m); if (m + step < mend) FB_STEP(vb, va, m + step); if (m + 2 * step < mend) FB_STEP(vc, vb, m + 2 * step); }
#undef FB_STEP
}
__device__ __forceinline__ void final_row(float* hrow, const float* gfin, int lane, float* drow) {
    GAS f32x4* xr = (GAS f32x4*)hrow + lane; GAS f32x4* dr = (GAS f32x4*)drow + lane; const GAS f32x4* gr = (const GAS f32x4*)gfin + lane;
    f32x4 v[8]; float s = 0.f;
#pragma unroll
    for (int j = 0; j < 8; ++j) { v[j] = xr[64 * j]; s += (v[j].x * v[j].x + v[j].y * v[j].y) + (v[j].z * v[j].z + v[j].w * v[j].w); }
    const float rstd = 1.0f / sqrtf(wave_sum(s) * (1.f / DM) + RMS_EPS);
#pragma unroll
    for (int j = 0; j < 8; ++j) dr[64 * j] = v[j] * rstd * gr[64 * j];
}

__device__ __forceinline__ void attn_subblock(const LAS bf16* KI, const LAS bf16* VI, int ts, const bf16x8 q0, const bf16x8 q1, int qpos, int kpos0, float slope2, float sink2,
                                              const u32x2 (&zz)[4], bf16* orow, bool store, int lane, f32x4 (&bias)[10], int& bkey) {
    const int r = lane & 15, g = lane >> 4;
    f32x4 sc[10]; float mx = -INFINITY;
    const int D = qpos - (kpos0 + 16 * ts + 4 * g); const unsigned U = (unsigned)(qpos < 128 ? qpos : 128);
    const float c0 = -slope2 * (float)D; const f32x4 cinit = {c0, c0, c0, c0};
    { bf16x8 ka[8], kb[6], kc[6];
      const LAS bf16* kr0 = KI + (16 * ts + r) * 80 + 8 * g;
#pragma unroll
      for (int i = 0; i < 4; ++i) { ka[2 * i] = *(const LAS bf16x8*)(kr0 + i * 1280); ka[2 * i + 1] = *(const LAS bf16x8*)(kr0 + i * 1280 + 32); }
      __builtin_amdgcn_sched_barrier(0);
#pragma unroll
      for (int i = 0; i < 3; ++i) { kb[2 * i] = *(const LAS bf16x8*)(kr0 + (4 + i) * 1280); kb[2 * i + 1] = *(const LAS bf16x8*)(kr0 + (4 + i) * 1280 + 32); }
#pragma unroll
      for (int i = 0; i < 4; ++i) { f32x4 a = MFMA16(ka[2 * i], q0, cinit); sc[i] = MFMA16(ka[2 * i + 1], q1, a); }
      __builtin_amdgcn_sched_barrier(0);
#pragma unroll
      for (int i = 0; i < 3; ++i) { kc[2 * i] = *(const LAS bf16x8*)(kr0 + (7 + i) * 1280); kc[2 * i + 1] = *(const LAS bf16x8*)(kr0 + (7 + i) * 1280 + 32); }
#pragma unroll
      for (int i = 0; i < 3; ++i) { f32x4 a = MFMA16(kb[2 * i], q0, cinit); sc[4 + i] = MFMA16(kb[2 * i + 1], q1, a); }
      __builtin_amdgcn_sched_barrier(0);
#pragma unroll
      for (int i = 0; i < 3; ++i) { f32x4 a = MFMA16(kc[2 * i], q0, cinit); sc[7 + i] = MFMA16(kc[2 * i + 1], q1, a); } }
    { const int key = __builtin_amdgcn_readfirstlane(D * 256 + (int)U);
      if (key != bkey) { bkey = key;
#pragma unroll
          for (int i = 0; i < 10; ++i)
#pragma unroll
              for (int e = 0; e < 4; ++e) { const unsigned dist = (unsigned)(D - (16 * i + e)); bias[i][e] = dist <= U ? slope2 * (float)(16 * i + e) : -INFINITY; } } }
#pragma unroll
    for (int i = 0; i < 10; ++i) { sc[i] = sc[i] + bias[i];
        mx = fmaxf(mx, fmaxf(fmaxf(sc[i][0], sc[i][1]), fmaxf(sc[i][2], sc[i][3]))); }
    mx = fmaxf(mx, __shfl_xor(mx, 16)); mx = fmaxf(mx, __shfl_xor(mx, 32)); mx = fmaxf(mx, sink2);
    float l = 0.f;
    f32x4 o[4];
#pragma unroll
    for (int dt = 0; dt < 4; ++dt) o[dt] = (f32x4){0.f, 0.f, 0.f, 0.f};
    { const LAS bf16* vr0 = VI + r * 264 + 16 * ts + 4 * g;
#define AT_VRD(dst, ks) do { _Pragma("unroll") for (int dt = 0; dt < 4; ++dt) { const LAS bf16* vr = vr0 + dt * 4224 + (ks) * 32; \
          const u32x2 lo = *(const LAS u32x2*)vr, hi = *(const LAS u32x2*)(vr + 16); dst[dt].x = lo.x; dst[dt].y = lo.y; dst[dt].z = hi.x; dst[dt].w = hi.y; } } while (0)
#define AT_EXP(ks) do { _Pragma("unroll") for (int i_ = 2 * (ks); i_ < 2 * (ks) + 2; ++i_) _Pragma("unroll") for (int e = 0; e < 4; ++e) { const float p = __builtin_amdgcn_exp2f(sc[i_][e] - mx); sc[i_][e] = p; l += p; } } while (0)
#define AT_PV(src, ks) do { v4u pp; pp.x = cvtpk2(sc[2 * (ks)][0], sc[2 * (ks)][1]); pp.y = cvtpk2(sc[2 * (ks)][2], sc[2 * (ks)][3]); pp.z = cvtpk2(sc[2 * (ks) + 1][0], sc[2 * (ks) + 1][1]); pp.w = cvtpk2(sc[2 * (ks) + 1][2], sc[2 * (ks) + 1][3]); \
          const bf16x8 pb = __builtin_bit_cast(bf16x8, pp); _Pragma("unroll") for (int dt = 0; dt < 4; ++dt) o[dt] = MFMA16(__builtin_bit_cast(bf16x8, src[dt]), pb, o[dt]); } while (0)
      v4u va[4], vb[4];
      AT_VRD(va, 0); AT_VRD(vb, 1);
      AT_EXP(0);
      __builtin_amdgcn_sched_barrier(0);
      AT_PV(va, 0); AT_VRD(va, 2); AT_EXP(1);
      __builtin_amdgcn_sched_barrier(0);
      AT_PV(vb, 1); AT_VRD(vb, 3); AT_EXP(2);
      __builtin_amdgcn_sched_barrier(0);
      AT_PV(va, 2); AT_VRD(va, 4); AT_EXP(3);
      __builtin_amdgcn_sched_barrier(0);
      AT_PV(vb, 3); AT_EXP(4);
      __builtin_amdgcn_sched_barrier(0);
      AT_PV(va, 4);
#undef AT_EXP
#undef AT_VRD
#undef AT_PV
    }
    l += __shfl_xor(l, 16); l += __shfl_xor(l, 32);
    const float inv = 1.0f / (l + __builtin_amdgcn_exp2f(sink2 - mx));
    if (store) {
#pragma unroll
        for (int dt = 0; dt < 4; ++dt) {
            u32x2 w; w.x = cvtpk2(o[dt][0] * inv * __uint_as_float(zz[dt].x << 16), o[dt][1] * inv * __uint_as_float(zz[dt].x & 0xffff0000u));
            w.y = cvtpk2(o[dt][2] * inv * __uint_as_float(zz[dt].y << 16), o[dt][3] * inv * __uint_as_float(zz[dt].y & 0xffff0000u));
            *(GAS u32x2*)(orow + 16 * dt + 4 * g) = w; }
    }
}
__device__ __forceinline__ void attn_wait(gu32* word, unsigned want, gu32* tmo, int tid) {
    if (tid < 64) {
        unsigned sp = 0;
        while (!__all(__hip_atomic_load(word, RLX_AGENT) >= want)) { __builtin_amdgcn_s_sleep(1);
            if ((++sp & 255u) == 0u) { if (__hip_atomic_load(tmo, RLX_AGENT)) break; if (sp > XB_SPIN_CAP) { __hip_atomic_store(tmo, 1u, RLX_AGENT); break; } } }
        __builtin_amdgcn_fence(__ATOMIC_ACQUIRE, "agent");
        VM_WAIT();
    }
    __syncthreads();
}
__device__ __forceinline__ void attn_prompt_unit(const Ptrs& P, LAS unsigned char* lds, int b, int qb, int kvh, int qs0, int qs1, int tid, int wave, int lane) {
    { gu32* ctl = (gu32*)(P.ws + WS_CTL);
      const int j = lane & 7, pmq = 8 * b + (qb >> 1), pk = (j & 1) ? pmq : ((qb >= 2 && !(qb & 1)) ? pmq - 1 : pmq);
      const int fi = j < 4 ? pmq * 17 + ((j & 2) << 2) + 2 * kvh + (j & 1) : (j < 6 ? pk * 17 + 16 : 544 + pk);
      attn_wait(ctl + CW_TILE + fi * 16, (unsigned)NWAVES, ctl + CW_BAR + XB_TMO, tid); }
    LAS bf16* KI = (LAS bf16*)lds;
    LAS bf16* VI = (LAS bf16*)(lds + 40960);
    const bf16* KB = (const bf16*)(P.ws + WS_KB); const bf16* VT2 = (const bf16*)(P.ws + WS_VT2); const bf16* QZ = (const bf16*)(P.ws + WS_QZ); bf16* A3 = (bf16*)(P.ws + WS_BUFA);
    const int kpos0 = (qb - 1) * 128;
    { v4u kq[4], vq[4];
#pragma unroll
      for (int it = 0; it < 4; ++it) { const int i = tid + it * 512;
          { const int j = i >> 3, ch = i & 7, kpos = kpos0 + j, kc = kpos < 0 ? 0 : kpos; kq[it] = *(const GAS v4u*)(KB + (size_t)(b * 2048 + kc) * 256 + kvh * 64 + ch * 8); }
          { const int d = i >> 5, ch = i & 31, kpos = kpos0 + ch * 8, kc = kpos < 0 ? 0 : kpos; vq[it] = *(const GAS v4u*)(VT2 + (size_t)(kvh * 64 + d) * MT + b * 2048 + kc); } }
#pragma unroll
      for (int it = 0; it < 4; ++it) { const int i = tid + it * 512; const v4u z = {0u, 0u, 0u, 0u};
          { const int j = i >> 3, ch = i & 7; *(LAS v4u*)(KI + j * 80 + ch * 8) = (kpos0 + j < 0) ? z : kq[it]; }
          { const int d = i >> 5, ch = i & 31; *(LAS v4u*)(VI + d * 264 + ch * 8) = (kpos0 + ch * 8 < 0) ? z : vq[it]; } } }
    __syncthreads();
    const int hh = kvh * 8 + wave;
    const float slope2 = __builtin_amdgcn_exp2f(-0.25f * (float)(hh + 1)) * LOG2E, sink2 = P.sinks[hh] * LOG2E;
    { const int g = lane >> 4; const bf16* qz0 = QZ + ((size_t)b * 2048 + qb * 128 + (lane & 15)) * 4096 + hh * 64;
      bf16x8 qc0 = *(const bf16x8*)(qz0 + (size_t)qs0 * 16 * 4096 + 8 * g), qc1 = *(const bf16x8*)(qz0 + (size_t)qs0 * 16 * 4096 + 32 + 8 * g);
      f32x4 bias[10]; int bkey = -1;
#pragma unroll
      for (int i = 0; i < 10; ++i) bias[i] = (f32x4){0.f, 0.f, 0.f, 0.f};
#pragma unroll 1
      for (int qs = qs0; qs < qs1; ++qs) { const int qpos = qb * 128 + 16 * qs + (lane & 15); const size_t row = (size_t)b * 2048 + qpos;
          const bf16* qzr = qz0 + (size_t)qs * 16 * 4096;
          u32x2 zz[4];
#pragma unroll
          for (int dt = 0; dt < 4; ++dt) zz[dt] = *(const GAS u32x2*)(qzr + 2048 + 16 * dt + 4 * g);
          const bf16* qzn = qzr + (qs < 7 ? 16 * 4096 : 0);
          const bf16x8 qn0 = *(const bf16x8*)(qzn + 8 * g), qn1 = *(const bf16x8*)(qzn + 32 + 8 * g);
          attn_subblock(KI, VI, qs < 6 ? qs : 6, qc0, qc1, qpos, kpos0, slope2, sink2, zz, A3 + row * DM + hh * 64, true, lane, bias, bkey);
          qc0 = qn0; qc1 = qn1; } }
    __syncthreads();
}
__device__ __forceinline__ void attn_sample_unit(const Ptrs& P, LAS unsigned char* lds, int u, int tid, int wave, int lane) {
    const int kvh = u & 3, b = u >> 2;
    { gu32* ctl = (gu32*)(P.ws + WS_CTL); attn_wait(ctl + CW_SIN, 144u, ctl + CW_BAR + XB_TMO, tid); }
    LAS bf16* KI = (LAS bf16*)lds;
    LAS bf16* VI = (LAS bf16*)(lds + 40960);
    const bf16* KB = (const bf16*)(P.ws + WS_KB); const bf16* VT2 = (const bf16*)(P.ws + WS_VT2); const bf16* QZ = (const bf16*)(P.ws + WS_QZ); bf16* A3 = (bf16*)(P.ws + WS_BUFA);
    { f32x4 kk[4], vv[4];
#pragma unroll
      for (int it = 0; it < 4; ++it) { const int i = tid + it * 512, j = i >> 4, d4 = i & 15; const size_t off = ((size_t)(b * 128 + j) * 4 + kvh) * 64 + 4 * d4;
          kk[it] = *(const GAS f32x4*)(P.ck + off); vv[it] = *(const GAS f32x4*)(P.cv + off); }
      const int jj = tid >> 6, dd = tid & 63;
      const bf16 kn = KB[(size_t)(MPR + b * 8 + jj) * 256 + kvh * 64 + dd], vn = VT2[(size_t)(kvh * 64 + dd) * MT + MPR + b * 8 + jj];
#pragma unroll
      for (int it = 0; it < 4; ++it) { const int i = tid + it * 512, j = i >> 4, d4 = i & 15;
          u32x2 w; w.x = cvtpk2(kk[it][0], kk[it][1]); w.y = cvtpk2(kk[it][2], kk[it][3]); *(LAS u32x2*)(KI + j * 80 + 4 * d4) = w;
          const unsigned v01 = cvtpk2(vv[it][0], vv[it][1]), v23 = cvtpk2(vv[it][2], vv[it][3]);
          VI[(4 * d4 + 0) * 264 + j] = (bf16)(v01 & 0xffffu); VI[(4 * d4 + 1) * 264 + j] = (bf16)(v01 >> 16); VI[(4 * d4 + 2) * 264 + j] = (bf16)(v23 & 0xffffu); VI[(4 * d4 + 3) * 264 + j] = (bf16)(v23 >> 16); }
      KI[(128 + jj) * 80 + dd] = kn; VI[dd * 264 + 128 + jj] = vn;
#pragma unroll
      for (int it = 0; it < 3; ++it) { const int i = tid + it * 512, j = 136 + (i >> 6), d = i & 63; KI[j * 80 + d] = (bf16)0; VI[d * 264 + j] = (bf16)0; } }
    __syncthreads();
    const int hh = kvh * 8 + wave;
    const float slope2 = __builtin_amdgcn_exp2f(-0.25f * (float)(hh + 1)) * LOG2E, sink2 = P.sinks[hh] * LOG2E;
    const int n = lane & 15, qi = n < 8 ? n : 7; const size_t row = (size_t)MPR + b * 8 + qi;
    { const int g = lane >> 4; const bf16* qzr = QZ + row * 4096 + hh * 64; u32x2 zz[4];
#pragma unroll
      for (int dt = 0; dt < 4; ++dt) zz[dt] = *(const GAS u32x2*)(qzr + 2048 + 16 * dt + 4 * g);
      f32x4 bias[10]; int bkey = -1;
#pragma unroll
      for (int i = 0; i < 10; ++i) bias[i] = (f32x4){0.f, 0.f, 0.f, 0.f};
      attn_subblock(KI, VI, 0, *(const bf16x8*)(qzr + 8 * g), *(const bf16x8*)(qzr + 32 + 8 * g), 128 + qi, 0, slope2, sink2, zz, A3 + row * DM + hh * 64, n < 8, lane, bias, bkey); }
    __syncthreads();
}
constexpr int SG_A = 0, SG_B = 10240, SG_STAGE = 30720, SG_RS = 2 * SG_STAGE;
template <bool NAT>
__device__ __forceinline__ void sgemm_core(LAS unsigned char* lds, const bf16* A, const bf16* B, f32x4 (&acc)[2][2], int tid, int wave, int lane, const int nkt = 32) {
    const int wm = wave >> 2, wn = wave & 3, r = lane & 15, g = lane >> 4, lr = tid >> 3, ch = tid & 7;
    const GAS v4u* ga = (const GAS v4u*)(A + (size_t)lr * 2048 + ch * 8); const GAS v4u* gb0 = (const GAS v4u*)(B + (size_t)lr * 2048 + ch * 8); const GAS v4u* gb1 = (const GAS v4u*)(B + (size_t)(64 + lr) * 2048 + ch * 8);
    v4u ra0, rb0, rc0, ra1, rb1, rc1, ra2, rb2, rc2, ra3, rb3, rc3;
#pragma unroll
    for (int i = 0; i < 2; ++i)
#pragma unroll
        for (int j = 0; j < 2; ++j) acc[i][j] = (f32x4){0.f, 0.f, 0.f, 0.f};
#define SG_LD(s, kt) do { ra##s = ga[(kt) * 8]; rb##s = gb0[(kt) * 8]; rc##s = gb1[(kt) * 8]; } while (0)
#define SG_ST(s, stg) do { *(LAS v4u*)(lds + (stg) * SG_STAGE + SG_A + lr * 160 + ch * 16) = ra##s; *(LAS v4u*)(lds + (stg) * SG_STAGE + SG_B + lr * 160 + ch * 16) = rb##s; \
                           *(LAS v4u*)(lds + (stg) * SG_STAGE + SG_B + (64 + lr) * 160 + ch * 16) = rc##s; } while (0)
#define SG_COMPUTE(stg) do { _Pragma("unroll") for (int kk = 0; kk < 2; ++kk) { bf16x8 af[2], bfr[2]; \
        _Pragma("unroll") for (int i = 0; i < 2; ++i) af[i] = *(const LAS bf16x8*)(lds + (stg) * SG_STAGE + SG_A + (32 * wm + 16 * i + r) * 160 + (32 * kk + 8 * g) * 2); \
        _Pragma("unroll") for (int j = 0; j < 2; ++j) bfr[j] = *(const LAS bf16x8*)(lds + (stg) * SG_STAGE + SG_B + (32 * wn + 16 * j + r) * 160 + (32 * kk + 8 * g) * 2); \
        _Pragma("unroll") for (int i = 0; i < 2; ++i) _Pragma("unroll") for (int j = 0; j < 2; ++j) acc[i][j] = NAT ? MFMA16(af[i], bfr[j], acc[i][j]) : MFMA16(bfr[j], af[i], acc[i][j]); } } while (0)
#define SG_STEP(kt, s, stg) do { SG_COMPUTE(stg); if ((kt) + 1 < nkt) SG_ST(s, (stg) ^ 1); if ((kt) + 5 < nkt) SG_LD(s, (kt) + 5); __syncthreads(); } while (0)
    SG_LD(0, 0); SG_LD(1, 1); SG_LD(2, 2); SG_LD(3, 3); SG_ST(0, 0); SG_LD(0, 4);
    __syncthreads();
#pragma unroll 1
    for (int kt = 0; kt < nkt; kt += 4) { SG_STEP(kt, 1, 0); SG_STEP(kt + 1, 2, 1); SG_STEP(kt + 2, 3, 0); SG_STEP(kt + 3, 0, 1); }
#undef SG_STEP
#undef SG_LD
#undef SG_ST
#undef SG_COMPUTE
}
template <bool NAT>
__device__ __forceinline__ void sgemm_core8(LAS unsigned char* lds, const bf16* A, const bf16* B, f32x4 (&acc)[2][2], int tid, int wave, int lane, const int nkt = 32) {
    const int wm = wave >> 2, wn = wave & 3, r = lane & 15, g = lane >> 4, lr = tid >> 3, ch = tid & 7;
    const GAS v4u* ga = (const GAS v4u*)(A + (size_t)lr * 2048 + ch * 8); const GAS v4u* gb0 = (const GAS v4u*)(B + (size_t)lr * 2048 + ch * 8); const GAS v4u* gb1 = (const GAS v4u*)(B + (size_t)(64 + lr) * 2048 + ch * 8);
    v4u ra0, rb0, rc0, ra1, rb1, rc1, ra2, rb2, rc2, ra3, rb3, rc3, ra4, rb4, rc4, ra5, rb5, rc5, ra6, rb6, rc6, ra7, rb7, rc7;
#pragma unroll
    for (int i = 0; i < 2; ++i)
#pragma unroll
        for (int j = 0; j < 2; ++j) acc[i][j] = (f32x4){0.f, 0.f, 0.f, 0.f};
#define SG_LD(s, kt) do { ra##s = ga[(kt) * 8]; rb##s = gb0[(kt) * 8]; rc##s = gb1[(kt) * 8]; } while (0)
#define SG_ST(s, stg) do { *(LAS v4u*)(lds + (stg) * SG_STAGE + SG_A + lr * 160 + ch * 16) = ra##s; *(LAS v4u*)(lds + (stg) * SG_STAGE + SG_B + lr * 160 + ch * 16) = rb##s; \
                           *(LAS v4u*)(lds + (stg) * SG_STAGE + SG_B + (64 + lr) * 160 + ch * 16) = rc##s; } while (0)
#define SG_COMPUTE(stg) do { _Pragma("unroll") for (int kk = 0; kk < 2; ++kk) { bf16x8 af[2], bfr[2]; \
        _Pragma("unroll") for (int i = 0; i < 2; ++i) af[i] = *(const LAS bf16x8*)(lds + (stg) * SG_STAGE + SG_A + (32 * wm + 16 * i + r) * 160 + (32 * kk + 8 * g) * 2); \
        _Pragma("unroll") for (int j = 0; j < 2; ++j) bfr[j] = *(const LAS bf16x8*)(lds + (stg) * SG_STAGE + SG_B + (32 * wn + 16 * j + r) * 160 + (32 * kk + 8 * g) * 2); \
        _Pragma("unroll") for (int i = 0; i < 2; ++i) _Pragma("unroll") for (int j = 0; j < 2; ++j) acc[i][j] = NAT ? MFMA16(af[i], bfr[j], acc[i][j]) : MFMA16(bfr[j], af[i], acc[i][j]); } } while (0)
#define SG_STEP(kt, s, stg) do { SG_COMPUTE(stg); if ((kt) + 1 < nkt) SG_ST(s, (stg) ^ 1); if ((kt) + 9 < nkt) SG_LD(s, (kt) + 9); __syncthreads(); } while (0)
    SG_LD(0, 0); SG_LD(1, 1); SG_LD(2, 2); SG_LD(3, 3); SG_LD(4, 4); SG_LD(5, 5); SG_LD(6, 6); SG_LD(7, 7); SG_ST(0, 0); if (8 < nkt) SG_LD(0, 8);
    __syncthreads();
#pragma unroll 1
    for (int kt = 0; kt < nkt; kt += 8) { SG_STEP(kt, 1, 0); SG_STEP(kt + 1, 2, 1); SG_STEP(kt + 2, 3, 0); SG_STEP(kt + 3, 4, 1); SG_STEP(kt + 4, 5, 0); SG_STEP(kt + 5, 6, 1); SG_STEP(kt + 6, 7, 0); SG_STEP(kt + 7, 0, 1); }
#undef SG_STEP
#undef SG_LD
#undef SG_ST
#undef SG_COMPUTE
}
template <bool SILU, bool WT = false>
__device__ __forceinline__ void sg_store_bf16(const f32x4 (&acc)[2][2], bf16* dst, int ld, int wave, int lane, float rs0, float rs1) {
    const int wm = wave >> 2, wn = wave & 3, r = lane & 15, g = lane >> 4;
#pragma unroll
    for (int i = 0; i < 2; ++i)
#pragma unroll
        for (int j = 0; j < 2; ++j) { f32x4 v = acc[i][j] * (i ? rs1 : rs0);
            if (SILU) { v[0] = pg8::silu_f(v[0]); v[1] = pg8::silu_f(v[1]); v[2] = pg8::silu_f(v[2]); v[3] = pg8::silu_f(v[3]); }
            u32x2 w; w.x = cvtpk2(v[0], v[1]); w.y = cvtpk2(v[2], v[3]);
            bf16* d_ = dst + (size_t)(32 * wm + 16 * i + r) * ld + 32 * wn + 16 * j + 4 * g;
            if (WT) __hip_atomic_store((gu64*)d_, (unsigned long long)w.x | ((unsigned long long)w.y << 32), RLX_AGENT); else *(GAS u32x2*)d_ = w; }
}
__device__ __forceinline__ void s_in_a_block(const Ptrs& P, LAS unsigned char* lds, int rb, int nbk, int tid, int wave, int lane) {
    asm volatile("" : "+v"(tid));
    const bf16* A = (const bf16*)(P.ws + WS_BUFA) + (size_t)(MPR + 64 * rb) * DM; const bf16* B = (const bf16*)(P.ws + WS_WINA) + (size_t)(128 * nbk) * DM;
    f32x4 acc[2][2];
    if (nbk >= 16 && nbk < 32) {
        sgemm_core8<true>(lds, A, B, acc, tid, wave, lane); asm volatile("" : "+v"(lane));
        const int wm = wave >> 2, wn = wave & 3, r = lane & 15, g = lane >> 4; bf16* VT = (bf16*)(P.ws + WS_VT);
#pragma unroll
        for (int i = 0; i < 2; ++i)
#pragma unroll
            for (int j = 0; j < 2; ++j) { u32x2 w; w.x = cvtpk2(acc[i][j][0], acc[i][j][1]); w.y = cvtpk2(acc[i][j][2], acc[i][j][3]);
                *(GAS u32x2*)(VT + (size_t)((nbk - 16) * 128 + 32 * wn + 16 * j + r) * MT + MPR + 64 * rb + 32 * wm + 16 * i + 4 * g) = w; }
    } else {
        sgemm_core8<false>(lds, A, B, acc, tid, wave, lane); asm volatile("" : "+v"(lane));
        if (nbk < 16) sg_store_bf16<false>(acc, (bf16*)(P.ws + WS_QK) + (size_t)(MPR + 64 * rb) * DM + nbk * 128, DM, wave, lane, 1.f, 1.f);
        else sg_store_bf16<true>(acc, (bf16*)(P.ws + WS_SR) + (size_t)(MPR + 64 * rb) * DM + (nbk - 32) * 128, DM, wave, lane, 1.f, 1.f);
    }
}
template <bool WITH_B16>
__device__ __forceinline__ void s_out_block(const Ptrs& P, LAS unsigned char* lds, const bf16* Abase, const bf16* Wt, const float* res, int rb, int nb, int tid, int wave, int lane) {
    f32x4 acc[2][2];
    sgemm_core<false>(lds, Abase + (size_t)(64 * rb) * DM, Wt + (size_t)(128 * nb) * DM, acc, tid, wave, lane);
    const int wm = wave >> 2, wn = wave & 3, r = lane & 15, g = lane >> 4;
    float* out = P.out + OUT_Y + (size_t)MPR * DM; bf16* H1b = (bf16*)(P.ws + WS_SR) + (size_t)MPR * DM; float* SSQ2 = (float*)(P.ws + WS_SSQP);
#pragma unroll
    for (int i = 0; i < 2; ++i) { const int row = 64 * rb + 32 * wm + 16 * i + r; float ss = 0.f;
#pragma unroll
        for (int j = 0; j < 2; ++j) { const size_t off = (size_t)row * DM + 128 * nb + 32 * wn + 16 * j + 4 * g;
            const f32x4 v = *(const GAS f32x4*)(res + off) + acc[i][j]; *(GAS f32x4*)(out + off) = v;
            if (WITH_B16) { u32x2 w; w.x = cvtpk2(v[0], v[1]); w.y = cvtpk2(v[2], v[3]); *(GAS u32x2*)(H1b + off) = w; ss += (v[0] * v[0] + v[1] * v[1]) + (v[2] * v[2] + v[3] * v[3]); } }
        if (WITH_B16) { ss += __shfl_xor(ss, 16); ss += __shfl_xor(ss, 32); if (g == 0) SSQ2[(size_t)row * 64 + nb * 4 + wn] = ss; } }
}
__device__ __forceinline__ void s_in_b_block(const Ptrs& P, LAS unsigned char* lds, int rb, int nbk, int tid, int wave, int lane) {
    const bf16* A = (const bf16*)(P.ws + WS_SR) + (size_t)(MPR + 64 * rb) * DM; const bf16* B = (const bf16*)(P.ws + WS_WINB) + (size_t)(128 * nbk) * DM;
    LAS float* RS = (LAS float*)(lds + SG_RS);
    { const int row = tid >> 3, part = tid & 7; const float* sp = (const float*)(P.ws + WS_SSQP) + (size_t)(64 * rb + row) * 64 + part * 8;
      const f32x4 a = *(const GAS f32x4*)sp, b = *(const GAS f32x4*)(sp + 4); float s = (a[0] + a[1]) + (a[2] + a[3]) + (b[0] + b[1]) + (b[2] + b[3]);
      s += __shfl_xor(s, 1); s += __shfl_xor(s, 2); s += __shfl_xor(s, 4);
      if (part == 0) RS[row] = 1.0f / sqrtf(s * (1.f / DM) + RMS_EPS); }
    f32x4 acc[2][2];
    const int wm = wave >> 2, wn = wave & 3, r = lane & 15, g = lane >> 4;
    if (nbk >= 34) {
        sgemm_core<true>(lds, A, B, acc, tid, wave, lane);
        bf16* VT2 = (bf16*)(P.ws + WS_VT2); float* vws = P.out + OUT_VWS;
#pragma unroll
        for (int i = 0; i < 2; ++i) { const f32x4 rs = *(const LAS f32x4*)(RS + 32 * wm + 16 * i + 4 * g);
#pragma unroll
            for (int j = 0; j < 2; ++j) { const f32x4 v = acc[i][j] * rs; const int col = (nbk - 34) * 128 + 32 * wn + 16 * j + r; const int srow = 64 * rb + 32 * wm + 16 * i + 4 * g;
                u32x2 w; w.x = cvtpk2(v[0], v[1]); w.y = cvtpk2(v[2], v[3]);
                __hip_atomic_store((gu64*)(VT2 + (size_t)col * MT + MPR + srow), (unsigned long long)w.x | ((unsigned long long)w.y << 32), RLX_AGENT);
#pragma unroll
                for (int e = 0; e < 4; ++e) { const int s = srow + e; vws[((size_t)(s >> 3) * 128 + 120 + (s & 7)) * 256 + col] = v[e]; } } }
    } else {
        sgemm_core<false>(lds, A, B, acc, tid, wave, lane);
        const float rs0 = RS[32 * wm + r], rs1 = RS[32 * wm + 16 + r];
        if (nbk < 16) sg_store_bf16<false, true>(acc, (bf16*)(P.ws + WS_QZ) + (size_t)(MPR + 64 * rb) * 4096 + nbk * 128, 4096, wave, lane, rs0, rs1);
        else if (nbk < 32) sg_store_bf16<true, true>(acc, (bf16*)(P.ws + WS_QZ) + (size_t)(MPR + 64 * rb) * 4096 + nbk * 128, 4096, wave, lane, rs0, rs1);
        else { sg_store_bf16<false, true>(acc, (bf16*)(P.ws + WS_KB) + (size_t)(MPR + 64 * rb) * 256 + (nbk - 32) * 128, 256, wave, lane, rs0, rs1);
            float* kws = P.out + OUT_KWS;
#pragma unroll
            for (int i = 0; i < 2; ++i) { const int s = 64 * rb + 32 * wm + 16 * i + r; float* d = kws + ((size_t)(s >> 3) * 128 + 120 + (s & 7)) * 256 + (nbk - 32) * 128 + 32 * wn + 4 * g;
#pragma unroll
                for (int j = 0; j < 2; ++j) *(GAS f32x4*)(d + 16 * j) = acc[i][j] * (i ? rs1 : rs0); } }
    }
}
__device__ __forceinline__ void s_out_b_quarter(const Ptrs& P, LAS unsigned char* lds, int blk, int kq, bool fuse_norm, int tid, int wave, int lane) {
    const int rb = blk >> 4, nb = blk & 15;
    f32x4 acc[2][2];
    sgemm_core<false>(lds, (const bf16*)(P.ws + WS_BUFA) + (size_t)(MPR + 64 * rb) * DM + 512 * kq, (const bf16*)(P.ws + WS_WOB) + (size_t)(128 * nb) * DM + 512 * kq, acc, tid, wave, lane, 8);
    const int wm = wave >> 2, wn = wave & 3, r = lane & 15, g = lane >> 4;
    gu32* ctl = (gu32*)(P.ws + WS_CTL);
    float* part = (float*)(P.ws + WS_SPART) + (size_t)blk * 3 * 8192;
    float* out = P.out + OUT_Y + (size_t)MPR * DM;
    if (kq) {
#pragma unroll
        for (int i = 0; i < 2; ++i)
#pragma unroll
            for (int j = 0; j < 2; ++j) { float* d = part + (kq - 1) * 8192 + (32 * wm + 16 * i + r) * 128 + 32 * wn + 16 * j + 4 * g; const f32x4 v = acc[i][j];
                asm volatile("global_store_dwordx4 %0, %1, off sc1\n\ts_nop 2" :: "v"(d), "v"(v) : "memory"); }
        VM_WAIT(); __syncthreads();
        if (tid == 0) (void)__hip_atomic_fetch_add(ctl + CW_SOBP + blk * 16, 1u, RLX_AGENT);
    } else {
        attn_wait(ctl + CW_SOBP + blk * 16, 3u, ctl + CW_BAR + XB_TMO, tid);
#pragma unroll
        for (int i = 0; i < 2; ++i)
#pragma unroll
            for (int j = 0; j < 2; ++j) { const size_t off = (size_t)(64 * rb + 32 * wm + 16 * i + r) * DM + 128 * nb + 32 * wn + 16 * j + 4 * g;
                const float* pp = part + (32 * wm + 16 * i + r) * 128 + 32 * wn + 16 * j + 4 * g;
                const f32x4 p1 = *(const GAS f32x4*)pp, p2 = *(const GAS f32x4*)(pp + 8192), p3 = *(const GAS f32x4*)(pp + 16384);
                const f32x4 v = (((*(const GAS f32x4*)(out + off) + acc[i][j]) + p1) + p2) + p3;
                asm volatile("global_store_dwordx4 %0, %1, off sc1\n\ts_nop 2" :: "v"(out + off), "v"(v) : "memory"); }
        if (!fuse_norm) return;
        VM_WAIT(); __syncthreads();
        if (tid == 0) (void)__hip_atomic_fetch_add(ctl + CW_SOBR + rb * 16, 1u, RLX_AGENT);
        attn_wait(ctl + CW_SOBR + rb * 16, 16u, ctl + CW_BAR + XB_TMO, tid);
        if (wave < 4) { float* row = out + (size_t)(64 * rb + 4 * nb + wave) * DM; final_row(row, P.g_final, lane, row); }
    }
}
__device__ __forceinline__ void s_out_b_partA(const Ptrs& P, LAS unsigned char* lds, int blk, int kq, f32x4 (&acc)[2][2], int tid, int wave, int lane) {
    const int rb = blk >> 4, nb = blk & 15;
    sgemm_core<false>(lds, (const bf16*)(P.ws + WS_BUFA) + (size_t)(MPR + 64 * rb) * DM + 512 * kq, (const bf16*)(P.ws + WS_WOB) + (size_t)(128 * nb) * DM + 512 * kq, acc, tid, wave, lane, 8);
    if (kq) { const int wm = wave >> 2, wn = wave & 3, r = lane & 15, g = lane >> 4;
        float* part = (float*)(P.ws + WS_SPART) + (size_t)blk * 3 * 8192;
#pragma unroll
        for (int i = 0; i < 2; ++i)
#pragma unroll
            for (int j = 0; j < 2; ++j) { float* d = part + (kq - 1) * 8192 + (32 * wm + 16 * i + r) * 128 + 32 * wn + 16 * j + 4 * g; const f32x4 v = acc[i][j];
                asm volatile("global_store_dwordx4 %0, %1, off sc1\n\ts_nop 2" :: "v"(d), "v"(v) : "memory"); }
        VM_WAIT(); __syncthreads();
        if (tid == 0) (void)__hip_atomic_fetch_add((gu32*)(P.ws + WS_CTL) + CW_SOBP + blk * 16, 1u, RLX_AGENT); }
}
__device__ __forceinline__ void s_out_b_partB(const Ptrs& P, LAS unsigned char* lds, int blk, const f32x4 (&acc)[2][2], bool fuse_norm, int tid, int wave, int lane) {
    const int rb = blk >> 4, nb = blk & 15, wm = wave >> 2, wn = wave & 3, r = lane & 15, g = lane >> 4;
    gu32* ctl = (gu32*)(P.ws + WS_CTL);
    const float* part = (const float*)(P.ws + WS_SPART) + (size_t)blk * 3 * 8192;
    float* out = P.out + OUT_Y + (size_t)MPR * DM;
    attn_wait(ctl + CW_SOBP + blk * 16, 3u, ctl + CW_BAR + XB_TMO, tid);
#pragma unroll
    for (int i = 0; i < 2; ++i)
#pragma unroll
        for (int j = 0; j < 2; ++j) { const size_t off = (size_t)(64 * rb + 32 * wm + 16 * i + r) * DM + 128 * nb + 32 * wn + 16 * j + 4 * g;
            const float* pp = part + (32 * wm + 16 * i + r) * 128 + 32 * wn + 16 * j + 4 * g;
            const f32x4 p1 = *(const GAS f32x4*)pp, p2 = *(const GAS f32x4*)(pp + 8192), p3 = *(const GAS f32x4*)(pp + 16384);
            const f32x4 v = (((*(const GAS f32x4*)(out + off) + acc[i][j]) + p1) + p2) + p3;
            asm volatile("global_store_dwordx4 %0, %1, off sc1\n\ts_nop 2" :: "v"(out + off), "v"(v) : "memory"); }
    if (!fuse_norm) return;
    VM_WAIT(); __syncthreads();
    if (tid == 0) (void)__hip_atomic_fetch_add(ctl + CW_SOBR + rb * 16, 1u, RLX_AGENT);
    attn_wait(ctl + CW_SOBR + rb * 16, 16u, ctl + CW_BAR + XB_TMO, tid);
    if (wave < 4) { float* row = out + (size_t)(64 * rb + 4 * nb + wave) * DM; final_row(row, P.g_final, lane, row); }
}
#ifndef MK_N_LAUNCHES
#define MK_N_LAUNCHES 1
#endif
constexpr int N_PHASES = 11;
constexpr int N_LAUNCHES = MK_N_LAUNCHES;
struct Args { Ptrs p; int ph_lo, ph_hi; };
static_assert(sizeof(Args) == 20 * 8 + 8, "Args has no padding");

__global__ void __launch_bounds__(NWAVES * 64, 2) yoco_fwd(Args args) {
    extern __shared__ __attribute__((aligned(16))) unsigned char lds_raw[];
    LAS unsigned char* lds = (LAS unsigned char*)lds_raw;
    volatile LAS unsigned* MISC = (volatile LAS unsigned*)(lds + MISC_OFF);
    const int tid = threadIdx.x, lane = tid & 63, wave = __builtin_amdgcn_readfirstlane(tid >> 6);
    const int G = gridDim.x, c = blockIdx.x;
    const int vcu = (G % 8 == 0) ? (c % 8) * (G / 8) + c / 8 : c;
    const Ptrs& P = args.p;
    gu32* ctl = (gu32*)(P.ws + WS_CTL);
    for (int u = tid; u < (LDS_BYTES - LDSCTL_OFF) / 4; u += NWAVES * 64) ((LAS unsigned*)(lds + LDSCTL_OFF))[u] = 0u;
    __syncthreads();
    XcdBarrier bar; bar.bar = (unsigned*)(ctl + CW_BAR); bar.x = 0; bar.st = nullptr;
    const int lo = args.ph_lo, hi = args.ph_hi;
    if (hi - lo > 1) bar = xcd_barrier_post((unsigned*)(ctl + CW_BAR), MISC + 8);
#define IN(k) (lo <= (k) && (k) < hi)
#define SEAM(k) do { if (IN(k) && IN((k) + 1)) xcd_barrier(bar); } while (0)
    const int gw = vcu * NWAVES + wave, NGW = G * NWAVES;

    if (IN(0)) { p0_prologue(P, lds, vcu, G, tid, wave, lane); SEAM(0); }

    if (IN(1)) {
        pg8::SchedInA S{G, c, (const char*)(P.ws + WS_BUFA), (const char*)(P.ws + WS_WINA)};
        pg8::EpiInA E{(pg8::bf16_t*)(P.ws + WS_QK), (pg8::bf16_t*)(P.ws + WS_SR), (pg8::bf16_t*)(P.ws + WS_VT), MT};
        const bool early_glow = G == 256 && (c & 8);
        if (early_glow) { const int slot = wave * 128 + ((c >> 4) * 8 + (c & 7)); if (slot < MT / 16) glow_task((const bf16*)(P.ws + WS_BUFA), (const bf16*)(P.ws + WS_WINA) + (size_t)6144 * DM, (float*)(P.ws + WS_GLOW), slot, lane); __syncthreads(); }
        pg8::gemm_phase<pg8::EpiInA, pg8::SchedInA, true, true>(lds, 2048, S, E);
        if (G != 256) for (int task = c * NWAVES + wave; task < MT / 16; task += NGW)
            glow_task((const bf16*)(P.ws + WS_BUFA), (const bf16*)(P.ws + WS_WINA) + (size_t)6144 * DM, (float*)(P.ws + WS_GLOW), task, lane);
        SEAM(1);
    }

    if (IN(2)) {
        for (int blk = c; blk < 192; blk += G) s_in_a_block(P, lds, blk / 48, blk % 48, tid, wave, lane);
        int t2 = threadIdx.x; asm volatile("" : "+v"(t2));
        const int w2 = __builtin_amdgcn_readfirstlane(t2 >> 6), l2 = t2 & 63;
        if (G == 256) { for (int j = 0; j < 2; ++j) gla_prep_unit(P, lds, (2 * (c & 7) + j) * 32 + (c >> 3), t2, w2, l2); }
        else for (int u = c; u < 512; u += G) gla_prep_unit(P, lds, u, t2, w2, l2);
        SEAM(2);
    }

    if (IN(3)) {
        if (G >= 256) {
            constexpr int CV_A = 1408;
            if (c < 128) { const int xcd = c & 7, idx = c >> 3; gla_scan_unit(P, lds, xcd * 2 + (idx >> 3), (idx >> 2) & 1, idx & 3, tid, wave, lane);
                convert_weights(P, lds, 1, CV_A + c * NWAVES + wave, 128 * NWAVES, 2176, wave, lane); }
            else { gla_sample_unit(P, lds, c - 128, tid, wave, lane);
                convert_weights(P, lds, 1, (c - 128) * NWAVES + wave, 128 * NWAVES, CV_A, wave, lane); }
        } else {
            for (int u = c; u < 128; u += G) gla_scan_unit(P, lds, u >> 3, (u >> 2) & 1, u & 3, tid, wave, lane);
            for (int t = c; t < 128; t += G) gla_sample_unit(P, lds, t, tid, wave, lane);
        }
        SEAM(3);
    }

    if (IN(4)) {
        const int NS = G >= 128 ? 64 : 0;
        constexpr int GR0 = 8192;
        if (c < NS) { for (int blk = c; blk < 64; blk += NS) s_out_block<true>(P, lds, (const bf16*)(P.ws + WS_BUFA) + (size_t)MPR * DM, (const bf16*)(P.ws + WS_WOA), P.x_sample, blk >> 4, blk & 15, tid, wave, lane);
            gate_rows(P, lane, GR0 + c * NWAVES + wave, NS * NWAVES, MPR); }
        else { gate_rows(P, lane, (c - NS) * NWAVES + wave, (G - NS) * NWAVES, NS ? GR0 : MPR);
            if (NS == 0) { __syncthreads(); for (int blk = c; blk < 64; blk += G) s_out_block<true>(P, lds, (const bf16*)(P.ws + WS_BUFA) + (size_t)MPR * DM, (const bf16*)(P.ws + WS_WOA), P.x_sample, blk >> 4, blk & 15, tid, wave, lane); } }
        SEAM(4);
    }

    if (IN(5)) {
        pg8::SchedOut S{G, c, (const char*)(P.ws + WS_BUFA), (const char*)(P.ws + WS_WOA)};
        pg8::EpiOutA E{P.x_prompt, (pg8::bf16_t*)(P.ws + WS_SR), (float*)(P.ws + WS_SSQ1)};
        pg8::gemm_phase<pg8::EpiOutA, pg8::SchedOut, true, true>(lds, 2048, S, E);
        SEAM(5);
    }

    if (IN(6)) {
        pg8::SchedInB S{G, c, (const char*)(P.ws + WS_SR), (const char*)(P.ws + WS_WINB), (const float*)(P.ws + WS_SSQ1), (LAS float*)(lds + TAB_OFF), (unsigned*)(ctl + CW_TILE)};
        pg8::EpiInB E{(pg8::bf16_t*)(P.ws + WS_QZ), (pg8::bf16_t*)(P.ws + WS_KB), (pg8::bf16_t*)(P.ws + WS_VT2), MT, P.out + OUT_KWP, P.out + OUT_VWP, P.out + OUT_KWS, P.out + OUT_VWS, (const LAS float*)(lds + TAB_OFF)};
#define SIN_PUBLISH(n) do { VM_WAIT(); __syncthreads(); if (tid == 0) (void)__hip_atomic_fetch_add(ctl + CW_SIN, (unsigned)(n), RLX_AGENT); } while (0)
        if (G == 256) { if (c >= 64 && c < 208) { s_in_b_block(P, lds, (c - 64) / 36, (c - 64) % 36, tid, wave, lane); SIN_PUBLISH(1); __syncthreads(); } }
        pg8::gemm_phase<pg8::EpiInB, pg8::SchedInB, true, true>(lds, 2048, S, E);
        if (G != 256) { int nb = 0; for (int blk = c; blk < 144; blk += G) { s_in_b_block(P, lds, blk / 36, blk % 36, tid, wave, lane); ++nb; } if (nb) SIN_PUBLISH(nb); }
#undef SIN_PUBLISH
    }

    if (IN(7)) {
#pragma unroll 1
        for (int t = c; t < 512; t += G) {
            if (t >= 256 && t < 320) continue;
            int t2 = threadIdx.x; asm volatile("" : "+v"(t2));
            const int w2 = __builtin_amdgcn_readfirstlane(t2 >> 6), l2 = t2 & 63;
            if (t >= 384) { attn_sample_unit(P, lds, t - 384, t2, w2, l2); continue; }
            int b, qb, kvh, qs0 = 0, qs1 = 8;
            if (t < 64) { const int l = t >> 1; b = l >> 3; qb = 14 + ((l >> 2) & 1); kvh = l & 3; qs0 = 4 * (t & 1); qs1 = qs0 + 4; }
            else { int e = t - 64; if (t >= 320) { e = 192 + ((t - 320) >> 1); qs0 = 4 * (t & 1); qs1 = qs0 + 4; } b = e / 56; qb = (e - 56 * b) >> 2; kvh = e & 3; }
            attn_prompt_unit(P, lds, b, qb, kvh, qs0, qs1, t2, w2, l2);
        }
        SEAM(7);
    }

    f32x4 sacc[2][2];
    const bool ovl9 = G == 256 && IN(8) && IN(9);
    if (IN(8)) {
        pg8::SchedOut S{G, c, (const char*)(P.ws + WS_BUFA), (const char*)(P.ws + WS_WOB)};
        if (G == 256) {
            auto mid = [&]() { if (ovl9) { int t2 = threadIdx.x; asm volatile("" : "+v"(t2));
                                           s_out_b_partA(P, lds, c & 63, c >> 6, sacc, t2, __builtin_amdgcn_readfirstlane(t2 >> 6), t2 & 63); } };
            pg8::EpiOutF<decltype(mid)> E{(const pg8::bf16_t*)(P.ws + WS_SR), P.out + OUT_Y, P.g_final, (float*)(P.ws + WS_SSQ1), (unsigned*)(ctl + CW_P8), (LAS float*)(lds + TAB_OFF), mid};
            pg8::gemm_phase<pg8::EpiOutF<decltype(mid)>, pg8::SchedOut, true, true>(lds, 2048, S, E);
        } else {
            pg8::EpiOutB E{(const pg8::bf16_t*)(P.ws + WS_SR), (pg8::bf16_t*)(P.ws + WS_QZ)};
            pg8::gemm_phase<pg8::EpiOutB, pg8::SchedOut, true, true>(lds, 2048, S, E);
            SEAM(8);
        }
    }

    if (IN(9)) {
        const int NS = G == 256 ? 0 : (G >= 128 ? 64 : 0);
        const bool fuse10 = G == 256 && IN(10);
        if (ovl9) { if ((c >> 6) == 0) s_out_b_partB(P, lds, c & 63, sacc, fuse10, tid, wave, lane); }
        else if (G == 256) s_out_b_quarter(P, lds, c & 63, c >> 6, fuse10, tid, wave, lane);
        else if (c < NS) { for (int blk = c; blk < 64; blk += NS) s_out_block<false>(P, lds, (const bf16*)(P.ws + WS_BUFA) + (size_t)MPR * DM, (const bf16*)(P.ws + WS_WOB), P.out + OUT_Y + (size_t)MPR * DM, blk >> 4, blk & 15, tid, wave, lane); }
        else { if (NS == 0) for (int blk = c; blk < 64; blk += G) s_out_block<false>(P, lds, (const bf16*)(P.ws + WS_BUFA) + (size_t)MPR * DM, (const bf16*)(P.ws + WS_WOB), P.out + OUT_Y + (size_t)MPR * DM, blk >> 4, blk & 15, tid, wave, lane);
            if (G != 256) final_rows_b16((const bf16*)(P.ws + WS_QZ), P.out + OUT_Y, P.g_final, lane, (c - NS) * NWAVES + wave, (G - NS) * NWAVES, MPR); }
        if (!fuse10) SEAM(9);
    }

    if (IN(10) && !(IN(9) && G == 256)) { for (int m = MPR + gw; m < MT; m += NGW) final_row(P.out + OUT_Y + (size_t)m * DM, P.g_final, lane, P.out + OUT_Y + (size_t)m * DM); }
#undef IN
#undef SEAM
}

extern "C" void kernel_launch(void* const* d_in, const int* in_sizes, int n_in, void* d_out, int out_size, void* d_ws, size_t ws_size, hipStream_t stream) {
    static int grid = 0;
    if (grid == 0) {
        if (n_in != 18 || (size_t)out_size != OUT_TOTAL || ws_size < WS_END) { fprintf(stderr, "kernel_launch: unexpected shapes (n_in %d, out %d, ws %zu); nothing launched\n", n_in, out_size, ws_size); grid = -1; return; }
        int dev = 0, cus = 0, per_cu = 0;
        if (hipGetDevice(&dev) != hipSuccess || hipDeviceGetAttribute(&cus, hipDeviceAttributeMultiprocessorCount, dev) != hipSuccess) { grid = -1; return; }
        if (hipFuncSetAttribute((const void*)yoco_fwd, hipFuncAttributeMaxDynamicSharedMemorySize, LDS_BYTES) != hipSuccess) { fprintf(stderr, "kernel_launch: hipFuncSetAttribute failed\n"); grid = -1; return; }
        if (hipOccupancyMaxActiveBlocksPerMultiprocessor(&per_cu, (const void*)yoco_fwd, NWAVES * 64, LDS_BYTES) != hipSuccess || per_cu < 1)
            fprintf(stderr, "kernel_launch: note: occupancy query reports %d workgroups per CU\n", per_cu);
        (void)hipGetLastError();
        grid = cus;
    }
    if (grid < 0) return;
    (void)hipMemsetAsync((char*)d_ws + WS_CTL, 0, CTL_ZERO_BYTES, stream);
    Args a{};
    const float** pp = (const float**)&a.p;
    for (int i = 0; i < 18; ++i) pp[i] = (const float*)d_in[i];
    a.p.out = (float*)d_out; a.p.ws = (unsigned char*)d_ws;
    for (int li = 0; li < N_LAUNCHES; ++li) {
        a.ph_lo = (N_LAUNCHES == 1) ? 0 : li; a.ph_hi = (N_LAUNCHES == 1) ? N_PHASES : li + 1;
        hipLaunchKernelGGL(yoco_fwd, dim3(grid), dim3(NWAVES * 64), LDS_BYTES, stream, a);
    }
}
```
